# Optimizing an MI355X kernel written in HIP

```python
import math
import jax, jax.numpy as jnp
from jax import lax
import numpy as np

D_MODEL = 1024
BATCH = 4
SEQ = 8192
DEPTH = 2

MLSTM_HEADS = 4
MLSTM_WIDTH = D_MODEL
MLSTM_HEAD_DIM = MLSTM_WIDTH // MLSTM_HEADS
MLSTM_CHUNK = 64
CONV_WIDTH = 4
ATTN_PATTERNS = ((128, 1), (512, 4), (2048, 16))
ATTN_GROUP_HEADS = 4
ATTN_HEAD_DIM = 128
ATTN_HEADS = ATTN_GROUP_HEADS * len(ATTN_PATTERNS)
ATTN_WIDTH = ATTN_HEADS * ATTN_HEAD_DIM
ATTN_OUT_WIDTH = ATTN_GROUP_HEADS * ATTN_HEAD_DIM
ATTN_BLOCK = 128
ALIBI_MAX_BIAS = 8.0
N_EXPERTS = 16
N_EXPERT_GROUPS = 4
EXPERTS_PER_GROUP = N_EXPERTS // N_EXPERT_GROUPS
TOP_K = 2
D_FF_EXPERT = 512
IN_SPLITS = (MLSTM_WIDTH, MLSTM_WIDTH, MLSTM_WIDTH, MLSTM_WIDTH, 2 * MLSTM_HEADS,
             ATTN_WIDTH, ATTN_WIDTH, ATTN_WIDTH, D_MODEL, D_MODEL)
IN_COLS = sum(IN_SPLITS)
EPS = 1e-6

kernel_name = "hybrid_mlstm_dilated_alibi_moe_block"


def rms_norm(x, g):
    xf = x.astype(jnp.float32)
    y = xf * lax.rsqrt(jnp.mean(xf * xf, axis=-1, keepdims=True) + EPS)
    return (y * g.astype(jnp.float32)).astype(x.dtype)


def modulate(h, shift, scale):
    return h * (1.0 + scale[:, None, :]) + shift[:, None, :]


def causal_depthwise_conv(x, w):
    k_w, ch = w.shape
    return lax.conv_general_dilated(
        x, w[:, None, :].astype(x.dtype), window_strides=(1,), padding=[(k_w - 1, 0)],
        dimension_numbers=("NWC", "WIO", "NWC"), feature_group_count=ch)


def mlstm_chunkwise(q, k, v, i_pre, f_pre):
    B, S, H, Dh = q.shape
    L = MLSTM_CHUNK
    NC = S // L
    f32 = jnp.float32

    def to_chunks(t):
        return t.astype(f32).reshape(B, NC, L, H, Dh).transpose(1, 0, 3, 2, 4)

    def gates_to_chunks(t):
        return t.astype(f32).reshape(B, NC, L, H).transpose(1, 0, 3, 2)

    qc = to_chunks(q) * (Dh ** -0.5)
    kc = to_chunks(k)
    vc = to_chunks(v)
    lic = gates_to_chunks(i_pre)
    lfc = jax.nn.log_sigmoid(gates_to_chunks(f_pre))
    causal = jnp.tril(jnp.ones((L, L), dtype=bool))

    def step(carry, inp):
        C, n, m = carry
        qb, kb, vb, li, lf = inp
        b = jnp.cumsum(lf, axis=-1)
        dmat = jnp.where(causal, b[..., :, None] - b[..., None, :] + li[..., None, :], -jnp.inf)
        inter = b + m[..., None]
        m_t = jnp.maximum(inter, jnp.max(dmat, axis=-1))
        w = jnp.exp(dmat - m_t[..., None])
        a_inter = jnp.exp(inter - m_t)
        s = jnp.einsum("bhtd,bhsd->bhts", qb, kb) * w
        num = jnp.einsum("bhts,bhsd->bhtd", s, vb) + a_inter[..., None] * jnp.einsum("bhtd,bhde->bhte", qb, C)
        den = jnp.sum(s, axis=-1) + a_inter * jnp.einsum("bhtd,bhd->bht", qb, n)
        h = num / jnp.maximum(jnp.abs(den), jnp.exp(-m_t))[..., None]
        b_last = b[..., -1]
        g = b_last[..., None] - b + li
        m_new = jnp.maximum(b_last + m, jnp.max(g, axis=-1))
        ws = jnp.exp(g - m_new[..., None])
        decay = jnp.exp(b_last + m - m_new)
        kw = kb * ws[..., None]
        C_new = decay[..., None, None] * C + jnp.einsum("bhsd,bhse->bhde", kw, vb)
        n_new = decay[..., None] * n + jnp.sum(kw, axis=2)
        return (C_new, n_new, m_new), h

    init = (jnp.zeros((B, H, Dh, Dh), f32), jnp.zeros((B, H, Dh), f32), jnp.zeros((B, H), f32))
    _, h = lax.scan(step, init, (qc, kc, vc, lic, lfc))
    return h.transpose(1, 0, 3, 2, 4).reshape(B, S, H, Dh)


def dilated_window_attention(q, k, v, window, dilation, slopes):
    B, S, H, Dh = q.shape
    d = dilation
    n_back = window // d
    Lsub = S // d
    blk = ATTN_BLOCK
    nb = -(-Lsub // blk)
    Lp = nb * blk
    f32 = jnp.float32

    def to_blocks(t):
        t = t.astype(f32).reshape(B, Lsub, d, H, Dh)
        t = jnp.pad(t, ((0, 0), (0, Lp - Lsub), (0, 0), (0, 0), (0, 0)))
        return t.reshape(B, nb, blk, d, H, Dh)

    qb = to_blocks(q)
    kb = to_blocks(k)
    vb = to_blocks(v)
    pad_prev = ((0, 0), (1, 0), (0, 0), (0, 0), (0, 0), (0, 0))
    kk = jnp.concatenate([jnp.pad(kb, pad_prev)[:, :-1], kb], axis=2)
    vv = jnp.concatenate([jnp.pad(vb, pad_prev)[:, :-1], vb], axis=2)
    scores = jnp.einsum("bnqrhd,bnkrhd->bnrhqk", qb, kk) * (Dh ** -0.5)

    qi = jnp.arange(blk)[:, None]
    kj = jnp.arange(2 * blk)[None, :]
    dist = blk + qi - kj
    key_pos = jnp.arange(nb)[:, None] * blk - blk + jnp.arange(2 * blk)[None, :]
    valid = ((dist >= 0) & (dist <= n_back))[None] & (key_pos >= 0)[:, None, :]
    valid = valid[:, None, None]
    alibi = -slopes.astype(f32)[:, None, None] * (dist * d).astype(f32)[None]
    scores = jnp.where(valid, scores + alibi, -jnp.inf)
    lse = jax.nn.logsumexp(scores, axis=-1)
    p = jnp.exp(scores - lse[..., None])
    out = jnp.einsum("bnrhqk,bnkrhd->bnqrhd", p, vv)
    out = out.reshape(B, Lp, d, H, Dh)[:, :Lsub].reshape(B, S, H, Dh)
    lse = lse.transpose(0, 1, 4, 2, 3).reshape(B, Lp, d, H)[:, :Lsub].reshape(B, S, H)
    return out, lse


def mixer(u, w_in, conv_w, gate_b, norm_g, w_branch_m, w_branch_a, w_out):
    B, S, _ = u.shape
    proj = u @ w_in
    idx = [int(i) for i in np.cumsum(IN_SPLITS)[:-1]]
    q_m, k_m, v_m, o_m, if_m, q_a, k_a, v_a, g_m, g_a = jnp.split(proj, idx, axis=-1)

    qk = jax.nn.silu(causal_depthwise_conv(jnp.concatenate([q_m, k_m], axis=-1), conv_w))
    q_m, k_m = jnp.split(qk, 2, axis=-1)
    heads = lambda t: t.reshape(B, S, MLSTM_HEADS, MLSTM_HEAD_DIM)
    if_m = if_m + gate_b
    i_pre, f_pre = if_m[..., :MLSTM_HEADS], if_m[..., MLSTM_HEADS:]
    hm = mlstm_chunkwise(heads(q_m), heads(k_m), heads(v_m), i_pre, f_pre)
    hm = hm * lax.rsqrt(jnp.mean(hm * hm, axis=-1, keepdims=True) + EPS)
    hm = hm.reshape(B, S, MLSTM_WIDTH) * norm_g.astype(jnp.float32)
    h_m = (jax.nn.sigmoid(o_m.astype(jnp.float32)) * hm).astype(u.dtype)

    ahead = lambda t: t.reshape(B, S, ATTN_HEADS, ATTN_HEAD_DIM)
    q_a, k_a, v_a = ahead(q_a), ahead(k_a), ahead(v_a)
    slopes = 2.0 ** (-ALIBI_MAX_BIAS * jnp.arange(1, ATTN_HEADS + 1, dtype=jnp.float32) / ATTN_HEADS)
    outs, lses = [], []
    for gi, (win, dil) in enumerate(ATTN_PATTERNS):
        hs = slice(gi * ATTN_GROUP_HEADS, (gi + 1) * ATTN_GROUP_HEADS)
        o_g, l_g = dilated_window_attention(q_a[:, :, hs], k_a[:, :, hs], v_a[:, :, hs], win, dil, slopes[hs])
        outs.append(o_g)
        lses.append(l_g)
    alpha = jax.nn.softmax(jnp.stack(lses, axis=0), axis=0)
    h_a = jnp.einsum("gbsh,gbshd->bshd", alpha, jnp.stack(outs, axis=0))
    h_a = h_a.reshape(B, S, ATTN_OUT_WIDTH).astype(u.dtype)

    y = jax.nn.sigmoid(g_m) * (h_m @ w_branch_m) + jax.nn.sigmoid(g_a) * (h_a @ w_branch_a)
    return y @ w_out


def moe(u, router_w, router_b, w_gate, w_up, w_down):
    B, S, D = u.shape
    xt = u.reshape(B * S, D)
    scores = jax.nn.sigmoid(xt.astype(jnp.float32) @ router_w.astype(jnp.float32))
    sel = scores + router_b.astype(jnp.float32)
    grp = sel.reshape(-1, N_EXPERT_GROUPS, EXPERTS_PER_GROUP)
    group_score = jnp.sum(lax.top_k(grp, TOP_K)[0], axis=-1)
    best_group = jnp.argmax(group_score, axis=-1)
    in_group = jnp.repeat(jax.nn.one_hot(best_group, N_EXPERT_GROUPS, dtype=jnp.float32) > 0,
                          EXPERTS_PER_GROUP, axis=-1)
    _, top_idx = lax.top_k(jnp.where(in_group, sel, -jnp.inf), TOP_K)
    top_s = jnp.take_along_axis(scores, top_idx, axis=-1)
    weights = top_s / jnp.sum(top_s, axis=-1, keepdims=True)
    combine = jnp.sum(jax.nn.one_hot(top_idx, N_EXPERTS, dtype=jnp.float32) * weights[..., None], axis=1)
    combine = combine.astype(u.dtype)
    out = jnp.zeros_like(xt)
    for e in range(N_EXPERTS):
        he = jax.nn.silu(xt @ w_gate[e]) * (xt @ w_up[e])
        out = out + combine[:, e:e + 1] * (he @ w_down[e])
    return out.reshape(B, S, D)


def setup_inputs(seed: int = 0) -> dict:
    key = jax.random.key(seed)
    ks = jax.random.split(key, 24)
    nrm = lambda k, shape, s: jax.random.normal(k, shape, jnp.float32) * s
    D, H = D_MODEL, MLSTM_HEADS
    i_b = nrm(ks[5], (DEPTH, H), 0.1)
    f_b = jnp.linspace(3.0, 6.0, H, dtype=jnp.float32)[None, :] + nrm(ks[6], (DEPTH, H), 0.1)
    return {
        "x": nrm(ks[0], (BATCH, SEQ, D), 1.0),
        "c": nrm(ks[1], (BATCH, D), 1.0),
        "ada_w": nrm(ks[2], (DEPTH, D, 6 * D), 0.5 * D ** -0.5),
        "ada_b": nrm(ks[3], (DEPTH, 6 * D), 0.02),
        "w_in": nrm(ks[4], (DEPTH, D, IN_COLS), D ** -0.5),
        "mlstm_conv": nrm(ks[7], (DEPTH, CONV_WIDTH, 2 * MLSTM_WIDTH), CONV_WIDTH ** -0.5),
        "mlstm_gate_b": jnp.concatenate([i_b, f_b], axis=-1),
        "mlstm_norm_g": 1.0 + nrm(ks[8], (DEPTH, MLSTM_WIDTH), 0.02),
        "w_branch_m": nrm(ks[9], (DEPTH, MLSTM_WIDTH, D), MLSTM_WIDTH ** -0.5),
        "w_branch_a": nrm(ks[10], (DEPTH, ATTN_OUT_WIDTH, D), ATTN_OUT_WIDTH ** -0.5),
        "w_out": nrm(ks[11], (DEPTH, D, D), D ** -0.5),
        "router_w": nrm(ks[12], (D, N_EXPERTS), D ** -0.5),
        "router_b": nrm(ks[13], (N_EXPERTS,), 0.01),
        "w_gate_e": nrm(ks[14], (DEPTH, N_EXPERTS, D, D_FF_EXPERT), D ** -0.5),
        "w_up_e": nrm(ks[15], (DEPTH, N_EXPERTS, D, D_FF_EXPERT), D ** -0.5),
        "w_down_e": nrm(ks[16], (DEPTH, N_EXPERTS, D_FF_EXPERT, D), D_FF_EXPERT ** -0.5),
        "norm_mix_g": 1.0 + nrm(ks[17], (DEPTH, D), 0.02),
        "norm_ffn_g": 1.0 + nrm(ks[18], (DEPTH, D), 0.02),
        "final_norm_g": 1.0 + nrm(ks[19], (D,), 0.02),
    }


def reference(x, c, ada_w, ada_b, w_in, mlstm_conv, mlstm_gate_b, mlstm_norm_g, w_branch_m,
              w_branch_a, w_out, router_w, router_b, w_gate_e, w_up_e, w_down_e,
              norm_mix_g, norm_ffn_g, final_norm_g):
    c_act = jax.nn.silu(c)
    for l in range(DEPTH):
        mod = c_act @ ada_w[l] + ada_b[l]
        sh_a, sc_a, gt_a, sh_f, sc_f, gt_f = jnp.split(mod, 6, axis=-1)
        u = modulate(rms_norm(x, norm_mix_g[l]), sh_a, sc_a)
        x = x + gt_a[:, None, :] * mixer(u, w_in[l], mlstm_conv[l], mlstm_gate_b[l], mlstm_norm_g[l],
                                         w_branch_m[l], w_branch_a[l], w_out[l])
        u = modulate(rms_norm(x, norm_ffn_g[l]), sh_f, sc_f)
        x = x + gt_f[:, None, :] * moe(u, router_w, router_b, w_gate_e[l], w_up_e[l], w_down_e[l])
    return rms_norm(x, final_norm_g)
```

```cpp
#define MK_ONE_LAUNCH 0
#include <hip/hip_runtime.h>
#include <cstdio>
#include <cstdint>

#define DI __device__ __forceinline__
#define LAS __attribute__((address_space(3)))
typedef unsigned short bf16_t;
typedef short bf16x8 __attribute__((ext_vector_type(8)));
typedef float f32x2 __attribute__((ext_vector_type(2)));
typedef float f32x4 __attribute__((ext_vector_type(4)));
typedef float f32x16 __attribute__((ext_vector_type(16)));
typedef unsigned u32x2 __attribute__((ext_vector_type(2)));
typedef unsigned u32x4 __attribute__((ext_vector_type(4)));
typedef __bf16 nbf16x2 __attribute__((ext_vector_type(2)));

constexpr int T_TOK = 32768, SEQ = 8192, DM = 1024, NBATCH = 4, DEPTH = 2;
constexpr int TQ = 8192;
constexpr int TP = 16384;
constexpr int INC = 10760;
constexpr int NNAT = 6144;
constexpr int NVT = 2560;
constexpr int NEXP = 16, DFF = 512;
constexpr int SLOT_ROWS = 69632;
constexpr float EPS = 1e-6f;

constexpr size_t al256(size_t x) { return (x + 255) & ~(size_t)255; }
constexpr size_t WS_CTL = 0;
constexpr size_t CTL_BYTES = 65536;
constexpr size_t WS_MOD = WS_CTL + CTL_BYTES;
constexpr size_t WS_WIF = WS_MOD + al256((size_t)2 * 4 * 6144 * 4);
constexpr size_t WS_RW = WS_WIF + (size_t)2 * 8 * 1024 * 4;
constexpr size_t WS_W = WS_RW + (size_t)16 * 1024 * 4;
constexpr size_t W_NAT = 0;
constexpr size_t W_VT = W_NAT + (size_t)NNAT * 1024 * 2;
constexpr size_t W_G = W_VT + (size_t)NVT * 1024 * 2;
constexpr size_t W_M = W_G + (size_t)2048 * 1024 * 2;
constexpr size_t W_A = W_M + (size_t)1024 * 1024 * 2;
constexpr size_t W_O = W_A + (size_t)1024 * 512 * 2;
constexpr size_t W_13 = W_O + (size_t)1024 * 1024 * 2;
constexpr size_t W_2 = W_13 + (size_t)16 * 1024 * 1024 * 2;
constexpr size_t W_BYTES = W_2 + (size_t)16 * 1024 * 512 * 2;
constexpr size_t WS_U = WS_W + W_BYTES;
constexpr size_t WS_GIF = WS_U + (size_t)T_TOK * 1024 * 2;
constexpr size_t WS_HM = WS_GIF + (size_t)T_TOK * 8 * 4;
constexpr size_t WS_HA = WS_HM + (size_t)TP * 1024 * 2;
constexpr size_t WS_TOKI = WS_HA + (size_t)TP * 512 * 2;
constexpr size_t WS_R0 = WS_TOKI + (size_t)2 * T_TOK * 32;
constexpr size_t R_P = 0;
constexpr size_t R_VT = R_P + (size_t)TQ * NNAT * 2;
constexpr size_t R_QC = R_VT + (size_t)NVT * TQ * 2;
constexpr size_t R_KC = R_QC + (size_t)TQ * 1024 * 2;
constexpr size_t R_KCT = R_KC + (size_t)TQ * 1024 * 2;
constexpr size_t R_NUM = R_KCT + (size_t)TQ * 1024 * 2;
constexpr size_t R_SLOC = R_NUM + (size_t)TQ * 1024 * 4;
constexpr size_t R_CST = R_SLOC + (size_t)4 * 32 * 65536 * 4;
constexpr size_t R_DENI = R_CST + (size_t)4 * 32 * 65536 * 2;
constexpr size_t R_EBC = R_DENI + (size_t)TQ * 4 * 4;
constexpr size_t R_EBL = R_EBC + (size_t)TQ * 4 * 4;
constexpr size_t R_SCB = R_EBL + (size_t)TQ * 4 * 4;
constexpr size_t R_CHB = R_SCB + 1024;
constexpr size_t R_DN = R_CHB + 2048;
constexpr size_t R_NST = R_DN + (size_t)4 * 128 * 256 * 4;
constexpr size_t R_LSE = R_NST + (size_t)4 * 128 * 256 * 4;
constexpr size_t R_END = R_LSE + (size_t)TQ * 12 * 4;
constexpr size_t R_GT = 0;
constexpr size_t R_HH = 0;
constexpr size_t R_YS = R_HH + (size_t)SLOT_ROWS * 512 * 2;
constexpr size_t R_SLOT = R_YS + (size_t)SLOT_ROWS * 1024 * 2;
constexpr size_t R_END2 = R_SLOT + (size_t)16 * 32768 * 4;
constexpr size_t WS_END = WS_R0 + (R_END > R_END2 ? R_END : R_END2);
static_assert(WS_END <= (size_t)536870912, "workspace over 512 MiB");

constexpr int CW_BAR = 0;
constexpr int CW_CNT = 4096;

DI float bflo(unsigned w) { return __uint_as_float(w << 16); }
DI float bfhi(unsigned w) { return __uint_as_float(w & 0xffff0000u); }
DI unsigned pack2(float lo, float hi) { f32x2 v = {lo, hi}; nbf16x2 b = __builtin_convertvector(v, nbf16x2); return __builtin_bit_cast(unsigned, b); }
DI float sigmoidf_(float x) { return __builtin_amdgcn_rcpf(1.0f + __expf(-x)); }
DI float siluf_(float x) { return x * sigmoidf_(x); }
DI float wave_sum(float v) { for (int o = 32; o >= 1; o >>= 1) v += __shfl_xor(v, o); return v; }
DI int crow(int reg, int h) { return (reg & 3) + 8 * (reg >> 2) + 4 * h; }
DI int pi23(int m) { return (m & ~12) | ((m & 4) << 1) | ((m & 8) >> 1); }
#define MFMA32(a, b, c) __builtin_amdgcn_mfma_f32_32x32x16_bf16((a), (b), (c), 0, 0, 0)
DI bf16x8 packf8(float a0, float a1, float a2, float a3, float a4, float a5, float a6, float a7) {
    u32x4 p; p.x = pack2(a0, a1); p.y = pack2(a2, a3); p.z = pack2(a4, a5); p.w = pack2(a6, a7); return __builtin_bit_cast(bf16x8, p); }
DI bf16x8 ldg8(const bf16_t* p) { return *(const bf16x8*)p; }
#define XB_TMO      128
#define XB_XCNT(j)  (256  + 64 * (j))
#define XB_XSUB(j)  (1280 + 64 * (j))
#define XB_XGEN(j)  (2304 + 64 * (j))
#define XB_TOP      3328
#define XB_TOPGEN   3392
#define XCD_BAR_WORDS 3456
#define XB_SPIN_CAP (1u << 21)

__device__ __forceinline__ unsigned xb_ld(unsigned* p)              { return __hip_atomic_load(p, __ATOMIC_RELAXED, __HIP_MEMORY_SCOPE_AGENT); }
__device__ __forceinline__ unsigned xb_add(unsigned* p, unsigned v) { return __hip_atomic_fetch_add(p, v, __ATOMIC_RELAXED, __HIP_MEMORY_SCOPE_AGENT); }
__device__ __forceinline__ unsigned xb_xcc_id() { return (unsigned)__builtin_amdgcn_s_getreg((3 << 11) | 20) & 0xFu; }
#define XB_SPIN(cond, bar) do { unsigned _sp = 0; while (cond) { __builtin_amdgcn_s_sleep(1); \
    if ((++_sp & 255u) == 0u) { if (xb_ld(&(bar)[XB_TMO])) break; if (_sp > XB_SPIN_CAP) { atomicAdd(&(bar)[XB_TMO], 1u); break; } } } } while (0)

struct XcdBarrier {
    unsigned* bar; unsigned x;
    volatile LAS unsigned* st;
};

__device__ __forceinline__ XcdBarrier xcd_barrier_post(unsigned* bar, volatile LAS unsigned* st) {
    XcdBarrier b; b.bar = bar; b.x = xb_xcc_id(); b.st = st;
    if (threadIdx.x == 0) (void)xb_add(&bar[XB_XCNT(b.x)], 1u);
    return b;
}
__device__ __forceinline__ void xcd_barrier_complete(unsigned* bar, unsigned x, unsigned& nloc, unsigned& nx) {
    const unsigned G = gridDim.x * gridDim.y * gridDim.z;
    unsigned sum, cnt, mine, sp = 0u;
    for (;;) {
        sum = 0u; cnt = 0u; mine = 0u;
#pragma unroll
        for (unsigned j = 0; j < 16; ++j) { const unsigned c = xb_ld(&bar[XB_XCNT(j)]); sum += c; cnt += (c > 0u) ? 1u : 0u; mine = (j == x) ? c : mine; }
        if (sum == G) break;
        __builtin_amdgcn_s_sleep(1);
        if ((++sp & 255u) == 0u) { if (xb_ld(&bar[XB_TMO])) break; if (sp > XB_SPIN_CAP) { atomicAdd(&bar[XB_TMO], 1u); break; } }
    }
    nloc = mine > 0u ? mine : 1u; nx = cnt > 0u ? cnt : 1u;
}

__device__ __forceinline__ void xcd_barrier(const XcdBarrier& b) {
    asm volatile("s_waitcnt vmcnt(0)" ::: "memory");
    __syncthreads();
    if (threadIdx.x == 0) {
        unsigned* bar = b.bar;
        __builtin_amdgcn_s_waitcnt(0);
        unsigned nloc = b.st[0], nx = b.st[1];
        if (nloc == 0u) { xcd_barrier_complete(bar, b.x, nloc, nx); b.st[0] = nloc; b.st[1] = nx; }
        const unsigned old = xb_add(&bar[XB_XSUB(b.x)], 1u);
        const unsigned gen = old / nloc;
        if (old + 1u == (gen + 1u) * nloc) {
            __builtin_amdgcn_fence(__ATOMIC_RELEASE, "agent");
            asm volatile("s_waitcnt vmcnt(0)" ::: "memory");
            const unsigned og = xb_add(&bar[XB_TOP], 1u);
            const unsigned tg = og / nx;
            if (og + 1u == (tg + 1u) * nx) xb_add(&bar[XB_TOPGEN], 1u);
            else XB_SPIN(xb_ld(&bar[XB_TOPGEN]) == tg, bar);
            __builtin_amdgcn_fence(__ATOMIC_ACQUIRE, "agent");
            xb_add(&bar[XB_XGEN(b.x)], 1u);
            asm volatile("s_waitcnt vmcnt(0)" ::: "memory");
        } else {
            XB_SPIN(xb_ld(&bar[XB_XGEN(b.x)]) == gen, bar);
            __builtin_amdgcn_fence(__ATOMIC_ACQUIRE, "agent");
            asm volatile("s_waitcnt vmcnt(0)" ::: "memory");
        }
    }
    __syncthreads();
}
namespace pg8 {
constexpr int BM = 256, BK = 64, HALF = 128, HTB = HALF * BK * 2, STAGE_BYTES = 8 * HTB, NXCD = 8, WGM = 8;
DI int lds_byte(int r, int c) { const int st = (r >> 4) * 2 + (c >> 5), rr = r & 15, cc = c & 31, ob = rr * 64 + cc * 2; return st * 1024 + (ob ^ (((ob >> 9) & 1) << 5)); }
DI void stage_rc(int b, int& R, int& C) { const int st = b / 1024, sb = b % 1024, swz = sb ^ (((sb >> 9) & 1) << 5); R = (st >> 1) * 16 + swz / 64; C = (st & 1) * 32 + (swz % 64) / 2; }
DI int perm32(int rho) { const int n = rho >> 4, i = rho & 15; return 8 * (i >> 2) + 4 * n + (i & 3); }

struct UnitD {
    const char* A; const char* B;
    unsigned lda, ldb;
    const int* arows; int acount;
    int kind, pm, pn, aux;
};
DI void tile_map(int L, int nM, int nN, int& pm, int& pn) {
    const int nwg = nM * nN; int wgid = L;
    { const int q = nwg / NXCD, r = nwg % NXCD, xcd = wgid % NXCD, off = wgid / NXCD; wgid = (xcd < r ? xcd * (q + 1) : r * (q + 1) + (xcd - r) * q) + off; }
    const int nig = WGM * nN, gid = wgid / nig, fm = gid * WGM, gsz = (nM - fm) < WGM ? (nM - fm) : WGM;
    pm = fm + ((wgid % nig) % gsz); pn = (wgid % nig) / gsz;
}
template <bool PERM, bool GATHER>
DI void unit_off(const UnitD& u, int tid, unsigned (&offA)[2][2], unsigned (&offB)[2]) {
#pragma unroll
    for (int i = 0; i < 2; ++i) {
        int R, C; stage_rc(tid * 16 + i * 8192, R, C);
        const int Rb = PERM ? ((R & ~31) + perm32(R & 31)) : R;
        offB[i] = (unsigned)Rb * u.ldb + (unsigned)C * 2u;
        if (GATHER) {
#pragma unroll
            for (int h = 0; h < 2; ++h) { const int ra = h * HALF + R; const int rr = ra < u.acount ? ra : 0; offA[h][i] = (unsigned)u.arows[rr] * u.lda + (unsigned)C * 2u; }
        } else { offA[0][i] = (unsigned)R * u.lda + (unsigned)C * 2u; offA[1][i] = 0u; }
    }
}

template <class Epi, class Sched, bool GATHER = false>
DI void gemm_run(LAS unsigned char* lds, const int K, const Sched& S, const Epi& E) {
    int tid_ = threadIdx.x; asm volatile("" : "+v"(tid_));
    const int tid = tid_, wid = __builtin_amdgcn_readfirstlane(tid >> 6), lane = tid & 63, wr = wid >> 2, wc = wid & 3, fr = lane & 15, fq = lane >> 4;
    const int nt = K / BK;
    const size_t kstep = (size_t)(BK * 2);
    const unsigned ldsw = (unsigned)wid * 1024u;
    const int aoff = lds_byte(wr * 64 + fr, fq * 8), boff = lds_byte(wc * 32 + fr, fq * 8);
#define PG8_SA(b, h) (((b) * 2 + (h)) * HTB)
#define PG8_SB(b, h) ((4 + (b) * 2 + (h)) * HTB)
#define PG8_STAGE(bufoff, gbase, voff) do { _Pragma("unroll") for (int _i = 0; _i < 2; ++_i) \
        __builtin_amdgcn_global_load_lds((const unsigned*)((const char*)(gbase) + (voff)[_i]), (LAS unsigned*)(lds + (bufoff) + ldsw + _i * 8192), 16, 0, 0); } while (0)
#define PG8_LDA(dst, b, h) do { _Pragma("unroll") for (int m = 0; m < 4; ++m) _Pragma("unroll") for (int k = 0; k < 2; ++k) dst[m][k] = *(const LAS bf16x8*)(lds + PG8_SA(b, h) + aoff + m * 2048 + k * 1024); } while (0)
#define PG8_LDB(dst, b, h) do { _Pragma("unroll") for (int n = 0; n < 2; ++n) _Pragma("unroll") for (int k = 0; k < 2; ++k) dst[n][k] = *(const LAS bf16x8*)(lds + PG8_SB(b, h) + boff + n * 2048 + k * 1024); } while (0)
#define PG8_MMA(ai, bj, At, Bt) do { __builtin_amdgcn_s_setprio(1); _Pragma("unroll") for (int m = 0; m < 4; ++m) _Pragma("unroll") for (int n = 0; n < 2; ++n) _Pragma("unroll") for (int k = 0; k < 2; ++k) \
        acc[ai][bj][m][n] = __builtin_amdgcn_mfma_f32_16x16x32_bf16(Bt[n][k], At[m][k], acc[ai][bj][m][n], 0, 0, 0); __builtin_amdgcn_s_setprio(0); } while (0)
#define PG8_WAIT_V(n) asm volatile("s_waitcnt vmcnt(" #n ")" ::: "memory")
#define PG8_WAIT_L(n) asm volatile("s_waitcnt lgkmcnt(" #n ")" ::: "memory")
#define PG8_BAR __builtin_amdgcn_s_barrier()
#define PG8_SCHED __builtin_amdgcn_sched_barrier(0)
    UnitD cur, nxt; int ui = 0;
    if (!S.next(0, cur)) return;
    unsigned offA[2][2], offB[2];
    unit_off<Epi::PERM, GATHER>(cur, tid, offA, offB);
    size_t hA = GATHER ? 0 : (size_t)HALF * cur.lda, hB = (size_t)HALF * cur.ldb;
#define OA(h) offA[GATHER ? (h) : 0]
    f32x4 acc[2][2][4][2];
#pragma unroll
    for (int a = 0; a < 2; ++a)
#pragma unroll
        for (int b = 0; b < 2; ++b)
#pragma unroll
            for (int m = 0; m < 4; ++m)
#pragma unroll
                for (int n = 0; n < 2; ++n) acc[a][b][m][n] = (f32x4){0.f, 0.f, 0.f, 0.f};
    bf16x8 At[4][2], B0[2][2], B1[2][2];
    PG8_STAGE(PG8_SB(0, 0), cur.B, offB); PG8_STAGE(PG8_SA(0, 0), cur.A, OA(0)); PG8_STAGE(PG8_SB(0, 1), cur.B + hB, offB); PG8_STAGE(PG8_SA(0, 1), cur.A + hA, OA(1));
    if (wr == 1) PG8_BAR;
    PG8_WAIT_V(4); PG8_BAR;
    PG8_STAGE(PG8_SB(1, 0), cur.B + kstep, offB); PG8_STAGE(PG8_SA(1, 0), cur.A + kstep, OA(0)); PG8_STAGE(PG8_SB(1, 1), cur.B + kstep + hB, offB);
    PG8_WAIT_V(6); PG8_BAR;
    for (;;) {
        const bool has_next = S.next(ui + 1, nxt);
        for (int t = 0; t < nt; t += 2) {
            const bool last = (t == nt - 2);
            const char* a1 = cur.A + (size_t)(t + 1) * kstep;
            PG8_LDB(B0, 0, 0); PG8_SCHED; PG8_LDA(At, 0, 0); PG8_STAGE(PG8_SA(1, 1), a1 + hA, OA(1));
            PG8_WAIT_L(8); PG8_BAR; PG8_WAIT_L(0); PG8_MMA(0, 0, At, B0); PG8_BAR; PG8_SCHED;
            const char* a2; const char* b2;
            if (last) { if (has_next) { unit_off<Epi::PERM, GATHER>(nxt, tid, offA, offB); a2 = nxt.A; b2 = nxt.B; hA = GATHER ? 0 : (size_t)HALF * nxt.lda; hB = (size_t)HALF * nxt.ldb; } else { a2 = cur.A; b2 = cur.B; } }
            else { a2 = cur.A + (size_t)(t + 2) * kstep; b2 = cur.B + (size_t)(t + 2) * kstep; }
            const char* a3 = a2 + kstep; const char* b3 = b2 + kstep;
            PG8_LDB(B1, 0, 1); PG8_STAGE(PG8_SB(0, 0), b2, offB);
            PG8_BAR; PG8_WAIT_L(0); PG8_MMA(0, 1, At, B1); PG8_BAR;
            PG8_LDA(At, 0, 1); PG8_STAGE(PG8_SA(0, 0), a2, OA(0));
            PG8_BAR; PG8_WAIT_L(0); PG8_MMA(1, 0, At, B0); PG8_BAR; PG8_SCHED;
            PG8_STAGE(PG8_SB(0, 1), b2 + hB, offB);
            PG8_WAIT_V(6); PG8_BAR; PG8_MMA(1, 1, At, B1); PG8_BAR;
            PG8_LDB(B0, 1, 0); PG8_SCHED; PG8_LDA(At, 1, 0); PG8_STAGE(PG8_SA(0, 1), a2 + hA, OA(1));
            PG8_WAIT_L(8); PG8_BAR; PG8_WAIT_L(0); PG8_MMA(0, 0, At, B0); PG8_BAR; PG8_SCHED;
            PG8_LDB(B1, 1, 1); PG8_STAGE(PG8_SB(1, 0), b3, offB);
            PG8_BAR; PG8_WAIT_L(0); PG8_MMA(0, 1, At, B1); PG8_BAR;
            PG8_LDA(At, 1, 1); PG8_STAGE(PG8_SA(1, 0), a3, OA(0));
            PG8_BAR; PG8_WAIT_L(0); PG8_MMA(1, 0, At, B0); PG8_BAR; PG8_SCHED;
            PG8_STAGE(PG8_SB(1, 1), b3 + hB, offB);
            PG8_WAIT_V(6); PG8_BAR; PG8_MMA(1, 1, At, B1); PG8_BAR;
        }
        { int fr_ = fr, fq_ = fq; asm volatile("" : "+v"(fr_), "+v"(fq_)); E(acc, cur, wr, wc, fr_, fq_); }
        if (!has_next) break;
#pragma unroll
        for (int a = 0; a < 2; ++a)
#pragma unroll
            for (int b = 0; b < 2; ++b)
#pragma unroll
                for (int m = 0; m < 4; ++m)
#pragma unroll
                    for (int n = 0; n < 2; ++n) acc[a][b][m][n] = (f32x4){0.f, 0.f, 0.f, 0.f};
        cur = nxt; ++ui;
    }
    PG8_WAIT_V(0);
    if (wr == 0) PG8_BAR;
    PG8_BAR;
#undef OA
#undef PG8_SA
#undef PG8_SB
#undef PG8_STAGE
#undef PG8_LDA
#undef PG8_LDB
#undef PG8_MMA
#undef PG8_WAIT_V
#undef PG8_WAIT_L
#undef PG8_BAR
#undef PG8_SCHED
}
}
struct Args { const float* in[19]; float* out; unsigned char* ws; int step_lo, step_hi; };
struct Frame {
    LAS unsigned char* lds; unsigned char* ldsg;
    int tid, lane, wave, G, bid;
    const float *x, *c, *ada_w, *ada_b, *w_in, *conv_w, *gate_b, *norm_g, *w_bm, *w_ba, *w_out, *router_w, *router_b, *w_gate, *w_up, *w_down, *g_mix, *g_ffn, *g_fin;
    float* out; unsigned char* ws; unsigned* ctl;
    float* MOD; float* WIF; float* RW; unsigned char* W;
    bf16_t* U; float* GIF; bf16_t* HM; bf16_t* HA; unsigned char* TOKI; unsigned char* R0;
};
#define CAS __attribute__((address_space(4)))
DI const void* karg(int idx) { asm volatile("" : "+s"(idx)); const void* const CAS* kp = (const void* const CAS*)__builtin_amdgcn_kernarg_segment_ptr(); return kp[idx]; }
DI void frame_init(Frame& F, unsigned char* lds_generic, int tid) {
    F.ldsg = lds_generic; F.lds = (LAS unsigned char*)lds_generic;
    F.tid = tid; F.lane = F.tid & 63; F.wave = __builtin_amdgcn_readfirstlane(F.tid >> 6); F.G = gridDim.x; F.bid = blockIdx.x;
    F.x = (const float*)karg(0); F.c = (const float*)karg(1); F.ada_w = (const float*)karg(2); F.ada_b = (const float*)karg(3); F.w_in = (const float*)karg(4); F.conv_w = (const float*)karg(5);
    F.gate_b = (const float*)karg(6); F.norm_g = (const float*)karg(7); F.w_bm = (const float*)karg(8); F.w_ba = (const float*)karg(9); F.w_out = (const float*)karg(10); F.router_w = (const float*)karg(11);
    F.router_b = (const float*)karg(12); F.w_gate = (const float*)karg(13); F.w_up = (const float*)karg(14); F.w_down = (const float*)karg(15); F.g_mix = (const float*)karg(16); F.g_ffn = (const float*)karg(17); F.g_fin = (const float*)karg(18);
    F.out = (float*)karg(19); unsigned char* ws = (unsigned char*)karg(20);
    F.ws = ws; F.ctl = (unsigned*)(ws + WS_CTL);
    F.MOD = (float*)(ws + WS_MOD); F.WIF = (float*)(ws + WS_WIF); F.RW = (float*)(ws + WS_RW); F.W = ws + WS_W;
    F.U = (bf16_t*)(ws + WS_U); F.GIF = (float*)(ws + WS_GIF); F.HM = (bf16_t*)(ws + WS_HM); F.HA = (bf16_t*)(ws + WS_HA);
    F.TOKI = ws + WS_TOKI; F.R0 = ws + WS_R0;
}

struct TJob { const float* src; int ld; int K; int N; bf16_t* dst; int rmul, radd; };
DI bool get_job(const Frame& F, int l, int j, TJob& J) {
    const float* win = F.w_in + (size_t)l * DM * INC;
    bf16_t* W = (bf16_t*)F.W;
    J.rmul = 1; J.radd = 0; J.K = 1024; J.ld = INC;
    if (j == 0) { J.src = win + 0;    J.N = 1024; J.dst = W + W_NAT / 2 + (size_t)0 * 1024; return true; }
    if (j == 1) { J.src = win + 1024; J.N = 1024; J.dst = W + W_NAT / 2 + (size_t)1024 * 1024; return true; }
    if (j == 2) { J.src = win + 3072; J.N = 1024; J.dst = W + W_NAT / 2 + (size_t)2048 * 1024; return true; }
    if (j == 3) { J.src = win + 4104; J.N = 1536; J.dst = W + W_NAT / 2 + (size_t)3072 * 1024; return true; }
    if (j == 4) { J.src = win + 5640; J.N = 1536; J.dst = W + W_NAT / 2 + (size_t)4608 * 1024; return true; }
    if (j == 5) { J.src = win + 2048; J.N = 1024; J.dst = W + W_VT / 2 + (size_t)0 * 1024; return true; }
    if (j == 6) { J.src = win + 7176; J.N = 1536; J.dst = W + W_VT / 2 + (size_t)1024 * 1024; return true; }
    if (j == 7) { J.src = win + 8712; J.N = 2048; J.dst = W + W_G / 2; return true; }
    if (j == 8) { J.src = F.w_bm + (size_t)l * 1024 * 1024; J.ld = 1024; J.N = 1024; J.dst = W + W_M / 2; return true; }
    if (j == 9) { J.src = F.w_ba + (size_t)l * 512 * 1024; J.ld = 1024; J.K = 512; J.N = 1024; J.dst = W + W_A / 2; return true; }
    if (j == 10) { J.src = F.w_out + (size_t)l * 1024 * 1024; J.ld = 1024; J.N = 1024; J.dst = W + W_O / 2; return true; }
    const int q = j - 11; if (q >= 48) return false;
    const int e = q / 3, which = q % 3;
    if (which == 0) { J.src = F.w_gate + ((size_t)l * 16 + e) * 1024 * 512; J.ld = 512; J.N = 512; J.dst = W + W_13 / 2 + (size_t)e * 1024 * 1024; J.rmul = 2; J.radd = 0; }
    else if (which == 1) { J.src = F.w_up + ((size_t)l * 16 + e) * 1024 * 512; J.ld = 512; J.N = 512; J.dst = W + W_13 / 2 + (size_t)e * 1024 * 1024; J.rmul = 2; J.radd = 1; }
    else { J.src = F.w_down + ((size_t)l * 16 + e) * 512 * 1024; J.ld = 1024; J.K = 512; J.N = 1024; J.dst = W + W_2 / 2 + (size_t)e * 1024 * 512; }
    return true;
}
constexpr int NJOBS = 59;
DI void tconv_tile(const Frame& F, const TJob& J, int tk, int tn) {
    bf16_t* tl = (bf16_t*)F.ldsg;
    const int tid = F.tid;
#pragma unroll
    for (int i = 0; i < 2; ++i) {
        const int row = (tid >> 4) + 32 * i, c4 = tid & 15;
        const f32x4 v = *(const f32x4*)(J.src + (size_t)(tk * 64 + row) * J.ld + tn * 64 + c4 * 4);
        const unsigned lo = pack2(v[0], v[1]), hi = pack2(v[2], v[3]);
        tl[(c4 * 4 + 0) * 72 + row] = (bf16_t)(lo & 0xffff); tl[(c4 * 4 + 1) * 72 + row] = (bf16_t)(lo >> 16);
        tl[(c4 * 4 + 2) * 72 + row] = (bf16_t)(hi & 0xffff); tl[(c4 * 4 + 3) * 72 + row] = (bf16_t)(hi >> 16);
    }
    __syncthreads();
    { const int n = tid >> 3, k8 = tid & 7;
      const u32x4 v = *(const u32x4*)(tl + n * 72 + k8 * 8);
      *(u32x4*)(J.dst + (size_t)(J.rmul * (tn * 64 + n) + J.radd) * J.K + tk * 64 + k8 * 8) = v; }
    __syncthreads();
}
DI void phase_pw(const Frame& F, int l, int b0, int nb) {
    const int me = F.bid - b0; if (me < 0 || me >= nb) return;
    int base = 0;
    for (int j = 0; j < NJOBS; ++j) {
        TJob J; get_job(F, l, j, J);
        const int nk = J.K / 64, nn = J.N / 64, ntile = nk * nn;
        int t = (me - base % nb + nb) % nb;
        for (; t < ntile; t += nb) tconv_tile(F, J, t % nk, t / nk);
        base += ntile;
    }
}
DI void phase_p0_small(const Frame& F) {
    float* sc = (float*)F.ldsg;
    float* part = sc + 4096;
    for (int i = F.tid; i < 4096; i += 512) sc[i] = siluf_(F.c[i]);
    __syncthreads();
    for (int it = F.bid; it < 192; it += F.G) {
        const int l = it / 96, cc = it % 96, col = cc * 64 + F.lane, w = F.wave;
        const float* aw = F.ada_w + (size_t)l * 1024 * 6144 + col;
        float a0 = 0.f, a1 = 0.f, a2 = 0.f, a3 = 0.f;
        for (int k = w * 128; k < w * 128 + 128; ++k) { const float wv = aw[(size_t)k * 6144]; a0 += sc[k] * wv; a1 += sc[1024 + k] * wv; a2 += sc[2048 + k] * wv; a3 += sc[3072 + k] * wv; }
        part[(w * 4 + 0) * 64 + F.lane] = a0; part[(w * 4 + 1) * 64 + F.lane] = a1; part[(w * 4 + 2) * 64 + F.lane] = a2; part[(w * 4 + 3) * 64 + F.lane] = a3;
        __syncthreads();
        if (F.tid < 256) { const int b = F.tid >> 6, ln = F.tid & 63; float s = 0.f;
            for (int ww = 0; ww < 8; ++ww) s += part[(ww * 4 + b) * 64 + ln];
            F.MOD[((size_t)l * 4 + b) * 6144 + cc * 64 + ln] = s + F.ada_b[(size_t)l * 6144 + cc * 64 + ln]; }
        __syncthreads();
    }
    for (int i = F.bid * 512 + F.tid; i < 2 * 8 * 1024 + 16 * 1024; i += F.G * 512) {
        if (i < 16384) { const int l = i >> 13, j = (i >> 10) & 7, k = i & 1023; F.WIF[i] = F.w_in[((size_t)l * 1024 + k) * INC + 4096 + j]; }
        else { const int q = i - 16384, e = q >> 10, k = q & 1023; F.RW[q] = F.router_w[k * 16 + e]; }
    }
}

DI void moe_offsets(const unsigned* cnt, int* pre, int tid) { if (tid == 0) { int s = 0; for (int e = 0; e < 16; ++e) { pre[e] = s; s += ((int)cnt[e] + 255) >> 8; } pre[16] = s; } }

struct RowCtx { float gm[16], sh[16]; };
DI void load_rowconst(const Frame& F, const float* g, const float* shv, const float* scv, RowCtx& rc) {
#pragma unroll
    for (int q = 0; q < 4; ++q) { const int c = F.lane * 4 + 256 * q; const f32x4 gv = *(const f32x4*)(g + c), s1 = *(const f32x4*)(scv + c), s0 = *(const f32x4*)(shv + c);
#pragma unroll
        for (int j = 0; j < 4; ++j) { rc.gm[q * 4 + j] = gv[j] * (1.0f + s1[j]); rc.sh[q * 4 + j] = s0[j]; } }
}
DI void moe_combine_row(const Frame& F, int lprev, int t, int b, const int* pre, float (&xv)[16]) {
    const int* ti = (const int*)(F.TOKI + ((size_t)lprev * T_TOK + t) * 32);
    const int e1 = ti[0], s1 = ti[1], e2 = ti[2], s2 = ti[3]; const float w1 = __int_as_float(ti[4]), w2 = __int_as_float(ti[5]);
    const bf16_t* YS = (const bf16_t*)(F.R0 + R_YS);
    const bf16_t* y1 = YS + (size_t)(pre[e1] * 256 + s1) * 1024; const bf16_t* y2 = YS + (size_t)(pre[e2] * 256 + s2) * 1024;
    const float* gt = F.MOD + ((size_t)lprev * 4 + b) * 6144 + 5120;
#pragma unroll
    for (int q = 0; q < 4; ++q) { const int c = F.lane * 4 + 256 * q; const u32x2 a = *(const u32x2*)(y1 + c), d = *(const u32x2*)(y2 + c); const f32x4 g = *(const f32x4*)(gt + c);
        xv[q * 4 + 0] += g[0] * (w1 * bflo(a.x) + w2 * bflo(d.x)); xv[q * 4 + 1] += g[1] * (w1 * bfhi(a.x) + w2 * bfhi(d.x));
        xv[q * 4 + 2] += g[2] * (w1 * bflo(a.y) + w2 * bflo(d.y)); xv[q * 4 + 3] += g[3] * (w1 * bfhi(a.y) + w2 * bfhi(d.y)); }
}
DI void phase_n1(const Frame& F, int l) {
    float* wif = (float*)F.ldsg;
    int* pre = (int*)(F.ldsg + 32768);
    for (int i = F.tid; i < 8192; i += 512) wif[i] = F.WIF[(size_t)l * 8192 + i];
    if (l > 0) moe_offsets(F.ctl + CW_CNT + 64 * (l - 1), pre, F.tid);
    __syncthreads();
    for (int blk = F.bid; blk < T_TOK / 128; blk += F.G) {
        const int b = blk / (SEQ / 128);
        const float* mod = F.MOD + ((size_t)l * 4 + b) * 6144;
        RowCtx rc; load_rowconst(F, F.g_mix + (size_t)l * 1024, mod, mod + 1024, rc);
#pragma unroll 1
        for (int i = 0; i < 16; ++i) {
            const int t = blk * 128 + F.wave * 16 + i;
            asm volatile("" ::: "memory");
            float xv[16];
            const float* xr = (l == 0 ? F.x : F.out) + (size_t)t * 1024;
#pragma unroll
            for (int q = 0; q < 4; ++q) { const f32x4 v = *(const f32x4*)(xr + F.lane * 4 + 256 * q); xv[q * 4] = v[0]; xv[q * 4 + 1] = v[1]; xv[q * 4 + 2] = v[2]; xv[q * 4 + 3] = v[3]; }
            if (l > 0) {
                moe_combine_row(F, l - 1, t, b, pre, xv);
#pragma unroll
                for (int q = 0; q < 4; ++q) *(f32x4*)(F.out + (size_t)t * 1024 + F.lane * 4 + 256 * q) = (f32x4){xv[q * 4], xv[q * 4 + 1], xv[q * 4 + 2], xv[q * 4 + 3]};
            }
            float ss = 0.f;
#pragma unroll
            for (int j = 0; j < 16; ++j) ss += xv[j] * xv[j];
            ss = wave_sum(ss);
            const float rn = __builtin_amdgcn_rsqf(ss * (1.0f / 1024.0f) + EPS);
            float uv[16];
#pragma unroll
            for (int j = 0; j < 16; ++j) uv[j] = xv[j] * rn * rc.gm[j] + rc.sh[j];
#pragma unroll
            for (int q = 0; q < 4; ++q) { u32x2 w; w.x = pack2(uv[q * 4], uv[q * 4 + 1]); w.y = pack2(uv[q * 4 + 2], uv[q * 4 + 3]); *(u32x2*)(F.U + (size_t)t * 1024 + F.lane * 4 + 256 * q) = w; }
            float d[8];
#pragma unroll
            for (int g = 0; g < 8; ++g) { float s = 0.f;
#pragma unroll
                for (int q = 0; q < 4; ++q) { const f32x4 wv = *(const f32x4*)(wif + g * 1024 + F.lane * 4 + 256 * q); s += uv[q * 4] * wv[0] + uv[q * 4 + 1] * wv[1] + uv[q * 4 + 2] * wv[2] + uv[q * 4 + 3] * wv[3]; }
                d[g] = wave_sum(s); }
            if (F.lane < 8) {
                float v = 0.f;
#pragma unroll
                for (int g = 0; g < 8; ++g) v = (F.lane == g) ? d[g] : v;
                v += F.gate_b[l * 8 + F.lane];
                if (F.lane >= 4) { const float e = __expf(-fabsf(v)); const float l1p = (e < 0.03f) ? e * (1.0f - e * (0.5f - e * (0.33333334f - 0.25f * e))) : __logf(1.0f + e); v = fminf(v, 0.f) - l1p; }
                F.GIF[(size_t)t * 8 + F.lane] = v;
            }
        }
    }
}

DI void phase_n2(const Frame& F, int l) {
    float* rw = (float*)F.ldsg;
    int* cntL = (int*)(F.ldsg + 65536);
    int* baseL = cntL + 16;
    int* rec = baseL + 16;
    for (int i = F.tid; i < 16384; i += 512) rw[i] = F.RW[i];
    __syncthreads();
    unsigned* gcnt = F.ctl + CW_CNT + 64 * l;
    int* SLOT = (int*)(F.R0 + R_SLOT);
    for (int blk = F.bid; blk < T_TOK / 128; blk += F.G) {
        const int b = blk / (SEQ / 128);
        const float* mod = F.MOD + ((size_t)l * 4 + b) * 6144;
        RowCtx rc; load_rowconst(F, F.g_ffn + (size_t)l * 1024, mod + 3072, mod + 4096, rc);
        if (F.tid < 16) cntL[F.tid] = 0;
        __syncthreads();
#pragma unroll 1
        for (int i = 0; i < 16; ++i) {
            const int rl = F.wave * 16 + i, t = blk * 128 + rl;
            asm volatile("" ::: "memory");
            float xv[16];
#pragma unroll
            for (int q = 0; q < 4; ++q) { const f32x4 v = *(const f32x4*)(F.out + (size_t)t * 1024 + F.lane * 4 + 256 * q); xv[q * 4] = v[0]; xv[q * 4 + 1] = v[1]; xv[q * 4 + 2] = v[2]; xv[q * 4 + 3] = v[3]; }
            float ss = 0.f;
#pragma unroll
            for (int j = 0; j < 16; ++j) ss += xv[j] * xv[j];
            ss = wave_sum(ss);
            const float rn = __builtin_amdgcn_rsqf(ss * (1.0f / 1024.0f) + EPS);
            float uv[16];
#pragma unroll
            for (int j = 0; j < 16; ++j) uv[j] = xv[j] * rn * rc.gm[j] + rc.sh[j];
#pragma unroll
            for (int q = 0; q < 4; ++q) { u32x2 w; w.x = pack2(uv[q * 4], uv[q * 4 + 1]); w.y = pack2(uv[q * 4 + 2], uv[q * 4 + 3]); *(u32x2*)(F.U + (size_t)t * 1024 + F.lane * 4 + 256 * q) = w; }
            float mine = 0.f;
#pragma unroll
            for (int e = 0; e < 16; ++e) { float s = 0.f;
#pragma unroll
                for (int q = 0; q < 4; ++q) { const f32x4 wv = *(const f32x4*)(rw + e * 1024 + F.lane * 4 + 256 * q); s += uv[q * 4] * wv[0] + uv[q * 4 + 1] * wv[1] + uv[q * 4 + 2] * wv[2] + uv[q * 4 + 3] * wv[3]; }
                s = wave_sum(s); mine = (F.lane == e) ? s : mine; }
            const float score = 1.0f / (1.0f + __expf(-mine));
            const float sel = score + ((F.lane < 16) ? F.router_b[F.lane] : 0.f);
            const float s0 = __shfl(sel, (F.lane & ~3) + 0), s1 = __shfl(sel, (F.lane & ~3) + 1), s2 = __shfl(sel, (F.lane & ~3) + 2), s3 = __shfl(sel, (F.lane & ~3) + 3);
            const float mx = fmaxf(fmaxf(s0, s1), fmaxf(s2, s3));
            const int im = (s0 == mx) ? 0 : (s1 == mx) ? 1 : (s2 == mx) ? 2 : 3;
            const float t0 = (im == 0) ? -INFINITY : s0, t1 = (im == 1) ? -INFINITY : s1, t2 = (im == 2) ? -INFINITY : s2, t3 = (im == 3) ? -INFINITY : s3;
            const float mx2 = fmaxf(fmaxf(t0, t1), fmaxf(t2, t3));
            const int im2 = (t0 == mx2) ? 0 : (t1 == mx2) ? 1 : (t2 == mx2) ? 2 : 3;
            const float gs = mx + mx2;
            const float g0 = __shfl(gs, 0), g1 = __shfl(gs, 4), g2 = __shfl(gs, 8), g3 = __shfl(gs, 12);
            const float gm = fmaxf(fmaxf(g0, g1), fmaxf(g2, g3));
            const int bg = (g0 == gm) ? 0 : (g1 == gm) ? 1 : (g2 == gm) ? 2 : 3;
            const int e1 = __shfl(bg * 4 + im, bg * 4), e2 = __shfl(bg * 4 + im2, bg * 4);
            const float sc1 = __shfl(score, e1), sc2 = __shfl(score, e2);
            if (F.lane == 0) {
                const float inv = 1.0f / (sc1 + sc2);
                const int r1 = atomicAdd(&cntL[e1], 1), r2 = atomicAdd(&cntL[e2], 1);
                int* r = rec + rl * 6; r[0] = e1; r[1] = r1; r[2] = e2; r[3] = r2; r[4] = __float_as_int(sc1 * inv); r[5] = __float_as_int(sc2 * inv);
            }
        }
        __syncthreads();
        if (F.tid < 16) baseL[F.tid] = (int)atomicAdd(&gcnt[F.tid], (unsigned)cntL[F.tid]);
        __syncthreads();
        if (F.tid < 128) {
            const int t = blk * 128 + F.tid; const int* r = rec + F.tid * 6;
            const int e1 = r[0], s1 = baseL[e1] + r[1], e2 = r[2], s2 = baseL[e2] + r[3];
            SLOT[e1 * 32768 + s1] = t; SLOT[e2 * 32768 + s2] = t;
            int* ti = (int*)(F.TOKI + ((size_t)l * T_TOK + t) * 32);
            ti[0] = e1; ti[1] = s1; ti[2] = e2; ti[3] = s2; ti[4] = r[4]; ti[5] = r[5];
        }
        __syncthreads();
    }
}

DI void phase_fn(const Frame& F) {
    int* pre = (int*)F.ldsg;
    moe_offsets(F.ctl + CW_CNT + 64 * (DEPTH - 1), pre, F.tid);
    __syncthreads();
    for (int blk = F.bid; blk < T_TOK / 128; blk += F.G) {
        const int b = blk / (SEQ / 128);
#pragma unroll 1
        for (int i = 0; i < 16; ++i) {
            const int t = blk * 128 + F.wave * 16 + i;
            float xv[16];
#pragma unroll
            for (int q = 0; q < 4; ++q) { const f32x4 v = *(const f32x4*)(F.out + (size_t)t * 1024 + F.lane * 4 + 256 * q); xv[q * 4] = v[0]; xv[q * 4 + 1] = v[1]; xv[q * 4 + 2] = v[2]; xv[q * 4 + 3] = v[3]; }
            moe_combine_row(F, DEPTH - 1, t, b, pre, xv);
            float ss = 0.f;
#pragma unroll
            for (int j = 0; j < 16; ++j) ss += xv[j] * xv[j];
            ss = wave_sum(ss);
            const float rn = __builtin_amdgcn_rsqf(ss * (1.0f / 1024.0f) + EPS);
#pragma unroll
            for (int q = 0; q < 4; ++q) { const f32x4 g = *(const f32x4*)(F.g_fin + F.lane * 4 + 256 * q);
                *(f32x4*)(F.out + (size_t)t * 1024 + F.lane * 4 + 256 * q) = (f32x4){xv[q * 4] * rn * g[0], xv[q * 4 + 1] * rn * g[1], xv[q * 4 + 2] * rn * g[2], xv[q * 4 + 3] * rn * g[3]}; }
        }
    }
}
DI void phase_cv(const Frame& F, int l) {
    const bf16_t* P = (const bf16_t*)(F.R0 + R_P);
    bf16_t* QC = (bf16_t*)(F.R0 + R_QC); bf16_t* KC = (bf16_t*)(F.R0 + R_KC); bf16_t* KCT = (bf16_t*)(F.R0 + R_KCT);
    bf16_t* raw = (bf16_t*)F.ldsg;
    bf16_t* tT = raw + 67 * 264;
    const int tid = F.tid;
    for (int u = F.bid; u < 128 * 8; u += F.G) {
        const int tt = u >> 3, ct = u & 7, t0 = tt * 64, c0 = ct * 256;
        for (int i = tid; i < 67 * 32; i += 512) { const int r = i >> 5, cg = i & 31, t = t0 - 3 + r;
            u32x4 v = (u32x4){0u, 0u, 0u, 0u};
            if (t >= 0) v = *(const u32x4*)(P + (size_t)t * NNAT + c0 + cg * 8);
            *(u32x4*)(raw + r * 264 + cg * 8) = v; }
        __syncthreads();
        const int cg = tid & 31, ch = c0 + cg * 8;
        float w[4][8];
#pragma unroll
        for (int j = 0; j < 4; ++j) { const f32x4 a = *(const f32x4*)(F.conv_w + ((size_t)l * 4 + j) * 2048 + ch), b = *(const f32x4*)(F.conv_w + ((size_t)l * 4 + j) * 2048 + ch + 4);
            w[j][0] = a[0]; w[j][1] = a[1]; w[j][2] = a[2]; w[j][3] = a[3]; w[j][4] = b[0]; w[j][5] = b[1]; w[j][6] = b[2]; w[j][7] = b[3]; }
        const bool isq = ct < 4; const float osc = isq ? 0.0625f : 1.0f;
#pragma unroll
        for (int i = 0; i < 4; ++i) {
            const int tr = (tid >> 5) + 16 * i;
            float y[8];
#pragma unroll
            for (int k = 0; k < 8; ++k) y[k] = 0.f;
#pragma unroll
            for (int j = 0; j < 4; ++j) { const u32x4 v = *(const u32x4*)(raw + (tr + j) * 264 + cg * 8);
                y[0] += w[j][0] * bflo(v.x); y[1] += w[j][1] * bfhi(v.x); y[2] += w[j][2] * bflo(v.y); y[3] += w[j][3] * bfhi(v.y);
                y[4] += w[j][4] * bflo(v.z); y[5] += w[j][5] * bfhi(v.z); y[6] += w[j][6] * bflo(v.w); y[7] += w[j][7] * bfhi(v.w); }
#pragma unroll
            for (int k = 0; k < 8; ++k) y[k] = siluf_(y[k]) * osc;
            u32x4 o; o.x = pack2(y[0], y[1]); o.y = pack2(y[2], y[3]); o.z = pack2(y[4], y[5]); o.w = pack2(y[6], y[7]);
            if (isq) *(u32x4*)(QC + (size_t)(t0 + tr) * 1024 + ch) = o;
            else { *(u32x4*)(KC + (size_t)(t0 + tr) * 1024 + (ch - 1024)) = o; *(u32x4*)(tT + tr * 264 + cg * 8) = o; }
        }
        __syncthreads();
        if (!isq) {
#pragma unroll
            for (int i = 0; i < 4; ++i) { const int chl = (tid >> 3) + 64 * i, oc = tid & 7;
                unsigned short e[8];
#pragma unroll
                for (int k = 0; k < 8; ++k) e[k] = tT[(oc * 8 + k) * 264 + chl];
                u32x4 o; o.x = e[0] | ((unsigned)e[1] << 16); o.y = e[2] | ((unsigned)e[3] << 16); o.z = e[4] | ((unsigned)e[5] << 16); o.w = e[6] | ((unsigned)e[7] << 16);
                *(u32x4*)(KCT + (size_t)(c0 - 1024 + chl) * TQ + t0 + oc * 8) = o; }
        }
        __syncthreads();
    }
}

DI void ml1_unit(const Frame& F, int h, int j, int eg) {
    const bf16_t* QC = (const bf16_t*)(F.R0 + R_QC); const bf16_t* KC = (const bf16_t*)(F.R0 + R_KC); const bf16_t* KCT = (const bf16_t*)(F.R0 + R_KCT);
    const bf16_t* VT = (const bf16_t*)(F.R0 + R_VT);
    float* NUM = (float*)(F.R0 + R_NUM); float* SLOC = (float*)(F.R0 + R_SLOC);
    float* DENI = (float*)(F.R0 + R_DENI); float* EBC = (float*)(F.R0 + R_EBC); float* EBL = (float*)(F.R0 + R_EBL);
    float* SCB = (float*)(F.R0 + R_SCB); float* CHB = (float*)(F.R0 + R_CHB); float* DN = (float*)(F.R0 + R_DN);
    const int tid = F.tid, lane = F.lane, w = F.wave, rr = lane & 31, hh = lane >> 5;
    const int tl0 = j * 256;
    const size_t tg0 = (size_t)eg * TQ + tl0;
    LAS unsigned char* L = F.lds;
    LAS bf16_t* Sl = (LAS bf16_t*)L;
    LAS float* Lb = (LAS float*)(L + 36864);
    LAS float* Lg = Lb + 256;
    LAS float* Lws = Lg + 256;
    LAS float* Leb = Lws + 256;
    LAS float* Lden = Leb + 256;
    LAS float* Lbl = Lden + 256;
    if (w < 4) {
        const int c = w, t = c * 64 + lane;
        const float li = F.GIF[(tg0 + t) * 8 + h], lf = F.GIF[(tg0 + t) * 8 + 4 + h];
        float b = lf;
#pragma unroll
        for (int o = 1; o < 64; o <<= 1) { const float v = __shfl_up(b, o); if (lane >= o) b += v; }
        const float bl = __shfl(b, 63);
        Lb[t] = b; Lg[t] = li - b; Lws[t] = __expf(bl - b + li); Leb[t] = __expf(b); Lden[t] = 0.f;
        if (lane == 0) Lbl[c] = bl;
    }
    __syncthreads();
    if (tid < 256) {
        const int c = tid >> 6; float pre = 0.f;
        for (int cc = 0; cc < c; ++cc) pre += Lbl[cc];
        EBC[(size_t)(tl0 + tid) * 4 + h] = Leb[tid];
        EBL[(size_t)(tl0 + tid) * 4 + h] = __expf(Lb[tid] + pre);
        if (tid < 4) CHB[h * 128 + j * 4 + tid] = Lbl[tid];
        if (tid == 0) SCB[h * 32 + j] = Lbl[0] + Lbl[1] + Lbl[2] + Lbl[3];
    }
    for (int idx = w; idx < 12; idx += 8) {
        const int c = idx / 3, k3 = idx % 3, ti = (k3 == 0) ? 0 : 1, si = (k3 == 2) ? 1 : 0;
        const bf16_t* kp = KC + (size_t)(tl0 + c * 64 + si * 32 + rr) * 1024 + h * 256 + hh * 8;
        const bf16_t* qp = QC + (size_t)(tl0 + c * 64 + ti * 32 + rr) * 1024 + h * 256 + hh * 8;
        f32x16 acc;
#pragma unroll
        for (int r = 0; r < 16; ++r) acc[r] = 0.f;
#pragma unroll
        for (int k4 = 0; k4 < 4; ++k4) {
#pragma unroll
            for (int kq = 0; kq < 4; ++kq) { const int ks = k4 * 4 + kq; acc = MFMA32(ldg8(kp + ks * 16), ldg8(qp + ks * 16), acc); }
            asm volatile("" ::: "memory"); }
        const int tloc = c * 64 + ti * 32 + rr; const float bt = Lb[tloc];
        float rs = 0.f;
#pragma unroll
        for (int g = 0; g < 4; ++g) {
            float v[4];
#pragma unroll
            for (int q = 0; q < 4; ++q) { const int r = g * 4 + q, sl = si * 32 + crow(r, hh);
                float wgt = __expf(bt + Lg[c * 64 + sl]);
                if (sl > ti * 32 + rr) wgt = 0.f;
                v[q] = acc[r] * wgt; rs += v[q]; }
            u32x2 o; o.x = pack2(v[0], v[1]); o.y = pack2(v[2], v[3]);
            *(LAS u32x2*)(Sl + (c * 64 + ti * 32 + rr) * 72 + si * 32 + 8 * g + 4 * hh) = o;
        }
        rs += __shfl_xor(rs, 32);
        if (hh == 0) atomicAdd((float*)(F.ldsg + 36864 + 4 * 1024) + tloc, rs);
    }
    __syncthreads();
    if (tid < 256) DENI[(size_t)(tl0 + tid) * 4 + h] = Lden[tid];
#pragma unroll
    for (int p2 = 0; p2 < 2; ++p2) {
        const int p = tid + 512 * p2, c = p >> 8, d = p & 255;
        const bf16_t* kt = KCT + (size_t)(h * 256 + d) * TQ + tl0 + c * 64;
        float s = 0.f;
#pragma unroll
        for (int o = 0; o < 8; ++o) { const u32x4 v = *(const u32x4*)(kt + o * 8); const LAS float* ws = Lws + c * 64 + o * 8;
            s += bflo(v.x) * ws[0] + bfhi(v.x) * ws[1] + bflo(v.y) * ws[2] + bfhi(v.y) * ws[3] + bflo(v.z) * ws[4] + bfhi(v.z) * ws[5] + bflo(v.w) * ws[6] + bfhi(v.w) * ws[7]; }
        DN[((size_t)h * 128 + j * 4 + c) * 256 + d] = s;
    }
    f32x16 Ct[8];
#pragma unroll
    for (int i = 0; i < 8; ++i)
#pragma unroll
        for (int r = 0; r < 16; ++r) Ct[i][r] = 0.f;
    for (int c = 0; c < 4; ++c) {
        int rr_ = rr, hh_ = hh; asm volatile("" : "+v"(rr_), "+v"(hh_));
        const bf16_t* vbase = VT + (size_t)(h * 256 + w * 32 + rr_) * TQ + tl0 + c * 64 + hh_ * 8;
        f32x16 a0, a1;
#pragma unroll
        for (int r = 0; r < 16; ++r) { a0[r] = 0.f; a1[r] = 0.f; }
        const bf16_t* q0 = QC + (size_t)(tl0 + c * 64 + rr_) * 1024 + h * 256 + hh_ * 8; const bf16_t* q1 = q0 + (size_t)32 * 1024;
#pragma unroll
        for (int db = 0; db < 8; ++db)
#pragma unroll
            for (int s2 = 0; s2 < 2; ++s2) {
                const bf16x8 cf = packf8(Ct[db][8 * s2], Ct[db][8 * s2 + 1], Ct[db][8 * s2 + 2], Ct[db][8 * s2 + 3], Ct[db][8 * s2 + 4], Ct[db][8 * s2 + 5], Ct[db][8 * s2 + 6], Ct[db][8 * s2 + 7]);
                a0 = MFMA32(ldg8(q0 + db * 32 + s2 * 16), cf, a0);
                a1 = MFMA32(ldg8(q1 + db * 32 + s2 * 16), cf, a1);
                if (s2 == 1 && (db & 1)) asm volatile("" ::: "memory");
            }
#pragma unroll
        for (int r = 0; r < 16; ++r) { a0[r] *= Leb[c * 64 + crow(r, hh)]; a1[r] *= Leb[c * 64 + 32 + crow(r, hh)]; }
#pragma unroll
        for (int ks = 0; ks < 4; ++ks) {
            const bf16x8 vf = ldg8(vbase + ks * 16);
            if (ks < 2) a0 = MFMA32(*(const LAS bf16x8*)(Sl + (c * 64 + rr) * 72 + ks * 16 + hh * 8), vf, a0);
            a1 = MFMA32(*(const LAS bf16x8*)(Sl + (c * 64 + 32 + rr) * 72 + ks * 16 + hh * 8), vf, a1);
        }
        { float* np = NUM + (size_t)(tl0 + c * 64) * 1024 + h * 256 + w * 32 + rr_;
#pragma unroll
          for (int r = 0; r < 16; ++r) { np[(size_t)crow(r, hh) * 1024] = a0[r]; np[(size_t)(32 + crow(r, hh)) * 1024] = a1[r]; } }
        asm volatile("" ::: "memory");
        const float dec = __expf(Lbl[c]);
        bf16x8 vs[4];
#pragma unroll
        for (int ks = 0; ks < 4; ++ks) {
            const u32x4 v = __builtin_bit_cast(u32x4, ldg8(vbase + ks * 16)); const LAS float* ws = Lws + c * 64 + ks * 16 + hh * 8;
            vs[ks] = packf8(bflo(v.x) * ws[0], bfhi(v.x) * ws[1], bflo(v.y) * ws[2], bfhi(v.y) * ws[3], bflo(v.z) * ws[4], bfhi(v.z) * ws[5], bflo(v.w) * ws[6], bfhi(v.w) * ws[7]);
        }
        const bf16_t* ktb = KCT + (size_t)(h * 256 + pi23(rr_)) * TQ + tl0 + c * 64 + hh_ * 8;
#pragma unroll
        for (int db = 0; db < 8; ++db) {
#pragma unroll
            for (int r = 0; r < 16; ++r) Ct[db][r] *= dec;
            const bf16_t* kt = ktb + (size_t)db * 32 * TQ;
#pragma unroll
            for (int ks = 0; ks < 4; ++ks) Ct[db] = MFMA32(ldg8(kt + ks * 16), vs[ks], Ct[db]);
            if (db & 1) asm volatile("" ::: "memory");
        }
    }
    { float* sp = SLOC + (((size_t)h * 32 + j) * 256 + w * 32 + rr) * 256 + hh * 8;
#pragma unroll
      for (int db = 0; db < 8; ++db)
#pragma unroll
          for (int a = 0; a < 2; ++a) {
              *(f32x4*)(sp + db * 32 + a * 16) = (f32x4){Ct[db][8 * a], Ct[db][8 * a + 1], Ct[db][8 * a + 2], Ct[db][8 * a + 3]};
              *(f32x4*)(sp + db * 32 + a * 16 + 4) = (f32x4){Ct[db][8 * a + 4], Ct[db][8 * a + 5], Ct[db][8 * a + 6], Ct[db][8 * a + 7]}; } }
    __syncthreads();
}

DI void at_unit(const Frame& F, int au) {
    bf16_t* P = (bf16_t*)(F.R0 + R_P); const bf16_t* VT = (const bf16_t*)(F.R0 + R_VT); float* LSE = (float*)(F.R0 + R_LSE);
    const int lane = F.lane, rr = lane & 31, hh = lane >> 5;
    const int hd = au >> 8, qt = au & 255, g = hd >> 2;
    const int dsh = 2 * g, d = 1 << dsh, lsub = TQ >> dsh, tiles = lsub >> 5;
    const int r = qt / tiles, l0 = (qt % tiles) * 32;
    const float slope_d = exp2f(-8.0f * (float)(hd + 1) / 12.0f) * (float)d;
    const size_t qrow = (size_t)((l0 + rr) * d + r) * NNAT + 3072 + hd * 128;
    bf16x8 qf[8];
#pragma unroll
    for (int ks = 0; ks < 8; ++ks) qf[ks] = ldg8(P + qrow + hh * 64 + ks * 8);
    f32x16 sc[5];
    float mx = -1e30f;
#pragma unroll
    for (int kt = 0; kt < 5; ++kt) {
        const int lk0 = l0 - 128 + 32 * kt;
#pragma unroll
        for (int i = 0; i < 16; ++i) sc[kt][i] = 0.f;
        if (lk0 >= 0) {
            const bf16_t* kp = P + (size_t)((lk0 + pi23(rr)) * d + r) * NNAT + 4608 + hd * 128 + hh * 64;
#pragma unroll
            for (int ks = 0; ks < 8; ++ks) sc[kt] = MFMA32(ldg8(kp + ks * 8), qf[ks], sc[kt]);
#pragma unroll
            for (int i = 0; i < 16; ++i) {
                const int kk = (i & 3) + 4 * ((i >> 2) & 1) + 8 * hh + 16 * (i >> 3);
                const int dist = 128 - 32 * kt + rr - kk;
                float s = sc[kt][i] - slope_d * (float)dist;
                s = (dist >= 0 && dist <= 128) ? s : -1e30f;
                sc[kt][i] = s; mx = fmaxf(mx, s);
            }
            asm volatile("" ::: "memory");
        } else {
#pragma unroll
            for (int i = 0; i < 16; ++i) sc[kt][i] = -1e30f;
        }
    }
    mx = fmaxf(mx, __shfl_xor(mx, 32));
    float sum = 0.f;
    bf16x8 pf[5][2];
#pragma unroll
    for (int kt = 0; kt < 5; ++kt) {
        float p[16];
#pragma unroll
        for (int i = 0; i < 16; ++i) { p[i] = __expf(sc[kt][i] - mx); sum += p[i]; }
        pf[kt][0] = packf8(p[0], p[1], p[2], p[3], p[4], p[5], p[6], p[7]);
        pf[kt][1] = packf8(p[8], p[9], p[10], p[11], p[12], p[13], p[14], p[15]);
    }
    sum += __shfl_xor(sum, 32);
    const float inv = 1.0f / sum;
#pragma unroll
    for (int ct = 0; ct < 4; ++ct) {
        f32x16 o;
#pragma unroll
        for (int i = 0; i < 16; ++i) o[i] = 0.f;
        const bf16_t* vp = VT + (size_t)(1024 + hd * 128 + ct * 32 + rr) * TQ + r * lsub + hh * 8;
#pragma unroll
        for (int kt = 0; kt < 5; ++kt) {
            const int lk0 = l0 - 128 + 32 * kt;
            if (lk0 >= 0) {
                o = MFMA32(ldg8(vp + lk0), pf[kt][0], o);
                o = MFMA32(ldg8(vp + lk0 + 16), pf[kt][1], o);
            }
        }
#pragma unroll
        for (int g4 = 0; g4 < 4; ++g4) { u32x2 w; w.x = pack2(o[4 * g4] * inv, o[4 * g4 + 1] * inv); w.y = pack2(o[4 * g4 + 2] * inv, o[4 * g4 + 3] * inv);
            *(u32x2*)(P + qrow + ct * 32 + 8 * g4 + 4 * hh) = w; }
        asm volatile("" ::: "memory");
    }
    if (hh == 0) LSE[(size_t)((l0 + rr) * d + r) * 12 + hd] = mx + __logf(sum);
}

DI void phase_p2(const Frame& F) {
    const float* SLOC = (const float*)(F.R0 + R_SLOC); bf16_t* CST = (bf16_t*)(F.R0 + R_CST);
    const float* SCB = (const float*)(F.R0 + R_SCB); const float* CHB = (const float*)(F.R0 + R_CHB);
    const float* DN = (const float*)(F.R0 + R_DN); float* NST = (float*)(F.R0 + R_NST);
    const int gt = F.bid * 512 + F.tid;
    if (gt < 65536) {
        const int h = gt >> 14, e4 = (gt & 16383) * 4;
        f32x4 run = (f32x4){0.f, 0.f, 0.f, 0.f};
        for (int j = 0; j < 32; ++j) {
            const size_t o = ((size_t)h * 32 + j) * 65536 + e4;
            u32x2 w; w.x = pack2(run[0], run[1]); w.y = pack2(run[2], run[3]); *(u32x2*)(CST + o) = w;
            const f32x4 s = *(const f32x4*)(SLOC + o); const float dec = __expf(SCB[h * 32 + j]);
            run = run * dec + s;
        }
    } else if (gt < 65536 + 1024) {
        const int q = gt - 65536, h = q >> 8, dd = q & 255; float run = 0.f;
        for (int c = 0; c < 128; ++c) { const size_t o = ((size_t)h * 128 + c) * 256 + dd; NST[o] = run; run = run * __expf(CHB[h * 128 + c]) + DN[o]; }
    }
}

DI void f_hm_unit(const Frame& F, int l, int h, int tt, int eg) {
    const bf16_t* QC = (const bf16_t*)(F.R0 + R_QC); const bf16_t* CST = (const bf16_t*)(F.R0 + R_CST); const float* NST = (const float*)(F.R0 + R_NST);
    const float* NUM = (const float*)(F.R0 + R_NUM); const bf16_t* P = (const bf16_t*)(F.R0 + R_P);
    const float* DENI = (const float*)(F.R0 + R_DENI); const float* EBC = (const float*)(F.R0 + R_EBC); const float* EBL = (const float*)(F.R0 + R_EBL);
    const int lane = F.lane, tr = lane & 15, kg = lane >> 4;
    const int tl0 = tt * 16, j = tl0 >> 8, c = tl0 >> 6, tl = tl0 + tr;
    f32x4 acc[16];
#pragma unroll
    for (int i = 0; i < 16; ++i) acc[i] = (f32x4){0.f, 0.f, 0.f, 0.f};
    const bf16_t* qp = QC + (size_t)tl * 1024 + h * 256 + kg * 8;
    const bf16_t* cp = CST + (((size_t)h * 32 + j) * 256 + tr) * 256 + kg * 8;
    const float* np = NST + ((size_t)h * 128 + c) * 256 + kg * 8;
    float dotn = 0.f;
#pragma unroll 2
    for (int ks = 0; ks < 8; ++ks) {
        asm volatile("" ::: "memory");
        const bf16x8 qf = ldg8(qp + ks * 32);
        const u32x4 qv = __builtin_bit_cast(u32x4, qf);
        const f32x4 n0 = *(const f32x4*)(np + ks * 32), n1 = *(const f32x4*)(np + ks * 32 + 4);
        dotn += bflo(qv.x) * n0[0] + bfhi(qv.x) * n0[1] + bflo(qv.y) * n0[2] + bfhi(qv.y) * n0[3] + bflo(qv.z) * n1[0] + bfhi(qv.z) * n1[1] + bflo(qv.w) * n1[2] + bfhi(qv.w) * n1[3];
#pragma unroll
        for (int et = 0; et < 16; ++et) acc[et] = __builtin_amdgcn_mfma_f32_16x16x32_bf16(ldg8(cp + (size_t)et * 16 * 256 + ks * 32), qf, acc[et], 0, 0, 0);
    }
    dotn += __shfl_xor(dotn, 16); dotn += __shfl_xor(dotn, 32);
    const float ebl = EBL[(size_t)tl * 4 + h], ebc = EBC[(size_t)tl * 4 + h];
    const float den = DENI[(size_t)tl * 4 + h] + ebc * dotn;
    const float invd = 1.0f / fmaxf(fabsf(den), 1.0f);
    float ssq = 0.f;
#pragma unroll
    for (int et = 0; et < 16; ++et) {
        const f32x4 nl = *(const f32x4*)(NUM + (size_t)tl * 1024 + h * 256 + et * 16 + 4 * kg);
#pragma unroll
        for (int q = 0; q < 4; ++q) { const float v = (nl[q] + ebl * acc[et][q]) * invd; acc[et][q] = v; ssq += v * v; }
        if ((et & 3) == 3) asm volatile("" ::: "memory");
    }
    ssq += __shfl_xor(ssq, 16); ssq += __shfl_xor(ssq, 32);
    const float rn = __builtin_amdgcn_rsqf(ssq * (1.0f / 256.0f) + EPS);
    const size_t tp = (size_t)(eg & 1) * TQ + tl;
#pragma unroll
    for (int et = 0; et < 16; ++et) {
        const int e = et * 16 + 4 * kg;
        const u32x2 og = *(const u32x2*)(P + (size_t)tl * NNAT + 2048 + h * 256 + e);
        const f32x4 ng = *(const f32x4*)(F.norm_g + (size_t)l * 1024 + h * 256 + e);
        u32x2 w; w.x = pack2(bflo(og.x) * acc[et][0] * rn * ng[0], bfhi(og.x) * acc[et][1] * rn * ng[1]);
        w.y = pack2(bflo(og.y) * acc[et][2] * rn * ng[2], bfhi(og.y) * acc[et][3] * rn * ng[3]);
        *(u32x2*)(F.HM + tp * 1024 + h * 256 + e) = w;
        if ((et & 3) == 3) asm volatile("" ::: "memory");
    }
}
DI void f_ha_token(const Frame& F, int tl, int eg) {
    const bf16_t* P = (const bf16_t*)(F.R0 + R_P); const float* LSE = (const float*)(F.R0 + R_LSE);
    const int lane = F.lane, hs = lane >> 4, ch0 = (lane & 15) * 8;
    const float l0 = LSE[(size_t)tl * 12 + hs], l1 = LSE[(size_t)tl * 12 + 4 + hs], l2 = LSE[(size_t)tl * 12 + 8 + hs];
    const float m = fmaxf(l0, fmaxf(l1, l2));
    float a0 = __expf(l0 - m), a1 = __expf(l1 - m), a2 = __expf(l2 - m); const float inv = 1.0f / (a0 + a1 + a2); a0 *= inv; a1 *= inv; a2 *= inv;
    const bf16_t* pr = P + (size_t)tl * NNAT + 3072 + hs * 128 + ch0;
    const u32x4 v0 = *(const u32x4*)(pr), v1 = *(const u32x4*)(pr + 512), v2 = *(const u32x4*)(pr + 1024);
    u32x4 o;
    o.x = pack2(a0 * bflo(v0.x) + a1 * bflo(v1.x) + a2 * bflo(v2.x), a0 * bfhi(v0.x) + a1 * bfhi(v1.x) + a2 * bfhi(v2.x));
    o.y = pack2(a0 * bflo(v0.y) + a1 * bflo(v1.y) + a2 * bflo(v2.y), a0 * bfhi(v0.y) + a1 * bfhi(v1.y) + a2 * bfhi(v2.y));
    o.z = pack2(a0 * bflo(v0.z) + a1 * bflo(v1.z) + a2 * bflo(v2.z), a0 * bfhi(v0.z) + a1 * bfhi(v1.z) + a2 * bfhi(v2.z));
    o.w = pack2(a0 * bflo(v0.w) + a1 * bflo(v1.w) + a2 * bflo(v2.w), a0 * bfhi(v0.w) + a1 * bfhi(v1.w) + a2 * bfhi(v2.w));
    *(u32x4*)(F.HA + ((size_t)(eg & 1) * TQ + tl) * 512 + hs * 128 + ch0) = o;
}
using pg8::UnitD;
DI u32x4 pack8(const f32x4& v0, const f32x4& v1) { u32x4 w; w.x = pack2(v0[0], v0[1]); w.y = pack2(v0[2], v0[3]); w.z = pack2(v1[0], v1[1]); w.w = pack2(v1[2], v1[3]); return w; }

struct SchedG1 {
    const char* U; const char* Wnat; const char* Wvt; int G, c;
    DI bool next(int i, UnitD& u) const {
        const int L = i * G + c; if (L >= 768 + 320) return false;
        u.arows = nullptr; u.acount = 0; u.aux = 0;
        if (L < 768) { int pm, pn; pg8::tile_map(L, 32, 24, pm, pn); u.kind = 0; u.pm = pm; u.pn = pn;
            u.A = U + (size_t)pm * 256 * 2048; u.lda = 2048; u.B = Wnat + (size_t)pn * 256 * 2048; u.ldb = 2048; }
        else { const int idx = L - 768, pm = idx % 10, pn = idx / 10; u.kind = 1; u.pm = pm; u.pn = pn;
            u.A = Wvt + (size_t)pm * 256 * 2048; u.lda = 2048;
            int tokbase = pn * 256, dmul = 1;
            if (pm >= 4) { const int g = (pm - 4) >> 1, dsh = 2 * g, lsub = TQ >> dsh, n0 = pn * 256; dmul = 1 << dsh; tokbase = (n0 % lsub) * dmul + n0 / lsub; }
            u.B = U + (size_t)tokbase * 2048; u.ldb = 2048u * (unsigned)dmul; }
        return true;
    }
};
struct EpiG1 {
    static constexpr bool PERM = true;
    bf16_t* P; bf16_t* VT;
    DI void operator()(const f32x4 (&acc)[2][2][4][2], const UnitD& u, int wr, int wc, int fr, int fq) const {
        bf16_t* base; size_t ld; int mode = 0;
        if (u.kind == 0) { base = P + (size_t)u.pm * 256 * NNAT + u.pn * 256; ld = NNAT; mode = (u.pn >= 8 && u.pn < 12) ? 1 : ((u.pn >= 12 && u.pn < 18) ? 2 : 0); }
        else { base = VT + (size_t)u.pm * 256 * TQ + u.pn * 256; ld = TQ; }
        const int row0 = wr * 64 + fr, col0 = wc * 32 + 8 * fq;
#pragma unroll
        for (int ai = 0; ai < 2; ++ai)
#pragma unroll
            for (int m = 0; m < 4; ++m) { bf16_t* rowp = base + (size_t)(row0 + ai * 128 + m * 16) * ld + col0;
#pragma unroll
                for (int bj = 0; bj < 2; ++bj) { f32x4 v0 = acc[ai][bj][m][0], v1 = acc[ai][bj][m][1];
                    if (mode == 1) {
#pragma unroll
                        for (int q = 0; q < 4; ++q) { v0[q] = sigmoidf_(v0[q]); v1[q] = sigmoidf_(v1[q]); } }
                    else if (mode == 2) { v0 *= 0.08838834764831845f; v1 *= 0.08838834764831845f; }
                    *(u32x4*)(rowp + bj * 128) = pack8(v0, v1); }
                asm volatile("" ::: "memory"); }
    }
};
struct SchedDense {
    const char* A; const char* B; unsigned lda, ldb; int nM, nN, G, c;
    DI bool next(int i, UnitD& u) const {
        const int L = i * G + c; if (L >= nM * nN) return false;
        int pm, pn; pg8::tile_map(L, nM, nN, pm, pn); u.kind = 0; u.pm = pm; u.pn = pn; u.aux = 0; u.arows = nullptr; u.acount = 0;
        u.A = A + (size_t)pm * 256 * lda; u.lda = lda; u.B = B + (size_t)pn * 256 * ldb; u.ldb = ldb; return true;
    }
};
struct EpiG1g {
    static constexpr bool PERM = true;
    bf16_t* GT;
    DI void operator()(const f32x4 (&acc)[2][2][4][2], const UnitD& u, int wr, int wc, int fr, int fq) const {
        bf16_t* base = GT + (size_t)u.pm * 256 * 2048 + u.pn * 256; const int row0 = wr * 64 + fr, col0 = wc * 32 + 8 * fq;
#pragma unroll
        for (int ai = 0; ai < 2; ++ai)
#pragma unroll
            for (int m = 0; m < 4; ++m) { bf16_t* rowp = base + (size_t)(row0 + ai * 128 + m * 16) * 2048 + col0;
#pragma unroll
                for (int bj = 0; bj < 2; ++bj) { f32x4 v0 = acc[ai][bj][m][0], v1 = acc[ai][bj][m][1];
#pragma unroll
                    for (int q = 0; q < 4; ++q) { v0[q] = sigmoidf_(v0[q]); v1[q] = sigmoidf_(v1[q]); }
                    *(u32x4*)(rowp + bj * 128) = pack8(v0, v1); }
                asm volatile("" ::: "memory"); }
    }
};
template <int WHICH> struct EpiG2 {
    static constexpr bool PERM = true;
    bf16_t* GT;
    DI void operator()(const f32x4 (&acc)[2][2][4][2], const UnitD& u, int wr, int wc, int fr, int fq) const {
        bf16_t* base = GT + (size_t)u.pm * 256 * 2048 + u.pn * 256 + (WHICH == 0 ? 1024 : 0); const int row0 = wr * 64 + fr, col0 = wc * 32 + 8 * fq;
#pragma unroll
        for (int ai = 0; ai < 2; ++ai)
#pragma unroll
            for (int m = 0; m < 4; ++m) { bf16_t* rowp = base + (size_t)(row0 + ai * 128 + m * 16) * 2048 + col0;
#pragma unroll
                for (int bj = 0; bj < 2; ++bj) { const f32x4 a0 = acc[ai][bj][m][0], a1 = acc[ai][bj][m][1];
                    const u32x4 g = *(const u32x4*)(rowp + bj * 128);
                    f32x4 v0 = (f32x4){bflo(g.x) * a0[0], bfhi(g.x) * a0[1], bflo(g.y) * a0[2], bfhi(g.y) * a0[3]};
                    f32x4 v1 = (f32x4){bflo(g.z) * a1[0], bfhi(g.z) * a1[1], bflo(g.w) * a1[2], bfhi(g.w) * a1[3]};
                    if (WHICH == 1) { const u32x4 y = *(const u32x4*)(rowp + bj * 128 + 1024);
                        v0 += (f32x4){bflo(y.x), bfhi(y.x), bflo(y.y), bfhi(y.y)}; v1 += (f32x4){bflo(y.z), bfhi(y.z), bflo(y.w), bfhi(y.w)}; }
                    *(u32x4*)(rowp + bj * 128) = pack8(v0, v1); }
                asm volatile("" ::: "memory"); }
    }
};
struct EpiG3 {
    static constexpr bool PERM = false;
    const float* xin; float* xout; const float* gta;
    int b0;
    DI void operator()(const f32x4 (&acc)[2][2][4][2], const UnitD& u, int wr, int wc, int fr, int fq) const {
        const int row0 = u.pm * 256 + wr * 64 + fr, col0 = u.pn * 256 + wc * 32 + 4 * fq;
        const float* g = gta + (size_t)(b0 + (u.pm >> 5)) * 6144 + col0;
        f32x4 gv[2][2];
#pragma unroll
        for (int bj = 0; bj < 2; ++bj)
#pragma unroll
            for (int n = 0; n < 2; ++n) gv[bj][n] = *(const f32x4*)(g + bj * 128 + n * 16);
#pragma unroll
        for (int ai = 0; ai < 2; ++ai)
#pragma unroll
            for (int m = 0; m < 4; ++m) { const size_t o = (size_t)(row0 + ai * 128 + m * 16) * 1024 + col0;
#pragma unroll
                for (int bj = 0; bj < 2; ++bj)
#pragma unroll
                    for (int n = 0; n < 2; ++n) { const f32x4 xv = *(const f32x4*)(xin + o + bj * 128 + n * 16); *(f32x4*)(xout + o + bj * 128 + n * 16) = xv + gv[bj][n] * acc[ai][bj][m][n]; }
                asm volatile("" ::: "memory"); }
    }
};
struct SchedMoe {
    const int* pre;
    const unsigned* cnt;
    const char* A; const char* W; const int* SLOT; int G, c; bool gate_up;
    DI bool next(int i, UnitD& u) const {
        const int L = i * G + c, nt = pre[16]; if (L >= nt * 4) return false;
        const int rt = L >> 2, ct = L & 3; int e = 0;
#pragma unroll
        for (int q = 1; q < 16; ++q) e += (rt >= pre[q]) ? 1 : 0;
        u.kind = 0; u.pm = rt; u.pn = ct; u.aux = e;
        const int ti = rt - pre[e];
        if (gate_up) { u.A = A; u.lda = 2048; u.arows = SLOT + (size_t)e * 32768 + ti * 256; u.acount = (int)cnt[e] - ti * 256;
            u.B = W + ((size_t)e * 1024 + ct * 256) * 2048; u.ldb = 2048; }
        else { u.A = A + (size_t)rt * 256 * 1024; u.lda = 1024; u.arows = nullptr; u.acount = 0;
            u.B = W + ((size_t)e * 1024 + ct * 256) * 1024; u.ldb = 1024; }
        return true;
    }
};
struct EpiG4 {
    static constexpr bool PERM = true;
    bf16_t* HH;
    DI void operator()(const f32x4 (&acc)[2][2][4][2], const UnitD& u, int wr, int wc, int fr, int fq) const {
        bf16_t* base = HH + (size_t)u.pm * 256 * 512 + u.pn * 128; const int row0 = wr * 64 + fr, col0 = wc * 16 + 4 * fq;
#pragma unroll
        for (int ai = 0; ai < 2; ++ai)
#pragma unroll
            for (int m = 0; m < 4; ++m) { bf16_t* rowp = base + (size_t)(row0 + ai * 128 + m * 16) * 512 + col0;
#pragma unroll
                for (int bj = 0; bj < 2; ++bj) { const f32x4 v0 = acc[ai][bj][m][0], v1 = acc[ai][bj][m][1];
                    u32x2 w; w.x = pack2(siluf_(v0[0]) * v0[1], siluf_(v0[2]) * v0[3]); w.y = pack2(siluf_(v1[0]) * v1[1], siluf_(v1[2]) * v1[3]);
                    *(u32x2*)(rowp + bj * 64) = w; }
                asm volatile("" ::: "memory"); }
    }
};
struct EpiG5 {
    static constexpr bool PERM = true;
    bf16_t* YS;
    DI void operator()(const f32x4 (&acc)[2][2][4][2], const UnitD& u, int wr, int wc, int fr, int fq) const {
        bf16_t* base = YS + (size_t)u.pm * 256 * 1024 + u.pn * 256; const int row0 = wr * 64 + fr, col0 = wc * 32 + 8 * fq;
#pragma unroll
        for (int ai = 0; ai < 2; ++ai)
#pragma unroll
            for (int m = 0; m < 4; ++m) { bf16_t* rowp = base + (size_t)(row0 + ai * 128 + m * 16) * 1024 + col0;
#pragma unroll
                for (int bj = 0; bj < 2; ++bj) *(u32x4*)(rowp + bj * 128) = pack8(acc[ai][bj][m][0], acc[ai][bj][m][1]);
                asm volatile("" ::: "memory"); }
    }
};
constexpr int LDS_BYTES = 131072 + 1024;
constexpr int LDS_MISC = 131072;
#ifndef MK_ONE_LAUNCH
#define MK_ONE_LAUNCH 1
#endif
constexpr int N_STEPS = 1 + DEPTH * (1 + 2 * (2 * 5 + 4) + 3) + 1;

__global__ void __launch_bounds__(512, 2) fwd_kernel(Args args) {
    extern __shared__ __attribute__((aligned(16))) unsigned char lds_raw[];
    const int tid0 = threadIdx.x;
    LAS unsigned char* lds0 = (LAS unsigned char*)lds_raw;
    if (tid0 < 4) ((volatile LAS unsigned*)(lds0 + LDS_MISC))[tid0] = 0u;
    __syncthreads();
    unsigned* ctl0 = (unsigned*)(args.ws + WS_CTL);
    XcdBarrier bar; bar.bar = ctl0 + CW_BAR; bar.x = 0; bar.st = nullptr;
    const int lo = args.step_lo, hi = args.step_hi;
    if (hi - lo > 1) bar = xcd_barrier_post(ctl0 + CW_BAR, (volatile LAS unsigned*)(lds0 + LDS_MISC));
    int step = 0;
#ifndef SITE_MASK
#define SITE_MASK 0xFFFFFFFFu
#endif
#define RUN(site, ...) do { if (step >= lo && step < hi) { if constexpr ((SITE_MASK >> (site)) & 1u) { Frame F; { int t_ = tid0; asm volatile("" : "+v"(t_)); frame_init(F, lds_raw, t_); } int* preL = (int*)(F.ldsg + LDS_MISC + 64); (void)preL; __VA_ARGS__; } if (step + 1 < hi) xcd_barrier(bar); } ++step; } while (0)

    RUN(0, { phase_p0_small(F); __syncthreads(); phase_pw(F, 0, 0, F.G); });
    for (int l = 0; l < DEPTH; ++l) {
        RUN(1, { if (l > 0) phase_pw(F, l, 0, F.G); phase_n1(F, l); });
        for (int p = 0; p < 2; ++p) {
            for (int e = 0; e < 2; ++e) {
                const int eg = 2 * p + e;
                RUN(2, { SchedG1 S{(const char*)(F.U + (size_t)eg * TQ * 1024), (const char*)(F.W + W_NAT), (const char*)(F.W + W_VT), F.G, F.bid};
                      EpiG1 E{(bf16_t*)(F.R0 + R_P), (bf16_t*)(F.R0 + R_VT)};
                      pg8::gemm_run<EpiG1, SchedG1>(F.lds, 1024, S, E); });
                RUN(3, { phase_cv(F, l); });
                RUN(4, { const int nbm = F.G >> 1;
                      if (F.bid < nbm) { for (int u = F.bid; u < 128; u += nbm) ml1_unit(F, u >> 5, u & 31, eg); }
                      else { for (int au = (F.bid - nbm) * 8 + F.wave; au < 3072; au += (F.G - nbm) * 8) at_unit(F, au); } });
                RUN(5, { phase_p2(F); });
                RUN(6, { const int nbm = F.G >> 1;
                      if (F.bid < nbm) { for (int u = F.bid * 8 + F.wave; u < 2048; u += nbm * 8) f_hm_unit(F, l, u >> 9, u & 511, eg); }
                      else { for (int t = (F.bid - nbm) * 8 + F.wave; t < TQ; t += (F.G - nbm) * 8) f_ha_token(F, t, eg); } });
            }
            RUN(7, { SchedDense S{(const char*)(F.U + (size_t)p * TP * 1024), (const char*)(F.W + W_G), 2048u, 2048u, 64, 8, F.G, F.bid};
                  EpiG1g E{(bf16_t*)(F.R0 + R_GT)}; pg8::gemm_run<EpiG1g, SchedDense>(F.lds, 1024, S, E); });
            RUN(8, { SchedDense S{(const char*)F.HA, (const char*)(F.W + W_A), 1024u, 1024u, 64, 4, F.G, F.bid};
                  EpiG2<0> E{(bf16_t*)(F.R0 + R_GT)}; pg8::gemm_run<EpiG2<0>, SchedDense>(F.lds, 512, S, E); });
            RUN(9, { SchedDense S{(const char*)F.HM, (const char*)(F.W + W_M), 2048u, 2048u, 64, 4, F.G, F.bid};
                  EpiG2<1> E{(bf16_t*)(F.R0 + R_GT)}; pg8::gemm_run<EpiG2<1>, SchedDense>(F.lds, 1024, S, E); });
            RUN(10, { SchedDense S{(const char*)(F.R0 + R_GT), (const char*)(F.W + W_O), 4096u, 2048u, 64, 4, F.G, F.bid};
                  EpiG3 E{(l == 0 ? F.x : F.out) + (size_t)p * TP * 1024, F.out + (size_t)p * TP * 1024, F.MOD + (size_t)l * 4 * 6144 + 2048, 2 * p};
                  pg8::gemm_run<EpiG3, SchedDense>(F.lds, 1024, S, E); });
        }
        RUN(11, { phase_n2(F, l); });
        RUN(12, { moe_offsets(F.ctl + CW_CNT + 64 * l, preL, F.tid); __syncthreads();
              SchedMoe S{preL, F.ctl + CW_CNT + 64 * l, (const char*)F.U, (const char*)(F.W + W_13), (const int*)(F.R0 + R_SLOT), F.G, F.bid, true};
              EpiG4 E{(bf16_t*)(F.R0 + R_HH)}; pg8::gemm_run<EpiG4, SchedMoe, true>(F.lds, 1024, S, E); });
        RUN(13, { moe_offsets(F.ctl + CW_CNT + 64 * l, preL, F.tid); __syncthreads();
              SchedMoe S{preL, F.ctl + CW_CNT + 64 * l, (const char*)(F.R0 + R_HH), (const char*)(F.W + W_2), (const int*)(F.R0 + R_SLOT), F.G, F.bid, false};
              EpiG5 E{(bf16_t*)(F.R0 + R_YS)}; pg8::gemm_run<EpiG5, SchedMoe>(F.lds, 512, S, E); });
    }
    RUN(14, { phase_fn(F); });
#undef RUN
}

extern "C" void kernel_launch(void* const* d_in, const int* in_sizes, int n_in, void* d_out, int out_size, void* d_ws, size_t ws_size, hipStream_t stream) {
    static int grid = 0;
    if (grid == 0) {
        if (n_in != 19 || out_size != T_TOK * DM || ws_size < WS_END) { fprintf(stderr, "kernel_launch: unexpected problem (n_in %d out %d ws %zu, need %zu)\n", n_in, out_size, ws_size, (size_t)WS_END); grid = -1; return; }
        int dev = 0, cus = 0, per_cu = 0;
        if (hipGetDevice(&dev) != hipSuccess || hipDeviceGetAttribute(&cus, hipDeviceAttributeMultiprocessorCount, dev) != hipSuccess) { grid = -1; return; }
        if (hipFuncSetAttribute((const void*)fwd_kernel, hipFuncAttributeMaxDynamicSharedMemorySize, LDS_BYTES) != hipSuccess) { fprintf(stderr, "kernel_launch: hipFuncSetAttribute failed\n"); grid = -1; return; }
        if (hipOccupancyMaxActiveBlocksPerMultiprocessor(&per_cu, (const void*)fwd_kernel, 512, LDS_BYTES) != hipSuccess || per_cu < 1) { fprintf(stderr, "kernel_launch: occupancy query says %d blocks per CU\n", per_cu); per_cu = 1; }
        (void)hipGetLastError();
        grid = cus;
        if (grid > 256) grid = 256;
        grid &= ~7;
    }
    if (grid <= 0) return;
    (void)hipMemsetAsync((char*)d_ws + WS_CTL, 0, CTL_BYTES, stream);
    Args a{};
    for (int i = 0; i < 19; ++i) a.in[i] = (const float*)d_in[i];
    a.out = (float*)d_out; a.ws = (unsigned char*)d_ws;
#if MK_ONE_LAUNCH
    a.step_lo = 0; a.step_hi = N_STEPS;
    hipLaunchKernelGGL(fwd_kernel, dim3(grid), dim3(512), LDS_BYTES, stream, a);
#else
    for (int s = 0; s < N_STEPS; ++s) { a.step_lo = s; a.step_hi = s + 1; hipLaunchKernelGGL(fwd_kernel, dim3(grid), dim3(512), LDS_BYTES, stream, a); }
#endif
}
```

```cpp
#define MK_ONE_LAUNCH 1
#include <hip/hip_runtime.h>
#include <cstdio>
#include <cstdint>

#define DI __device__ __forceinline__
#define LAS __attribute__((address_space(3)))
typedef unsigned short bf16_t;
typedef short bf16x8 __attribute__((ext_vector_type(8)));
typedef float f32x2 __attribute__((ext_vector_type(2)));
typedef float f32x4 __attribute__((ext_vector_type(4)));
typedef float f32x16 __attribute__((ext_vector_type(16)));
typedef unsigned u32x2 __attribute__((ext_vector_type(2)));
typedef unsigned u32x4 __attribute__((ext_vector_type(4)));
typedef __bf16 nbf16x2 __attribute__((ext_vector_type(2)));

constexpr int T_TOK = 32768, SEQ = 8192, DM = 1024, NBATCH = 4, DEPTH = 2;
constexpr int TQ = 8192;
constexpr int TP = 16384;
constexpr int INC = 10760;
constexpr int NNAT = 6144;
constexpr int NVT = 2560;
constexpr int NEXP = 16, DFF = 512;
constexpr int SLOT_ROWS = 69632;
constexpr float EPS = 1e-6f;

constexpr size_t al256(size_t x) { return (x + 255) & ~(size_t)255; }
constexpr size_t WS_CTL = 0;
constexpr size_t CTL_BYTES = 65536;
constexpr size_t WS_MOD = WS_CTL + CTL_BYTES;
constexpr size_t WS_WIF = WS_MOD + al256((size_t)2 * 4 * 6144 * 4);
constexpr size_t WS_RW = WS_WIF + (size_t)2 * 8 * 1024 * 4;
constexpr size_t WS_W = WS_RW + (size_t)16 * 1024 * 4;
constexpr size_t W_NAT = 0;
constexpr size_t W_VT = W_NAT + (size_t)NNAT * 1024 * 2;
constexpr size_t W_G = W_VT + (size_t)NVT * 1024 * 2;
constexpr size_t W_M = W_G + (size_t)2048 * 1024 * 2;
constexpr size_t W_A = W_M + (size_t)1024 * 1024 * 2;
constexpr size_t W_O = W_A + (size_t)1024 * 512 * 2;
constexpr size_t W_13 = W_O + (size_t)1024 * 1024 * 2;
constexpr size_t W_2 = W_13 + (size_t)16 * 1024 * 1024 * 2;
constexpr size_t W_BYTES = W_2 + (size_t)16 * 1024 * 512 * 2;
constexpr size_t WS_U = WS_W + W_BYTES;
constexpr size_t WS_GIF = WS_U + (size_t)T_TOK * 1024 * 2;
constexpr size_t WS_HM = WS_GIF + (size_t)T_TOK * 8 * 4;
constexpr size_t WS_HA = WS_HM + (size_t)TP * 1024 * 2;
constexpr size_t WS_TOKI = WS_HA + (size_t)TP * 512 * 2;
constexpr size_t WS_R0 = WS_TOKI + (size_t)2 * T_TOK * 32;
constexpr size_t R_P = 0;
constexpr size_t R_VT = R_P + (size_t)TQ * NNAT * 2;
constexpr size_t R_QC = R_VT + (size_t)NVT * TQ * 2;
constexpr size_t R_KC = R_QC + (size_t)TQ * 1024 * 2;
constexpr size_t R_KCT = R_KC + (size_t)TQ * 1024 * 2;
constexpr size_t R_NUM = R_KCT + (size_t)TQ * 1024 * 2;
constexpr size_t R_SLOC = R_NUM + (size_t)TQ * 1024 * 4;
constexpr size_t R_CST = R_SLOC + (size_t)4 * 32 * 65536 * 4;
constexpr size_t R_DENI = R_CST + (size_t)4 * 32 * 65536 * 2;
constexpr size_t R_EBC = R_DENI + (size_t)TQ * 4 * 4;
constexpr size_t R_EBL = R_EBC + (size_t)TQ * 4 * 4;
constexpr size_t R_SCB = R_EBL + (size_t)TQ * 4 * 4;
constexpr size_t R_CHB = R_SCB + 1024;
constexpr size_t R_DN = R_CHB + 2048;
constexpr size_t R_NST = R_DN + (size_t)4 * 128 * 256 * 4;
constexpr size_t R_LSE = R_NST + (size_t)4 * 128 * 256 * 4;
constexpr size_t R_END = R_LSE + (size_t)TQ * 12 * 4;
constexpr size_t R_GT = 0;
constexpr size_t R_HH = 0;
constexpr size_t R_YS = R_HH + (size_t)SLOT_ROWS * 512 * 2;
constexpr size_t R_SLOT = R_YS + (size_t)SLOT_ROWS * 1024 * 2;
constexpr size_t R_END2 = R_SLOT + (size_t)16 * 32768 * 4;
constexpr size_t WS_END = WS_R0 + (R_END > R_END2 ? R_END : R_END2);
static_assert(WS_END <= (size_t)536870912, "workspace over 512 MiB");

constexpr int CW_BAR = 0;
constexpr int CW_CNT = 4096;

DI float bflo(unsigned w) { return __uint_as_float(w << 16); }
DI float bfhi(unsigned w) { return __uint_as_float(w & 0xffff0000u); }
DI unsigned pack2(float lo, float hi) { f32x2 v = {lo, hi}; nbf16x2 b = __builtin_convertvector(v, nbf16x2); return __builtin_bit_cast(unsigned, b); }
DI float sigmoidf_(float x) { return __builtin_amdgcn_rcpf(1.0f + __expf(-x)); }
DI float siluf_(float x) { return x * sigmoidf_(x); }
DI float wave_sum(float v) { for (int o = 32; o >= 1; o >>= 1) v += __shfl_xor(v, o); return v; }
DI int crow(int reg, int h) { return (reg & 3) + 8 * (reg >> 2) + 4 * h; }
DI int pi23(int m) { return (m & ~12) | ((m & 4) << 1) | ((m & 8) >> 1); }
#define MFMA32(a, b, c) __builtin_amdgcn_mfma_f32_32x32x16_bf16((a), (b), (c), 0, 0, 0)
DI bf16x8 packf8(float a0, float a1, float a2, float a3, float a4, float a5, float a6, float a7) {
    u32x4 p; p.x = pack2(a0, a1); p.y = pack2(a2, a3); p.z = pack2(a4, a5); p.w = pack2(a6, a7); return __builtin_bit_cast(bf16x8, p); }
DI bf16x8 ldg8(const bf16_t* p) { return *(const bf16x8*)p; }
#define XB_TMO      128
#define XB_XCNT(j)  (256  + 64 * (j))
#define XB_XSUB(j)  (1280 + 64 * (j))
#define XB_XGEN(j)  (2304 + 64 * (j))
#define XB_TOP      3328
#define XB_TOPGEN   3392
#define XCD_BAR_WORDS 3456
#define XB_SPIN_CAP (1u << 21)

__device__ __forceinline__ unsigned xb_ld(unsigned* p)              { return __hip_atomic_load(p, __ATOMIC_RELAXED, __HIP_MEMORY_SCOPE_AGENT); }
__device__ __forceinline__ unsigned xb_add(unsigned* p, unsigned v) { return __hip_atomic_fetch_add(p, v, __ATOMIC_RELAXED, __HIP_MEMORY_SCOPE_AGENT); }
__device__ __forceinline__ unsigned xb_xcc_id() { return (unsigned)__builtin_amdgcn_s_getreg((3 << 11) | 20) & 0xFu; }
#define XB_SPIN(cond, bar) do { unsigned _sp = 0; while (cond) { __builtin_amdgcn_s_sleep(1); \
    if ((++_sp & 255u) == 0u) { if (xb_ld(&(bar)[XB_TMO])) break; if (_sp > XB_SPIN_CAP) { atomicAdd(&(bar)[XB_TMO], 1u); break; } } } } while (0)

struct XcdBarrier {
    unsigned* bar; unsigned x;
    volatile LAS unsigned* st;
};

__device__ __forceinline__ XcdBarrier xcd_barrier_post(unsigned* bar, volatile LAS unsigned* st) {
    XcdBarrier b; b.bar = bar; b.x = xb_xcc_id(); b.st = st;
    if (threadIdx.x == 0) (void)xb_add(&bar[XB_XCNT(b.x)], 1u);
    return b;
}
__device__ __forceinline__ void xcd_barrier_complete(unsigned* bar, unsigned x, unsigned& nloc, unsigned& nx) {
    const unsigned G = gridDim.x * gridDim.y * gridDim.z;
    unsigned sum, cnt, mine, sp = 0u;
    for (;;) {
        sum = 0u; cnt = 0u; mine = 0u;
#pragma unroll
        for (unsigned j = 0; j < 16; ++j) { const unsigned c = xb_ld(&bar[XB_XCNT(j)]); sum += c; cnt += (c > 0u) ? 1u : 0u; mine = (j == x) ? c : mine; }
        if (sum == G) break;
        __builtin_amdgcn_s_sleep(1);
        if ((++sp & 255u) == 0u) { if (xb_ld(&bar[XB_TMO])) break; if (sp > XB_SPIN_CAP) { atomicAdd(&bar[XB_TMO], 1u); break; } }
    }
    nloc = mine > 0u ? mine : 1u; nx = cnt > 0u ? cnt : 1u;
}

__device__ __forceinline__ void xcd_barrier(const XcdBarrier& b) {
    asm volatile("s_waitcnt vmcnt(0)" ::: "memory");
    __syncthreads();
    if (threadIdx.x == 0) {
        unsigned* bar = b.bar;
        __builtin_amdgcn_s_waitcnt(0);
        unsigned nloc = b.st[0], nx = b.st[1];
        if (nloc == 0u) { xcd_barrier_complete(bar, b.x, nloc, nx); b.st[0] = nloc; b.st[1] = nx; }
        const unsigned old = xb_add(&bar[XB_XSUB(b.x)], 1u);
        const unsigned gen = old / nloc;
        if (old + 1u == (gen + 1u) * nloc) {
            __builtin_amdgcn_fence(__ATOMIC_RELEASE, "agent");
            asm volatile("s_waitcnt vmcnt(0)" ::: "memory");
            const unsigned og = xb_add(&bar[XB_TOP], 1u);
            const unsigned tg = og / nx;
            if (og + 1u == (tg + 1u) * nx) xb_add(&bar[XB_TOPGEN], 1u);
            else XB_SPIN(xb_ld(&bar[XB_TOPGEN]) == tg, bar);
            __builtin_amdgcn_fence(__ATOMIC_ACQUIRE, "agent");
            xb_add(&bar[XB_XGEN(b.x)], 1u);
            asm volatile("s_waitcnt vmcnt(0)" ::: "memory");
        } else {
            XB_SPIN(xb_ld(&bar[XB_XGEN(b.x)]) == gen, bar);
            __builtin_amdgcn_fence(__ATOMIC_ACQUIRE, "agent");
            asm volatile("s_waitcnt vmcnt(0)" ::: "memory");
        }
    }
    __syncthreads();
}
namespace pg8 {
constexpr int BM = 256, BK = 64, HALF = 128, HTB = HALF * BK * 2, STAGE_BYTES = 8 * HTB, NXCD = 8, WGM = 8;
DI int lds_byte(int r, int c) { const int st = (r >> 4) * 2 + (c >> 5), rr = r & 15, cc = c & 31, ob = rr * 64 + cc * 2; return st * 1024 + (ob ^ (((ob >> 9) & 1) << 5)); }
DI void stage_rc(int b, int& R, int& C) { const int st = b / 1024, sb = b % 1024, swz = sb ^ (((sb >> 9) & 1) << 5); R = (st >> 1) * 16 + swz / 64; C = (st & 1) * 32 + (swz % 64) / 2; }
DI int perm32(int rho) { const int n = rho >> 4, i = rho & 15; return 8 * (i >> 2) + 4 * n + (i & 3); }

struct UnitD {
    const char* A; const char* B;
    unsigned lda, ldb;
    const int* arows; int acount;
    int kind, pm, pn, aux;
};
DI void tile_map(int L, int nM, int nN, int& pm, int& pn) {
    const int nwg = nM * nN; int wgid = L;
    { const int q = nwg / NXCD, r = nwg % NXCD, xcd = wgid % NXCD, off = wgid / NXCD; wgid = (xcd < r ? xcd * (q + 1) : r * (q + 1) + (xcd - r) * q) + off; }
    const int nig = WGM * nN, gid = wgid / nig, fm = gid * WGM, gsz = (nM - fm) < WGM ? (nM - fm) : WGM;
    pm = fm + ((wgid % nig) % gsz); pn = (wgid % nig) / gsz;
}
template <bool PERM, bool GATHER>
DI void unit_off(const UnitD& u, int tid, unsigned (&offA)[2][2], unsigned (&offB)[2]) {
#pragma unroll
    for (int i = 0; i < 2; ++i) {
        int R, C; stage_rc(tid * 16 + i * 8192, R, C);
        const int Rb = PERM ? ((R & ~31) + perm32(R & 31)) : R;
        offB[i] = (unsigned)Rb * u.ldb + (unsigned)C * 2u;
        if (GATHER) {
#pragma unroll
            for (int h = 0; h < 2; ++h) { const int ra = h * HALF + R; const int rr = ra < u.acount ? ra : 0; offA[h][i] = (unsigned)u.arows[rr] * u.lda + (unsigned)C * 2u; }
        } else { offA[0][i] = (unsigned)R * u.lda + (unsigned)C * 2u; offA[1][i] = 0u; }
    }
}

template <class Epi, class Sched, bool GATHER = false>
DI void gemm_run(LAS unsigned char* lds, const int K, const Sched& S, const Epi& E) {
    int tid_ = threadIdx.x; asm volatile("" : "+v"(tid_));
    const int tid = tid_, wid = __builtin_amdgcn_readfirstlane(tid >> 6), lane = tid & 63, wr = wid >> 2, wc = wid & 3, fr = lane & 15, fq = lane >> 4;
    const int nt = K / BK;
    const size_t kstep = (size_t)(BK * 2);
    const unsigned ldsw = (unsigned)wid * 1024u;
    const int aoff = lds_byte(wr * 64 + fr, fq * 8), boff = lds_byte(wc * 32 + fr, fq * 8);
#define PG8_SA(b, h) (((b) * 2 + (h)) * HTB)
#define PG8_SB(b, h) ((4 + (b) * 2 + (h)) * HTB)
#define PG8_STAGE(bufoff, gbase, voff) do { _Pragma("unroll") for (int _i = 0; _i < 2; ++_i) \
        __builtin_amdgcn_global_load_lds((const unsigned*)((const char*)(gbase) + (voff)[_i]), (LAS unsigned*)(lds + (bufoff) + ldsw + _i * 8192), 16, 0, 0); } while (0)
#define PG8_LDA(dst, b, h) do { _Pragma("unroll") for (int m = 0; m < 4; ++m) _Pragma("unroll") for (int k = 0; k < 2; ++k) dst[m][k] = *(const LAS bf16x8*)(lds + PG8_SA(b, h) + aoff + m * 2048 + k * 1024); } while (0)
#define PG8_LDB(dst, b, h) do { _Pragma("unroll") for (int n = 0; n < 2; ++n) _Pragma("unroll") for (int k = 0; k < 2; ++k) dst[n][k] = *(const LAS bf16x8*)(lds + PG8_SB(b, h) + boff + n * 2048 + k * 1024); } while (0)
#define PG8_MMA(ai, bj, At, Bt) do { __builtin_amdgcn_s_setprio(1); _Pragma("unroll") for (int m = 0; m < 4; ++m) _Pragma("unroll") for (int n = 0; n < 2; ++n) _Pragma("unroll") for (int k = 0; k < 2; ++k) \
        acc[ai][bj][m][n] = __builtin_amdgcn_mfma_f32_16x16x32_bf16(Bt[n][k], At[m][k], acc[ai][bj][m][n], 0, 0, 0); __builtin_amdgcn_s_setprio(0); } while (0)
#define PG8_WAIT_V(n) asm volatile("s_waitcnt vmcnt(" #n ")" ::: "memory")
#define PG8_WAIT_L(n) asm volatile("s_waitcnt lgkmcnt(" #n ")" ::: "memory")
#define PG8_BAR __builtin_amdgcn_s_barrier()
#define PG8_SCHED __builtin_amdgcn_sched_barrier(0)
    UnitD cur, nxt; int ui = 0;
    if (!S.next(0, cur)) return;
    unsigned offA[2][2], offB[2];
    unit_off<Epi::PERM, GATHER>(cur, tid, offA, offB);
    size_t hA = GATHER ? 0 : (size_t)HALF * cur.lda, hB = (size_t)HALF * cur.ldb;
#define OA(h) offA[GATHER ? (h) : 0]
    f32x4 acc[2][2][4][2];
#pragma unroll
    for (int a = 0; a < 2; ++a)
#pragma unroll
        for (int b = 0; b < 2; ++b)
#pragma unroll
            for (int m = 0; m < 4; ++m)
#pragma unroll
                for (int n = 0; n < 2; ++n) acc[a][b][m][n] = (f32x4){0.f, 0.f, 0.f, 0.f};
    bf16x8 At[4][2], B0[2][2], B1[2][2];
    PG8_STAGE(PG8_SB(0, 0), cur.B, offB); PG8_STAGE(PG8_SA(0, 0), cur.A, OA(0)); PG8_STAGE(PG8_SB(0, 1), cur.B + hB, offB); PG8_STAGE(PG8_SA(0, 1), cur.A + hA, OA(1));
    if (wr == 1) PG8_BAR;
    PG8_WAIT_V(4); PG8_BAR;
    PG8_STAGE(PG8_SB(1, 0), cur.B + kstep, offB); PG8_STAGE(PG8_SA(1, 0), cur.A + kstep, OA(0)); PG8_STAGE(PG8_SB(1, 1), cur.B + kstep + hB, offB);
    PG8_WAIT_V(6); PG8_BAR;
    for (;;) {
        const bool has_next = S.next(ui + 1, nxt);
        for (int t = 0; t < nt; t += 2) {
            const bool last = (t == nt - 2);
            const char* a1 = cur.A + (size_t)(t + 1) * kstep;
            PG8_LDB(B0, 0, 0); PG8_SCHED; PG8_LDA(At, 0, 0); PG8_STAGE(PG8_SA(1, 1), a1 + hA, OA(1));
            PG8_WAIT_L(8); PG8_BAR; PG8_WAIT_L(0); PG8_MMA(0, 0, At, B0); PG8_BAR; PG8_SCHED;
            const char* a2; const char* b2;
            if (last) { if (has_next) { unit_off<Epi::PERM, GATHER>(nxt, tid, offA, offB); a2 = nxt.A; b2 = nxt.B; hA = GATHER ? 0 : (size_t)HALF * nxt.lda; hB = (size_t)HALF * nxt.ldb; } else { a2 = cur.A; b2 = cur.B; } }
            else { a2 = cur.A + (size_t)(t + 2) * kstep; b2 = cur.B + (size_t)(t + 2) * kstep; }
            const char* a3 = a2 + kstep; const char* b3 = b2 + kstep;
            PG8_LDB(B1, 0, 1); PG8_STAGE(PG8_SB(0, 0), b2, offB);
            PG8_BAR; PG8_WAIT_L(0); PG8_MMA(0, 1, At, B1); PG8_BAR;
            PG8_LDA(At, 0, 1); PG8_STAGE(PG8_SA(0, 0), a2, OA(0));
            PG8_BAR; PG8_WAIT_L(0); PG8_MMA(1, 0, At, B0); PG8_BAR; PG8_SCHED;
            PG8_STAGE(PG8_SB(0, 1), b2 + hB, offB);
            PG8_WAIT_V(6); PG8_BAR; PG8_MMA(1, 1, At, B1); PG8_BAR;
            PG8_LDB(B0, 1, 0); PG8_SCHED; PG8_LDA(At, 1, 0); PG8_STAGE(PG8_SA(0, 1), a2 + hA, OA(1));
            PG8_WAIT_L(8); PG8_BAR; PG8_WAIT_L(0); PG8_MMA(0, 0, At, B0); PG8_BAR; PG8_SCHED;
            PG8_LDB(B1, 1, 1); PG8_STAGE(PG8_SB(1, 0), b3, offB);
            PG8_BAR; PG8_WAIT_L(0); PG8_MMA(0, 1, At, B1); PG8_BAR;
            PG8_LDA(At, 1, 1); PG8_STAGE(PG8_SA(1, 0), a3, OA(0));
            PG8_BAR; PG8_WAIT_L(0); PG8_MMA(1, 0, At, B0); PG8_BAR; PG8_SCHED;
            PG8_STAGE(PG8_SB(1, 1), b3 + hB, offB);
            PG8_WAIT_V(6); PG8_BAR; PG8_MMA(1, 1, At, B1); PG8_BAR;
        }
        { int fr_ = fr, fq_ = fq; asm volatile("" : "+v"(fr_), "+v"(fq_)); E(acc, cur, wr, wc, fr_, fq_); }
        if (!has_next) break;
#pragma unroll
        for (int a = 0; a < 2; ++a)
#pragma unroll
            for (int b = 0; b < 2; ++b)
#pragma unroll
                for (int m = 0; m < 4; ++m)
#pragma unroll
                    for (int n = 0; n < 2; ++n) acc[a][b][m][n] = (f32x4){0.f, 0.f, 0.f, 0.f};
        cur = nxt; ++ui;
    }
    PG8_WAIT_V(0);
    if (wr == 0) PG8_BAR;
    PG8_BAR;
#undef OA
#undef PG8_SA
#undef PG8_SB
#undef PG8_STAGE
#undef PG8_LDA
#undef PG8_LDB
#undef PG8_MMA
#undef PG8_WAIT_V
#undef PG8_WAIT_L
#undef PG8_BAR
#undef PG8_SCHED
}
}
struct Args { const float* in[19]; float* out; unsigned char* ws; int step_lo, step_hi; };
struct Frame {
    LAS unsigned char* lds; unsigned char* ldsg;
    int tid, lane, wave, G, bid;
    const float *x, *c, *ada_w, *ada_b, *w_in, *conv_w, *gate_b, *norm_g, *w_bm, *w_ba, *w_out, *router_w, *router_b, *w_gate, *w_up, *w_down, *g_mix, *g_ffn, *g_fin;
    float* out; unsigned char* ws; unsigned* ctl;
    float* MOD; float* WIF; float* RW; unsigned char* W;
    bf16_t* U; float* GIF; bf16_t* HM; bf16_t* HA; unsigned char* TOKI; unsigned char* R0;
};
#define CAS __attribute__((address_space(4)))
DI const void* karg(int idx) { asm volatile("" : "+s"(idx)); const void* const CAS* kp = (const void* const CAS*)__builtin_amdgcn_kernarg_segment_ptr(); return kp[idx]; }
DI void frame_init(Frame& F, unsigned char* lds_generic, int tid) {
    F.ldsg = lds_generic; F.lds = (LAS unsigned char*)lds_generic;
    F.tid = tid; F.lane = F.tid & 63; F.wave = __builtin_amdgcn_readfirstlane(F.tid >> 6); F.G = gridDim.x; F.bid = blockIdx.x;
    F.x = (const float*)karg(0); F.c = (const float*)karg(1); F.ada_w = (const float*)karg(2); F.ada_b = (const float*)karg(3); F.w_in = (const float*)karg(4); F.conv_w = (const float*)karg(5);
    F.gate_b = (const float*)karg(6); F.norm_g = (const float*)karg(7); F.w_bm = (const float*)karg(8); F.w_ba = (const float*)karg(9); F.w_out = (const float*)karg(10); F.router_w = (const float*)karg(11);
    F.router_b = (const float*)karg(12); F.w_gate = (const float*)karg(13); F.w_up = (const float*)karg(14); F.w_down = (const float*)karg(15); F.g_mix = (const float*)karg(16); F.g_ffn = (const float*)karg(17); F.g_fin = (const float*)karg(18);
    F.out = (float*)karg(19); unsigned char* ws = (unsigned char*)karg(20);
    F.ws = ws; F.ctl = (unsigned*)(ws + WS_CTL);
    F.MOD = (float*)(ws + WS_MOD); F.WIF = (float*)(ws + WS_WIF); F.RW = (float*)(ws + WS_RW); F.W = ws + WS_W;
    F.U = (bf16_t*)(ws + WS_U); F.GIF = (float*)(ws + WS_GIF); F.HM = (bf16_t*)(ws + WS_HM); F.HA = (bf16_t*)(ws + WS_HA);
    F.TOKI = ws + WS_TOKI; F.R0 = ws + WS_R0;
}

struct TJob { const float* src; int ld; int K; int N; bf16_t* dst; int rmul, radd; };
DI bool get_job(const Frame& F, int l, int j, TJob& J) {
    const float* win = F.w_in + (size_t)l * DM * INC;
    bf16_t* W = (bf16_t*)F.W;
    J.rmul = 1; J.radd = 0; J.K = 1024; J.ld = INC;
    if (j == 0) { J.src = win + 0;    J.N = 1024; J.dst = W + W_NAT / 2 + (size_t)0 * 1024; return true; }
    if (j == 1) { J.src = win + 1024; J.N = 1024; J.dst = W + W_NAT / 2 + (size_t)1024 * 1024; return true; }
    if (j == 2) { J.src = win + 3072; J.N = 1024; J.dst = W + W_NAT / 2 + (size_t)2048 * 1024; return true; }
    if (j == 3) { J.src = win + 4104; J.N = 1536; J.dst = W + W_NAT / 2 + (size_t)3072 * 1024; return true; }
    if (j == 4) { J.src = win + 5640; J.N = 1536; J.dst = W + W_NAT / 2 + (size_t)4608 * 1024; return true; }
    if (j == 5) { J.src = win + 2048; J.N = 1024; J.dst = W + W_VT / 2 + (size_t)0 * 1024; return true; }
    if (j == 6) { J.src = win + 7176; J.N = 1536; J.dst = W + W_VT / 2 + (size_t)1024 * 1024; return true; }
    if (j == 7) { J.src = win + 8712; J.N = 2048; J.dst = W + W_G / 2; return true; }
    if (j == 8) { J.src = F.w_bm + (size_t)l * 1024 * 1024; J.ld = 1024; J.N = 1024; J.dst = W + W_M / 2; return true; }
    if (j == 9) { J.src = F.w_ba + (size_t)l * 512 * 1024; J.ld = 1024; J.K = 512; J.N = 1024; J.dst = W + W_A / 2; return true; }
    if (j == 10) { J.src = F.w_out + (size_t)l * 1024 * 1024; J.ld = 1024; J.N = 1024; J.dst = W + W_O / 2; return true; }
    const int q = j - 11; if (q >= 48) return false;
    const int e = q / 3, which = q % 3;
    if (which == 0) { J.src = F.w_gate + ((size_t)l * 16 + e) * 1024 * 512; J.ld = 512; J.N = 512; J.dst = W + W_13 / 2 + (size_t)e * 1024 * 1024; J.rmul = 2; J.radd = 0; }
    else if (which == 1) { J.src = F.w_up + ((size_t)l * 16 + e) * 1024 * 512; J.ld = 512; J.N = 512; J.dst = W + W_13 / 2 + (size_t)e * 1024 * 1024; J.rmul = 2; J.radd = 1; }
    else { J.src = F.w_down + ((size_t)l * 16 + e) * 512 * 1024; J.ld = 1024; J.K = 512; J.N = 1024; J.dst = W + W_2 / 2 + (size_t)e * 1024 * 512; }
    return true;
}
constexpr int NJOBS = 59;
DI void tconv_tile(const Frame& F, const TJob& J, int tk, int tn) {
    bf16_t* tl = (bf16_t*)F.ldsg;
    const int tid = F.tid;
#pragma unroll
    for (int i = 0; i < 2; ++i) {
        const int row = (tid >> 4) + 32 * i, c4 = tid & 15;
        const f32x4 v = *(const f32x4*)(J.src + (size_t)(tk * 64 + row) * J.ld + tn * 64 + c4 * 4);
        const unsigned lo = pack2(v[0], v[1]), hi = pack2(v[2], v[3]);
        tl[(c4 * 4 + 0) * 72 + row] = (bf16_t)(lo & 0xffff); tl[(c4 * 4 + 1) * 72 + row] = (bf16_t)(lo >> 16);
        tl[(c4 * 4 + 2) * 72 + row] = (bf16_t)(hi & 0xffff); tl[(c4 * 4 + 3) * 72 + row] = (bf16_t)(hi >> 16);
    }
    __syncthreads();
    { const int n = tid >> 3, k8 = tid & 7;
      const u32x4 v = *(const u32x4*)(tl + n * 72 + k8 * 8);
      *(u32x4*)(J.dst + (size_t)(J.rmul * (tn * 64 + n) + J.radd) * J.K + tk * 64 + k8 * 8) = v; }
    __syncthreads();
}
DI void phase_pw(const Frame& F, int l, int b0, int nb) {
    const int me = F.bid - b0; if (me < 0 || me >= nb) return;
    int base = 0;
    for (int j = 0; j < NJOBS; ++j) {
        TJob J; get_job(F, l, j, J);
        const int nk = J.K / 64, nn = J.N / 64, ntile = nk * nn;
        int t = (me - base % nb + nb) % nb;
        for (; t < ntile; t += nb) tconv_tile(F, J, t % nk, t / nk);
        base += ntile;
    }
}
DI void phase_p0_small(const Frame& F) {
    float* sc = (float*)F.ldsg;
    float* part = sc + 4096;
    for (int i = F.tid; i < 4096; i += 512) sc[i] = siluf_(F.c[i]);
    __syncthreads();
    for (int it = F.bid; it < 192; it += F.G) {
        const int l = it / 96, cc = it % 96, col = cc * 64 + F.lane, w = F.wave;
        const float* aw = F.ada_w + (size_t)l * 1024 * 6144 + col;
        float a0 = 0.f, a1 = 0.f, a2 = 0.f, a3 = 0.f;
        for (int k = w * 128; k < w * 128 + 128; ++k) { const float wv = aw[(size_t)k * 6144]; a0 += sc[k] * wv; a1 += sc[1024 + k] * wv; a2 += sc[2048 + k] * wv; a3 += sc[3072 + k] * wv; }
        part[(w * 4 + 0) * 64 + F.lane] = a0; part[(w * 4 + 1) * 64 + F.lane] = a1; part[(w * 4 + 2) * 64 + F.lane] = a2; part[(w * 4 + 3) * 64 + F.lane] = a3;
        __syncthreads();
        if (F.tid < 256) { const int b = F.tid >> 6, ln = F.tid & 63; float s = 0.f;
            for (int ww = 0; ww < 8; ++ww) s += part[(ww * 4 + b) * 64 + ln];
            F.MOD[((size_t)l * 4 + b) * 6144 + cc * 64 + ln] = s + F.ada_b[(size_t)l * 6144 + cc * 64 + ln]; }
        __syncthreads();
    }
    for (int i = F.bid * 512 + F.tid; i < 2 * 8 * 1024 + 16 * 1024; i += F.G * 512) {
        if (i < 16384) { const int l = i >> 13, j = (i >> 10) & 7, k = i & 1023; F.WIF[i] = F.w_in[((size_t)l * 1024 + k) * INC + 4096 + j]; }
        else { const int q = i - 16384, e = q >> 10, k = q & 1023; F.RW[q] = F.router_w[k * 16 + e]; }
    }
}

DI void moe_offsets(const unsigned* cnt, int* pre, int tid) { if (tid == 0) { int s = 0; for (int e = 0; e < 16; ++e) { pre[e] = s; s += ((int)cnt[e] + 255) >> 8; } pre[16] = s; } }

struct RowCtx { float gm[16], sh[16]; };
DI void load_rowconst(const Frame& F, const float* g, const float* shv, const float* scv, RowCtx& rc) {
#pragma unroll
    for (int q = 0; q < 4; ++q) { const int c = F.lane * 4 + 256 * q; const f32x4 gv = *(const f32x4*)(g + c), s1 = *(const f32x4*)(scv + c), s0 = *(const f32x4*)(shv + c);
#pragma unroll
        for (int j = 0; j < 4; ++j) { rc.gm[q * 4 + j] = gv[j] * (1.0f + s1[j]); rc.sh[q * 4 + j] = s0[j]; } }
}
DI void moe_combine_row(const Frame& F, int lprev, int t, int b, const int* pre, float (&xv)[16]) {
    const int* ti = (const int*)(F.TOKI + ((size_t)lprev * T_TOK + t) * 32);
    const int e1 = ti[0], s1 = ti[1], e2 = ti[2], s2 = ti[3]; const float w1 = __int_as_float(ti[4]), w2 = __int_as_float(ti[5]);
    const bf16_t* YS = (const bf16_t*)(F.R0 + R_YS);
    const bf16_t* y1 = YS + (size_t)(pre[e1] * 256 + s1) * 1024; const bf16_t* y2 = YS + (size_t)(pre[e2] * 256 + s2) * 1024;
    const float* gt = F.MOD + ((size_t)lprev * 4 + b) * 6144 + 5120;
#pragma unroll
    for (int q = 0; q < 4; ++q) { const int c = F.lane * 4 + 256 * q; const u32x2 a = *(const u32x2*)(y1 + c), d = *(const u32x2*)(y2 + c); const f32x4 g = *(const f32x4*)(gt + c);
        xv[q * 4 + 0] += g[0] * (w1 * bflo(a.x) + w2 * bflo(d.x)); xv[q * 4 + 1] += g[1] * (w1 * bfhi(a.x) + w2 * bfhi(d.x));
        xv[q * 4 + 2] += g[2] * (w1 * bflo(a.y) + w2 * bflo(d.y)); xv[q * 4 + 3] += g[3] * (w1 * bfhi(a.y) + w2 * bfhi(d.y)); }
}
DI void phase_n1(const Frame& F, int l) {
    float* wif = (float*)F.ldsg;
    int* pre = (int*)(F.ldsg + 32768);
    for (int i = F.tid; i < 8192; i += 512) wif[i] = F.WIF[(size_t)l * 8192 + i];
    if (l > 0) moe_offsets(F.ctl + CW_CNT + 64 * (l - 1), pre, F.tid);
    __syncthreads();
    for (int blk = F.bid; blk < T_TOK / 128; blk += F.G) {
        const int b = blk / (SEQ / 128);
        const float* mod = F.MOD + ((size_t)l * 4 + b) * 6144;
        RowCtx rc; load_rowconst(F, F.g_mix + (size_t)l * 1024, mod, mod + 1024, rc);
#pragma unroll 1
        for (int i = 0; i < 16; ++i) {
            const int t = blk * 128 + F.wave * 16 + i;
            asm volatile("" ::: "memory");
            float xv[16];
            const float* xr = (l == 0 ? F.x : F.out) + (size_t)t * 1024;
#pragma unroll
            for (int q = 0; q < 4; ++q) { const f32x4 v = *(const f32x4*)(xr + F.lane * 4 + 256 * q); xv[q * 4] = v[0]; xv[q * 4 + 1] = v[1]; xv[q * 4 + 2] = v[2]; xv[q * 4 + 3] = v[3]; }
            if (l > 0) {
                moe_combine_row(F, l - 1, t, b, pre, xv);
#pragma unroll
                for (int q = 0; q < 4; ++q) *(f32x4*)(F.out + (size_t)t * 1024 + F.lane * 4 + 256 * q) = (f32x4){xv[q * 4], xv[q * 4 + 1], xv[q * 4 + 2], xv[q * 4 + 3]};
            }
            float ss = 0.f;
#pragma unroll
            for (int j = 0; j < 16; ++j) ss += xv[j] * xv[j];
            ss = wave_sum(ss);
            const float rn = __builtin_amdgcn_rsqf(ss * (1.0f / 1024.0f) + EPS);
            float uv[16];
#pragma unroll
            for (int j = 0; j < 16; ++j) uv[j] = xv[j] * rn * rc.gm[j] + rc.sh[j];
#pragma unroll
            for (int q = 0; q < 4; ++q) { u32x2 w; w.x = pack2(uv[q * 4], uv[q * 4 + 1]); w.y = pack2(uv[q * 4 + 2], uv[q * 4 + 3]); *(u32x2*)(F.U + (size_t)t * 1024 + F.lane * 4 + 256 * q) = w; }
            float d[8];
#pragma unroll
            for (int g = 0; g < 8; ++g) { float s = 0.f;
#pragma unroll
                for (int q = 0; q < 4; ++q) { const f32x4 wv = *(const f32x4*)(wif + g * 1024 + F.lane * 4 + 256 * q); s += uv[q * 4] * wv[0] + uv[q * 4 + 1] * wv[1] + uv[q * 4 + 2] * wv[2] + uv[q * 4 + 3] * wv[3]; }
                d[g] = wave_sum(s); }
            if (F.lane < 8) {
                float v = 0.f;
#pragma unroll
                for (int g = 0; g < 8; ++g) v = (F.lane == g) ? d[g] : v;
                v += F.gate_b[l * 8 + F.lane];
                if (F.lane >= 4) { const float e = __expf(-fabsf(v)); const float l1p = (e < 0.03f) ? e * (1.0f - e * (0.5f - e * (0.33333334f - 0.25f * e))) : __logf(1.0f + e); v = fminf(v, 0.f) - l1p; }
                F.GIF[(size_t)t * 8 + F.lane] = v;
            }
        }
    }
}

DI void phase_n2(const Frame& F, int l) {
    float* rw = (float*)F.ldsg;
    int* cntL = (int*)(F.ldsg + 65536);
    int* baseL = cntL + 16;
    int* rec = baseL + 16;
    for (int i = F.tid; i < 16384; i += 512) rw[i] = F.RW[i];
    __syncthreads();
    unsigned* gcnt = F.ctl + CW_CNT + 64 * l;
    int* SLOT = (int*)(F.R0 + R_SLOT);
    for (int blk = F.bid; blk < T_TOK / 128; blk += F.G) {
        const int b = blk / (SEQ / 128);
        const float* mod = F.MOD + ((size_t)l * 4 + b) * 6144;
        RowCtx rc; load_rowconst(F, F.g_ffn + (size_t)l * 1024, mod + 3072, mod + 4096, rc);
        if (F.tid < 16) cntL[F.tid] = 0;
        __syncthreads();
#pragma unroll 1
        for (int i = 0; i < 16; ++i) {
            const int rl = F.wave * 16 + i, t = blk * 128 + rl;
            asm volatile("" ::: "memory");
            float xv[16];
#pragma unroll
            for (int q = 0; q < 4; ++q) { const f32x4 v = *(const f32x4*)(F.out + (size_t)t * 1024 + F.lane * 4 + 256 * q); xv[q * 4] = v[0]; xv[q * 4 + 1] = v[1]; xv[q * 4 + 2] = v[2]; xv[q * 4 + 3] = v[3]; }
            float ss = 0.f;
#pragma unroll
            for (int j = 0; j < 16; ++j) ss += xv[j] * xv[j];
            ss = wave_sum(ss);
            const float rn = __builtin_amdgcn_rsqf(ss * (1.0f / 1024.0f) + EPS);
            float uv[16];
#pragma unroll
            for (int j = 0; j < 16; ++j) uv[j] = xv[j] * rn * rc.gm[j] + rc.sh[j];
#pragma unroll
            for (int q = 0; q < 4; ++q) { u32x2 w; w.x = pack2(uv[q * 4], uv[q * 4 + 1]); w.y = pack2(uv[q * 4 + 2], uv[q * 4 + 3]); *(u32x2*)(F.U + (size_t)t * 1024 + F.lane * 4 + 256 * q) = w; }
            float mine = 0.f;
#pragma unroll
            for (int e = 0; e < 16; ++e) { float s = 0.f;
#pragma unroll
                for (int q = 0; q < 4; ++q) { const f32x4 wv = *(const f32x4*)(rw + e * 1024 + F.lane * 4 + 256 * q); s += uv[q * 4] * wv[0] + uv[q * 4 + 1] * wv[1] + uv[q * 4 + 2] * wv[2] + uv[q * 4 + 3] * wv[3]; }
                s = wave_sum(s); mine = (F.lane == e) ? s : mine; }
            const float score = 1.0f / (1.0f + __expf(-mine));
            const float sel = score + ((F.lane < 16) ? F.router_b[F.lane] : 0.f);
            const float s0 = __shfl(sel, (F.lane & ~3) + 0), s1 = __shfl(sel, (F.lane & ~3) + 1), s2 = __shfl(sel, (F.lane & ~3) + 2), s3 = __shfl(sel, (F.lane & ~3) + 3);
            const float mx = fmaxf(fmaxf(s0, s1), fmaxf(s2, s3));
            const int im = (s0 == mx) ? 0 : (s1 == mx) ? 1 : (s2 == mx) ? 2 : 3;
            const float t0 = (im == 0) ? -INFINITY : s0, t1 = (im == 1) ? -INFINITY : s1, t2 = (im == 2) ? -INFINITY : s2, t3 = (im == 3) ? -INFINITY : s3;
            const float mx2 = fmaxf(fmaxf(t0, t1), fmaxf(t2, t3));
            const int im2 = (t0 == mx2) ? 0 : (t1 == mx2) ? 1 : (t2 == mx2) ? 2 : 3;
            const float gs = mx + mx2;
            const float g0 = __shfl(gs, 0), g1 = __shfl(gs, 4), g2 = __shfl(gs, 8), g3 = __shfl(gs, 12);
            const float gm = fmaxf(fmaxf(g0, g1), fmaxf(g2, g3));
            const int bg = (g0 == gm) ? 0 : (g1 == gm) ? 1 : (g2 == gm) ? 2 : 3;
            const int e1 = __shfl(bg * 4 + im, bg * 4), e2 = __shfl(bg * 4 + im2, bg * 4);
            const float sc1 = __shfl(score, e1), sc2 = __shfl(score, e2);
            if (F.lane == 0) {
                const float inv = 1.0f / (sc1 + sc2);
                const int r1 = atomicAdd(&cntL[e1], 1), r2 = atomicAdd(&cntL[e2], 1);
                int* r = rec + rl * 6; r[0] = e1; r[1] = r1; r[2] = e2; r[3] = r2; r[4] = __float_as_int(sc1 * inv); r[5] = __float_as_int(sc2 * inv);
            }
        }
        __syncthreads();
        if (F.tid < 16) baseL[F.tid] = (int)atomicAdd(&gcnt[F.tid], (unsigned)cntL[F.tid]);
        __syncthreads();
        if (F.tid < 128) {
            const int t = blk * 128 + F.tid; const int* r = rec + F.tid * 6;
            const int e1 = r[0], s1 = baseL[e1] + r[1], e2 = r[2], s2 = baseL[e2] + r[3];
            SLOT[e1 * 32768 + s1] = t; SLOT[e2 * 32768 + s2] = t;
            int* ti = (int*)(F.TOKI + ((size_t)l * T_TOK + t) * 32);
            ti[0] = e1; ti[1] = s1; ti[2] = e2; ti[3] = s2; ti[4] = r[4]; ti[5] = r[5];
        }
        __syncthreads();
    }
}

DI void phase_fn(const Frame& F) {
    int* pre = (int*)F.ldsg;
    moe_offsets(F.ctl + CW_CNT + 64 * (DEPTH - 1), pre, F.tid);
    __syncthreads();
    for (int blk = F.bid; blk < T_TOK / 128; blk += F.G) {
        const int b = blk / (SEQ / 128);
#pragma unroll 1
        for (int i = 0; i < 16; ++i) {
            const int t = blk * 128 + F.wave * 16 + i;
            float xv[16];
#pragma unroll
            for (int q = 0; q < 4; ++q) { const f32x4 v = *(const f32x4*)(F.out + (size_t)t * 1024 + F.lane * 4 + 256 * q); xv[q * 4] = v[0]; xv[q * 4 + 1] = v[1]; xv[q * 4 + 2] = v[2]; xv[q * 4 + 3] = v[3]; }
            moe_combine_row(F, DEPTH - 1, t, b, pre, xv);
            float ss = 0.f;
#pragma unroll
            for (int j = 0; j < 16; ++j) ss += xv[j] * xv[j];
            ss = wave_sum(ss);
            const float rn = __builtin_amdgcn_rsqf(ss * (1.0f / 1024.0f) + EPS);
#pragma unroll
            for (int q = 0; q < 4; ++q) { const f32x4 g = *(const f32x4*)(F.g_fin + F.lane * 4 + 256 * q);
                *(f32x4*)(F.out + (size_t)t * 1024 + F.lane * 4 + 256 * q) = (f32x4){xv[q * 4] * rn * g[0], xv[q * 4 + 1] * rn * g[1], xv[q * 4 + 2] * rn * g[2], xv[q * 4 + 3] * rn * g[3]}; }
        }
    }
}
DI void phase_cv(const Frame& F, int l) {
    const bf16_t* P = (const bf16_t*)(F.R0 + R_P);
    bf16_t* QC = (bf16_t*)(F.R0 + R_QC); bf16_t* KC = (bf16_t*)(F.R0 + R_KC); bf16_t* KCT = (bf16_t*)(F.R0 + R_KCT);
    bf16_t* raw = (bf16_t*)F.ldsg;
    bf16_t* tT = raw + 67 * 264;
    const int tid = F.tid;
    for (int u = F.bid; u < 128 * 8; u += F.G) {
        const int tt = u >> 3, ct = u & 7, t0 = tt * 64, c0 = ct * 256;
        for (int i = tid; i < 67 * 32; i += 512) { const int r = i >> 5, cg = i & 31, t = t0 - 3 + r;
            u32x4 v = (u32x4){0u, 0u, 0u, 0u};
            if (t >= 0) v = *(const u32x4*)(P + (size_t)t * NNAT + c0 + cg * 8);
            *(u32x4*)(raw + r * 264 + cg * 8) = v; }
        __syncthreads();
        const int cg = tid & 31, ch = c0 + cg * 8;
        float w[4][8];
#pragma unroll
        for (int j = 0; j < 4; ++j) { const f32x4 a = *(const f32x4*)(F.conv_w + ((size_t)l * 4 + j) * 2048 + ch), b = *(const f32x4*)(F.conv_w + ((size_t)l * 4 + j) * 2048 + ch + 4);
            w[j][0] = a[0]; w[j][1] = a[1]; w[j][2] = a[2]; w[j][3] = a[3]; w[j][4] = b[0]; w[j][5] = b[1]; w[j][6] = b[2]; w[j][7] = b[3]; }
        const bool isq = ct < 4; const float osc = isq ? 0.0625f : 1.0f;
#pragma unroll
        for (int i = 0; i < 4; ++i) {
            const int tr = (tid >> 5) + 16 * i;
            float y[8];
#pragma unroll
            for (int k = 0; k < 8; ++k) y[k] = 0.f;
#pragma unroll
            for (int j = 0; j < 4; ++j) { const u32x4 v = *(const u32x4*)(raw + (tr + j) * 264 + cg * 8);
                y[0] += w[j][0] * bflo(v.x); y[1] += w[j][1] * bfhi(v.x); y[2] += w[j][2] * bflo(v.y); y[3] += w[j][3] * bfhi(v.y);
                y[4] += w[j][4] * bflo(v.z); y[5] += w[j][5] * bfhi(v.z); y[6] += w[j][6] * bflo(v.w); y[7] += w[j][7] * bfhi(v.w); }
#pragma unroll
            for (int k = 0; k < 8; ++k) y[k] = siluf_(y[k]) * osc;
            u32x4 o; o.x = pack2(y[0], y[1]); o.y = pack2(y[2], y[3]); o.z = pack2(y[4], y[5]); o.w = pack2(y[6], y[7]);
            if (isq) *(u32x4*)(QC + (size_t)(t0 + tr) * 1024 + ch) = o;
            else { *(u32x4*)(KC + (size_t)(t0 + tr) * 1024 + (ch - 1024)) = o; *(u32x4*)(tT + tr * 264 + cg * 8) = o; }
        }
        __syncthreads();
        if (!isq) {
#pragma unroll
            for (int i = 0; i < 4; ++i) { const int chl = (tid >> 3) + 64 * i, oc = tid & 7;
                unsigned short e[8];
#pragma unroll
                for (int k = 0; k < 8; ++k) e[k] = tT[(oc * 8 + k) * 264 + chl];
                u32x4 o; o.x = e[0] | ((unsigned)e[1] << 16); o.y = e[2] | ((unsigned)e[3] << 16); o.z = e[4] | ((unsigned)e[5] << 16); o.w = e[6] | ((unsigned)e[7] << 16);
                *(u32x4*)(KCT + (size_t)(c0 - 1024 + chl) * TQ + t0 + oc * 8) = o; }
        }
        __syncthreads();
    }
}

DI void ml1_unit(const Frame& F, int h, int j, int eg) {
    const bf16_t* QC = (const bf16_t*)(F.R0 + R_QC); const bf16_t* KC = (const bf16_t*)(F.R0 + R_KC); const bf16_t* KCT = (const bf16_t*)(F.R0 + R_KCT);
    const bf16_t* VT = (const bf16_t*)(F.R0 + R_VT);
    float* NUM = (float*)(F.R0 + R_NUM); float* SLOC = (float*)(F.R0 + R_SLOC);
    float* DENI = (float*)(F.R0 + R_DENI); float* EBC = (float*)(F.R0 + R_EBC); float* EBL = (float*)(F.R0 + R_EBL);
    float* SCB = (float*)(F.R0 + R_SCB); float* CHB = (float*)(F.R0 + R_CHB); float* DN = (float*)(F.R0 + R_DN);
    const int tid = F.tid, lane = F.lane, w = F.wave, rr = lane & 31, hh = lane >> 5;
    const int tl0 = j * 256;
    const size_t tg0 = (size_t)eg * TQ + tl0;
    LAS unsigned char* L = F.lds;
    LAS bf16_t* Sl = (LAS bf16_t*)L;
    LAS float* Lb = (LAS float*)(L + 36864);
    LAS float* Lg = Lb + 256;
    LAS float* Lws = Lg + 256;
    LAS float* Leb = Lws + 256;
    LAS float* Lden = Leb + 256;
    LAS float* Lbl = Lden + 256;
    if (w < 4) {
        const int c = w, t = c * 64 + lane;
        const float li = F.GIF[(tg0 + t) * 8 + h], lf = F.GIF[(tg0 + t) * 8 + 4 + h];
        float b = lf;
#pragma unroll
        for (int o = 1; o < 64; o <<= 1) { const float v = __shfl_up(b, o); if (lane >= o) b += v; }
        const float bl = __shfl(b, 63);
        Lb[t] = b; Lg[t] = li - b; Lws[t] = __expf(bl - b + li); Leb[t] = __expf(b); Lden[t] = 0.f;
        if (lane == 0) Lbl[c] = bl;
    }
    __syncthreads();
    if (tid < 256) {
        const int c = tid >> 6; float pre = 0.f;
        for (int cc = 0; cc < c; ++cc) pre += Lbl[cc];
        EBC[(size_t)(tl0 + tid) * 4 + h] = Leb[tid];
        EBL[(size_t)(tl0 + tid) * 4 + h] = __expf(Lb[tid] + pre);
        if (tid < 4) CHB[h * 128 + j * 4 + tid] = Lbl[tid];
        if (tid == 0) SCB[h * 32 + j] = Lbl[0] + Lbl[1] + Lbl[2] + Lbl[3];
    }
    for (int idx = w; idx < 12; idx += 8) {
        const int c = idx / 3, k3 = idx % 3, ti = (k3 == 0) ? 0 : 1, si = (k3 == 2) ? 1 : 0;
        const bf16_t* kp = KC + (size_t)(tl0 + c * 64 + si * 32 + rr) * 1024 + h * 256 + hh * 8;
        const bf16_t* qp = QC + (size_t)(tl0 + c * 64 + ti * 32 + rr) * 1024 + h * 256 + hh * 8;
        f32x16 acc;
#pragma unroll
        for (int r = 0; r < 16; ++r) acc[r] = 0.f;
#pragma unroll
        for (int k4 = 0; k4 < 4; ++k4) {
#pragma unroll
            for (int kq = 0; kq < 4; ++kq) { const int ks = k4 * 4 + kq; acc = MFMA32(ldg8(kp + ks * 16), ldg8(qp + ks * 16), acc); }
            asm volatile("" ::: "memory"); }
        const int tloc = c * 64 + ti * 32 + rr; const float bt = Lb[tloc];
        float rs = 0.f;
#pragma unroll
        for (int g = 0; g < 4; ++g) {
            float v[4];
#pragma unroll
            for (int q = 0; q < 4; ++q) { const int r = g * 4 + q, sl = si * 32 + crow(r, hh);
                float wgt = __expf(bt + Lg[c * 64 + sl]);
                if (sl > ti * 32 + rr) wgt = 0.f;
                v[q] = acc[r] * wgt; rs += v[q]; }
            u32x2 o; o.x = pack2(v[0], v[1]); o.y = pack2(v[2], v[3]);
            *(LAS u32x2*)(Sl + (c * 64 + ti * 32 + rr) * 72 + si * 32 + 8 * g + 4 * hh) = o;
        }
        rs += __shfl_xor(rs, 32);
        if (hh == 0) atomicAdd((float*)(F.ldsg + 36864 + 4 * 1024) + tloc, rs);
    }
    __syncthreads();
    if (tid < 256) DENI[(size_t)(tl0 + tid) * 4 + h] = Lden[tid];
#pragma unroll
    for (int p2 = 0; p2 < 2; ++p2) {
        const int p = tid + 512 * p2, c = p >> 8, d = p & 255;
        const bf16_t* kt = KCT + (size_t)(h * 256 + d) * TQ + tl0 + c * 64;
        float s = 0.f;
#pragma unroll
        for (int o = 0; o < 8; ++o) { const u32x4 v = *(const u32x4*)(kt + o * 8); const LAS float* ws = Lws + c * 64 + o * 8;
            s += bflo(v.x) * ws[0] + bfhi(v.x) * ws[1] + bflo(v.y) * ws[2] + bfhi(v.y) * ws[3] + bflo(v.z) * ws[4] + bfhi(v.z) * ws[5] + bflo(v.w) * ws[6] + bfhi(v.w) * ws[7]; }
        DN[((size_t)h * 128 + j * 4 + c) * 256 + d] = s;
    }
    f32x16 Ct[8];
#pragma unroll
    for (int i = 0; i < 8; ++i)
#pragma unroll
        for (int r = 0; r < 16; ++r) Ct[i][r] = 0.f;
    for (int c = 0; c < 4; ++c) {
        int rr_ = rr, hh_ = hh; asm volatile("" : "+v"(rr_), "+v"(hh_));
        const bf16_t* vbase = VT + (size_t)(h * 256 + w * 32 + rr_) * TQ + tl0 + c * 64 + hh_ * 8;
        f32x16 a0, a1;
#pragma unroll
        for (int r = 0; r < 16; ++r) { a0[r] = 0.f; a1[r] = 0.f; }
        const bf16_t* q0 = QC + (size_t)(tl0 + c * 64 + rr_) * 1024 + h * 256 + hh_ * 8; const bf16_t* q1 = q0 + (size_t)32 * 1024;
#pragma unroll
        for (int db = 0; db < 8; ++db)
#pragma unroll
            for (int s2 = 0; s2 < 2; ++s2) {
                const bf16x8 cf = packf8(Ct[db][8 * s2], Ct[db][8 * s2 + 1], Ct[db][8 * s2 + 2], Ct[db][8 * s2 + 3], Ct[db][8 * s2 + 4], Ct[db][8 * s2 + 5], Ct[db][8 * s2 + 6], Ct[db][8 * s2 + 7]);
                a0 = MFMA32(ldg8(q0 + db * 32 + s2 * 16), cf, a0);
                a1 = MFMA32(ldg8(q1 + db * 32 + s2 * 16), cf, a1);
                if (s2 == 1 && (db & 1)) asm volatile("" ::: "memory");
            }
#pragma unroll
        for (int r = 0; r < 16; ++r) { a0[r] *= Leb[c * 64 + crow(r, hh)]; a1[r] *= Leb[c * 64 + 32 + crow(r, hh)]; }
#pragma unroll
        for (int ks = 0; ks < 4; ++ks) {
            const bf16x8 vf = ldg8(vbase + ks * 16);
            if (ks < 2) a0 = MFMA32(*(const LAS bf16x8*)(Sl + (c * 64 + rr) * 72 + ks * 16 + hh * 8), vf, a0);
            a1 = MFMA32(*(const LAS bf16x8*)(Sl + (c * 64 + 32 + rr) * 72 + ks * 16 + hh * 8), vf, a1);
        }
        { float* np = NUM + (size_t)(tl0 + c * 64) * 1024 + h * 256 + w * 32 + rr_;
#pragma unroll
          for (int r = 0; r < 16; ++r) { np[(size_t)crow(r, hh) * 1024] = a0[r]; np[(size_t)(32 + crow(r, hh)) * 1024] = a1[r]; } }
        asm volatile("" ::: "memory");
        const float dec = __expf(Lbl[c]);
        bf16x8 vs[4];
#pragma unroll
        for (int ks = 0; ks < 4; ++ks) {
            const u32x4 v = __builtin_bit_cast(u32x4, ldg8(vbase + ks * 16)); const LAS float* ws = Lws + c * 64 + ks * 16 + hh * 8;
            vs[ks] = packf8(bflo(v.x) * ws[0], bfhi(v.x) * ws[1], bflo(v.y) * ws[2], bfhi(v.y) * ws[3], bflo(v.z) * ws[4], bfhi(v.z) * ws[5], bflo(v.w) * ws[6], bfhi(v.w) * ws[7]);
        }
        const bf16_t* ktb = KCT + (size_t)(h * 256 + pi23(rr_)) * TQ + tl0 + c * 64 + hh_ * 8;
#pragma unroll
        for (int db = 0; db < 8; ++db) {
#pragma unroll
            for (int r = 0; r < 16; ++r) Ct[db][r] *= dec;
            const bf16_t* kt = ktb + (size_t)db * 32 * TQ;
#pragma unroll
            for (int ks = 0; ks < 4; ++ks) Ct[db] = MFMA32(ldg8(kt + ks * 16), vs[ks], Ct[db]);
            if (db & 1) asm volatile("" ::: "memory");
        }
    }
    { float* sp = SLOC + (((size_t)h * 32 + j) * 256 + w * 32 + rr) * 256 + hh * 8;
#pragma unroll
      for (int db = 0; db < 8; ++db)
#pragma unroll
          for (int a = 0; a < 2; ++a) {
              *(f32x4*)(sp + db * 32 + a * 16) = (f32x4){Ct[db][8 * a], Ct[db][8 * a + 1], Ct[db][8 * a + 2], Ct[db][8 * a + 3]};
              *(f32x4*)(sp + db * 32 + a * 16 + 4) = (f32x4){Ct[db][8 * a + 4], Ct[db][8 * a + 5], Ct[db][8 * a + 6], Ct[db][8 * a + 7]}; } }
    __syncthreads();
}

DI void at_unit(const Frame& F, int au) {
    bf16_t* P = (bf16_t*)(F.R0 + R_P); const bf16_t* VT = (const bf16_t*)(F.R0 + R_VT); float* LSE = (float*)(F.R0 + R_LSE);
    const int lane = F.lane, rr = lane & 31, hh = lane >> 5;
    const int hd = au >> 8, qt = au & 255, g = hd >> 2;
    const int dsh = 2 * g, d = 1 << dsh, lsub = TQ >> dsh, tiles = lsub >> 5;
    const int r = qt / tiles, l0 = (qt % tiles) * 32;
    const float slope_d = exp2f(-8.0f * (float)(hd + 1) / 12.0f) * (float)d;
    const size_t qrow = (size_t)((l0 + rr) * d + r) * NNAT + 3072 + hd * 128;
    bf16x8 qf[8];
#pragma unroll
    for (int ks = 0; ks < 8; ++ks) qf[ks] = ldg8(P + qrow + hh * 64 + ks * 8);
    f32x16 sc[5];
    float mx = -1e30f;
#pragma unroll
    for (int kt = 0; kt < 5; ++kt) {
        const int lk0 = l0 - 128 + 32 * kt;
#pragma unroll
        for (int i = 0; i < 16; ++i) sc[kt][i] = 0.f;
        if (lk0 >= 0) {
            const bf16_t* kp = P + (size_t)((lk0 + pi23(rr)) * d + r) * NNAT + 4608 + hd * 128 + hh * 64;
#pragma unroll
            for (int ks = 0; ks < 8; ++ks) sc[kt] = MFMA32(ldg8(kp + ks * 8), qf[ks], sc[kt]);
#pragma unroll
            for (int i = 0; i < 16; ++i) {
                const int kk = (i & 3) + 4 * ((i >> 2) & 1) + 8 * hh + 16 * (i >> 3);
                const int dist = 128 - 32 * kt + rr - kk;
                float s = sc[kt][i] - slope_d * (float)dist;
                s = (dist >= 0 && dist <= 128) ? s : -1e30f;
                sc[kt][i] = s; mx = fmaxf(mx, s);
            }
            asm volatile("" ::: "memory");
        } else {
#pragma unroll
            for (int i = 0; i < 16; ++i) sc[kt][i] = -1e30f;
        }
    }
    mx = fmaxf(mx, __shfl_xor(mx, 32));
    float sum = 0.f;
    bf16x8 pf[5][2];
#pragma unroll
    for (int kt = 0; kt < 5; ++kt) {
        float p[16];
#pragma unroll
        for (int i = 0; i < 16; ++i) { p[i] = __expf(sc[kt][i] - mx); sum += p[i]; }
        pf[kt][0] = packf8(p[0], p[1], p[2], p[3], p[4], p[5], p[6], p[7]);
        pf[kt][1] = packf8(p[8], p[9], p[10], p[11], p[12], p[13], p[14], p[15]);
    }
    sum += __shfl_xor(sum, 32);
    const float inv = 1.0f / sum;
#pragma unroll
    for (int ct = 0; ct < 4; ++ct) {
        f32x16 o;
#pragma unroll
        for (int i = 0; i < 16; ++i) o[i] = 0.f;
        const bf16_t* vp = VT + (size_t)(1024 + hd * 128 + ct * 32 + rr) * TQ + r * lsub + hh * 8;
#pragma unroll
        for (int kt = 0; kt < 5; ++kt) {
            const int lk0 = l0 - 128 + 32 * kt;
            if (lk0 >= 0) {
                o = MFMA32(ldg8(vp + lk0), pf[kt][0], o);
                o = MFMA32(ldg8(vp + lk0 + 16), pf[kt][1], o);
            }
        }
#pragma unroll
        for (int g4 = 0; g4 < 4; ++g4) { u32x2 w; w.x = pack2(o[4 * g4] * inv, o[4 * g4 + 1] * inv); w.y = pack2(o[4 * g4 + 2] * inv, o[4 * g4 + 3] * inv);
            *(u32x2*)(P + qrow + ct * 32 + 8 * g4 + 4 * hh) = w; }
        asm volatile("" ::: "memory");
    }
    if (hh == 0) LSE[(size_t)((l0 + rr) * d + r) * 12 + hd] = mx + __logf(sum);
}

DI void phase_p2(const Frame& F) {
    const float* SLOC = (const float*)(F.R0 + R_SLOC); bf16_t* CST = (bf16_t*)(F.R0 + R_CST);
    const float* SCB = (const float*)(F.R0 + R_SCB); const float* CHB = (const float*)(F.R0 + R_CHB);
    const float* DN = (const float*)(F.R0 + R_DN); float* NST = (float*)(F.R0 + R_NST);
    const int gt = F.bid * 512 + F.tid;
    if (gt < 65536) {
        const int h = gt >> 14, e4 = (gt & 16383) * 4;
        f32x4 run = (f32x4){0.f, 0.f, 0.f, 0.f};
        for (int j = 0; j < 32; ++j) {
            const size_t o = ((size_t)h * 32 + j) * 65536 + e4;
            u32x2 w; w.x = pack2(run[0], run[1]); w.y = pack2(run[2], run[3]); *(u32x2*)(CST + o) = w;
            const f32x4 s = *(const f32x4*)(SLOC + o); const float dec = __expf(SCB[h * 32 + j]);
            run = run * dec + s;
        }
    } else if (gt < 65536 + 1024) {
        const int q = gt - 65536, h = q >> 8, dd = q & 255; float run = 0.f;
        for (int c = 0; c < 128; ++c) { const size_t o = ((size_t)h * 128 + c) * 256 + dd; NST[o] = run; run = run * __expf(CHB[h * 128 + c]) + DN[o]; }
    }
}

DI void f_hm_unit(const Frame& F, int l, int h, int tt, int eg) {
    const bf16_t* QC = (const bf16_t*)(F.R0 + R_QC); const bf16_t* CST = (const bf16_t*)(F.R0 + R_CST); const float* NST = (const float*)(F.R0 + R_NST);
    const float* NUM = (const float*)(F.R0 + R_NUM); const bf16_t* P = (const bf16_t*)(F.R0 + R_P);
    const float* DENI = (const float*)(F.R0 + R_DENI); const float* EBC = (const float*)(F.R0 + R_EBC); const float* EBL = (const float*)(F.R0 + R_EBL);
    const int lane = F.lane, tr = lane & 15, kg = lane >> 4;
    const int tl0 = tt * 16, j = tl0 >> 8, c = tl0 >> 6, tl = tl0 + tr;
    f32x4 acc[16];
#pragma unroll
    for (int i = 0; i < 16; ++i) acc[i] = (f32x4){0.f, 0.f, 0.f, 0.f};
    const bf16_t* qp = QC + (size_t)tl * 1024 + h * 256 + kg * 8;
    const bf16_t* cp = CST + (((size_t)h * 32 + j) * 256 + tr) * 256 + kg * 8;
    const float* np = NST + ((size_t)h * 128 + c) * 256 + kg * 8;
    float dotn = 0.f;
#pragma unroll 2
    for (int ks = 0; ks < 8; ++ks) {
        asm volatile("" ::: "memory");
        const bf16x8 qf = ldg8(qp + ks * 32);
        const u32x4 qv = __builtin_bit_cast(u32x4, qf);
        const f32x4 n0 = *(const f32x4*)(np + ks * 32), n1 = *(const f32x4*)(np + ks * 32 + 4);
        dotn += bflo(qv.x) * n0[0] + bfhi(qv.x) * n0[1] + bflo(qv.y) * n0[2] + bfhi(qv.y) * n0[3] + bflo(qv.z) * n1[0] + bfhi(qv.z) * n1[1] + bflo(qv.w) * n1[2] + bfhi(qv.w) * n1[3];
#pragma unroll
        for (int et = 0; et < 16; ++et) acc[et] = __builtin_amdgcn_mfma_f32_16x16x32_bf16(ldg8(cp + (size_t)et * 16 * 256 + ks * 32), qf, acc[et], 0, 0, 0);
    }
    dotn += __shfl_xor(dotn, 16); dotn += __shfl_xor(dotn, 32);
    const float ebl = EBL[(size_t)tl * 4 + h], ebc = EBC[(size_t)tl * 4 + h];
    const float den = DENI[(size_t)tl * 4 + h] + ebc * dotn;
    const float invd = 1.0f / fmaxf(fabsf(den), 1.0f);
    float ssq = 0.f;
#pragma unroll
    for (int et = 0; et < 16; ++et) {
        const f32x4 nl = *(const f32x4*)(NUM + (size_t)tl * 1024 + h * 256 + et * 16 + 4 * kg);
#pragma unroll
        for (int q = 0; q < 4; ++q) { const float v = (nl[q] + ebl * acc[et][q]) * invd; acc[et][q] = v; ssq += v * v; }
        if ((et & 3) == 3) asm volatile("" ::: "memory");
    }
    ssq += __shfl_xor(ssq, 16); ssq += __shfl_xor(ssq, 32);
    const float rn = __builtin_amdgcn_rsqf(ssq * (1.0f / 256.0f) + EPS);
    const size_t tp = (size_t)(eg & 1) * TQ + tl;
#pragma unroll
    for (int et = 0; et < 16; ++et) {
        const int e = et * 16 + 4 * kg;
        const u32x2 og = *(const u32x2*)(P + (size_t)tl * NNAT + 2048 + h * 256 + e);
        const f32x4 ng = *(const f32x4*)(F.norm_g + (size_t)l * 1024 + h * 256 + e);
        u32x2 w; w.x = pack2(bflo(og.x) * acc[et][0] * rn * ng[0], bfhi(og.x) * acc[et][1] * rn * ng[1]);
        w.y = pack2(bflo(og.y) * acc[et][2] * rn * ng[2], bfhi(og.y) * acc[et][3] * rn * ng[3]);
        *(u32x2*)(F.HM + tp * 1024 + h * 256 + e) = w;
        if ((et & 3) == 3) asm volatile("" ::: "memory");
    }
}
DI void f_ha_token(const Frame& F, int tl, int eg) {
    const bf16_t* P = (const bf16_t*)(F.R0 + R_P); const float* LSE = (const float*)(F.R0 + R_LSE);
    const int lane = F.lane, hs = lane >> 4, ch0 = (lane & 15) * 8;
    const float l0 = LSE[(size_t)tl * 12 + hs], l1 = LSE[(size_t)tl * 12 + 4 + hs], l2 = LSE[(size_t)tl * 12 + 8 + hs];
    const float m = fmaxf(l0, fmaxf(l1, l2));
    float a0 = __expf(l0 - m), a1 = __expf(l1 - m), a2 = __expf(l2 - m); const float inv = 1.0f / (a0 + a1 + a2); a0 *= inv; a1 *= inv; a2 *= inv;
    const bf16_t* pr = P + (size_t)tl * NNAT + 3072 + hs * 128 + ch0;
    const u32x4 v0 = *(const u32x4*)(pr), v1 = *(const u32x4*)(pr + 512), v2 = *(const u32x4*)(pr + 1024);
    u32x4 o;
    o.x = pack2(a0 * bflo(v0.x) + a1 * bflo(v1.x) + a2 * bflo(v2.x), a0 * bfhi(v0.x) + a1 * bfhi(v1.x) + a2 * bfhi(v2.x));
    o.y = pack2(a0 * bflo(v0.y) + a1 * bflo(v1.y) + a2 * bflo(v2.y), a0 * bfhi(v0.y) + a1 * bfhi(v1.y) + a2 * bfhi(v2.y));
    o.z = pack2(a0 * bflo(v0.z) + a1 * bflo(v1.z) + a2 * bflo(v2.z), a0 * bfhi(v0.z) + a1 * bfhi(v1.z) + a2 * bfhi(v2.z));
    o.w = pack2(a0 * bflo(v0.w) + a1 * bflo(v1.w) + a2 * bflo(v2.w), a0 * bfhi(v0.w) + a1 * bfhi(v1.w) + a2 * bfhi(v2.w));
    *(u32x4*)(F.HA + ((size_t)(eg & 1) * TQ + tl) * 512 + hs * 128 + ch0) = o;
}
using pg8::UnitD;
DI u32x4 pack8(const f32x4& v0, const f32x4& v1) { u32x4 w; w.x = pack2(v0[0], v0[1]); w.y = pack2(v0[2], v0[3]); w.z = pack2(v1[0], v1[1]); w.w = pack2(v1[2], v1[3]); return w; }

struct SchedG1 {
    const char* U; const char* Wnat; const char* Wvt; int G, c;
    DI bool next(int i, UnitD& u) const {
        const int L = i * G + c; if (L >= 768 + 320) return false;
        u.arows = nullptr; u.acount = 0; u.aux = 0;
        if (L < 768) { int pm, pn; pg8::tile_map(L, 32, 24, pm, pn); u.kind = 0; u.pm = pm; u.pn = pn;
            u.A = U + (size_t)pm * 256 * 2048; u.lda = 2048; u.B = Wnat + (size_t)pn * 256 * 2048; u.ldb = 2048; }
        else { const int idx = L - 768, pm = idx % 10, pn = idx / 10; u.kind = 1; u.pm = pm; u.pn = pn;
            u.A = Wvt + (size_t)pm * 256 * 2048; u.lda = 2048;
            int tokbase = pn * 256, dmul = 1;
            if (pm >= 4) { const int g = (pm - 4) >> 1, dsh = 2 * g, lsub = TQ >> dsh, n0 = pn * 256; dmul = 1 << dsh; tokbase = (n0 % lsub) * dmul + n0 / lsub; }
            u.B = U + (size_t)tokbase * 2048; u.ldb = 2048u * (unsigned)dmul; }
        return true;
    }
};
struct EpiG1 {
    static constexpr bool PERM = true;
    bf16_t* P; bf16_t* VT;
    DI void operator()(const f32x4 (&acc)[2][2][4][2], const UnitD& u, int wr, int wc, int fr, int fq) const {
        bf16_t* base; size_t ld; int mode = 0;
        if (u.kind == 0) { base = P + (size_t)u.pm * 256 * NNAT + u.pn * 256; ld = NNAT; mode = (u.pn >= 8 && u.pn < 12) ? 1 : ((u.pn >= 12 && u.pn < 18) ? 2 : 0); }
        else { base = VT + (size_t)u.pm * 256 * TQ + u.pn * 256; ld = TQ; }
        const int row0 = wr * 64 + fr, col0 = wc * 32 + 8 * fq;
#pragma unroll
        for (int ai = 0; ai < 2; ++ai)
#pragma unroll
            for (int m = 0; m < 4; ++m) { bf16_t* rowp = base + (size_t)(row0 + ai * 128 + m * 16) * ld + col0;
#pragma unroll
                for (int bj = 0; bj < 2; ++bj) { f32x4 v0 = acc[ai][bj][m][0], v1 = acc[ai][bj][m][1];
                    if (mode == 1) {
#pragma unroll
                        for (int q = 0; q < 4; ++q) { v0[q] = sigmoidf_(v0[q]); v1[q] = sigmoidf_(v1[q]); } }
                    else if (mode == 2) { v0 *= 0.08838834764831845f; v1 *= 0.08838834764831845f; }
                    *(u32x4*)(rowp + bj * 128) = pack8(v0, v1); }
                asm volatile("" ::: "memory"); }
    }
};
struct SchedDense {
    const char* A; const char* B; unsigned lda, ldb; int nM, nN, G, c;
    DI bool next(int i, UnitD& u) const {
        const int L = i * G + c; if (L >= nM * nN) return false;
        int pm, pn; pg8::tile_map(L, nM, nN, pm, pn); u.kind = 0; u.pm = pm; u.pn = pn; u.aux = 0; u.arows = nullptr; u.acount = 0;
        u.A = A + (size_t)pm * 256 * lda; u.lda = lda; u.B = B + (size_t)pn * 256 * ldb; u.ldb = ldb; return true;
    }
};
struct EpiG1g {
    static constexpr bool PERM = true;
    bf16_t* GT;
    DI void operator()(const f32x4 (&acc)[2][2][4][2], const UnitD& u, int wr, int wc, int fr, int fq) const {
        bf16_t* base = GT + (size_t)u.pm * 256 * 2048 + u.pn * 256; const int row0 = wr * 64 + fr, col0 = wc * 32 + 8 * fq;
#pragma unroll
        for (int ai = 0; ai < 2; ++ai)
#pragma unroll
            for (int m = 0; m < 4; ++m) { bf16_t* rowp = base + (size_t)(row0 + ai * 128 + m * 16) * 2048 + col0;
#pragma unroll
                for (int bj = 0; bj < 2; ++bj) { f32x4 v0 = acc[ai][bj][m][0], v1 = acc[ai][bj][m][1];
#pragma unroll
                    for (int q = 0; q < 4; ++q) { v0[q] = sigmoidf_(v0[q]); v1[q] = sigmoidf_(v1[q]); }
                    *(u32x4*)(rowp + bj * 128) = pack8(v0, v1); }
                asm volatile("" ::: "memory"); }
    }
};
template <int WHICH> struct EpiG2 {
    static constexpr bool PERM = true;
    bf16_t* GT;
    DI void operator()(const f32x4 (&acc)[2][2][4][2], const UnitD& u, int wr, int wc, int fr, int fq) const {
        bf16_t* base = GT + (size_t)u.pm * 256 * 2048 + u.pn * 256 + (WHICH == 0 ? 1024 : 0); const int row0 = wr * 64 + fr, col0 = wc * 32 + 8 * fq;
#pragma unroll
        for (int ai = 0; ai < 2; ++ai)
#pragma unroll
            for (int m = 0; m < 4; ++m) { bf16_t* rowp = base + (size_t)(row0 + ai * 128 + m * 16) * 2048 + col0;
#pragma unroll
                for (int bj = 0; bj < 2; ++bj) { const f32x4 a0 = acc[ai][bj][m][0], a1 = acc[ai][bj][m][1];
                    const u32x4 g = *(const u32x4*)(rowp + bj * 128);
                    f32x4 v0 = (f32x4){bflo(g.x) * a0[0], bfhi(g.x) * a0[1], bflo(g.y) * a0[2], bfhi(g.y) * a0[3]};
                    f32x4 v1 = (f32x4){bflo(g.z) * a1[0], bfhi(g.z) * a1[1], bflo(g.w) * a1[2], bfhi(g.w) * a1[3]};
                    if (WHICH == 1) { const u32x4 y = *(const u32x4*)(rowp + bj * 128 + 1024);
                        v0 += (f32x4){bflo(y.x), bfhi(y.x), bflo(y.y), bfhi(y.y)}; v1 += (f32x4){bflo(y.z), bfhi(y.z), bflo(y.w), bfhi(y.w)}; }
                    *(u32x4*)(rowp + bj * 128) = pack8(v0, v1); }
                asm volatile("" ::: "memory"); }
    }
};
struct EpiG3 {
    static constexpr bool PERM = false;
    const float* xin; float* xout; const float* gta;
    int b0;
    DI void operator()(const f32x4 (&acc)[2][2][4][2], const UnitD& u, int wr, int wc, int fr, int fq) const {
        const int row0 = u.pm * 256 + wr * 64 + fr, col0 = u.pn * 256 + wc * 32 + 4 * fq;
        const float* g = gta + (size_t)(b0 + (u.pm >> 5)) * 6144 + col0;
        f32x4 gv[2][2];
#pragma unroll
        for (int bj = 0; bj < 2; ++bj)
#pragma unroll
            for (int n = 0; n < 2; ++n) gv[bj][n] = *(const f32x4*)(g + bj * 128 + n * 16);
#pragma unroll
        for (int ai = 0; ai < 2; ++ai)
#pragma unroll
            for (int m = 0; m < 4; ++m) { const size_t o = (size_t)(row0 + ai * 128 + m * 16) * 1024 + col0;
#pragma unroll
                for (int bj = 0; bj < 2; ++bj)
#pragma unroll
                    for (int n = 0; n < 2; ++n) { const f32x4 xv = *(const f32x4*)(xin + o + bj * 128 + n * 16); *(f32x4*)(xout + o + bj * 128 + n * 16) = xv + gv[bj][n] * acc[ai][bj][m][n]; }
                asm volatile("" ::: "memory"); }
    }
};
struct SchedMoe {
    const int* pre;
    const unsigned* cnt;
    const char* A; const char* W; const int* SLOT; int G, c; bool gate_up;
    DI bool next(int i, UnitD& u) const {
        const int L = i * G + c, nt = pre[16]; if (L >= nt * 4) return false;
        const int rt = L >> 2, ct = L & 3; int e = 0;
#pragma unroll
        for (int q = 1; q < 16; ++q) e += (rt >= pre[q]) ? 1 : 0;
        u.kind = 0; u.pm = rt; u.pn = ct; u.aux = e;
        const int ti = rt - pre[e];
        if (gate_up) { u.A = A; u.lda = 2048; u.arows = SLOT + (size_t)e * 32768 + ti * 256; u.acount = (int)cnt[e] - ti * 256;
            u.B = W + ((size_t)e * 1024 + ct * 256) * 2048; u.ldb = 2048; }
        else { u.A = A + (size_t)rt * 256 * 1024; u.lda = 1024; u.arows = nullptr; u.acount = 0;
            u.B = W + ((size_t)e * 1024 + ct * 256) * 1024; u.ldb = 1024; }
        return true;
    }
};
struct EpiG4 {
    static constexpr bool PERM = true;
    bf16_t* HH;
    DI void operator()(const f32x4 (&acc)[2][2][4][2], const UnitD& u, int wr, int wc, int fr, int fq) const {
        bf16_t* base = HH + (size_t)u.pm * 256 * 512 + u.pn * 128; const int row0 = wr * 64 + fr, col0 = wc * 16 + 4 * fq;
#pragma unroll
        for (int ai = 0; ai < 2; ++ai)
#pragma unroll
            for (int m = 0; m < 4; ++m) { bf16_t* rowp = base + (size_t)(row0 + ai * 128 + m * 16) * 512 + col0;
#pragma unroll
                for (int bj = 0; bj < 2; ++bj) { const f32x4 v0 = acc[ai][bj][m][0], v1 = acc[ai][bj][m][1];
                    u32x2 w; w.x = pack2(siluf_(v0[0]) * v0[1], siluf_(v0[2]) * v0[3]); w.y = pack2(siluf_(v1[0]) * v1[1], siluf_(v1[2]) * v1[3]);
                    *(u32x2*)(rowp + bj * 64) = w; }
                asm volatile("" ::: "memory"); }
    }
};
struct EpiG5 {
    static constexpr bool PERM = true;
    bf16_t* YS;
    DI void operator()(const f32x4 (&acc)[2][2][4][2], const UnitD& u, int wr, int wc, int fr, int fq) const {
        bf16_t* base = YS + (size_t)u.pm * 256 * 1024 + u.pn * 256; const int row0 = wr * 64 + fr, col0 = wc * 32 + 8 * fq;
#pragma unroll
        for (int ai = 0; ai < 2; ++ai)
#pragma unroll
            for (int m = 0; m < 4; ++m) { bf16_t* rowp = base + (size_t)(row0 + ai * 128 + m * 16) * 1024 + col0;
#pragma unroll
                for (int bj = 0; bj < 2; ++bj) *(u32x4*)(rowp + bj * 128) = pack8(acc[ai][bj][m][0], acc[ai][bj][m][1]);
                asm volatile("" ::: "memory"); }
    }
};
constexpr int LDS_BYTES = 131072 + 1024;
constexpr int LDS_MISC = 131072;
#ifndef MK_ONE_LAUNCH
#define MK_ONE_LAUNCH 1
#endif
constexpr int N_STEPS = 1 + DEPTH * (1 + 2 * (2 * 5 + 4) + 3) + 1;

__global__ void __launch_bounds__(512, 2) fwd_kernel(Args args) {
    extern __shared__ __attribute__((aligned(16))) unsigned char lds_raw[];
    const int tid0 = threadIdx.x;
    LAS unsigned char* lds0 = (LAS unsigned char*)lds_raw;
    if (tid0 < 4) ((volatile LAS unsigned*)(lds0 + LDS_MISC))[tid0] = 0u;
    __syncthreads();
    unsigned* ctl0 = (unsigned*)(args.ws + WS_CTL);
    XcdBarrier bar; bar.bar = ctl0 + CW_BAR; bar.x = 0; bar.st = nullptr;
    const int lo = args.step_lo, hi = args.step_hi;
    if (hi - lo > 1) bar = xcd_barrier_post(ctl0 + CW_BAR, (volatile LAS unsigned*)(lds0 + LDS_MISC));
    int step = 0;
#ifndef SITE_MASK
#define SITE_MASK 0xFFFFFFFFu
#endif
#define RUN(site, ...) do { if (step >= lo && step < hi) { if constexpr ((SITE_MASK >> (site)) & 1u) { Frame F; { int t_ = tid0; asm volatile("" : "+v"(t_)); frame_init(F, lds_raw, t_); } int* preL = (int*)(F.ldsg + LDS_MISC + 64); (void)preL; __VA_ARGS__; } if (step + 1 < hi) xcd_barrier(bar); } ++step; } while (0)

    RUN(0, { phase_p0_small(F); __syncthreads(); phase_pw(F, 0, 0, F.G); });
    for (int l = 0; l < DEPTH; ++l) {
        RUN(1, { if (l > 0) phase_pw(F, l, 0, F.G); phase_n1(F, l); });
        for (int p = 0; p < 2; ++p) {
            for (int e = 0; e < 2; ++e) {
                const int eg = 2 * p + e;
                RUN(2, { SchedG1 S{(const char*)(F.U + (size_t)eg * TQ * 1024), (const char*)(F.W + W_NAT), (const char*)(F.W + W_VT), F.G, F.bid};
                      EpiG1 E{(bf16_t*)(F.R0 + R_P), (bf16_t*)(F.R0 + R_VT)};
                      pg8::gemm_run<EpiG1, SchedG1>(F.lds, 1024, S, E); });
                RUN(3, { phase_cv(F, l); });
                RUN(4, { const int nbm = F.G >> 1;
                      if (F.bid < nbm) { for (int u = F.bid; u < 128; u += nbm) ml1_unit(F, u >> 5, u & 31, eg); }
                      else { for (int au = (F.bid - nbm) * 8 + F.wave; au < 3072; au += (F.G - nbm) * 8) at_unit(F, au); } });
                RUN(5, { phase_p2(F); });
                RUN(6, { const int nbm = F.G >> 1;
                      if (F.bid < nbm) { for (int u = F.bid * 8 + F.wave; u < 2048; u += nbm * 8) f_hm_unit(F, l, u >> 9, u & 511, eg); }
                      else { for (int t = (F.bid - nbm) * 8 + F.wave; t < TQ; t += (F.G - nbm) * 8) f_ha_token(F, t, eg); } });
            }
            RUN(7, { SchedDense S{(const char*)(F.U + (size_t)p * TP * 1024), (const char*)(F.W + W_G), 2048u, 2048u, 64, 8, F.G, F.bid};
                  EpiG1g E{(bf16_t*)(F.R0 + R_GT)}; pg8::gemm_run<EpiG1g, SchedDense>(F.lds, 1024, S, E); });
            RUN(8, { SchedDense S{(const char*)F.HA, (const char*)(F.W + W_A), 1024u, 1024u, 64, 4, F.G, F.bid};
                  EpiG2<0> E{(bf16_t*)(F.R0 + R_GT)}; pg8::gemm_run<EpiG2<0>, SchedDense>(F.lds, 512, S, E); });
            RUN(9, { SchedDense S{(const char*)F.HM, (const char*)(F.W + W_M), 2048u, 2048u, 64, 4, F.G, F.bid};
                  EpiG2<1> E{(bf16_t*)(F.R0 + R_GT)}; pg8::gemm_run<EpiG2<1>, SchedDense>(F.lds, 1024, S, E); });
            RUN(10, { SchedDense S{(const char*)(F.R0 + R_GT), (const char*)(F.W + W_O), 4096u, 2048u, 64, 4, F.G, F.bid};
                  EpiG3 E{(l == 0 ? F.x : F.out) + (size_t)p * TP * 1024, F.out + (size_t)p * TP * 1024, F.MOD + (size_t)l * 4 * 6144 + 2048, 2 * p};
                  pg8::gemm_run<EpiG3, SchedDense>(F.lds, 1024, S, E); });
        }
        RUN(11, { phase_n2(F, l); });
        RUN(12, { moe_offsets(F.ctl + CW_CNT + 64 * l, preL, F.tid); __syncthreads();
              SchedMoe S{preL, F.ctl + CW_CNT + 64 * l, (const char*)F.U, (const char*)(F.W + W_13), (const int*)(F.R0 + R_SLOT), F.G, F.bid, true};
              EpiG4 E{(bf16_t*)(F.R0 + R_HH)}; pg8::gemm_run<EpiG4, SchedMoe, true>(F.lds, 1024, S, E); });
        RUN(13, { moe_offsets(F.ctl + CW_CNT + 64 * l, preL, F.tid); __syncthreads();
              SchedMoe S{preL, F.ctl + CW_CNT + 64 * l, (const char*)(F.R0 + R_HH), (const char*)(F.W + W_2), (const int*)(F.R0 + R_SLOT), F.G, F.bid, false};
              EpiG5 E{(bf16_t*)(F.R0 + R_YS)}; pg8::gemm_run<EpiG5, SchedMoe>(F.lds, 512, S, E); });
    }
    RUN(14, { phase_fn(F); });
#undef RUN
}

extern "C" void kernel_launch(void* const* d_in, const int* in_sizes, int n_in, void* d_out, int out_size, void* d_ws, size_t ws_size, hipStream_t stream) {
    static int grid = 0;
    if (grid == 0) {
        if (n_in != 19 || out_size != T_TOK * DM || ws_size < WS_END) { fprintf(stderr, "kernel_launch: unexpected problem (n_in %d out %d ws %zu, need %zu)\n", n_in, out_size, ws_size, (size_t)WS_END); grid = -1; return; }
        int dev = 0, cus = 0, per_cu = 0;
        if (hipGetDevice(&dev) != hipSuccess || hipDeviceGetAttribute(&cus, hipDeviceAttributeMultiprocessorCount, dev) != hipSuccess) { grid = -1; return; }
        if (hipFuncSetAttribute((const void*)fwd_kernel, hipFuncAttributeMaxDynamicSharedMemorySize, LDS_BYTES) != hipSuccess) { fprintf(stderr, "kernel_launch: hipFuncSetAttribute failed\n"); grid = -1; return; }
        if (hipOccupancyMaxActiveBlocksPerMultiprocessor(&per_cu, (const void*)fwd_kernel, 512, LDS_BYTES) != hipSuccess || per_cu < 1) { fprintf(stderr, "kernel_launch: occupancy query says %d blocks per CU\n", per_cu); per_cu = 1; }
        (void)hipGetLastError();
        grid = cus;
        if (grid > 256) grid = 256;
        grid &= ~7;
    }
    if (grid <= 0) return;
    (void)hipMemsetAsync((char*)d_ws + WS_CTL, 0, CTL_BYTES, stream);
    Args a{};
    for (int i = 0; i < 19; ++i) a.in[i] = (const float*)d_in[i];
    a.out = (float*)d_out; a.ws = (unsigned char*)d_ws;
#if MK_ONE_LAUNCH
    a.step_lo = 0; a.step_hi = N_STEPS;
    hipLaunchKernelGGL(fwd_kernel, dim3(grid), dim3(512), LDS_BYTES, stream, a);
#else
    for (int s = 0; s < N_STEPS; ++s) { a.step_lo = s; a.step_hi = s + 1; hipLaunchKernelGGL(fwd_kernel, dim3(grid), dim3(512), LDS_BYTES, stream, a); }
#endif
}
```

```cpp
#define MK_ONE_LAUNCH 1
#include <hip/hip_runtime.h>
#include <cstdio>
#include <cstdint>

#define DI __device__ __forceinline__
#define LAS __attribute__((address_space(3)))
typedef unsigned short bf16_t;
typedef short bf16x8 __attribute__((ext_vector_type(8)));
typedef float f32x2 __attribute__((ext_vector_type(2)));
typedef float f32x4 __attribute__((ext_vector_type(4)));
typedef float f32x16 __attribute__((ext_vector_type(16)));
typedef unsigned u32x2 __attribute__((ext_vector_type(2)));
typedef unsigned u32x4 __attribute__((ext_vector_type(4)));
typedef __bf16 nbf16x2 __attribute__((ext_vector_type(2)));

constexpr int T_TOK = 32768, SEQ = 8192, DM = 1024, NBATCH = 4, DEPTH = 2;
constexpr int TQ = 8192;
constexpr int TP = 16384;
constexpr int INC = 10760;
constexpr int NNAT = 6144;
constexpr int NVT = 2560;
constexpr int NEXP = 16, DFF = 512;
constexpr int SLOT_ROWS = 69632;
constexpr float EPS = 1e-6f;

constexpr size_t al256(size_t x) { return (x + 255) & ~(size_t)255; }
constexpr size_t WS_CTL = 0;
constexpr size_t CTL_BYTES = 65536;
constexpr size_t WS_MOD = WS_CTL + CTL_BYTES;
constexpr size_t WS_WIF = WS_MOD + al256((size_t)2 * 4 * 6144 * 4);
constexpr size_t WS_RW = WS_WIF + (size_t)2 * 8 * 1024 * 4;
constexpr size_t WS_W = WS_RW + (size_t)16 * 1024 * 4;
constexpr size_t W_NAT = 0;
constexpr size_t W_VT = W_NAT + (size_t)NNAT * 1024 * 2;
constexpr size_t W_G = W_VT + (size_t)NVT * 1024 * 2;
constexpr size_t W_M = W_G + (size_t)2048 * 1024 * 2;
constexpr size_t W_A = W_M + (size_t)1024 * 1024 * 2;
constexpr size_t W_O = W_A + (size_t)1024 * 512 * 2;
constexpr size_t W_13 = W_O + (size_t)1024 * 1024 * 2;
constexpr size_t W_2 = W_13 + (size_t)16 * 1024 * 1024 * 2;
constexpr size_t W_BYTES = W_2 + (size_t)16 * 1024 * 512 * 2;
constexpr size_t WS_U = WS_W + W_BYTES;
constexpr size_t WS_GIF = WS_U + (size_t)T_TOK * 1024 * 2;
constexpr size_t WS_HM = WS_GIF + (size_t)T_TOK * 8 * 4;
constexpr size_t WS_HA = WS_HM + (size_t)TP * 1024 * 2;
constexpr size_t WS_TOKI = WS_HA + (size_t)TP * 512 * 2;
constexpr size_t WS_R0 = WS_TOKI + (size_t)2 * T_TOK * 32;
constexpr size_t R_P = 0;
constexpr size_t R_VT = R_P + (size_t)TQ * NNAT * 2;
constexpr size_t R_QC = R_VT + (size_t)NVT * TQ * 2;
constexpr size_t R_KC = R_QC + (size_t)TQ * 1024 * 2;
constexpr size_t R_KCT = R_KC + (size_t)TQ * 1024 * 2;
constexpr size_t R_NUM = R_KCT + (size_t)TQ * 1024 * 2;
constexpr size_t R_SLOC = R_NUM + (size_t)TQ * 1024 * 4;
constexpr size_t R_CST = R_SLOC + (size_t)4 * 32 * 65536 * 4;
constexpr size_t R_DENI = R_CST + (size_t)4 * 32 * 65536 * 2;
constexpr size_t R_EBC = R_DENI + (size_t)TQ * 4 * 4;
constexpr size_t R_EBL = R_EBC + (size_t)TQ * 4 * 4;
constexpr size_t R_SCB = R_EBL + (size_t)TQ * 4 * 4;
constexpr size_t R_CHB = R_SCB + 1024;
constexpr size_t R_DN = R_CHB + 2048;
constexpr size_t R_NST = R_DN + (size_t)4 * 128 * 256 * 4;
constexpr size_t R_LSE = R_NST + (size_t)4 * 128 * 256 * 4;
constexpr size_t R_OUTG = R_LSE + (size_t)TQ * 12 * 4;
constexpr size_t R_END = R_OUTG + (size_t)TQ * 1536 * 2;
constexpr size_t R_GT = 0;
constexpr size_t R_HH = 0;
constexpr size_t R_YS = R_HH + (size_t)SLOT_ROWS * 512 * 2;
constexpr size_t R_SLOT = R_YS + (size_t)SLOT_ROWS * 1024 * 2;
constexpr size_t R_END2 = R_SLOT + (size_t)16 * 32768 * 4;
constexpr size_t WS_END = WS_R0 + (R_END > R_END2 ? R_END : R_END2);
static_assert(WS_END <= (size_t)536870912, "workspace over 512 MiB");

constexpr int CW_BAR = 0;
constexpr int CW_CNT = 4096;

DI float bflo(unsigned w) { return __uint_as_float(w << 16); }
DI float bfhi(unsigned w) { return __uint_as_float(w & 0xffff0000u); }
DI unsigned pack2(float lo, float hi) { f32x2 v = {lo, hi}; nbf16x2 b = __builtin_convertvector(v, nbf16x2); return __builtin_bit_cast(unsigned, b); }
DI float sigmoidf_(float x) { return __builtin_amdgcn_rcpf(1.0f + __expf(-x)); }
DI float siluf_(float x) { return x * sigmoidf_(x); }
DI float wave_sum(float v) { for (int o = 32; o >= 1; o >>= 1) v += __shfl_xor(v, o); return v; }
DI int crow(int reg, int h) { return (reg & 3) + 8 * (reg >> 2) + 4 * h; }
DI int pi23(int m) { return (m & ~12) | ((m & 4) << 1) | ((m & 8) >> 1); }
#define MFMA32(a, b, c) __builtin_amdgcn_mfma_f32_32x32x16_bf16((a), (b), (c), 0, 0, 0)
DI bf16x8 packf8(float a0, float a1, float a2, float a3, float a4, float a5, float a6, float a7) {
    u32x4 p; p.x = pack2(a0, a1); p.y = pack2(a2, a3); p.z = pack2(a4, a5); p.w = pack2(a6, a7); return __builtin_bit_cast(bf16x8, p); }
DI bf16x8 ldg8(const bf16_t* p) { return *(const bf16x8*)p; }
#define XB_TMO      128
#define XB_XCNT(j)  (256  + 64 * (j))
#define XB_XSUB(j)  (1280 + 64 * (j))
#define XB_XGEN(j)  (2304 + 64 * (j))
#define XB_TOP      3328
#define XB_TOPGEN   3392
#define XCD_BAR_WORDS 3456
#define XB_SPIN_CAP (1u << 21)

__device__ __forceinline__ unsigned xb_ld(unsigned* p)              { return __hip_atomic_load(p, __ATOMIC_RELAXED, __HIP_MEMORY_SCOPE_AGENT); }
__device__ __forceinline__ unsigned xb_add(unsigned* p, unsigned v) { return __hip_atomic_fetch_add(p, v, __ATOMIC_RELAXED, __HIP_MEMORY_SCOPE_AGENT); }
__device__ __forceinline__ unsigned xb_xcc_id() { return (unsigned)__builtin_amdgcn_s_getreg((3 << 11) | 20) & 0xFu; }
#define XB_SPIN(cond, bar) do { unsigned _sp = 0; while (cond) { __builtin_amdgcn_s_sleep(1); \
    if ((++_sp & 255u) == 0u) { if (xb_ld(&(bar)[XB_TMO])) break; if (_sp > XB_SPIN_CAP) { atomicAdd(&(bar)[XB_TMO], 1u); break; } } } } while (0)

struct XcdBarrier {
    unsigned* bar; unsigned x;
    volatile LAS unsigned* st;
};

__device__ __forceinline__ XcdBarrier xcd_barrier_post(unsigned* bar, volatile LAS unsigned* st) {
    XcdBarrier b; b.bar = bar; b.x = xb_xcc_id(); b.st = st;
    if (threadIdx.x == 0) (void)xb_add(&bar[XB_XCNT(b.x)], 1u);
    return b;
}
__device__ __forceinline__ void xcd_barrier_complete(unsigned* bar, unsigned x, unsigned& nloc, unsigned& nx) {
    const unsigned G = gridDim.x * gridDim.y * gridDim.z;
    unsigned sum, cnt, mine, sp = 0u;
    for (;;) {
        sum = 0u; cnt = 0u; mine = 0u;
#pragma unroll
        for (unsigned j = 0; j < 16; ++j) { const unsigned c = xb_ld(&bar[XB_XCNT(j)]); sum += c; cnt += (c > 0u) ? 1u : 0u; mine = (j == x) ? c : mine; }
        if (sum == G) break;
        __builtin_amdgcn_s_sleep(1);
        if ((++sp & 255u) == 0u) { if (xb_ld(&bar[XB_TMO])) break; if (sp > XB_SPIN_CAP) { atomicAdd(&bar[XB_TMO], 1u); break; } }
    }
    nloc = mine > 0u ? mine : 1u; nx = cnt > 0u ? cnt : 1u;
}

__device__ __forceinline__ void xcd_barrier(const XcdBarrier& b) {
    asm volatile("s_waitcnt vmcnt(0)" ::: "memory");
    __syncthreads();
    if (threadIdx.x == 0) {
        unsigned* bar = b.bar;
        __builtin_amdgcn_s_waitcnt(0);
        unsigned nloc = b.st[0], nx = b.st[1];
        if (nloc == 0u) { xcd_barrier_complete(bar, b.x, nloc, nx); b.st[0] = nloc; b.st[1] = nx; }
        const unsigned old = xb_add(&bar[XB_XSUB(b.x)], 1u);
        const unsigned gen = old / nloc;
        if (old + 1u == (gen + 1u) * nloc) {
            __builtin_amdgcn_fence(__ATOMIC_RELEASE, "agent");
            asm volatile("s_waitcnt vmcnt(0)" ::: "memory");
            const unsigned og = xb_add(&bar[XB_TOP], 1u);
            const unsigned tg = og / nx;
            if (og + 1u == (tg + 1u) * nx) xb_add(&bar[XB_TOPGEN], 1u);
            else XB_SPIN(xb_ld(&bar[XB_TOPGEN]) == tg, bar);
            __builtin_amdgcn_fence(__ATOMIC_ACQUIRE, "agent");
            xb_add(&bar[XB_XGEN(b.x)], 1u);
            asm volatile("s_waitcnt vmcnt(0)" ::: "memory");
        } else {
            XB_SPIN(xb_ld(&bar[XB_XGEN(b.x)]) == gen, bar);
            __builtin_amdgcn_fence(__ATOMIC_ACQUIRE, "agent");
            asm volatile("s_waitcnt vmcnt(0)" ::: "memory");
        }
    }
    __syncthreads();
}
namespace pg8 {
constexpr int BM = 256, BK = 64, HALF = 128, HTB = HALF * BK * 2, STAGE_BYTES = 8 * HTB, NXCD = 8, WGM = 8;
DI int lds_byte(int r, int c) { const int st = (r >> 4) * 2 + (c >> 5), rr = r & 15, cc = c & 31, ob = rr * 64 + cc * 2; return st * 1024 + (ob ^ (((ob >> 9) & 1) << 5)); }
DI void stage_rc(int b, int& R, int& C) { const int st = b / 1024, sb = b % 1024, swz = sb ^ (((sb >> 9) & 1) << 5); R = (st >> 1) * 16 + swz / 64; C = (st & 1) * 32 + (swz % 64) / 2; }
DI int perm32(int rho) { const int n = rho >> 4, i = rho & 15; return 8 * (i >> 2) + 4 * n + (i & 3); }

struct UnitD {
    const char* A; const char* B;
    unsigned lda, ldb;
    const int* arows; int acount;
    int kind, pm, pn, aux;
};
DI void tile_map(int L, int nM, int nN, int& pm, int& pn) {
    const int nwg = nM * nN; int wgid = L;
    { const int q = nwg / NXCD, r = nwg % NXCD, xcd = wgid % NXCD, off = wgid / NXCD; wgid = (xcd < r ? xcd * (q + 1) : r * (q + 1) + (xcd - r) * q) + off; }
    const int nig = WGM * nN, gid = wgid / nig, fm = gid * WGM, gsz = (nM - fm) < WGM ? (nM - fm) : WGM;
    pm = fm + ((wgid % nig) % gsz); pn = (wgid % nig) / gsz;
}
template <bool PERM, bool GATHER>
DI void unit_off(const UnitD& u, int tid, unsigned (&offA)[2][2], unsigned (&offB)[2]) {
#pragma unroll
    for (int i = 0; i < 2; ++i) {
        int R, C; stage_rc(tid * 16 + i * 8192, R, C);
        const int Rb = PERM ? ((R & ~31) + perm32(R & 31)) : R;
        offB[i] = (unsigned)Rb * u.ldb + (unsigned)C * 2u;
        if (GATHER) {
#pragma unroll
            for (int h = 0; h < 2; ++h) { const int ra = h * HALF + R; const int rr = ra < u.acount ? ra : 0; offA[h][i] = (unsigned)u.arows[rr] * u.lda + (unsigned)C * 2u; }
        } else { offA[0][i] = (unsigned)R * u.lda + (unsigned)C * 2u; offA[1][i] = 0u; }
    }
}

template <class Epi, class Sched, bool GATHER = false>
DI void gemm_run(LAS unsigned char* lds, const int K, const Sched& S, const Epi& E) {
    int tid_ = threadIdx.x; asm volatile("" : "+v"(tid_));
    const int tid = tid_, wid = __builtin_amdgcn_readfirstlane(tid >> 6), lane = tid & 63, wr = wid >> 2, wc = wid & 3, fr = lane & 15, fq = lane >> 4;
    const int nt = K / BK;
    const size_t kstep = (size_t)(BK * 2);
    const unsigned ldsw = (unsigned)wid * 1024u;
    const int aoff = lds_byte(wr * 64 + fr, fq * 8), boff = lds_byte(wc * 32 + fr, fq * 8);
#define PG8_SA(b, h) (((b) * 2 + (h)) * HTB)
#define PG8_SB(b, h) ((4 + (b) * 2 + (h)) * HTB)
#define PG8_STAGE(bufoff, gbase, voff) do { _Pragma("unroll") for (int _i = 0; _i < 2; ++_i) \
        __builtin_amdgcn_global_load_lds((const unsigned*)((const char*)(gbase) + (voff)[_i]), (LAS unsigned*)(lds + (bufoff) + ldsw + _i * 8192), 16, 0, 0); } while (0)
#define PG8_LDA(dst, b, h) do { _Pragma("unroll") for (int m = 0; m < 4; ++m) _Pragma("unroll") for (int k = 0; k < 2; ++k) dst[m][k] = *(const LAS bf16x8*)(lds + PG8_SA(b, h) + aoff + m * 2048 + k * 1024); } while (0)
#define PG8_LDB(dst, b, h) do { _Pragma("unroll") for (int n = 0; n < 2; ++n) _Pragma("unroll") for (int k = 0; k < 2; ++k) dst[n][k] = *(const LAS bf16x8*)(lds + PG8_SB(b, h) + boff + n * 2048 + k * 1024); } while (0)
#define PG8_MMA(ai, bj, At, Bt) do { __builtin_amdgcn_s_setprio(1); _Pragma("unroll") for (int m = 0; m < 4; ++m) _Pragma("unroll") for (int n = 0; n < 2; ++n) _Pragma("unroll") for (int k = 0; k < 2; ++k) \
        acc[ai][bj][m][n] = __builtin_amdgcn_mfma_f32_16x16x32_bf16(Bt[n][k], At[m][k], acc[ai][bj][m][n], 0, 0, 0); __builtin_amdgcn_s_setprio(0); } while (0)
#define PG8_WAIT_V(n) asm volatile("s_waitcnt vmcnt(" #n ")" ::: "memory")
#define PG8_WAIT_L(n) asm volatile("s_waitcnt lgkmcnt(" #n ")" ::: "memory")
#define PG8_BAR __builtin_amdgcn_s_barrier()
#define PG8_SCHED __builtin_amdgcn_sched_barrier(0)
    UnitD cur, nxt; int ui = 0;
    if (!S.next(0, cur)) return;
    unsigned offA[2][2], offB[2];
    unit_off<Epi::PERM, GATHER>(cur, tid, offA, offB);
    size_t hA = GATHER ? 0 : (size_t)HALF * cur.lda, hB = (size_t)HALF * cur.ldb;
#define OA(h) offA[GATHER ? (h) : 0]
    f32x4 acc[2][2][4][2];
#pragma unroll
    for (int a = 0; a < 2; ++a)
#pragma unroll
        for (int b = 0; b < 2; ++b)
#pragma unroll
            for (int m = 0; m < 4; ++m)
#pragma unroll
                for (int n = 0; n < 2; ++n) acc[a][b][m][n] = (f32x4){0.f, 0.f, 0.f, 0.f};
    bf16x8 At[4][2], B0[2][2], B1[2][2];
    PG8_STAGE(PG8_SB(0, 0), cur.B, offB); PG8_STAGE(PG8_SA(0, 0), cur.A, OA(0)); PG8_STAGE(PG8_SB(0, 1), cur.B + hB, offB); PG8_STAGE(PG8_SA(0, 1), cur.A + hA, OA(1));
    if (wr == 1) PG8_BAR;
    PG8_WAIT_V(4); PG8_BAR;
    PG8_STAGE(PG8_SB(1, 0), cur.B + kstep, offB); PG8_STAGE(PG8_SA(1, 0), cur.A + kstep, OA(0)); PG8_STAGE(PG8_SB(1, 1), cur.B + kstep + hB, offB);
    PG8_WAIT_V(6); PG8_BAR;
    for (;;) {
        const bool has_next = S.next(ui + 1, nxt);
        for (int t = 0; t < nt; t += 2) {
            const bool last = (t == nt - 2);
            const char* a1 = cur.A + (size_t)(t + 1) * kstep;
            PG8_LDB(B0, 0, 0); PG8_SCHED; PG8_LDA(At, 0, 0); PG8_STAGE(PG8_SA(1, 1), a1 + hA, OA(1));
            PG8_WAIT_L(8); PG8_BAR; PG8_WAIT_L(0); PG8_MMA(0, 0, At, B0); PG8_BAR; PG8_SCHED;
            const char* a2; const char* b2;
            if (last) { if (has_next) { unit_off<Epi::PERM, GATHER>(nxt, tid, offA, offB); a2 = nxt.A; b2 = nxt.B; hA = GATHER ? 0 : (size_t)HALF * nxt.lda; hB = (size_t)HALF * nxt.ldb; } else { a2 = cur.A; b2 = cur.B; } }
            else { a2 = cur.A + (size_t)(t + 2) * kstep; b2 = cur.B + (size_t)(t + 2) * kstep; }
            const char* a3 = a2 + kstep; const char* b3 = b2 + kstep;
            PG8_LDB(B1, 0, 1); PG8_STAGE(PG8_SB(0, 0), b2, offB);
            PG8_BAR; PG8_WAIT_L(0); PG8_MMA(0, 1, At, B1); PG8_BAR;
            PG8_LDA(At, 0, 1); PG8_STAGE(PG8_SA(0, 0), a2, OA(0));
            PG8_BAR; PG8_WAIT_L(0); PG8_MMA(1, 0, At, B0); PG8_BAR; PG8_SCHED;
            PG8_STAGE(PG8_SB(0, 1), b2 + hB, offB);
            PG8_WAIT_V(6); PG8_BAR; PG8_MMA(1, 1, At, B1); PG8_BAR;
            PG8_LDB(B0, 1, 0); PG8_SCHED; PG8_LDA(At, 1, 0); PG8_STAGE(PG8_SA(0, 1), a2 + hA, OA(1));
            PG8_WAIT_L(8); PG8_BAR; PG8_WAIT_L(0); PG8_MMA(0, 0, At, B0); PG8_BAR; PG8_SCHED;
            PG8_LDB(B1, 1, 1); PG8_STAGE(PG8_SB(1, 0), b3, offB);
            PG8_BAR; PG8_WAIT_L(0); PG8_MMA(0, 1, At, B1); PG8_BAR;
            PG8_LDA(At, 1, 1); PG8_STAGE(PG8_SA(1, 0), a3, OA(0));
            PG8_BAR; PG8_WAIT_L(0); PG8_MMA(1, 0, At, B0); PG8_BAR; PG8_SCHED;
            PG8_STAGE(PG8_SB(1, 1), b3 + hB, offB);
            PG8_WAIT_V(6); PG8_BAR; PG8_MMA(1, 1, At, B1); PG8_BAR;
        }
        { int fr_ = fr, fq_ = fq; asm volatile("" : "+v"(fr_), "+v"(fq_)); E(acc, cur, wr, wc, fr_, fq_); }
        if (!has_next) break;
#pragma unroll
        for (int a = 0; a < 2; ++a)
#pragma unroll
            for (int b = 0; b < 2; ++b)
#pragma unroll
                for (int m = 0; m < 4; ++m)
#pragma unroll
                    for (int n = 0; n < 2; ++n) acc[a][b][m][n] = (f32x4){0.f, 0.f, 0.f, 0.f};
        cur = nxt; ++ui;
    }
    PG8_WAIT_V(0);
    if (wr == 0) PG8_BAR;
    PG8_BAR;
#undef OA
#undef PG8_SA
#undef PG8_SB
#undef PG8_STAGE
#undef PG8_LDA
#undef PG8_LDB
#undef PG8_MMA
#undef PG8_WAIT_V
#undef PG8_WAIT_L
#undef PG8_BAR
#undef PG8_SCHED
}
}
struct Args { const float* in[19]; float* out; unsigned char* ws; int step_lo, step_hi; };
struct Frame {
    LAS unsigned char* lds; unsigned char* ldsg;
    int tid, lane, wave, G, bid;
    const float *x, *c, *ada_w, *ada_b, *w_in, *conv_w, *gate_b, *norm_g, *w_bm, *w_ba, *w_out, *router_w, *router_b, *w_gate, *w_up, *w_down, *g_mix, *g_ffn, *g_fin;
    float* out; unsigned char* ws; unsigned* ctl;
    float* MOD; float* WIF; float* RW; unsigned char* W;
    bf16_t* U; float* GIF; bf16_t* HM; bf16_t* HA; unsigned char* TOKI; unsigned char* R0;
};
#define CAS __attribute__((address_space(4)))
DI const void* karg(int idx) { asm volatile("" : "+s"(idx)); const void* const CAS* kp = (const void* const CAS*)__builtin_amdgcn_kernarg_segment_ptr(); return kp[idx]; }
DI void frame_init(Frame& F, unsigned char* lds_generic, int tid) {
    F.ldsg = lds_generic; F.lds = (LAS unsigned char*)lds_generic;
    F.tid = tid; F.lane = F.tid & 63; F.wave = __builtin_amdgcn_readfirstlane(F.tid >> 6); F.G = gridDim.x; F.bid = blockIdx.x;
    F.x = (const float*)karg(0); F.c = (const float*)karg(1); F.ada_w = (const float*)karg(2); F.ada_b = (const float*)karg(3); F.w_in = (const float*)karg(4); F.conv_w = (const float*)karg(5);
    F.gate_b = (const float*)karg(6); F.norm_g = (const float*)karg(7); F.w_bm = (const float*)karg(8); F.w_ba = (const float*)karg(9); F.w_out = (const float*)karg(10); F.router_w = (const float*)karg(11);
    F.router_b = (const float*)karg(12); F.w_gate = (const float*)karg(13); F.w_up = (const float*)karg(14); F.w_down = (const float*)karg(15); F.g_mix = (const float*)karg(16); F.g_ffn = (const float*)karg(17); F.g_fin = (const float*)karg(18);
    F.out = (float*)karg(19); unsigned char* ws = (unsigned char*)karg(20);
    F.ws = ws; F.ctl = (unsigned*)(ws + WS_CTL);
    F.MOD = (float*)(ws + WS_MOD); F.WIF = (float*)(ws + WS_WIF); F.RW = (float*)(ws + WS_RW); F.W = ws + WS_W;
    F.U = (bf16_t*)(ws + WS_U); F.GIF = (float*)(ws + WS_GIF); F.HM = (bf16_t*)(ws + WS_HM); F.HA = (bf16_t*)(ws + WS_HA);
    F.TOKI = ws + WS_TOKI; F.R0 = ws + WS_R0;
}

struct TJob { const float* src; int ld; int K; int N; bf16_t* dst; int rmul, radd; };
DI bool get_job(const Frame& F, int l, int j, TJob& J) {
    const float* win = F.w_in + (size_t)l * DM * INC;
    bf16_t* W = (bf16_t*)F.W;
    J.rmul = 1; J.radd = 0; J.K = 1024; J.ld = INC;
    if (j == 0) { J.src = win + 0;    J.N = 1024; J.dst = W + W_NAT / 2 + (size_t)0 * 1024; return true; }
    if (j == 1) { J.src = win + 1024; J.N = 1024; J.dst = W + W_NAT / 2 + (size_t)1024 * 1024; return true; }
    if (j == 2) { J.src = win + 3072; J.N = 1024; J.dst = W + W_NAT / 2 + (size_t)2048 * 1024; return true; }
    if (j == 3) { J.src = win + 4104; J.N = 1536; J.dst = W + W_NAT / 2 + (size_t)3072 * 1024; return true; }
    if (j == 4) { J.src = win + 5640; J.N = 1536; J.dst = W + W_NAT / 2 + (size_t)4608 * 1024; return true; }
    if (j == 5) { J.src = win + 2048; J.N = 1024; J.dst = W + W_VT / 2 + (size_t)0 * 1024; return true; }
    if (j == 6) { J.src = win + 7176; J.N = 1536; J.dst = W + W_VT / 2 + (size_t)1024 * 1024; return true; }
    if (j == 7) { J.src = win + 8712; J.N = 2048; J.dst = W + W_G / 2; return true; }
    if (j == 8) { J.src = F.w_bm + (size_t)l * 1024 * 1024; J.ld = 1024; J.N = 1024; J.dst = W + W_M / 2; return true; }
    if (j == 9) { J.src = F.w_ba + (size_t)l * 512 * 1024; J.ld = 1024; J.K = 512; J.N = 1024; J.dst = W + W_A / 2; return true; }
    if (j == 10) { J.src = F.w_out + (size_t)l * 1024 * 1024; J.ld = 1024; J.N = 1024; J.dst = W + W_O / 2; return true; }
    const int q = j - 11; if (q >= 48) return false;
    const int e = q / 3, which = q % 3;
    if (which == 0) { J.src = F.w_gate + ((size_t)l * 16 + e) * 1024 * 512; J.ld = 512; J.N = 512; J.dst = W + W_13 / 2 + (size_t)e * 1024 * 1024; J.rmul = 2; J.radd = 0; }
    else if (which == 1) { J.src = F.w_up + ((size_t)l * 16 + e) * 1024 * 512; J.ld = 512; J.N = 512; J.dst = W + W_13 / 2 + (size_t)e * 1024 * 1024; J.rmul = 2; J.radd = 1; }
    else { J.src = F.w_down + ((size_t)l * 16 + e) * 512 * 1024; J.ld = 1024; J.K = 512; J.N = 1024; J.dst = W + W_2 / 2 + (size_t)e * 1024 * 512; }
    return true;
}
constexpr int NJOBS = 59;
DI void tconv_tile(const Frame& F, const TJob& J, int tk, int tn) {
    bf16_t* tl = (bf16_t*)F.ldsg;
    const int tid = F.tid;
#pragma unroll
    for (int i = 0; i < 2; ++i) {
        const int row = (tid >> 4) + 32 * i, c4 = tid & 15;
        const f32x4 v = *(const f32x4*)(J.src + (size_t)(tk * 64 + row) * J.ld + tn * 64 + c4 * 4);
        const unsigned lo = pack2(v[0], v[1]), hi = pack2(v[2], v[3]);
        tl[(c4 * 4 + 0) * 72 + row] = (bf16_t)(lo & 0xffff); tl[(c4 * 4 + 1) * 72 + row] = (bf16_t)(lo >> 16);
        tl[(c4 * 4 + 2) * 72 + row] = (bf16_t)(hi & 0xffff); tl[(c4 * 4 + 3) * 72 + row] = (bf16_t)(hi >> 16);
    }
    __syncthreads();
    { const int n = tid >> 3, k8 = tid & 7;
      const u32x4 v = *(const u32x4*)(tl + n * 72 + k8 * 8);
      *(u32x4*)(J.dst + (size_t)(J.rmul * (tn * 64 + n) + J.radd) * J.K + tk * 64 + k8 * 8) = v; }
    __syncthreads();
}
DI void phase_pw(const Frame& F, int l, int b0, int nb) {
    const int me = F.bid - b0; if (me < 0 || me >= nb) return;
    int base = 0;
    for (int j = 0; j < NJOBS; ++j) {
        TJob J; get_job(F, l, j, J);
        const int nk = J.K / 64, nn = J.N / 64, ntile = nk * nn;
        int t = (me - base % nb + nb) % nb;
        for (; t < ntile; t += nb) tconv_tile(F, J, t % nk, t / nk);
        base += ntile;
    }
}
DI void phase_p0_small(const Frame& F) {
    float* sc = (float*)F.ldsg;
    float* part = sc + 4096;
    for (int i = F.tid; i < 4096; i += 512) sc[i] = siluf_(F.c[i]);
    __syncthreads();
    for (int it = F.bid; it < 192; it += F.G) {
        const int l = it / 96, cc = it % 96, col = cc * 64 + F.lane, w = F.wave;
        const float* aw = F.ada_w + (size_t)l * 1024 * 6144 + col;
        float a0 = 0.f, a1 = 0.f, a2 = 0.f, a3 = 0.f;
        for (int k = w * 128; k < w * 128 + 128; ++k) { const float wv = aw[(size_t)k * 6144]; a0 += sc[k] * wv; a1 += sc[1024 + k] * wv; a2 += sc[2048 + k] * wv; a3 += sc[3072 + k] * wv; }
        part[(w * 4 + 0) * 64 + F.lane] = a0; part[(w * 4 + 1) * 64 + F.lane] = a1; part[(w * 4 + 2) * 64 + F.lane] = a2; part[(w * 4 + 3) * 64 + F.lane] = a3;
        __syncthreads();
        if (F.tid < 256) { const int b = F.tid >> 6, ln = F.tid & 63; float s = 0.f;
            for (int ww = 0; ww < 8; ++ww) s += part[(ww * 4 + b) * 64 + ln];
            F.MOD[((size_t)l * 4 + b) * 6144 + cc * 64 + ln] = s + F.ada_b[(size_t)l * 6144 + cc * 64 + ln]; }
        __syncthreads();
    }
    for (int i = F.bid * 512 + F.tid; i < 2 * 8 * 1024 + 16 * 1024; i += F.G * 512) {
        if (i < 16384) { const int l = i >> 13, j = (i >> 10) & 7, k = i & 1023; F.WIF[i] = F.w_in[((size_t)l * 1024 + k) * INC + 4096 + j]; }
        else { const int q = i - 16384, e = q >> 10, k = q & 1023; F.RW[q] = F.router_w[k * 16 + e]; }
    }
}

DI void moe_offsets(const unsigned* cnt, int* pre, int tid) { if (tid == 0) { int s = 0; for (int e = 0; e < 16; ++e) { pre[e] = s; s += ((int)cnt[e] + 255) >> 8; } pre[16] = s; } }

struct RowCtx { float gm[16], sh[16]; };
DI void load_rowconst(const Frame& F, const float* g, const float* shv, const float* scv, RowCtx& rc) {
#pragma unroll
    for (int q = 0; q < 4; ++q) { const int c = F.lane * 4 + 256 * q; const f32x4 gv = *(const f32x4*)(g + c), s1 = *(const f32x4*)(scv + c), s0 = *(const f32x4*)(shv + c);
#pragma unroll
        for (int j = 0; j < 4; ++j) { rc.gm[q * 4 + j] = gv[j] * (1.0f + s1[j]); rc.sh[q * 4 + j] = s0[j]; } }
}
DI void moe_combine_row(const Frame& F, int lprev, int t, int b, const int* pre, float (&xv)[16]) {
    const int* ti = (const int*)(F.TOKI + ((size_t)lprev * T_TOK + t) * 32);
    const int e1 = ti[0], s1 = ti[1], e2 = ti[2], s2 = ti[3]; const float w1 = __int_as_float(ti[4]), w2 = __int_as_float(ti[5]);
    const bf16_t* YS = (const bf16_t*)(F.R0 + R_YS);
    const bf16_t* y1 = YS + (size_t)(pre[e1] * 256 + s1) * 1024; const bf16_t* y2 = YS + (size_t)(pre[e2] * 256 + s2) * 1024;
    const float* gt = F.MOD + ((size_t)lprev * 4 + b) * 6144 + 5120;
#pragma unroll
    for (int q = 0; q < 4; ++q) { const int c = F.lane * 4 + 256 * q; const u32x2 a = *(const u32x2*)(y1 + c), d = *(const u32x2*)(y2 + c); const f32x4 g = *(const f32x4*)(gt + c);
        xv[q * 4 + 0] += g[0] * (w1 * bflo(a.x) + w2 * bflo(d.x)); xv[q * 4 + 1] += g[1] * (w1 * bfhi(a.x) + w2 * bfhi(d.x));
        xv[q * 4 + 2] += g[2] * (w1 * bflo(a.y) + w2 * bflo(d.y)); xv[q * 4 + 3] += g[3] * (w1 * bfhi(a.y) + w2 * bfhi(d.y)); }
}
DI void phase_n1(const Frame& F, int l) {
    float* wif = (float*)F.ldsg;
    int* pre = (int*)(F.ldsg + 32768);
    for (int i = F.tid; i < 8192; i += 512) wif[i] = F.WIF[(size_t)l * 8192 + i];
    if (l > 0) moe_offsets(F.ctl + CW_CNT + 64 * (l - 1), pre, F.tid);
    __syncthreads();
    for (int blk = F.bid; blk < T_TOK / 128; blk += F.G) {
        const int b = blk / (SEQ / 128);
        const float* mod = F.MOD + ((size_t)l * 4 + b) * 6144;
        RowCtx rc; load_rowconst(F, F.g_mix + (size_t)l * 1024, mod, mod + 1024, rc);
#pragma unroll 1
        for (int i = 0; i < 16; ++i) {
            const int t = blk * 128 + F.wave * 16 + i;
            asm volatile("" ::: "memory");
            float xv[16];
            const float* xr = (l == 0 ? F.x : F.out) + (size_t)t * 1024;
#pragma unroll
            for (int q = 0; q < 4; ++q) { const f32x4 v = *(const f32x4*)(xr + F.lane * 4 + 256 * q); xv[q * 4] = v[0]; xv[q * 4 + 1] = v[1]; xv[q * 4 + 2] = v[2]; xv[q * 4 + 3] = v[3]; }
            if (l > 0) {
                moe_combine_row(F, l - 1, t, b, pre, xv);
#pragma unroll
                for (int q = 0; q < 4; ++q) *(f32x4*)(F.out + (size_t)t * 1024 + F.lane * 4 + 256 * q) = (f32x4){xv[q * 4], xv[q * 4 + 1], xv[q * 4 + 2], xv[q * 4 + 3]};
            }
            float ss = 0.f;
#pragma unroll
            for (int j = 0; j < 16; ++j) ss += xv[j] * xv[j];
            ss = wave_sum(ss);
            const float rn = __builtin_amdgcn_rsqf(ss * (1.0f / 1024.0f) + EPS);
            float uv[16];
#pragma unroll
            for (int j = 0; j < 16; ++j) uv[j] = xv[j] * rn * rc.gm[j] + rc.sh[j];
#pragma unroll
            for (int q = 0; q < 4; ++q) { u32x2 w; w.x = pack2(uv[q * 4], uv[q * 4 + 1]); w.y = pack2(uv[q * 4 + 2], uv[q * 4 + 3]); *(u32x2*)(F.U + (size_t)t * 1024 + F.lane * 4 + 256 * q) = w; }
            float d[8];
#pragma unroll
            for (int g = 0; g < 8; ++g) { float s = 0.f;
#pragma unroll
                for (int q = 0; q < 4; ++q) { const f32x4 wv = *(const f32x4*)(wif + g * 1024 + F.lane * 4 + 256 * q); s += uv[q * 4] * wv[0] + uv[q * 4 + 1] * wv[1] + uv[q * 4 + 2] * wv[2] + uv[q * 4 + 3] * wv[3]; }
                d[g] = wave_sum(s); }
            if (F.lane < 8) {
                float v = 0.f;
#pragma unroll
                for (int g = 0; g < 8; ++g) v = (F.lane == g) ? d[g] : v;
                v += F.gate_b[l * 8 + F.lane];
                if (F.lane >= 4) { const float e = __expf(-fabsf(v)); const float l1p = (e < 0.03f) ? e * (1.0f - e * (0.5f - e * (0.33333334f - 0.25f * e))) : __logf(1.0f + e); v = fminf(v, 0.f) - l1p; }
                F.GIF[(size_t)t * 8 + F.lane] = v;
            }
        }
    }
}

DI void phase_n2(const Frame& F, int l) {
    float* rw = (float*)F.ldsg;
    int* cntL = (int*)(F.ldsg + 65536);
    int* baseL = cntL + 16;
    int* rec = baseL + 16;
    for (int i = F.tid; i < 16384; i += 512) rw[i] = F.RW[i];
    __syncthreads();
    unsigned* gcnt = F.ctl + CW_CNT + 64 * l;
    int* SLOT = (int*)(F.R0 + R_SLOT);
    for (int blk = F.bid; blk < T_TOK / 128; blk += F.G) {
        const int b = blk / (SEQ / 128);
        const float* mod = F.MOD + ((size_t)l * 4 + b) * 6144;
        RowCtx rc; load_rowconst(F, F.g_ffn + (size_t)l * 1024, mod + 3072, mod + 4096, rc);
        if (F.tid < 16) cntL[F.tid] = 0;
        __syncthreads();
#pragma unroll 1
        for (int i = 0; i < 16; ++i) {
            const int rl = F.wave * 16 + i, t = blk * 128 + rl;
            asm volatile("" ::: "memory");
            float xv[16];
#pragma unroll
            for (int q = 0; q < 4; ++q) { const f32x4 v = *(const f32x4*)(F.out + (size_t)t * 1024 + F.lane * 4 + 256 * q); xv[q * 4] = v[0]; xv[q * 4 + 1] = v[1]; xv[q * 4 + 2] = v[2]; xv[q * 4 + 3] = v[3]; }
            float ss = 0.f;
#pragma unroll
            for (int j = 0; j < 16; ++j) ss += xv[j] * xv[j];
            ss = wave_sum(ss);
            const float rn = __builtin_amdgcn_rsqf(ss * (1.0f / 1024.0f) + EPS);
            float uv[16];
#pragma unroll
            for (int j = 0; j < 16; ++j) uv[j] = xv[j] * rn * rc.gm[j] + rc.sh[j];
#pragma unroll
            for (int q = 0; q < 4; ++q) { u32x2 w; w.x = pack2(uv[q * 4], uv[q * 4 + 1]); w.y = pack2(uv[q * 4 + 2], uv[q * 4 + 3]); *(u32x2*)(F.U + (size_t)t * 1024 + F.lane * 4 + 256 * q) = w; }
            float mine = 0.f;
#pragma unroll
            for (int e = 0; e < 16; ++e) { float s = 0.f;
#pragma unroll
                for (int q = 0; q < 4; ++q) { const f32x4 wv = *(const f32x4*)(rw + e * 1024 + F.lane * 4 + 256 * q); s += uv[q * 4] * wv[0] + uv[q * 4 + 1] * wv[1] + uv[q * 4 + 2] * wv[2] + uv[q * 4 + 3] * wv[3]; }
                s = wave_sum(s); mine = (F.lane == e) ? s : mine; }
            const float score = 1.0f / (1.0f + __expf(-mine));
            const float sel = score + ((F.lane < 16) ? F.router_b[F.lane] : 0.f);
            const float s0 = __shfl(sel, (F.lane & ~3) + 0), s1 = __shfl(sel, (F.lane & ~3) + 1), s2 = __shfl(sel, (F.lane & ~3) + 2), s3 = __shfl(sel, (F.lane & ~3) + 3);
            const float mx = fmaxf(fmaxf(s0, s1), fmaxf(s2, s3));
            const int im = (s0 == mx) ? 0 : (s1 == mx) ? 1 : (s2 == mx) ? 2 : 3;
            const float t0 = (im == 0) ? -INFINITY : s0, t1 = (im == 1) ? -INFINITY : s1, t2 = (im == 2) ? -INFINITY : s2, t3 = (im == 3) ? -INFINITY : s3;
            const float mx2 = fmaxf(fmaxf(t0, t1), fmaxf(t2, t3));
            const int im2 = (t0 == mx2) ? 0 : (t1 == mx2) ? 1 : (t2 == mx2) ? 2 : 3;
            const float gs = mx + mx2;
            const float g0 = __shfl(gs, 0), g1 = __shfl(gs, 4), g2 = __shfl(gs, 8), g3 = __shfl(gs, 12);
            const float gm = fmaxf(fmaxf(g0, g1), fmaxf(g2, g3));
            const int bg = (g0 == gm) ? 0 : (g1 == gm) ? 1 : (g2 == gm) ? 2 : 3;
            const int e1 = __shfl(bg * 4 + im, bg * 4), e2 = __shfl(bg * 4 + im2, bg * 4);
            const float sc1 = __shfl(score, e1), sc2 = __shfl(score, e2);
            if (F.lane == 0) {
                const float inv = 1.0f / (sc1 + sc2);
                const int r1 = atomicAdd(&cntL[e1], 1), r2 = atomicAdd(&cntL[e2], 1);
                int* r = rec + rl * 6; r[0] = e1; r[1] = r1; r[2] = e2; r[3] = r2; r[4] = __float_as_int(sc1 * inv); r[5] = __float_as_int(sc2 * inv);
            }
        }
        __syncthreads();
        if (F.tid < 16) baseL[F.tid] = (int)atomicAdd(&gcnt[F.tid], (unsigned)cntL[F.tid]);
        __syncthreads();
        if (F.tid < 128) {
            const int t = blk * 128 + F.tid; const int* r = rec + F.tid * 6;
            const int e1 = r[0], s1 = baseL[e1] + r[1], e2 = r[2], s2 = baseL[e2] + r[3];
            SLOT[e1 * 32768 + s1] = t; SLOT[e2 * 32768 + s2] = t;
            int* ti = (int*)(F.TOKI + ((size_t)l * T_TOK + t) * 32);
            ti[0] = e1; ti[1] = s1; ti[2] = e2; ti[3] = s2; ti[4] = r[4]; ti[5] = r[5];
        }
        __syncthreads();
    }
}

DI void phase_fn(const Frame& F) {
    int* pre = (int*)F.ldsg;
    moe_offsets(F.ctl + CW_CNT + 64 * (DEPTH - 1), pre, F.tid);
    __syncthreads();
    for (int blk = F.bid; blk < T_TOK / 128; blk += F.G) {
        const int b = blk / (SEQ / 128);
#pragma unroll 1
        for (int i = 0; i < 16; ++i) {
            const int t = blk * 128 + F.wave * 16 + i;
            float xv[16];
#pragma unroll
            for (int q = 0; q < 4; ++q) { const f32x4 v = *(const f32x4*)(F.out + (size_t)t * 1024 + F.lane * 4 + 256 * q); xv[q * 4] = v[0]; xv[q * 4 + 1] = v[1]; xv[q * 4 + 2] = v[2]; xv[q * 4 + 3] = v[3]; }
            moe_combine_row(F, DEPTH - 1, t, b, pre, xv);
            float ss = 0.f;
#pragma unroll
            for (int j = 0; j < 16; ++j) ss += xv[j] * xv[j];
            ss = wave_sum(ss);
            const float rn = __builtin_amdgcn_rsqf(ss * (1.0f / 1024.0f) + EPS);
#pragma unroll
            for (int q = 0; q < 4; ++q) { const f32x4 g = *(const f32x4*)(F.g_fin + F.lane * 4 + 256 * q);
                *(f32x4*)(F.out + (size_t)t * 1024 + F.lane * 4 + 256 * q) = (f32x4){xv[q * 4] * rn * g[0], xv[q * 4 + 1] * rn * g[1], xv[q * 4 + 2] * rn * g[2], xv[q * 4 + 3] * rn * g[3]}; }
        }
    }
}
DI void phase_cv(const Frame& F, int l) {
    const bf16_t* P = (const bf16_t*)(F.R0 + R_P);
    bf16_t* QC = (bf16_t*)(F.R0 + R_QC); bf16_t* KC = (bf16_t*)(F.R0 + R_KC); bf16_t* KCT = (bf16_t*)(F.R0 + R_KCT);
    bf16_t* raw = (bf16_t*)F.ldsg;
    bf16_t* tT = raw + 67 * 264;
    const int tid = F.tid;
    for (int u = F.bid; u < 128 * 8; u += F.G) {
        const int tt = u >> 3, ct = u & 7, t0 = tt * 64, c0 = ct * 256;
        for (int i = tid; i < 67 * 32; i += 512) { const int r = i >> 5, cg = i & 31, t = t0 - 3 + r;
            u32x4 v = (u32x4){0u, 0u, 0u, 0u};
            if (t >= 0) v = *(const u32x4*)(P + (size_t)t * NNAT + c0 + cg * 8);
            *(u32x4*)(raw + r * 264 + cg * 8) = v; }
        __syncthreads();
        const int cg = tid & 31, ch = c0 + cg * 8;
        float w[4][8];
#pragma unroll
        for (int j = 0; j < 4; ++j) { const f32x4 a = *(const f32x4*)(F.conv_w + ((size_t)l * 4 + j) * 2048 + ch), b = *(const f32x4*)(F.conv_w + ((size_t)l * 4 + j) * 2048 + ch + 4);
            w[j][0] = a[0]; w[j][1] = a[1]; w[j][2] = a[2]; w[j][3] = a[3]; w[j][4] = b[0]; w[j][5] = b[1]; w[j][6] = b[2]; w[j][7] = b[3]; }
        const bool isq = ct < 4; const float osc = isq ? 0.0625f : 1.0f;
#pragma unroll
        for (int i = 0; i < 4; ++i) {
            const int tr = (tid >> 5) + 16 * i;
            float y[8];
#pragma unroll
            for (int k = 0; k < 8; ++k) y[k] = 0.f;
#pragma unroll
            for (int j = 0; j < 4; ++j) { const u32x4 v = *(const u32x4*)(raw + (tr + j) * 264 + cg * 8);
                y[0] += w[j][0] * bflo(v.x); y[1] += w[j][1] * bfhi(v.x); y[2] += w[j][2] * bflo(v.y); y[3] += w[j][3] * bfhi(v.y);
                y[4] += w[j][4] * bflo(v.z); y[5] += w[j][5] * bfhi(v.z); y[6] += w[j][6] * bflo(v.w); y[7] += w[j][7] * bfhi(v.w); }
#pragma unroll
            for (int k = 0; k < 8; ++k) y[k] = siluf_(y[k]) * osc;
            u32x4 o; o.x = pack2(y[0], y[1]); o.y = pack2(y[2], y[3]); o.z = pack2(y[4], y[5]); o.w = pack2(y[6], y[7]);
            if (isq) *(u32x4*)(QC + (size_t)(t0 + tr) * 1024 + ch) = o;
            else { *(u32x4*)(KC + (size_t)(t0 + tr) * 1024 + (ch - 1024)) = o; *(u32x4*)(tT + tr * 264 + cg * 8) = o; }
        }
        __syncthreads();
        if (!isq) {
#pragma unroll
            for (int i = 0; i < 4; ++i) { const int chl = (tid >> 3) + 64 * i, oc = tid & 7;
                unsigned short e[8];
#pragma unroll
                for (int k = 0; k < 8; ++k) e[k] = tT[(oc * 8 + k) * 264 + chl];
                u32x4 o; o.x = e[0] | ((unsigned)e[1] << 16); o.y = e[2] | ((unsigned)e[3] << 16); o.z = e[4] | ((unsigned)e[5] << 16); o.w = e[6] | ((unsigned)e[7] << 16);
                *(u32x4*)(KCT + (size_t)(c0 - 1024 + chl) * TQ + t0 + oc * 8) = o; }
        }
        __syncthreads();
    }
}

DI void ml1_unit(const Frame& F, int h, int j, int eg) {
    const bf16_t* QC = (const bf16_t*)(F.R0 + R_QC); const bf16_t* KC = (const bf16_t*)(F.R0 + R_KC); const bf16_t* KCT = (const bf16_t*)(F.R0 + R_KCT);
    const bf16_t* VT = (const bf16_t*)(F.R0 + R_VT);
    float* NUM = (float*)(F.R0 + R_NUM); float* SLOC = (float*)(F.R0 + R_SLOC);
    float* DENI = (float*)(F.R0 + R_DENI); float* EBC = (float*)(F.R0 + R_EBC); float* EBL = (float*)(F.R0 + R_EBL);
    float* SCB = (float*)(F.R0 + R_SCB); float* CHB = (float*)(F.R0 + R_CHB); float* DN = (float*)(F.R0 + R_DN);
    const int tid = F.tid, lane = F.lane, w = F.wave, rr = lane & 31, hh = lane >> 5;
    const int tl0 = j * 256;
    const size_t tg0 = (size_t)eg * TQ + tl0;
    LAS unsigned char* L = F.lds;
    LAS bf16_t* Sl = (LAS bf16_t*)L;
    LAS float* Lb = (LAS float*)(L + 36864);
    LAS float* Lg = Lb + 256;
    LAS float* Lws = Lg + 256;
    LAS float* Leb = Lws + 256;
    LAS float* Lden = Leb + 256;
    LAS float* Lbl = Lden + 256;
    if (w < 4) {
        const int c = w, t = c * 64 + lane;
        const float li = F.GIF[(tg0 + t) * 8 + h], lf = F.GIF[(tg0 + t) * 8 + 4 + h];
        float b = lf;
#pragma unroll
        for (int o = 1; o < 64; o <<= 1) { const float v = __shfl_up(b, o); if (lane >= o) b += v; }
        const float bl = __shfl(b, 63);
        Lb[t] = b; Lg[t] = li - b; Lws[t] = __expf(bl - b + li); Leb[t] = __expf(b); Lden[t] = 0.f;
        if (lane == 0) Lbl[c] = bl;
    }
    __syncthreads();
    if (tid < 256) {
        const int c = tid >> 6; float pre = 0.f;
        for (int cc = 0; cc < c; ++cc) pre += Lbl[cc];
        EBC[(size_t)(tl0 + tid) * 4 + h] = Leb[tid];
        EBL[(size_t)(tl0 + tid) * 4 + h] = __expf(Lb[tid] + pre);
        if (tid < 4) CHB[h * 128 + j * 4 + tid] = Lbl[tid];
        if (tid == 0) SCB[h * 32 + j] = Lbl[0] + Lbl[1] + Lbl[2] + Lbl[3];
    }
    for (int idx = w; idx < 12; idx += 8) {
        const int c = idx / 3, k3 = idx % 3, ti = (k3 == 0) ? 0 : 1, si = (k3 == 2) ? 1 : 0;
        const bf16_t* kp = KC + (size_t)(tl0 + c * 64 + si * 32 + rr) * 1024 + h * 256 + hh * 8;
        const bf16_t* qp = QC + (size_t)(tl0 + c * 64 + ti * 32 + rr) * 1024 + h * 256 + hh * 8;
        f32x16 acc;
#pragma unroll
        for (int r = 0; r < 16; ++r) acc[r] = 0.f;
        bf16x8 kq[2][8];
#pragma unroll
        for (int kq4 = 0; kq4 < 4; ++kq4) { kq[0][2 * kq4] = ldg8(kp + kq4 * 16); kq[0][2 * kq4 + 1] = ldg8(qp + kq4 * 16); }
#pragma unroll
        for (int k4 = 0; k4 < 4; ++k4) {
            if (k4 < 3) {
#pragma unroll
                for (int kq4 = 0; kq4 < 4; ++kq4) { kq[(k4 + 1) & 1][2 * kq4] = ldg8(kp + ((k4 + 1) * 4 + kq4) * 16); kq[(k4 + 1) & 1][2 * kq4 + 1] = ldg8(qp + ((k4 + 1) * 4 + kq4) * 16); } }
            asm volatile("" ::: "memory");
#pragma unroll
            for (int kq4 = 0; kq4 < 4; ++kq4) acc = MFMA32(kq[k4 & 1][2 * kq4], kq[k4 & 1][2 * kq4 + 1], acc);
        }
        const int tloc = c * 64 + ti * 32 + rr; const float bt = Lb[tloc];
        float rs = 0.f;
#pragma unroll
        for (int g = 0; g < 4; ++g) {
            float v[4];
#pragma unroll
            for (int q = 0; q < 4; ++q) { const int r = g * 4 + q, sl = si * 32 + crow(r, hh);
                float wgt = __expf(bt + Lg[c * 64 + sl]);
                if (sl > ti * 32 + rr) wgt = 0.f;
                v[q] = acc[r] * wgt; rs += v[q]; }
            u32x2 o; o.x = pack2(v[0], v[1]); o.y = pack2(v[2], v[3]);
            *(LAS u32x2*)(Sl + (c * 64 + ti * 32 + rr) * 72 + si * 32 + 8 * g + 4 * hh) = o;
        }
        rs += __shfl_xor(rs, 32);
        if (hh == 0) atomicAdd((float*)(F.ldsg + 36864 + 4 * 1024) + tloc, rs);
    }
    __syncthreads();
    if (tid < 256) DENI[(size_t)(tl0 + tid) * 4 + h] = Lden[tid];
#pragma unroll
    for (int p2 = 0; p2 < 2; ++p2) {
        const int p = tid + 512 * p2, c = p >> 8, d = p & 255;
        const bf16_t* kt = KCT + (size_t)(h * 256 + d) * TQ + tl0 + c * 64;
        float s = 0.f;
#pragma unroll
        for (int o = 0; o < 8; ++o) { const u32x4 v = *(const u32x4*)(kt + o * 8); const LAS float* ws = Lws + c * 64 + o * 8;
            s += bflo(v.x) * ws[0] + bfhi(v.x) * ws[1] + bflo(v.y) * ws[2] + bfhi(v.y) * ws[3] + bflo(v.z) * ws[4] + bfhi(v.z) * ws[5] + bflo(v.w) * ws[6] + bfhi(v.w) * ws[7]; }
        DN[((size_t)h * 128 + j * 4 + c) * 256 + d] = s;
    }
    f32x16 Ct[8];
#pragma unroll
    for (int i = 0; i < 8; ++i)
#pragma unroll
        for (int r = 0; r < 16; ++r) Ct[i][r] = 0.f;
    for (int c = 0; c < 4; ++c) {
        int rr_ = rr, hh_ = hh; asm volatile("" : "+v"(rr_), "+v"(hh_));
        const bf16_t* vbase = VT + (size_t)(h * 256 + w * 32 + rr_) * TQ + tl0 + c * 64 + hh_ * 8;
        f32x16 a0, a1;
#pragma unroll
        for (int r = 0; r < 16; ++r) { a0[r] = 0.f; a1[r] = 0.f; }
        const bf16_t* q0 = QC + (size_t)(tl0 + c * 64 + rr_) * 1024 + h * 256 + hh_ * 8; const bf16_t* q1 = q0 + (size_t)32 * 1024;
        bf16x8 qb[2][2];
        qb[0][0] = ldg8(q0); qb[0][1] = ldg8(q1);
#pragma unroll
        for (int gq = 0; gq < 16; ++gq) {
            const int db = gq >> 1, s2 = gq & 1;
            if (gq < 15) { qb[(gq + 1) & 1][0] = ldg8(q0 + (gq + 1) * 16); qb[(gq + 1) & 1][1] = ldg8(q1 + (gq + 1) * 16); }
            asm volatile("" ::: "memory");
            const bf16x8 cf = packf8(Ct[db][8 * s2], Ct[db][8 * s2 + 1], Ct[db][8 * s2 + 2], Ct[db][8 * s2 + 3], Ct[db][8 * s2 + 4], Ct[db][8 * s2 + 5], Ct[db][8 * s2 + 6], Ct[db][8 * s2 + 7]);
            a0 = MFMA32(qb[gq & 1][0], cf, a0);
            a1 = MFMA32(qb[gq & 1][1], cf, a1);
        }
#pragma unroll
        for (int r = 0; r < 16; ++r) { a0[r] *= Leb[c * 64 + crow(r, hh)]; a1[r] *= Leb[c * 64 + 32 + crow(r, hh)]; }
#pragma unroll
        for (int ks = 0; ks < 4; ++ks) {
            const bf16x8 vf = ldg8(vbase + ks * 16);
            if (ks < 2) a0 = MFMA32(*(const LAS bf16x8*)(Sl + (c * 64 + rr) * 72 + ks * 16 + hh * 8), vf, a0);
            a1 = MFMA32(*(const LAS bf16x8*)(Sl + (c * 64 + 32 + rr) * 72 + ks * 16 + hh * 8), vf, a1);
        }
        { float* np = NUM + (size_t)(tl0 + c * 64) * 1024 + h * 256 + w * 32 + rr_;
#pragma unroll
          for (int r = 0; r < 16; ++r) { np[(size_t)crow(r, hh) * 1024] = a0[r]; np[(size_t)(32 + crow(r, hh)) * 1024] = a1[r]; } }
        asm volatile("" ::: "memory");
        const float dec = __expf(Lbl[c]);
        bf16x8 vs[4];
#pragma unroll
        for (int ks = 0; ks < 4; ++ks) {
            const u32x4 v = __builtin_bit_cast(u32x4, ldg8(vbase + ks * 16)); const LAS float* ws = Lws + c * 64 + ks * 16 + hh * 8;
            vs[ks] = packf8(bflo(v.x) * ws[0], bfhi(v.x) * ws[1], bflo(v.y) * ws[2], bfhi(v.y) * ws[3], bflo(v.z) * ws[4], bfhi(v.z) * ws[5], bflo(v.w) * ws[6], bfhi(v.w) * ws[7]);
        }
        const bf16_t* ktb = KCT + (size_t)(h * 256 + pi23(rr_)) * TQ + tl0 + c * 64 + hh_ * 8;
        bf16x8 kb[2][4];
#pragma unroll
        for (int ks = 0; ks < 4; ++ks) kb[0][ks] = ldg8(ktb + ks * 16);
#pragma unroll
        for (int db = 0; db < 8; ++db) {
            if (db < 7) { const bf16_t* kt = ktb + (size_t)(db + 1) * 32 * TQ;
#pragma unroll
                for (int ks = 0; ks < 4; ++ks) kb[(db + 1) & 1][ks] = ldg8(kt + ks * 16); }
            asm volatile("" ::: "memory");
#pragma unroll
            for (int r = 0; r < 16; ++r) Ct[db][r] *= dec;
#pragma unroll
            for (int ks = 0; ks < 4; ++ks) Ct[db] = MFMA32(kb[db & 1][ks], vs[ks], Ct[db]);
        }
    }
    { float* sp = SLOC + (((size_t)h * 32 + j) * 256 + w * 32 + rr) * 256 + hh * 8;
#pragma unroll
      for (int db = 0; db < 8; ++db)
#pragma unroll
          for (int a = 0; a < 2; ++a) {
              *(f32x4*)(sp + db * 32 + a * 16) = (f32x4){Ct[db][8 * a], Ct[db][8 * a + 1], Ct[db][8 * a + 2], Ct[db][8 * a + 3]};
              *(f32x4*)(sp + db * 32 + a * 16 + 4) = (f32x4){Ct[db][8 * a + 4], Ct[db][8 * a + 5], Ct[db][8 * a + 6], Ct[db][8 * a + 7]}; } }
    __syncthreads();
}

DI void at_unit(const Frame& F, int au) {
    const bf16_t* P = (const bf16_t*)(F.R0 + R_P); const bf16_t* VT = (const bf16_t*)(F.R0 + R_VT); float* LSE = (float*)(F.R0 + R_LSE); bf16_t* OUTG = (bf16_t*)(F.R0 + R_OUTG);
    int lane = F.lane; asm volatile("" : "+v"(lane));
    const int rr = lane & 31, hh = lane >> 5;
    const int hd = au >> 8, qt = au & 255, g = hd >> 2;
    const int dsh = 2 * g, d = 1 << dsh, lsub = TQ >> dsh, tiles = lsub >> 5;
    const int r = qt / tiles, l0 = (qt % tiles) * 32;
    const float slope_d = exp2f(-8.0f * (float)(hd + 1) / 12.0f) * (float)d;
    const size_t qrow = (size_t)((l0 + rr) * d + r) * NNAT + 3072 + hd * 128;
    bf16x8 qf[8];
#pragma unroll
    for (int ks = 0; ks < 8; ++ks) qf[ks] = ldg8(P + qrow + hh * 64 + ks * 8);
    const int prr = pi23(rr);
    bf16x8 kb[2][4];
    { const int lk = l0 - 128 < 0 ? 0 : l0 - 128; const bf16_t* kp = P + (size_t)((lk + prr) * d + r) * NNAT + 4608 + hd * 128 + hh * 64;
#pragma unroll
      for (int ks = 0; ks < 4; ++ks) kb[0][ks] = ldg8(kp + ks * 8); }
    f32x16 sc[5];
    float mx = -1e30f;
#pragma unroll
    for (int gq = 0; gq < 10; ++gq) {
        const int kt = gq >> 1, hf = gq & 1, lk0 = l0 - 128 + 32 * kt;
        if (gq < 9) { const int ktn = (gq + 1) >> 1, hfn = (gq + 1) & 1; const int lkn = l0 - 128 + 32 * ktn < 0 ? 0 : l0 - 128 + 32 * ktn;
            const bf16_t* kp = P + (size_t)((lkn + prr) * d + r) * NNAT + 4608 + hd * 128 + hh * 64 + hfn * 32;
#pragma unroll
            for (int ks = 0; ks < 4; ++ks) kb[(gq + 1) & 1][ks] = ldg8(kp + ks * 8); }
        asm volatile("" ::: "memory");
        if (hf == 0) {
#pragma unroll
            for (int i = 0; i < 16; ++i) sc[kt][i] = 0.f; }
#pragma unroll
        for (int ks = 0; ks < 4; ++ks) sc[kt] = MFMA32(kb[gq & 1][ks], qf[hf * 4 + ks], sc[kt]);
        if (hf == 1) {
            const bool tile_ok = lk0 >= 0;
#pragma unroll
            for (int i = 0; i < 16; ++i) {
                const int kk = (i & 3) + 4 * ((i >> 2) & 1) + 8 * hh + 16 * (i >> 3);
                const int dist = 128 - 32 * kt + rr - kk;
                float s = sc[kt][i] - slope_d * (float)dist;
                s = (tile_ok && dist >= 0 && dist <= 128) ? s : -1e30f;
                sc[kt][i] = s; mx = fmaxf(mx, s);
            }
        }
    }
    mx = fmaxf(mx, __shfl_xor(mx, 32));
    float sum = 0.f;
    bf16x8 pf[5][2];
#pragma unroll
    for (int kt = 0; kt < 5; ++kt) {
        float p[16];
#pragma unroll
        for (int i = 0; i < 16; ++i) { p[i] = __expf(sc[kt][i] - mx); sum += p[i]; }
        pf[kt][0] = packf8(p[0], p[1], p[2], p[3], p[4], p[5], p[6], p[7]);
        pf[kt][1] = packf8(p[8], p[9], p[10], p[11], p[12], p[13], p[14], p[15]);
    }
    sum += __shfl_xor(sum, 32);
    const float inv = 1.0f / sum;
    const bf16_t* vrow = VT + (size_t)(1024 + hd * 128 + rr) * TQ + r * lsub + hh * 8;
    bf16x8 vb[2][5];
#pragma unroll
    for (int kt = 0; kt < 5; ++kt) { const int lk = l0 - 128 + 32 * kt < 0 ? 0 : l0 - 128 + 32 * kt; vb[0][kt] = ldg8(vrow + lk); }
    f32x16 o;
#pragma unroll
    for (int gq = 0; gq < 8; ++gq) {
        const int ct = gq >> 1, s = gq & 1;
        if (gq < 7) { const int ctn = (gq + 1) >> 1, sn = (gq + 1) & 1; const bf16_t* vp = vrow + (size_t)ctn * 32 * TQ + sn * 16;
#pragma unroll
            for (int kt = 0; kt < 5; ++kt) { const int lk = l0 - 128 + 32 * kt < 0 ? 0 : l0 - 128 + 32 * kt; vb[(gq + 1) & 1][kt] = ldg8(vp + lk); } }
        asm volatile("" ::: "memory");
        if (s == 0) {
#pragma unroll
            for (int i = 0; i < 16; ++i) o[i] = 0.f; }
#pragma unroll
        for (int kt = 0; kt < 5; ++kt) o = MFMA32(vb[gq & 1][kt], pf[kt][s], o);
        if (s == 1) {
#pragma unroll
            for (int g4 = 0; g4 < 4; ++g4) { u32x2 w; w.x = pack2(o[4 * g4] * inv, o[4 * g4 + 1] * inv); w.y = pack2(o[4 * g4 + 2] * inv, o[4 * g4 + 3] * inv);
                *(u32x2*)(OUTG + (size_t)((l0 + rr) * d + r) * 1536 + hd * 128 + ct * 32 + 8 * g4 + 4 * hh) = w; }
        }
    }
    if (hh == 0) LSE[(size_t)((l0 + rr) * d + r) * 12 + hd] = mx + __logf(sum);
}

DI void phase_p2(const Frame& F) {
    const float* SLOC = (const float*)(F.R0 + R_SLOC); bf16_t* CST = (bf16_t*)(F.R0 + R_CST);
    const float* SCB = (const float*)(F.R0 + R_SCB); const float* CHB = (const float*)(F.R0 + R_CHB);
    const float* DN = (const float*)(F.R0 + R_DN); float* NST = (float*)(F.R0 + R_NST);
    for (int gt = F.bid * 512 + F.tid; gt < 131072; gt += F.G * 512) {
        const int h = gt >> 15, e2 = (gt & 32767) * 2;
        f32x2 run = (f32x2){0.f, 0.f};
#pragma unroll 1
        for (int j0 = 0; j0 < 32; j0 += 8) {
            f32x2 s[8]; float dec[8];
#pragma unroll
            for (int jj = 0; jj < 8; ++jj) { s[jj] = *(const f32x2*)(SLOC + ((size_t)h * 32 + j0 + jj) * 65536 + e2); dec[jj] = SCB[h * 32 + j0 + jj]; }
#pragma unroll
            for (int jj = 0; jj < 8; ++jj) { *(unsigned*)(CST + ((size_t)h * 32 + j0 + jj) * 65536 + e2) = pack2(run[0], run[1]); run = run * __expf(dec[jj]) + s[jj]; }
        }
    }
    const int q = ((F.G - 1 - F.bid) * 512 + F.tid);
    if (q < 1024) {
        const int h = q >> 8, dd = q & 255; float run = 0.f;
#pragma unroll 1
        for (int c0 = 0; c0 < 128; c0 += 16) {
            float dn[16], cb[16];
#pragma unroll
            for (int cc = 0; cc < 16; ++cc) { dn[cc] = DN[((size_t)h * 128 + c0 + cc) * 256 + dd]; cb[cc] = CHB[h * 128 + c0 + cc]; }
#pragma unroll
            for (int cc = 0; cc < 16; ++cc) { NST[((size_t)h * 128 + c0 + cc) * 256 + dd] = run; run = run * __expf(cb[cc]) + dn[cc]; }
        }
    }
}

DI void f_hm_unit(const Frame& F, int l, int h, int tt, int eg) {
    const bf16_t* QC = (const bf16_t*)(F.R0 + R_QC); const bf16_t* CST = (const bf16_t*)(F.R0 + R_CST); const float* NST = (const float*)(F.R0 + R_NST);
    const float* NUM = (const float*)(F.R0 + R_NUM); const bf16_t* P = (const bf16_t*)(F.R0 + R_P);
    const float* DENI = (const float*)(F.R0 + R_DENI); const float* EBC = (const float*)(F.R0 + R_EBC); const float* EBL = (const float*)(F.R0 + R_EBL);
    int lane = F.lane; asm volatile("" : "+v"(lane));
    const int tr = lane & 15, kg = lane >> 4;
    const int tl0 = tt * 16, j = tl0 >> 8, c = tl0 >> 6, tl = tl0 + tr;
    f32x4 acc[16];
#pragma unroll
    for (int i = 0; i < 16; ++i) acc[i] = (f32x4){0.f, 0.f, 0.f, 0.f};
    const bf16_t* qp = QC + (size_t)tl * 1024 + h * 256 + kg * 8;
    const bf16_t* cp = CST + (((size_t)h * 32 + j) * 256 + tr) * 256 + kg * 8;
    const float* np = NST + ((size_t)h * 128 + c) * 256 + kg * 8;
    const float ebl = EBL[(size_t)tl * 4 + h], ebc = EBC[(size_t)tl * 4 + h], deni = DENI[(size_t)tl * 4 + h];
    bf16x8 qf[8];
#pragma unroll
    for (int ks = 0; ks < 8; ++ks) qf[ks] = ldg8(qp + ks * 32);
    float dotn = 0.f;
#pragma unroll
    for (int ks = 0; ks < 8; ++ks) {
        const f32x4 n0 = *(const f32x4*)(np + ks * 32), n1 = *(const f32x4*)(np + ks * 32 + 4);
        const u32x4 qv = __builtin_bit_cast(u32x4, qf[ks]);
        dotn += bflo(qv.x) * n0[0] + bfhi(qv.x) * n0[1] + bflo(qv.y) * n0[2] + bfhi(qv.y) * n0[3] + bflo(qv.z) * n1[0] + bfhi(qv.z) * n1[1] + bflo(qv.w) * n1[2] + bfhi(qv.w) * n1[3];
    }
    bf16x8 cb[2][8];
#pragma unroll
    for (int ks = 0; ks < 8; ++ks) cb[0][ks] = ldg8(cp + ks * 32);
#pragma unroll
    for (int et = 0; et < 16; ++et) {
        if (et < 15) { const bf16_t* cn = cp + (size_t)(et + 1) * 16 * 256;
#pragma unroll
            for (int ks = 0; ks < 8; ++ks) cb[(et + 1) & 1][ks] = ldg8(cn + ks * 32); }
        asm volatile("" ::: "memory");
#pragma unroll
        for (int ks = 0; ks < 8; ++ks) acc[et] = __builtin_amdgcn_mfma_f32_16x16x32_bf16(cb[et & 1][ks], qf[ks], acc[et], 0, 0, 0);
    }
    dotn += __shfl_xor(dotn, 16); dotn += __shfl_xor(dotn, 32);
    const float den = deni + ebc * dotn;
    const float invd = 1.0f / fmaxf(fabsf(den), 1.0f);
    float ssq = 0.f;
    { f32x4 nl[16];
#pragma unroll
      for (int et = 0; et < 16; ++et) nl[et] = *(const f32x4*)(NUM + (size_t)tl * 1024 + h * 256 + et * 16 + 4 * kg);
#pragma unroll
      for (int et = 0; et < 16; ++et)
#pragma unroll
          for (int q = 0; q < 4; ++q) { const float v = (nl[et][q] + ebl * acc[et][q]) * invd; acc[et][q] = v; ssq += v * v; } }
    ssq += __shfl_xor(ssq, 16); ssq += __shfl_xor(ssq, 32);
    const float rn = __builtin_amdgcn_rsqf(ssq * (1.0f / 256.0f) + EPS);
    const size_t tp = (size_t)(eg & 1) * TQ + tl;
    asm volatile("" ::: "memory");
#pragma unroll
    for (int e8 = 0; e8 < 2; ++e8) {
        u32x2 og[8]; f32x4 ng[8];
#pragma unroll
        for (int i = 0; i < 8; ++i) { const int e = (e8 * 8 + i) * 16 + 4 * kg; og[i] = *(const u32x2*)(P + (size_t)tl * NNAT + 2048 + h * 256 + e); ng[i] = *(const f32x4*)(F.norm_g + (size_t)l * 1024 + h * 256 + e); }
#pragma unroll
        for (int i = 0; i < 8; ++i) { const int et = e8 * 8 + i, e = et * 16 + 4 * kg;
            u32x2 w; w.x = pack2(bflo(og[i].x) * acc[et][0] * rn * ng[i][0], bfhi(og[i].x) * acc[et][1] * rn * ng[i][1]);
            w.y = pack2(bflo(og[i].y) * acc[et][2] * rn * ng[i][2], bfhi(og[i].y) * acc[et][3] * rn * ng[i][3]);
            *(u32x2*)(F.HM + tp * 1024 + h * 256 + e) = w; }
        asm volatile("" ::: "memory");
    }
}
DI void f_ha_token(const Frame& F, int tl, int eg) {
    const bf16_t* OUTG = (const bf16_t*)(F.R0 + R_OUTG); const float* LSE = (const float*)(F.R0 + R_LSE);
    int lane = F.lane; asm volatile("" : "+v"(lane));
    const int hs = lane >> 4, ch0 = (lane & 15) * 8;
    const float l0 = LSE[(size_t)tl * 12 + hs], l1 = LSE[(size_t)tl * 12 + 4 + hs], l2 = LSE[(size_t)tl * 12 + 8 + hs];
    const float m = fmaxf(l0, fmaxf(l1, l2));
    float a0 = __expf(l0 - m), a1 = __expf(l1 - m), a2 = __expf(l2 - m); const float inv = 1.0f / (a0 + a1 + a2); a0 *= inv; a1 *= inv; a2 *= inv;
    const bf16_t* pr = OUTG + (size_t)tl * 1536 + hs * 128 + ch0;
    const u32x4 v0 = *(const u32x4*)(pr), v1 = *(const u32x4*)(pr + 512), v2 = *(const u32x4*)(pr + 1024);
    u32x4 o;
    o.x = pack2(a0 * bflo(v0.x) + a1 * bflo(v1.x) + a2 * bflo(v2.x), a0 * bfhi(v0.x) + a1 * bfhi(v1.x) + a2 * bfhi(v2.x));
    o.y = pack2(a0 * bflo(v0.y) + a1 * bflo(v1.y) + a2 * bflo(v2.y), a0 * bfhi(v0.y) + a1 * bfhi(v1.y) + a2 * bfhi(v2.y));
    o.z = pack2(a0 * bflo(v0.z) + a1 * bflo(v1.z) + a2 * bflo(v2.z), a0 * bfhi(v0.z) + a1 * bfhi(v1.z) + a2 * bfhi(v2.z));
    o.w = pack2(a0 * bflo(v0.w) + a1 * bflo(v1.w) + a2 * bflo(v2.w), a0 * bfhi(v0.w) + a1 * bfhi(v1.w) + a2 * bfhi(v2.w));
    *(u32x4*)(F.HA + ((size_t)(eg & 1) * TQ + tl) * 512 + hs * 128 + ch0) = o;
}
using pg8::UnitD;
DI u32x4 pack8(const f32x4& v0, const f32x4& v1) { u32x4 w; w.x = pack2(v0[0], v0[1]); w.y = pack2(v0[2], v0[3]); w.z = pack2(v1[0], v1[1]); w.w = pack2(v1[2], v1[3]); return w; }

struct SchedG1 {
    const char* U; const char* Wnat; const char* Wvt; int G, c;
    DI bool next(int i, UnitD& u) const {
        const int L = i * G + c; if (L >= 768 + 320) return false;
        u.arows = nullptr; u.acount = 0; u.aux = 0;
        if (L < 768) { int pm, pn; pg8::tile_map(L, 32, 24, pm, pn); u.kind = 0; u.pm = pm; u.pn = pn;
            u.A = U + (size_t)pm * 256 * 2048; u.lda = 2048; u.B = Wnat + (size_t)pn * 256 * 2048; u.ldb = 2048; }
        else { const int idx = L - 768, pm = idx % 10, pn = idx / 10; u.kind = 1; u.pm = pm; u.pn = pn;
            u.A = Wvt + (size_t)pm * 256 * 2048; u.lda = 2048;
            int tokbase = pn * 256, dmul = 1;
            if (pm >= 4) { const int g = (pm - 4) >> 1, dsh = 2 * g, lsub = TQ >> dsh, n0 = pn * 256; dmul = 1 << dsh; tokbase = (n0 % lsub) * dmul + n0 / lsub; }
            u.B = U + (size_t)tokbase * 2048; u.ldb = 2048u * (unsigned)dmul; }
        return true;
    }
};
struct EpiG1 {
    static constexpr bool PERM = true;
    bf16_t* P; bf16_t* VT;
    DI void operator()(const f32x4 (&acc)[2][2][4][2], const UnitD& u, int wr, int wc, int fr, int fq) const {
        bf16_t* base; size_t ld; int mode = 0;
        if (u.kind == 0) { base = P + (size_t)u.pm * 256 * NNAT + u.pn * 256; ld = NNAT; mode = (u.pn >= 8 && u.pn < 12) ? 1 : ((u.pn >= 12 && u.pn < 18) ? 2 : 0); }
        else { base = VT + (size_t)u.pm * 256 * TQ + u.pn * 256; ld = TQ; }
        const int row0 = wr * 64 + fr, col0 = wc * 32 + 8 * fq;
#pragma unroll
        for (int ai = 0; ai < 2; ++ai)
#pragma unroll
            for (int m = 0; m < 4; ++m) { bf16_t* rowp = base + (size_t)(row0 + ai * 128 + m * 16) * ld + col0;
#pragma unroll
                for (int bj = 0; bj < 2; ++bj) { f32x4 v0 = acc[ai][bj][m][0], v1 = acc[ai][bj][m][1];
                    if (mode == 1) {
#pragma unroll
                        for (int q = 0; q < 4; ++q) { v0[q] = sigmoidf_(v0[q]); v1[q] = sigmoidf_(v1[q]); } }
                    else if (mode == 2) { v0 *= 0.08838834764831845f; v1 *= 0.08838834764831845f; }
                    *(u32x4*)(rowp + bj * 128) = pack8(v0, v1); }
                asm volatile("" ::: "memory"); }
    }
};
struct SchedDense {
    const char* A; const char* B; unsigned lda, ldb; int nM, nN, G, c;
    DI bool next(int i, UnitD& u) const {
        const int L = i * G + c; if (L >= nM * nN) return false;
        int pm, pn; pg8::tile_map(L, nM, nN, pm, pn); u.kind = 0; u.pm = pm; u.pn = pn; u.aux = 0; u.arows = nullptr; u.acount = 0;
        u.A = A + (size_t)pm * 256 * lda; u.lda = lda; u.B = B + (size_t)pn * 256 * ldb; u.ldb = ldb; return true;
    }
};
struct EpiG1g {
    static constexpr bool PERM = true;
    bf16_t* GT;
    DI void operator()(const f32x4 (&acc)[2][2][4][2], const UnitD& u, int wr, int wc, int fr, int fq) const {
        bf16_t* base = GT + (size_t)u.pm * 256 * 2048 + u.pn * 256; const int row0 = wr * 64 + fr, col0 = wc * 32 + 8 * fq;
#pragma unroll
        for (int ai = 0; ai < 2; ++ai)
#pragma unroll
            for (int m = 0; m < 4; ++m) { bf16_t* rowp = base + (size_t)(row0 + ai * 128 + m * 16) * 2048 + col0;
#pragma unroll
                for (int bj = 0; bj < 2; ++bj) { f32x4 v0 = acc[ai][bj][m][0], v1 = acc[ai][bj][m][1];
#pragma unroll
                    for (int q = 0; q < 4; ++q) { v0[q] = sigmoidf_(v0[q]); v1[q] = sigmoidf_(v1[q]); }
                    *(u32x4*)(rowp + bj * 128) = pack8(v0, v1); }
                asm volatile("" ::: "memory"); }
    }
};
template <int WHICH> struct EpiG2 {
    static constexpr bool PERM = true;
    bf16_t* GT;
    DI void operator()(const f32x4 (&acc)[2][2][4][2], const UnitD& u, int wr, int wc, int fr, int fq) const {
        bf16_t* base = GT + (size_t)u.pm * 256 * 2048 + u.pn * 256 + (WHICH == 0 ? 1024 : 0); const int row0 = wr * 64 + fr, col0 = wc * 32 + 8 * fq;
#pragma unroll
        for (int ai = 0; ai < 2; ++ai)
#pragma unroll
            for (int m = 0; m < 4; ++m) { bf16_t* rowp = base + (size_t)(row0 + ai * 128 + m * 16) * 2048 + col0;
#pragma unroll
                for (int bj = 0; bj < 2; ++bj) { const f32x4 a0 = acc[ai][bj][m][0], a1 = acc[ai][bj][m][1];
                    const u32x4 g = *(const u32x4*)(rowp + bj * 128);
                    f32x4 v0 = (f32x4){bflo(g.x) * a0[0], bfhi(g.x) * a0[1], bflo(g.y) * a0[2], bfhi(g.y) * a0[3]};
                    f32x4 v1 = (f32x4){bflo(g.z) * a1[0], bfhi(g.z) * a1[1], bflo(g.w) * a1[2], bfhi(g.w) * a1[3]};
                    if (WHICH == 1) { const u32x4 y = *(const u32x4*)(rowp + bj * 128 + 1024);
                        v0 += (f32x4){bflo(y.x), bfhi(y.x), bflo(y.y), bfhi(y.y)}; v1 += (f32x4){bflo(y.z), bfhi(y.z), bflo(y.w), bfhi(y.w)}; }
                    *(u32x4*)(rowp + bj * 128) = pack8(v0, v1); }
                asm volatile("" ::: "memory"); }
    }
};
struct EpiG3 {
    static constexpr bool PERM = false;
    const float* xin; float* xout; const float* gta;
    int b0;
    DI void operator()(const f32x4 (&acc)[2][2][4][2], const UnitD& u, int wr, int wc, int fr, int fq) const {
        const int row0 = u.pm * 256 + wr * 64 + fr, col0 = u.pn * 256 + wc * 32 + 4 * fq;
        const float* g = gta + (size_t)(b0 + (u.pm >> 5)) * 6144 + col0;
        f32x4 gv[2][2];
#pragma unroll
        for (int bj = 0; bj < 2; ++bj)
#pragma unroll
            for (int n = 0; n < 2; ++n) gv[bj][n] = *(const f32x4*)(g + bj * 128 + n * 16);
#pragma unroll
        for (int ai = 0; ai < 2; ++ai)
#pragma unroll
            for (int m = 0; m < 4; ++m) { const size_t o = (size_t)(row0 + ai * 128 + m * 16) * 1024 + col0;
#pragma unroll
                for (int bj = 0; bj < 2; ++bj)
#pragma unroll
                    for (int n = 0; n < 2; ++n) { const f32x4 xv = *(const f32x4*)(xin + o + bj * 128 + n * 16); *(f32x4*)(xout + o + bj * 128 + n * 16) = xv + gv[bj][n] * acc[ai][bj][m][n]; }
                asm volatile("" ::: "memory"); }
    }
};
struct SchedMoe {
    const int* pre;
    const unsigned* cnt;
    const char* A; const char* W; const int* SLOT; int G, c; bool gate_up;
    DI bool next(int i, UnitD& u) const {
        const int L = i * G + c, nt = pre[16]; if (L >= nt * 4) return false;
        const int rt = L >> 2, ct = L & 3; int e = 0;
#pragma unroll
        for (int q = 1; q < 16; ++q) e += (rt >= pre[q]) ? 1 : 0;
        u.kind = 0; u.pm = rt; u.pn = ct; u.aux = e;
        const int ti = rt - pre[e];
        if (gate_up) { u.A = A; u.lda = 2048; u.arows = SLOT + (size_t)e * 32768 + ti * 256; u.acount = (int)cnt[e] - ti * 256;
            u.B = W + ((size_t)e * 1024 + ct * 256) * 2048; u.ldb = 2048; }
        else { u.A = A + (size_t)rt * 256 * 1024; u.lda = 1024; u.arows = nullptr; u.acount = 0;
            u.B = W + ((size_t)e * 1024 + ct * 256) * 1024; u.ldb = 1024; }
        return true;
    }
};
struct EpiG4 {
    static constexpr bool PERM = true;
    bf16_t* HH;
    DI void operator()(const f32x4 (&acc)[2][2][4][2], const UnitD& u, int wr, int wc, int fr, int fq) const {
        bf16_t* base = HH + (size_t)u.pm * 256 * 512 + u.pn * 128; const int row0 = wr * 64 + fr, col0 = wc * 16 + 4 * fq;
#pragma unroll
        for (int ai = 0; ai < 2; ++ai)
#pragma unroll
            for (int m = 0; m < 4; ++m) { bf16_t* rowp = base + (size_t)(row0 + ai * 128 + m * 16) * 512 + col0;
#pragma unroll
                for (int bj = 0; bj < 2; ++bj) { const f32x4 v0 = acc[ai][bj][m][0], v1 = acc[ai][bj][m][1];
                    u32x2 w; w.x = pack2(siluf_(v0[0]) * v0[1], siluf_(v0[2]) * v0[3]); w.y = pack2(siluf_(v1[0]) * v1[1], siluf_(v1[2]) * v1[3]);
                    *(u32x2*)(rowp + bj * 64) = w; }
                asm volatile("" ::: "memory"); }
    }
};
struct EpiG5 {
    static constexpr bool PERM = true;
    bf16_t* YS;
    DI void operator()(const f32x4 (&acc)[2][2][4][2], const UnitD& u, int wr, int wc, int fr, int fq) const {
        bf16_t* base = YS + (size_t)u.pm * 256 * 1024 + u.pn * 256; const int row0 = wr * 64 + fr, col0 = wc * 32 + 8 * fq;
#pragma unroll
        for (int ai = 0; ai < 2; ++ai)
#pragma unroll
            for (int m = 0; m < 4; ++m) { bf16_t* rowp = base + (size_t)(row0 + ai * 128 + m * 16) * 1024 + col0;
#pragma unroll
                for (int bj = 0; bj < 2; ++bj) *(u32x4*)(rowp + bj * 128) = pack8(acc[ai][bj][m][0], acc[ai][bj][m][1]);
                asm volatile("" ::: "memory"); }
    }
};
constexpr int LDS_BYTES = 131072 + 1024;
constexpr int LDS_MISC = 131072;
#ifndef MK_ONE_LAUNCH
#define MK_ONE_LAUNCH 1
#endif
constexpr int N_STEPS = 1 + DEPTH * (1 + 2 * (2 * 5 + 4) + 3) + 1;

__global__ void __launch_bounds__(512, 2) fwd_kernel(Args args) {
    extern __shared__ __attribute__((aligned(16))) unsigned char lds_raw[];
    const int tid0 = threadIdx.x;
    LAS unsigned char* lds0 = (LAS unsigned char*)lds_raw;
    if (tid0 < 4) ((volatile LAS unsigned*)(lds0 + LDS_MISC))[tid0] = 0u;
    __syncthreads();
    unsigned* ctl0 = (unsigned*)(args.ws + WS_CTL);
    XcdBarrier bar; bar.bar = ctl0 + CW_BAR; bar.x = 0; bar.st = nullptr;
    const int lo = args.step_lo, hi = args.step_hi;
    if (hi - lo > 1) bar = xcd_barrier_post(ctl0 + CW_BAR, (volatile LAS unsigned*)(lds0 + LDS_MISC));
    int step = 0; int l_probe = 0;
#ifndef SITE_MASK
#define SITE_MASK 0xFFFFFFFFu
#endif
#ifndef DUP_MASK
#define DUP_MASK 0u
#endif
#ifndef DUP_L0
#define DUP_L0 0
#endif
#ifndef EXTRA_BARS
#define EXTRA_BARS 0
#endif
#define RUN(site, ...) do { if (step >= lo && step < hi) { if constexpr ((DUP_MASK >> (site)) & 1u) { if (!DUP_L0 || l_probe == 0) { Frame F; { int t_ = tid0; asm volatile("" : "+v"(t_)); frame_init(F, lds_raw, t_); } int* preL = (int*)(F.ldsg + LDS_MISC + 64); (void)preL; __VA_ARGS__; xcd_barrier(bar); } } if constexpr ((SITE_MASK >> (site)) & 1u) { Frame F; { int t_ = tid0; asm volatile("" : "+v"(t_)); frame_init(F, lds_raw, t_); } int* preL = (int*)(F.ldsg + LDS_MISC + 64); (void)preL; __VA_ARGS__; } if (step + 1 < hi) xcd_barrier(bar); } ++step; } while (0)

    RUN(0, { phase_p0_small(F); __syncthreads(); phase_pw(F, 0, 0, F.G); });
    for (int l = 0; l < DEPTH; ++l) { l_probe = l;
        RUN(1, { if (l > 0) phase_pw(F, l, 0, F.G); phase_n1(F, l); });
        for (int p = 0; p < 2; ++p) {
            for (int e = 0; e < 2; ++e) {
                const int eg = 2 * p + e;
                RUN(2, { SchedG1 S{(const char*)(F.U + (size_t)eg * TQ * 1024), (const char*)(F.W + W_NAT), (const char*)(F.W + W_VT), F.G, F.bid};
                      EpiG1 E{(bf16_t*)(F.R0 + R_P), (bf16_t*)(F.R0 + R_VT)};
                      pg8::gemm_run<EpiG1, SchedG1>(F.lds, 1024, S, E); });
                RUN(3, { phase_cv(F, l); });
                RUN(4, { const int nbm = F.G >> 1;
                      if (F.bid < nbm) {
#ifndef NO_ML1
 for (int u = F.bid; u < 128; u += nbm) ml1_unit(F, u >> 5, u & 31, eg);
#endif
 }
                      else {
#ifndef NO_AT
 for (int au = (F.bid - nbm) * 8 + F.wave; au < 3072; au += (F.G - nbm) * 8) at_unit(F, au);
#endif
 } });
                RUN(5, { phase_p2(F); });
                RUN(6, { for (int u = F.bid * 8 + F.wave; u < 2048; u += F.G * 8) f_hm_unit(F, l, u >> 9, u & 511, eg);
                      for (int t = F.bid * 8 + F.wave; t < TQ; t += F.G * 8) f_ha_token(F, t, eg); });
            }
            RUN(7, { SchedDense S{(const char*)(F.U + (size_t)p * TP * 1024), (const char*)(F.W + W_G), 2048u, 2048u, 64, 8, F.G, F.bid};
                  EpiG1g E{(bf16_t*)(F.R0 + R_GT)}; pg8::gemm_run<EpiG1g, SchedDense>(F.lds, 1024, S, E); });
            RUN(8, { SchedDense S{(const char*)F.HA, (const char*)(F.W + W_A), 1024u, 1024u, 64, 4, F.G, F.bid};
                  EpiG2<0> E{(bf16_t*)(F.R0 + R_GT)}; pg8::gemm_run<EpiG2<0>, SchedDense>(F.lds, 512, S, E); });
            RUN(9, { SchedDense S{(const char*)F.HM, (const char*)(F.W + W_M), 2048u, 2048u, 64, 4, F.G, F.bid};
                  EpiG2<1> E{(bf16_t*)(F.R0 + R_GT)}; pg8::gemm_run<EpiG2<1>, SchedDense>(F.lds, 1024, S, E); });
            RUN(10, { SchedDense S{(const char*)(F.R0 + R_GT), (const char*)(F.W + W_O), 4096u, 2048u, 64, 4, F.G, F.bid};
                  EpiG3 E{(l == 0 ? F.x : F.out) + (size_t)p * TP * 1024, F.out + (size_t)p * TP * 1024, F.MOD + (size_t)l * 4 * 6144 + 2048, 2 * p};
                  pg8::gemm_run<EpiG3, SchedDense>(F.lds, 1024, S, E); });
        }
        RUN(11, { phase_n2(F, l); });
        RUN(12, { moe_offsets(F.ctl + CW_CNT + 64 * l, preL, F.tid); __syncthreads();
              SchedMoe S{preL, F.ctl + CW_CNT + 64 * l, (const char*)F.U, (const char*)(F.W + W_13), (const int*)(F.R0 + R_SLOT), F.G, F.bid, true};
              EpiG4 E{(bf16_t*)(F.R0 + R_HH)}; pg8::gemm_run<EpiG4, SchedMoe, true>(F.lds, 1024, S, E); });
        RUN(13, { moe_offsets(F.ctl + CW_CNT + 64 * l, preL, F.tid); __syncthreads();
              SchedMoe S{preL, F.ctl + CW_CNT + 64 * l, (const char*)(F.R0 + R_HH), (const char*)(F.W + W_2), (const int*)(F.R0 + R_SLOT), F.G, F.bid, false};
              EpiG5 E{(bf16_t*)(F.R0 + R_YS)}; pg8::gemm_run<EpiG5, SchedMoe>(F.lds, 512, S, E); });
    }
    for (int xb = 0; xb < EXTRA_BARS; ++xb) xcd_barrier(bar);
    RUN(14, { phase_fn(F); });
#undef RUN
}

extern "C" void kernel_launch(void* const* d_in, const int* in_sizes, int n_in, void* d_out, int out_size, void* d_ws, size_t ws_size, hipStream_t stream) {
    static int grid = 0;
    if (grid == 0) {
        if (n_in != 19 || out_size != T_TOK * DM || ws_size < WS_END) { fprintf(stderr, "kernel_launch: unexpected problem (n_in %d out %d ws %zu, need %zu)\n", n_in, out_size, ws_size, (size_t)WS_END); grid = -1; return; }
        int dev = 0, cus = 0, per_cu = 0;
        if (hipGetDevice(&dev) != hipSuccess || hipDeviceGetAttribute(&cus, hipDeviceAttributeMultiprocessorCount, dev) != hipSuccess) { grid = -1; return; }
        if (hipFuncSetAttribute((const void*)fwd_kernel, hipFuncAttributeMaxDynamicSharedMemorySize, LDS_BYTES) != hipSuccess) { fprintf(stderr, "kernel_launch: hipFuncSetAttribute failed\n"); grid = -1; return; }
        if (hipOccupancyMaxActiveBlocksPerMultiprocessor(&per_cu, (const void*)fwd_kernel, 512, LDS_BYTES) != hipSuccess || per_cu < 1) { fprintf(stderr, "kernel_launch: occupancy query says %d blocks per CU\n", per_cu); per_cu = 1; }
        (void)hipGetLastError();
        grid = cus;
        if (grid > 256) grid = 256;
        grid &= ~7;
    }
    if (grid <= 0) return;
    (void)hipMemsetAsync((char*)d_ws + WS_CTL, 0, CTL_BYTES, stream);
    Args a{};
    for (int i = 0; i < 19; ++i) a.in[i] = (const float*)d_in[i];
    a.out = (float*)d_out; a.ws = (unsigned char*)d_ws;
#if MK_ONE_LAUNCH
    a.step_lo = 0; a.step_hi = N_STEPS;
    hipLaunchKernelGGL(fwd_kernel, dim3(grid), dim3(512), LDS_BYTES, stream, a);
#else
    for (int s = 0; s < N_STEPS; ++s) { a.step_lo = s; a.step_hi = s + 1; hipLaunchKernelGGL(fwd_kernel, dim3(grid), dim3(512), LDS_BYTES, stream, a); }
#endif
}
```

```cpp
#define MK_ONE_LAUNCH 1
#include <hip/hip_runtime.h>
#include <cstdio>
#include <cstdint>

#define DI __device__ __forceinline__
#define LAS __attribute__((address_space(3)))
typedef unsigned short bf16_t;
typedef short bf16x8 __attribute__((ext_vector_type(8)));
typedef float f32x2 __attribute__((ext_vector_type(2)));
typedef float f32x4 __attribute__((ext_vector_type(4)));
typedef float f32x16 __attribute__((ext_vector_type(16)));
typedef unsigned u32x2 __attribute__((ext_vector_type(2)));
typedef unsigned u32x4 __attribute__((ext_vector_type(4)));
typedef __bf16 nbf16x2 __attribute__((ext_vector_type(2)));

constexpr int T_TOK = 32768, SEQ = 8192, DM = 1024, NBATCH = 4, DEPTH = 2;
constexpr int TQ = 8192;
constexpr int TP = 16384;
constexpr int INC = 10760;
constexpr int NNAT = 6144;
constexpr int NVT = 2560;
constexpr int NEXP = 16, DFF = 512;
constexpr int SLOT_ROWS = 69632;
constexpr float EPS = 1e-6f;

constexpr size_t al256(size_t x) { return (x + 255) & ~(size_t)255; }
constexpr size_t WS_CTL = 0;
constexpr size_t CTL_BYTES = 65536;
constexpr size_t WS_MOD = WS_CTL + CTL_BYTES;
constexpr size_t WS_WIF = WS_MOD + al256((size_t)2 * 4 * 6144 * 4);
constexpr size_t WS_RW = WS_WIF + (size_t)2 * 8 * 1024 * 4;
constexpr size_t WS_W = WS_RW + (size_t)16 * 1024 * 4;
constexpr size_t W_NAT = 0;
constexpr size_t W_VT = W_NAT + (size_t)NNAT * 1024 * 2;
constexpr size_t W_G = W_VT + (size_t)NVT * 1024 * 2;
constexpr size_t W_M = W_G + (size_t)2048 * 1024 * 2;
constexpr size_t W_A = W_M + (size_t)1024 * 1024 * 2;
constexpr size_t W_O = W_A + (size_t)1024 * 512 * 2;
constexpr size_t W_13 = W_O + (size_t)1024 * 1024 * 2;
constexpr size_t W_2 = W_13 + (size_t)16 * 1024 * 1024 * 2;
constexpr size_t W_BYTES = W_2 + (size_t)16 * 1024 * 512 * 2;
constexpr size_t WS_U = WS_W + W_BYTES;
constexpr size_t WS_GIF = WS_U + (size_t)T_TOK * 1024 * 2;
constexpr size_t WS_HM = WS_GIF + (size_t)T_TOK * 8 * 4;
constexpr size_t WS_HA = WS_HM + (size_t)TP * 1024 * 2;
constexpr size_t WS_TOKI = WS_HA + (size_t)TP * 512 * 2;
constexpr size_t WS_R0 = WS_TOKI + (size_t)2 * T_TOK * 32;
constexpr size_t R_P = 0;
constexpr size_t R_VT = R_P + (size_t)TQ * NNAT * 2;
constexpr size_t R_QC = R_VT + (size_t)NVT * TQ * 2;
constexpr size_t R_KC = R_QC + (size_t)TQ * 1024 * 2;
constexpr size_t R_KCT = R_KC + (size_t)TQ * 1024 * 2;
constexpr size_t R_NUM = R_KCT + (size_t)TQ * 1024 * 2;
constexpr size_t R_SLOC = R_NUM + (size_t)TQ * 1024 * 4;
constexpr size_t R_CST = R_SLOC + (size_t)4 * 32 * 65536 * 4;
constexpr size_t R_DENI = R_CST + (size_t)4 * 32 * 65536 * 2;
constexpr size_t R_EBC = R_DENI + (size_t)TQ * 4 * 4;
constexpr size_t R_EBL = R_EBC + (size_t)TQ * 4 * 4;
constexpr size_t R_SCB = R_EBL + (size_t)TQ * 4 * 4;
constexpr size_t R_CHB = R_SCB + 1024;
constexpr size_t R_DN = R_CHB + 2048;
constexpr size_t R_NST = R_DN + (size_t)4 * 128 * 256 * 4;
constexpr size_t R_LSE = R_NST + (size_t)4 * 128 * 256 * 4;
constexpr size_t R_OUTG = R_LSE + (size_t)TQ * 12 * 4;
constexpr size_t R_END = R_OUTG + (size_t)TQ * 1536 * 2;
constexpr size_t R_GT = 0;
constexpr size_t R_HH = 0;
constexpr size_t R_YS = R_HH + (size_t)SLOT_ROWS * 512 * 2;
constexpr size_t R_SLOT = R_YS + (size_t)SLOT_ROWS * 1024 * 2;
constexpr size_t R_END2 = R_SLOT + (size_t)16 * 32768 * 4;
constexpr size_t WS_END = WS_R0 + (R_END > R_END2 ? R_END : R_END2);
static_assert(WS_END <= (size_t)536870912, "workspace over 512 MiB");

constexpr int CW_BAR = 0;
constexpr int CW_CNT = 4096;

DI float bflo(unsigned w) { return __uint_as_float(w << 16); }
DI float bfhi(unsigned w) { return __uint_as_float(w & 0xffff0000u); }
DI unsigned pack2(float lo, float hi) { f32x2 v = {lo, hi}; nbf16x2 b = __builtin_convertvector(v, nbf16x2); return __builtin_bit_cast(unsigned, b); }
DI float sigmoidf_(float x) { return __builtin_amdgcn_rcpf(1.0f + __expf(-x)); }
DI float siluf_(float x) { return x * sigmoidf_(x); }
DI float wave_sum(float v) { for (int o = 32; o >= 1; o >>= 1) v += __shfl_xor(v, o); return v; }
DI int crow(int reg, int h) { return (reg & 3) + 8 * (reg >> 2) + 4 * h; }
DI int pi23(int m) { return (m & ~12) | ((m & 4) << 1) | ((m & 8) >> 1); }
#define MFMA32(a, b, c) __builtin_amdgcn_mfma_f32_32x32x16_bf16((a), (b), (c), 0, 0, 0)
DI bf16x8 packf8(float a0, float a1, float a2, float a3, float a4, float a5, float a6, float a7) {
    u32x4 p; p.x = pack2(a0, a1); p.y = pack2(a2, a3); p.z = pack2(a4, a5); p.w = pack2(a6, a7); return __builtin_bit_cast(bf16x8, p); }
DI bf16x8 ldg8(const bf16_t* p) { return *(const bf16x8*)p; }
#define XB_TMO      128
#define XB_XCNT(j)  (256  + 64 * (j))
#define XB_XSUB(j)  (1280 + 64 * (j))
#define XB_XGEN(j)  (2304 + 64 * (j))
#define XB_TOP      3328
#define XB_TOPGEN   3392
#define XCD_BAR_WORDS 3456
#define XB_SPIN_CAP (1u << 21)

__device__ __forceinline__ unsigned xb_ld(unsigned* p)              { return __hip_atomic_load(p, __ATOMIC_RELAXED, __HIP_MEMORY_SCOPE_AGENT); }
__device__ __forceinline__ unsigned xb_add(unsigned* p, unsigned v) { return __hip_atomic_fetch_add(p, v, __ATOMIC_RELAXED, __HIP_MEMORY_SCOPE_AGENT); }
__device__ __forceinline__ unsigned xb_xcc_id() { return (unsigned)__builtin_amdgcn_s_getreg((3 << 11) | 20) & 0xFu; }
#define XB_SPIN(cond, bar) do { unsigned _sp = 0; while (cond) { __builtin_amdgcn_s_sleep(1); \
    if ((++_sp & 255u) == 0u) { if (xb_ld(&(bar)[XB_TMO])) break; if (_sp > XB_SPIN_CAP) { atomicAdd(&(bar)[XB_TMO], 1u); break; } } } } while (0)

struct XcdBarrier {
    unsigned* bar; unsigned x;
    volatile LAS unsigned* st;
};

__device__ __forceinline__ XcdBarrier xcd_barrier_post(unsigned* bar, volatile LAS unsigned* st) {
    XcdBarrier b; b.bar = bar; b.x = xb_xcc_id(); b.st = st;
    if (threadIdx.x == 0) (void)xb_add(&bar[XB_XCNT(b.x)], 1u);
    return b;
}
__device__ __forceinline__ void xcd_barrier_complete(unsigned* bar, unsigned x, unsigned& nloc, unsigned& nx) {
    const unsigned G = gridDim.x * gridDim.y * gridDim.z;
    unsigned sum, cnt, mine, sp = 0u;
    for (;;) {
        sum = 0u; cnt = 0u; mine = 0u;
#pragma unroll
        for (unsigned j = 0; j < 16; ++j) { const unsigned c = xb_ld(&bar[XB_XCNT(j)]); sum += c; cnt += (c > 0u) ? 1u : 0u; mine = (j == x) ? c : mine; }
        if (sum == G) break;
        __builtin_amdgcn_s_sleep(1);
        if ((++sp & 255u) == 0u) { if (xb_ld(&bar[XB_TMO])) break; if (sp > XB_SPIN_CAP) { atomicAdd(&bar[XB_TMO], 1u); break; } }
    }
    nloc = mine > 0u ? mine : 1u; nx = cnt > 0u ? cnt : 1u;
}

__device__ __forceinline__ void xcd_barrier(const XcdBarrier& b) {
    asm volatile("s_waitcnt vmcnt(0)" ::: "memory");
    __syncthreads();
    if (threadIdx.x == 0) {
        unsigned* bar = b.bar;
        __builtin_amdgcn_s_waitcnt(0);
        unsigned nloc = b.st[0], nx = b.st[1];
        if (nloc == 0u) { xcd_barrier_complete(bar, b.x, nloc, nx); b.st[0] = nloc; b.st[1] = nx; }
        const unsigned old = xb_add(&bar[XB_XSUB(b.x)], 1u);
        const unsigned gen = old / nloc;
        if (old + 1u == (gen + 1u) * nloc) {
            __builtin_amdgcn_fence(__ATOMIC_RELEASE, "agent");
            asm volatile("s_waitcnt vmcnt(0)" ::: "memory");
            const unsigned og = xb_add(&bar[XB_TOP], 1u);
            const unsigned tg = og / nx;
            if (og + 1u == (tg + 1u) * nx) xb_add(&bar[XB_TOPGEN], 1u);
            else XB_SPIN(xb_ld(&bar[XB_TOPGEN]) == tg, bar);
            __builtin_amdgcn_fence(__ATOMIC_ACQUIRE, "agent");
            xb_add(&bar[XB_XGEN(b.x)], 1u);
            asm volatile("s_waitcnt vmcnt(0)" ::: "memory");
        } else {
            XB_SPIN(xb_ld(&bar[XB_XGEN(b.x)]) == gen, bar);
            __builtin_amdgcn_fence(__ATOMIC_ACQUIRE, "agent");
            asm volatile("s_waitcnt vmcnt(0)" ::: "memory");
        }
    }
    __syncthreads();
}
namespace pg8 {
constexpr int BM = 256, BK = 64, HALF = 128, HTB = HALF * BK * 2, STAGE_BYTES = 8 * HTB, NXCD = 8, WGM = 8;
DI int lds_byte(int r, int c) { const int st = (r >> 4) * 2 + (c >> 5), rr = r & 15, cc = c & 31, ob = rr * 64 + cc * 2; return st * 1024 + (ob ^ (((ob >> 9) & 1) << 5)); }
DI void stage_rc(int b, int& R, int& C) { const int st = b / 1024, sb = b % 1024, swz = sb ^ (((sb >> 9) & 1) << 5); R = (st >> 1) * 16 + swz / 64; C = (st & 1) * 32 + (swz % 64) / 2; }
DI int perm32(int rho) { const int n = rho >> 4, i = rho & 15; return 8 * (i >> 2) + 4 * n + (i & 3); }

struct UnitD {
    const char* A; const char* B;
    unsigned lda, ldb;
    const int* arows; int acount;
    int kind, pm, pn, aux;
};
DI void tile_map(int L, int nM, int nN, int& pm, int& pn) {
    const int nwg = nM * nN; int wgid = L;
    { const int q = nwg / NXCD, r = nwg % NXCD, xcd = wgid % NXCD, off = wgid / NXCD; wgid = (xcd < r ? xcd * (q + 1) : r * (q + 1) + (xcd - r) * q) + off; }
    const int nig = WGM * nN, gid = wgid / nig, fm = gid * WGM, gsz = (nM - fm) < WGM ? (nM - fm) : WGM;
    pm = fm + ((wgid % nig) % gsz); pn = (wgid % nig) / gsz;
}
template <bool PERM, bool GATHER>
DI void unit_off(const UnitD& u, int tid, unsigned (&offA)[2][2], unsigned (&offB)[2]) {
#pragma unroll
    for (int i = 0; i < 2; ++i) {
        int R, C; stage_rc(tid * 16 + i * 8192, R, C);
        const int Rb = PERM ? ((R & ~31) + perm32(R & 31)) : R;
        offB[i] = (unsigned)Rb * u.ldb + (unsigned)C * 2u;
        if (GATHER) {
#pragma unroll
            for (int h = 0; h < 2; ++h) { const int ra = h * HALF + R; const int rr = ra < u.acount ? ra : 0; offA[h][i] = (unsigned)u.arows[rr] * u.lda + (unsigned)C * 2u; }
        } else { offA[0][i] = (unsigned)R * u.lda + (unsigned)C * 2u; offA[1][i] = 0u; }
    }
}

template <class Epi, class Sched, bool GATHER = false>
DI void gemm_run(LAS unsigned char* lds, const int K, const Sched& S, const Epi& E) {
    int tid_ = threadIdx.x; asm volatile("" : "+v"(tid_));
    const int tid = tid_, wid = __builtin_amdgcn_readfirstlane(tid >> 6), lane = tid & 63, wr = wid >> 2, wc = wid & 3, fr = lane & 15, fq = lane >> 4;
    const int nt = K / BK;
    const size_t kstep = (size_t)(BK * 2);
    const unsigned ldsw = (unsigned)wid * 1024u;
    const int aoff = lds_byte(wr * 64 + fr, fq * 8), boff = lds_byte(wc * 32 + fr, fq * 8);
#define PG8_SA(b, h) (((b) * 2 + (h)) * HTB)
#define PG8_SB(b, h) ((4 + (b) * 2 + (h)) * HTB)
#define PG8_STAGE(bufoff, gbase, voff) do { _Pragma("unroll") for (int _i = 0; _i < 2; ++_i) \
        __builtin_amdgcn_global_load_lds((const unsigned*)((const char*)(gbase) + (voff)[_i]), (LAS unsigned*)(lds + (bufoff) + ldsw + _i * 8192), 16, 0, 0); } while (0)
#define PG8_LDA(dst, b, h) do { _Pragma("unroll") for (int m = 0; m < 4; ++m) _Pragma("unroll") for (int k = 0; k < 2; ++k) dst[m][k] = *(const LAS bf16x8*)(lds + PG8_SA(b, h) + aoff + m * 2048 + k * 1024); } while (0)
#define PG8_LDB(dst, b, h) do { _Pragma("unroll") for (int n = 0; n < 2; ++n) _Pragma("unroll") for (int k = 0; k < 2; ++k) dst[n][k] = *(const LAS bf16x8*)(lds + PG8_SB(b, h) + boff + n * 2048 + k * 1024); } while (0)
#define PG8_MMA(ai, bj, At, Bt) do { __builtin_amdgcn_s_setprio(1); _Pragma("unroll") for (int m = 0; m < 4; ++m) _Pragma("unroll") for (int n = 0; n < 2; ++n) _Pragma("unroll") for (int k = 0; k < 2; ++k) \
        acc[ai][bj][m][n] = __builtin_amdgcn_mfma_f32_16x16x32_bf16(Bt[n][k], At[m][k], acc[ai][bj][m][n], 0, 0, 0); __builtin_amdgcn_s_setprio(0); } while (0)
#define PG8_WAIT_V(n) asm volatile("s_waitcnt vmcnt(" #n ")" ::: "memory")
#define PG8_WAIT_L(n) asm volatile("s_waitcnt lgkmcnt(" #n ")" ::: "memory")
#define PG8_BAR __builtin_amdgcn_s_barrier()
#define PG8_SCHED __builtin_amdgcn_sched_barrier(0)
    UnitD cur, nxt; int ui = 0;
    if (!S.next(0, cur)) return;
    unsigned offA[2][2], offB[2];
    unit_off<Epi::PERM, GATHER>(cur, tid, offA, offB);
    size_t hA = GATHER ? 0 : (size_t)HALF * cur.lda, hB = (size_t)HALF * cur.ldb;
#define OA(h) offA[GATHER ? (h) : 0]
    f32x4 acc[2][2][4][2];
#pragma unroll
    for (int a = 0; a < 2; ++a)
#pragma unroll
        for (int b = 0; b < 2; ++b)
#pragma unroll
            for (int m = 0; m < 4; ++m)
#pragma unroll
                for (int n = 0; n < 2; ++n) acc[a][b][m][n] = (f32x4){0.f, 0.f, 0.f, 0.f};
    bf16x8 At[4][2], B0[2][2], B1[2][2];
    PG8_STAGE(PG8_SB(0, 0), cur.B, offB); PG8_STAGE(PG8_SA(0, 0), cur.A, OA(0)); PG8_STAGE(PG8_SB(0, 1), cur.B + hB, offB); PG8_STAGE(PG8_SA(0, 1), cur.A + hA, OA(1));
    if (wr == 1) PG8_BAR;
    PG8_WAIT_V(4); PG8_BAR;
    PG8_STAGE(PG8_SB(1, 0), cur.B + kstep, offB); PG8_STAGE(PG8_SA(1, 0), cur.A + kstep, OA(0)); PG8_STAGE(PG8_SB(1, 1), cur.B + kstep + hB, offB);
    PG8_WAIT_V(6); PG8_BAR;
    for (;;) {
        const bool has_next = S.next(ui + 1, nxt);
        for (int t = 0; t < nt; t += 2) {
            const bool last = (t == nt - 2);
            const char* a1 = cur.A + (size_t)(t + 1) * kstep;
            PG8_LDB(B0, 0, 0); PG8_SCHED; PG8_LDA(At, 0, 0); PG8_STAGE(PG8_SA(1, 1), a1 + hA, OA(1));
            PG8_WAIT_L(8); PG8_BAR; PG8_WAIT_L(0); PG8_MMA(0, 0, At, B0); PG8_BAR; PG8_SCHED;
            const char* a2; const char* b2;
            if (last) { if (has_next) { unit_off<Epi::PERM, GATHER>(nxt, tid, offA, offB); a2 = nxt.A; b2 = nxt.B; hA = GATHER ? 0 : (size_t)HALF * nxt.lda; hB = (size_t)HALF * nxt.ldb; } else { a2 = cur.A; b2 = cur.B; } }
            else { a2 = cur.A + (size_t)(t + 2) * kstep; b2 = cur.B + (size_t)(t + 2) * kstep; }
            const char* a3 = a2 + kstep; const char* b3 = b2 + kstep;
            PG8_LDB(B1, 0, 1); PG8_STAGE(PG8_SB(0, 0), b2, offB);
            PG8_BAR; PG8_WAIT_L(0); PG8_MMA(0, 1, At, B1); PG8_BAR;
            PG8_LDA(At, 0, 1); PG8_STAGE(PG8_SA(0, 0), a2, OA(0));
            PG8_BAR; PG8_WAIT_L(0); PG8_MMA(1, 0, At, B0); PG8_BAR; PG8_SCHED;
            PG8_STAGE(PG8_SB(0, 1), b2 + hB, offB);
            PG8_WAIT_V(6); PG8_BAR; PG8_MMA(1, 1, At, B1); PG8_BAR;
            PG8_LDB(B0, 1, 0); PG8_SCHED; PG8_LDA(At, 1, 0); PG8_STAGE(PG8_SA(0, 1), a2 + hA, OA(1));
            PG8_WAIT_L(8); PG8_BAR; PG8_WAIT_L(0); PG8_MMA(0, 0, At, B0); PG8_BAR; PG8_SCHED;
            PG8_LDB(B1, 1, 1); PG8_STAGE(PG8_SB(1, 0), b3, offB);
            PG8_BAR; PG8_WAIT_L(0); PG8_MMA(0, 1, At, B1); PG8_BAR;
            PG8_LDA(At, 1, 1); PG8_STAGE(PG8_SA(1, 0), a3, OA(0));
            PG8_BAR; PG8_WAIT_L(0); PG8_MMA(1, 0, At, B0); PG8_BAR; PG8_SCHED;
            PG8_STAGE(PG8_SB(1, 1), b3 + hB, offB);
            PG8_WAIT_V(6); PG8_BAR; PG8_MMA(1, 1, At, B1); PG8_BAR;
        }
        { int fr_ = fr, fq_ = fq; asm volatile("" : "+v"(fr_), "+v"(fq_)); E(acc, cur, wr, wc, fr_, fq_); }
        if (!has_next) break;
#pragma unroll
        for (int a = 0; a < 2; ++a)
#pragma unroll
            for (int b = 0; b < 2; ++b)
#pragma unroll
                for (int m = 0; m < 4; ++m)
#pragma unroll
                    for (int n = 0; n < 2; ++n) acc[a][b][m][n] = (f32x4){0.f, 0.f, 0.f, 0.f};
        cur = nxt; ++ui;
    }
    PG8_WAIT_V(0);
    if (wr == 0) PG8_BAR;
    PG8_BAR;
#undef OA
#undef PG8_SA
#undef PG8_SB
#undef PG8_STAGE
#undef PG8_LDA
#undef PG8_LDB
#undef PG8_MMA
#undef PG8_WAIT_V
#undef PG8_WAIT_L
#undef PG8_BAR
#undef PG8_SCHED
}
}
struct Args { const float* in[19]; float* out; unsigned char* ws; int step_lo, step_hi; };
struct Frame {
    LAS unsigned char* lds; unsigned char* ldsg;
    int tid, lane, wave, G, bid;
    const float *x, *c, *ada_w, *ada_b, *w_in, *conv_w, *gate_b, *norm_g, *w_bm, *w_ba, *w_out, *router_w, *router_b, *w_gate, *w_up, *w_down, *g_mix, *g_ffn, *g_fin;
    float* out; unsigned char* ws; unsigned* ctl;
    float* MOD; float* WIF; float* RW; unsigned char* W;
    bf16_t* U; float* GIF; bf16_t* HM; bf16_t* HA; unsigned char* TOKI; unsigned char* R0;
};
#define CAS __attribute__((address_space(4)))
DI const void* karg(int idx) { asm volatile("" : "+s"(idx)); const void* const CAS* kp = (const void* const CAS*)__builtin_amdgcn_kernarg_segment_ptr(); return kp[idx]; }
DI void frame_init(Frame& F, unsigned char* lds_generic, int tid) {
    F.ldsg = lds_generic; F.lds = (LAS unsigned char*)lds_generic;
    F.tid = tid; F.lane = F.tid & 63; F.wave = __builtin_amdgcn_readfirstlane(F.tid >> 6); F.G = gridDim.x; F.bid = blockIdx.x;
    F.x = (const float*)karg(0); F.c = (const float*)karg(1); F.ada_w = (const float*)karg(2); F.ada_b = (const float*)karg(3); F.w_in = (const float*)karg(4); F.conv_w = (const float*)karg(5);
    F.gate_b = (const float*)karg(6); F.norm_g = (const float*)karg(7); F.w_bm = (const float*)karg(8); F.w_ba = (const float*)karg(9); F.w_out = (const float*)karg(10); F.router_w = (const float*)karg(11);
    F.router_b = (const float*)karg(12); F.w_gate = (const float*)karg(13); F.w_up = (const float*)karg(14); F.w_down = (const float*)karg(15); F.g_mix = (const float*)karg(16); F.g_ffn = (const float*)karg(17); F.g_fin = (const float*)karg(18);
    F.out = (float*)karg(19); unsigned char* ws = (unsigned char*)karg(20);
    F.ws = ws; F.ctl = (unsigned*)(ws + WS_CTL);
    F.MOD = (float*)(ws + WS_MOD); F.WIF = (float*)(ws + WS_WIF); F.RW = (float*)(ws + WS_RW); F.W = ws + WS_W;
    F.U = (bf16_t*)(ws + WS_U); F.GIF = (float*)(ws + WS_GIF); F.HM = (bf16_t*)(ws + WS_HM); F.HA = (bf16_t*)(ws + WS_HA);
    F.TOKI = ws + WS_TOKI; F.R0 = ws + WS_R0;
}

struct TJob { const float* src; int ld; int K; int N; bf16_t* dst; int rmul, radd; };
DI bool get_job(const Frame& F, int l, int j, TJob& J) {
    const float* win = F.w_in + (size_t)l * DM * INC;
    bf16_t* W = (bf16_t*)F.W;
    J.rmul = 1; J.radd = 0; J.K = 1024; J.ld = INC;
    if (j == 0) { J.src = win + 0;    J.N = 1024; J.dst = W + W_NAT / 2 + (size_t)0 * 1024; return true; }
    if (j == 1) { J.src = win + 1024; J.N = 1024; J.dst = W + W_NAT / 2 + (size_t)1024 * 1024; return true; }
    if (j == 2) { J.src = win + 3072; J.N = 1024; J.dst = W + W_NAT / 2 + (size_t)2048 * 1024; return true; }
    if (j == 3) { J.src = win + 4104; J.N = 1536; J.dst = W + W_NAT / 2 + (size_t)3072 * 1024; return true; }
    if (j == 4) { J.src = win + 5640; J.N = 1536; J.dst = W + W_NAT / 2 + (size_t)4608 * 1024; return true; }
    if (j == 5) { J.src = win + 2048; J.N = 1024; J.dst = W + W_VT / 2 + (size_t)0 * 1024; return true; }
    if (j == 6) { J.src = win + 7176; J.N = 1536; J.dst = W + W_VT / 2 + (size_t)1024 * 1024; return true; }
    if (j == 7) { J.src = win + 8712; J.N = 2048; J.dst = W + W_G / 2; return true; }
    if (j == 8) { J.src = F.w_bm + (size_t)l * 1024 * 1024; J.ld = 1024; J.N = 1024; J.dst = W + W_M / 2; return true; }
    if (j == 9) { J.src = F.w_ba + (size_t)l * 512 * 1024; J.ld = 1024; J.K = 512; J.N = 1024; J.dst = W + W_A / 2; return true; }
    if (j == 10) { J.src = F.w_out + (size_t)l * 1024 * 1024; J.ld = 1024; J.N = 1024; J.dst = W + W_O / 2; return true; }
    const int q = j - 11; if (q >= 48) return false;
    const int e = q / 3, which = q % 3;
    if (which == 0) { J.src = F.w_gate + ((size_t)l * 16 + e) * 1024 * 512; J.ld = 512; J.N = 512; J.dst = W + W_13 / 2 + (size_t)e * 1024 * 1024; J.rmul = 2; J.radd = 0; }
    else if (which == 1) { J.src = F.w_up + ((size_t)l * 16 + e) * 1024 * 512; J.ld = 512; J.N = 512; J.dst = W + W_13 / 2 + (size_t)e * 1024 * 1024; J.rmul = 2; J.radd = 1; }
    else { J.src = F.w_down + ((size_t)l * 16 + e) * 512 * 1024; J.ld = 1024; J.K = 512; J.N = 1024; J.dst = W + W_2 / 2 + (size_t)e * 1024 * 512; }
    return true;
}
constexpr int NJOBS = 59;
DI void tconv_tile(const Frame& F, const TJob& J, int tk, int tn) {
    bf16_t* tl = (bf16_t*)F.ldsg;
    const int tid = F.tid;
#pragma unroll
    for (int i = 0; i < 2; ++i) {
        const int row = (tid >> 4) + 32 * i, c4 = tid & 15;
        const f32x4 v = *(const f32x4*)(J.src + (size_t)(tk * 64 + row) * J.ld + tn * 64 + c4 * 4);
        const unsigned lo = pack2(v[0], v[1]), hi = pack2(v[2], v[3]);
        tl[(c4 * 4 + 0) * 72 + row] = (bf16_t)(lo & 0xffff); tl[(c4 * 4 + 1) * 72 + row] = (bf16_t)(lo >> 16);
        tl[(c4 * 4 + 2) * 72 + row] = (bf16_t)(hi & 0xffff); tl[(c4 * 4 + 3) * 72 + row] = (bf16_t)(hi >> 16);
    }
    __syncthreads();
    { const int n = tid >> 3, k8 = tid & 7;
      const u32x4 v = *(const u32x4*)(tl + n * 72 + k8 * 8);
      *(u32x4*)(J.dst + (size_t)(J.rmul * (tn * 64 + n) + J.radd) * J.K + tk * 64 + k8 * 8) = v; }
    __syncthreads();
}
DI void phase_pw(const Frame& F, int l, int b0, int nb) {
    const int me = F.bid - b0; if (me < 0 || me >= nb) return;
    int base = 0;
    for (int j = 0; j < NJOBS; ++j) {
        TJob J; get_job(F, l, j, J);
        const int nk = J.K / 64, nn = J.N / 64, ntile = nk * nn;
        int t = (me - base % nb + nb) % nb;
        for (; t < ntile; t += nb) tconv_tile(F, J, t % nk, t / nk);
        base += ntile;
    }
}
DI void phase_p0_small(const Frame& F) {
    float* sc = (float*)F.ldsg;
    float* part = sc + 4096;
    for (int i = F.tid; i < 4096; i += 512) sc[i] = siluf_(F.c[i]);
    __syncthreads();
    for (int it = F.bid; it < 192; it += F.G) {
        const int l = it / 96, cc = it % 96, col = cc * 64 + F.lane, w = F.wave;
        const float* aw = F.ada_w + (size_t)l * 1024 * 6144 + col;
        float a0 = 0.f, a1 = 0.f, a2 = 0.f, a3 = 0.f;
        for (int k = w * 128; k < w * 128 + 128; ++k) { const float wv = aw[(size_t)k * 6144]; a0 += sc[k] * wv; a1 += sc[1024 + k] * wv; a2 += sc[2048 + k] * wv; a3 += sc[3072 + k] * wv; }
        part[(w * 4 + 0) * 64 + F.lane] = a0; part[(w * 4 + 1) * 64 + F.lane] = a1; part[(w * 4 + 2) * 64 + F.lane] = a2; part[(w * 4 + 3) * 64 + F.lane] = a3;
        __syncthreads();
        if (F.tid < 256) { const int b = F.tid >> 6, ln = F.tid & 63; float s = 0.f;
            for (int ww = 0; ww < 8; ++ww) s += part[(ww * 4 + b) * 64 + ln];
            F.MOD[((size_t)l * 4 + b) * 6144 + cc * 64 + ln] = s + F.ada_b[(size_t)l * 6144 + cc * 64 + ln]; }
        __syncthreads();
    }
    for (int i = F.bid * 512 + F.tid; i < 2 * 8 * 1024 + 16 * 1024; i += F.G * 512) {
        if (i < 16384) { const int l = i >> 13, j = (i >> 10) & 7, k = i & 1023; F.WIF[i] = F.w_in[((size_t)l * 1024 + k) * INC + 4096 + j]; }
        else { const int q = i - 16384, e = q >> 10, k = q & 1023; F.RW[q] = F.router_w[k * 16 + e]; }
    }
}

DI void moe_offsets(const unsigned* cnt, int* pre, int tid) { if (tid == 0) { int s = 0; for (int e = 0; e < 16; ++e) { pre[e] = s; s += ((int)cnt[e] + 255) >> 8; } pre[16] = s; } }

struct RowCtx { float gm[16], sh[16]; };
DI void load_rowconst(const Frame& F, const float* g, const float* shv, const float* scv, RowCtx& rc) {
#pragma unroll
    for (int q = 0; q < 4; ++q) { const int c = F.lane * 4 + 256 * q; const f32x4 gv = *(const f32x4*)(g + c), s1 = *(const f32x4*)(scv + c), s0 = *(const f32x4*)(shv + c);
#pragma unroll
        for (int j = 0; j < 4; ++j) { rc.gm[q * 4 + j] = gv[j] * (1.0f + s1[j]); rc.sh[q * 4 + j] = s0[j]; } }
}
DI void moe_combine_row(const Frame& F, int lprev, int t, int b, const int* pre, float (&xv)[16]) {
    const int* ti = (const int*)(F.TOKI + ((size_t)lprev * T_TOK + t) * 32);
    const int e1 = ti[0], s1 = ti[1], e2 = ti[2], s2 = ti[3]; const float w1 = __int_as_float(ti[4]), w2 = __int_as_float(ti[5]);
    const bf16_t* YS = (const bf16_t*)(F.R0 + R_YS);
    const bf16_t* y1 = YS + (size_t)(pre[e1] * 256 + s1) * 1024; const bf16_t* y2 = YS + (size_t)(pre[e2] * 256 + s2) * 1024;
    const float* gt = F.MOD + ((size_t)lprev * 4 + b) * 6144 + 5120;
#pragma unroll
    for (int q = 0; q < 4; ++q) { const int c = F.lane * 4 + 256 * q; const u32x2 a = *(const u32x2*)(y1 + c), d = *(const u32x2*)(y2 + c); const f32x4 g = *(const f32x4*)(gt + c);
        xv[q * 4 + 0] += g[0] * (w1 * bflo(a.x) + w2 * bflo(d.x)); xv[q * 4 + 1] += g[1] * (w1 * bfhi(a.x) + w2 * bfhi(d.x));
        xv[q * 4 + 2] += g[2] * (w1 * bflo(a.y) + w2 * bflo(d.y)); xv[q * 4 + 3] += g[3] * (w1 * bfhi(a.y) + w2 * bfhi(d.y)); }
}
DI void phase_n1(const Frame& F, int l) {
    float* wif = (float*)F.ldsg;
    int* pre = (int*)(F.ldsg + 32768);
    for (int i = F.tid; i < 8192; i += 512) wif[i] = F.WIF[(size_t)l * 8192 + i];
    if (l > 0) moe_offsets(F.ctl + CW_CNT + 64 * (l - 1), pre, F.tid);
    __syncthreads();
    for (int blk = F.bid; blk < T_TOK / 128; blk += F.G) {
        const int b = blk / (SEQ / 128);
        const float* mod = F.MOD + ((size_t)l * 4 + b) * 6144;
        RowCtx rc; load_rowconst(F, F.g_mix + (size_t)l * 1024, mod, mod + 1024, rc);
#pragma unroll 1
        for (int i = 0; i < 16; ++i) {
            const int t = blk * 128 + F.wave * 16 + i;
            asm volatile("" ::: "memory");
            float xv[16];
            const float* xr = (l == 0 ? F.x : F.out) + (size_t)t * 1024;
#pragma unroll
            for (int q = 0; q < 4; ++q) { const f32x4 v = *(const f32x4*)(xr + F.lane * 4 + 256 * q); xv[q * 4] = v[0]; xv[q * 4 + 1] = v[1]; xv[q * 4 + 2] = v[2]; xv[q * 4 + 3] = v[3]; }
            if (l > 0) {
                moe_combine_row(F, l - 1, t, b, pre, xv);
#pragma unroll
                for (int q = 0; q < 4; ++q) *(f32x4*)(F.out + (size_t)t * 1024 + F.lane * 4 + 256 * q) = (f32x4){xv[q * 4], xv[q * 4 + 1], xv[q * 4 + 2], xv[q * 4 + 3]};
            }
            float ss = 0.f;
#pragma unroll
            for (int j = 0; j < 16; ++j) ss += xv[j] * xv[j];
            ss = wave_sum(ss);
            const float rn = __builtin_amdgcn_rsqf(ss * (1.0f / 1024.0f) + EPS);
            float uv[16];
#pragma unroll
            for (int j = 0; j < 16; ++j) uv[j] = xv[j] * rn * rc.gm[j] + rc.sh[j];
#pragma unroll
            for (int q = 0; q < 4; ++q) { u32x2 w; w.x = pack2(uv[q * 4], uv[q * 4 + 1]); w.y = pack2(uv[q * 4 + 2], uv[q * 4 + 3]); *(u32x2*)(F.U + (size_t)t * 1024 + F.lane * 4 + 256 * q) = w; }
            float d[8];
#pragma unroll
            for (int g = 0; g < 8; ++g) { float s = 0.f;
#pragma unroll
                for (int q = 0; q < 4; ++q) { const f32x4 wv = *(const f32x4*)(wif + g * 1024 + F.lane * 4 + 256 * q); s += uv[q * 4] * wv[0] + uv[q * 4 + 1] * wv[1] + uv[q * 4 + 2] * wv[2] + uv[q * 4 + 3] * wv[3]; }
                d[g] = wave_sum(s); }
            if (F.lane < 8) {
                float v = 0.f;
#pragma unroll
                for (int g = 0; g < 8; ++g) v = (F.lane == g) ? d[g] : v;
                v += F.gate_b[l * 8 + F.lane];
                if (F.lane >= 4) { const float e = __expf(-fabsf(v)); const float l1p = (e < 0.03f) ? e * (1.0f - e * (0.5f - e * (0.33333334f - 0.25f * e))) : __logf(1.0f + e); v = fminf(v, 0.f) - l1p; }
                F.GIF[(size_t)t * 8 + F.lane] = v;
            }
        }
    }
}

DI void phase_n2(const Frame& F, int l) {
    float* rw = (float*)F.ldsg;
    int* cntL = (int*)(F.ldsg + 65536);
    int* baseL = cntL + 16;
    int* rec = baseL + 16;
    for (int i = F.tid; i < 16384; i += 512) rw[i] = F.RW[i];
    __syncthreads();
    unsigned* gcnt = F.ctl + CW_CNT + 64 * l;
    int* SLOT = (int*)(F.R0 + R_SLOT);
    for (int blk = F.bid; blk < T_TOK / 128; blk += F.G) {
        const int b = blk / (SEQ / 128);
        const float* mod = F.MOD + ((size_t)l * 4 + b) * 6144;
        RowCtx rc; load_rowconst(F, F.g_ffn + (size_t)l * 1024, mod + 3072, mod + 4096, rc);
        if (F.tid < 16) cntL[F.tid] = 0;
        __syncthreads();
#pragma unroll 1
        for (int i = 0; i < 16; ++i) {
            const int rl = F.wave * 16 + i, t = blk * 128 + rl;
            asm volatile("" ::: "memory");
            float xv[16];
#pragma unroll
            for (int q = 0; q < 4; ++q) { const f32x4 v = *(const f32x4*)(F.out + (size_t)t * 1024 + F.lane * 4 + 256 * q); xv[q * 4] = v[0]; xv[q * 4 + 1] = v[1]; xv[q * 4 + 2] = v[2]; xv[q * 4 + 3] = v[3]; }
            float ss = 0.f;
#pragma unroll
            for (int j = 0; j < 16; ++j) ss += xv[j] * xv[j];
            ss = wave_sum(ss);
            const float rn = __builtin_amdgcn_rsqf(ss * (1.0f / 1024.0f) + EPS);
            float uv[16];
#pragma unroll
            for (int j = 0; j < 16; ++j) uv[j] = xv[j] * rn * rc.gm[j] + rc.sh[j];
#pragma unroll
            for (int q = 0; q < 4; ++q) { u32x2 w; w.x = pack2(uv[q * 4], uv[q * 4 + 1]); w.y = pack2(uv[q * 4 + 2], uv[q * 4 + 3]); *(u32x2*)(F.U + (size_t)t * 1024 + F.lane * 4 + 256 * q) = w; }
            float mine = 0.f;
#pragma unroll
            for (int e = 0; e < 16; ++e) { float s = 0.f;
#pragma unroll
                for (int q = 0; q < 4; ++q) { const f32x4 wv = *(const f32x4*)(rw + e * 1024 + F.lane * 4 + 256 * q); s += uv[q * 4] * wv[0] + uv[q * 4 + 1] * wv[1] + uv[q * 4 + 2] * wv[2] + uv[q * 4 + 3] * wv[3]; }
                s = wave_sum(s); mine = (F.lane == e) ? s : mine; }
            const float score = 1.0f / (1.0f + __expf(-mine));
            const float sel = score + ((F.lane < 16) ? F.router_b[F.lane] : 0.f);
            const float s0 = __shfl(sel, (F.lane & ~3) + 0), s1 = __shfl(sel, (F.lane & ~3) + 1), s2 = __shfl(sel, (F.lane & ~3) + 2), s3 = __shfl(sel, (F.lane & ~3) + 3);
            const float mx = fmaxf(fmaxf(s0, s1), fmaxf(s2, s3));
            const int im = (s0 == mx) ? 0 : (s1 == mx) ? 1 : (s2 == mx) ? 2 : 3;
            const float t0 = (im == 0) ? -INFINITY : s0, t1 = (im == 1) ? -INFINITY : s1, t2 = (im == 2) ? -INFINITY : s2, t3 = (im == 3) ? -INFINITY : s3;
            const float mx2 = fmaxf(fmaxf(t0, t1), fmaxf(t2, t3));
            const int im2 = (t0 == mx2) ? 0 : (t1 == mx2) ? 1 : (t2 == mx2) ? 2 : 3;
            const float gs = mx + mx2;
            const float g0 = __shfl(gs, 0), g1 = __shfl(gs, 4), g2 = __shfl(gs, 8), g3 = __shfl(gs, 12);
            const float gm = fmaxf(fmaxf(g0, g1), fmaxf(g2, g3));
            const int bg = (g0 == gm) ? 0 : (g1 == gm) ? 1 : (g2 == gm) ? 2 : 3;
            const int e1 = __shfl(bg * 4 + im, bg * 4), e2 = __shfl(bg * 4 + im2, bg * 4);
            const float sc1 = __shfl(score, e1), sc2 = __shfl(score, e2);
            if (F.lane == 0) {
                const float inv = 1.0f / (sc1 + sc2);
                const int r1 = atomicAdd(&cntL[e1], 1), r2 = atomicAdd(&cntL[e2], 1);
                int* r = rec + rl * 6; r[0] = e1; r[1] = r1; r[2] = e2; r[3] = r2; r[4] = __float_as_int(sc1 * inv); r[5] = __float_as_int(sc2 * inv);
            }
        }
        __syncthreads();
        if (F.tid < 16) baseL[F.tid] = (int)atomicAdd(&gcnt[F.tid], (unsigned)cntL[F.tid]);
        __syncthreads();
        if (F.tid < 128) {
            const int t = blk * 128 + F.tid; const int* r = rec + F.tid * 6;
            const int e1 = r[0], s1 = baseL[e1] + r[1], e2 = r[2], s2 = baseL[e2] + r[3];
            SLOT[e1 * 32768 + s1] = t; SLOT[e2 * 32768 + s2] = t;
            int* ti = (int*)(F.TOKI + ((size_t)l * T_TOK + t) * 32);
            ti[0] = e1; ti[1] = s1; ti[2] = e2; ti[3] = s2; ti[4] = r[4]; ti[5] = r[5];
        }
        __syncthreads();
    }
}

DI void phase_fn(const Frame& F) {
    int* pre = (int*)F.ldsg;
    moe_offsets(F.ctl + CW_CNT + 64 * (DEPTH - 1), pre, F.tid);
    __syncthreads();
    for (int blk = F.bid; blk < T_TOK / 128; blk += F.G) {
        const int b = blk / (SEQ / 128);
#pragma unroll 1
        for (int i = 0; i < 16; ++i) {
            const int t = blk * 128 + F.wave * 16 + i;
            float xv[16];
#pragma unroll
            for (int q = 0; q < 4; ++q) { const f32x4 v = *(const f32x4*)(F.out + (size_t)t * 1024 + F.lane * 4 + 256 * q); xv[q * 4] = v[0]; xv[q * 4 + 1] = v[1]; xv[q * 4 + 2] = v[2]; xv[q * 4 + 3] = v[3]; }
            moe_combine_row(F, DEPTH - 1, t, b, pre, xv);
            float ss = 0.f;
#pragma unroll
            for (int j = 0; j < 16; ++j) ss += xv[j] * xv[j];
            ss = wave_sum(ss);
            const float rn = __builtin_amdgcn_rsqf(ss * (1.0f / 1024.0f) + EPS);
#pragma unroll
            for (int q = 0; q < 4; ++q) { const f32x4 g = *(const f32x4*)(F.g_fin + F.lane * 4 + 256 * q);
                *(f32x4*)(F.out + (size_t)t * 1024 + F.lane * 4 + 256 * q) = (f32x4){xv[q * 4] * rn * g[0], xv[q * 4 + 1] * rn * g[1], xv[q * 4 + 2] * rn * g[2], xv[q * 4 + 3] * rn * g[3]}; }
        }
    }
}
DI void phase_cv(const Frame& F, int l) {
    const bf16_t* P = (const bf16_t*)(F.R0 + R_P);
    bf16_t* QC = (bf16_t*)(F.R0 + R_QC); bf16_t* KC = (bf16_t*)(F.R0 + R_KC); bf16_t* KCT = (bf16_t*)(F.R0 + R_KCT);
    bf16_t* raw = (bf16_t*)F.ldsg;
    bf16_t* tT = raw + 67 * 264;
    const int tid = F.tid;
    for (int u = F.bid; u < 128 * 8; u += F.G) {
        const int tt = u >> 3, ct = u & 7, t0 = tt * 64, c0 = ct * 256;
        for (int i = tid; i < 67 * 32; i += 512) { const int r = i >> 5, cg = i & 31, t = t0 - 3 + r;
            u32x4 v = (u32x4){0u, 0u, 0u, 0u};
            if (t >= 0) v = *(const u32x4*)(P + (size_t)t * NNAT + c0 + cg * 8);
            *(u32x4*)(raw + r * 264 + cg * 8) = v; }
        __syncthreads();
        const int cg = tid & 31, ch = c0 + cg * 8;
        float w[4][8];
#pragma unroll
        for (int j = 0; j < 4; ++j) { const f32x4 a = *(const f32x4*)(F.conv_w + ((size_t)l * 4 + j) * 2048 + ch), b = *(const f32x4*)(F.conv_w + ((size_t)l * 4 + j) * 2048 + ch + 4);
            w[j][0] = a[0]; w[j][1] = a[1]; w[j][2] = a[2]; w[j][3] = a[3]; w[j][4] = b[0]; w[j][5] = b[1]; w[j][6] = b[2]; w[j][7] = b[3]; }
        const bool isq = ct < 4; const float osc = isq ? 0.0625f : 1.0f;
#pragma unroll
        for (int i = 0; i < 4; ++i) {
            const int tr = (tid >> 5) + 16 * i;
            float y[8];
#pragma unroll
            for (int k = 0; k < 8; ++k) y[k] = 0.f;
#pragma unroll
            for (int j = 0; j < 4; ++j) { const u32x4 v = *(const u32x4*)(raw + (tr + j) * 264 + cg * 8);
                y[0] += w[j][0] * bflo(v.x); y[1] += w[j][1] * bfhi(v.x); y[2] += w[j][2] * bflo(v.y); y[3] += w[j][3] * bfhi(v.y);
                y[4] += w[j][4] * bflo(v.z); y[5] += w[j][5] * bfhi(v.z); y[6] += w[j][6] * bflo(v.w); y[7] += w[j][7] * bfhi(v.w); }
#pragma unroll
            for (int k = 0; k < 8; ++k) y[k] = siluf_(y[k]) * osc;
            u32x4 o; o.x = pack2(y[0], y[1]); o.y = pack2(y[2], y[3]); o.z = pack2(y[4], y[5]); o.w = pack2(y[6], y[7]);
            if (isq) *(u32x4*)(QC + (size_t)(t0 + tr) * 1024 + ch) = o;
            else { *(u32x4*)(KC + (size_t)(t0 + tr) * 1024 + (ch - 1024)) = o; *(u32x4*)(tT + tr * 264 + cg * 8) = o; }
        }
        __syncthreads();
        if (!isq) {
#pragma unroll
            for (int i = 0; i < 4; ++i) { const int chl = (tid >> 3) + 64 * i, oc = tid & 7;
                unsigned short e[8];
#pragma unroll
                for (int k = 0; k < 8; ++k) e[k] = tT[(oc * 8 + k) * 264 + chl];
                u32x4 o; o.x = e[0] | ((unsigned)e[1] << 16); o.y = e[2] | ((unsigned)e[3] << 16); o.z = e[4] | ((unsigned)e[5] << 16); o.w = e[6] | ((unsigned)e[7] << 16);
                *(u32x4*)(KCT + (size_t)(c0 - 1024 + chl) * TQ + t0 + oc * 8) = o; }
        }
        __syncthreads();
    }
}

DI void ml1_unit(const Frame& F, int h, int j, int eg) {
    const bf16_t* QC = (const bf16_t*)(F.R0 + R_QC); const bf16_t* KC = (const bf16_t*)(F.R0 + R_KC); const bf16_t* KCT = (const bf16_t*)(F.R0 + R_KCT);
    const bf16_t* VT = (const bf16_t*)(F.R0 + R_VT);
    float* NUM = (float*)(F.R0 + R_NUM); float* SLOC = (float*)(F.R0 + R_SLOC);
    float* DENI = (float*)(F.R0 + R_DENI); float* EBC = (float*)(F.R0 + R_EBC); float* EBL = (float*)(F.R0 + R_EBL);
    float* SCB = (float*)(F.R0 + R_SCB); float* CHB = (float*)(F.R0 + R_CHB); float* DN = (float*)(F.R0 + R_DN);
    const int tid = F.tid, lane = F.lane, w = F.wave, rr = lane & 31, hh = lane >> 5;
    const int tl0 = j * 256;
    const size_t tg0 = (size_t)eg * TQ + tl0;
    LAS unsigned char* L = F.lds;
    LAS bf16_t* Sl = (LAS bf16_t*)L;
    LAS float* Lb = (LAS float*)(L + 36864);
    LAS float* Lg = Lb + 256;
    LAS float* Lws = Lg + 256;
    LAS float* Leb = Lws + 256;
    LAS float* Lden = Leb + 256;
    LAS float* Lbl = Lden + 256;
    if (w < 4) {
        const int c = w, t = c * 64 + lane;
        const float li = F.GIF[(tg0 + t) * 8 + h], lf = F.GIF[(tg0 + t) * 8 + 4 + h];
        float b = lf;
#pragma unroll
        for (int o = 1; o < 64; o <<= 1) { const float v = __shfl_up(b, o); if (lane >= o) b += v; }
        const float bl = __shfl(b, 63);
        Lb[t] = b; Lg[t] = li - b; Lws[t] = __expf(bl - b + li); Leb[t] = __expf(b); Lden[t] = 0.f;
        if (lane == 0) Lbl[c] = bl;
    }
    __syncthreads();
    if (tid < 256) {
        const int c = tid >> 6; float pre = 0.f;
        for (int cc = 0; cc < c; ++cc) pre += Lbl[cc];
        EBC[(size_t)(tl0 + tid) * 4 + h] = Leb[tid];
        EBL[(size_t)(tl0 + tid) * 4 + h] = __expf(Lb[tid] + pre);
        if (tid < 4) CHB[h * 128 + j * 4 + tid] = Lbl[tid];
        if (tid == 0) SCB[h * 32 + j] = Lbl[0] + Lbl[1] + Lbl[2] + Lbl[3];
    }
    for (int idx = w; idx < 12; idx += 8) {
        const int c = idx / 3, k3 = idx % 3, ti = (k3 == 0) ? 0 : 1, si = (k3 == 2) ? 1 : 0;
        const bf16_t* kp = KC + (size_t)(tl0 + c * 64 + si * 32 + rr) * 1024 + h * 256 + hh * 8;
        const bf16_t* qp = QC + (size_t)(tl0 + c * 64 + ti * 32 + rr) * 1024 + h * 256 + hh * 8;
        f32x16 acc;
#pragma unroll
        for (int r = 0; r < 16; ++r) acc[r] = 0.f;
        bf16x8 kq[2][8];
#pragma unroll
        for (int kq4 = 0; kq4 < 4; ++kq4) { kq[0][2 * kq4] = ldg8(kp + kq4 * 16); kq[0][2 * kq4 + 1] = ldg8(qp + kq4 * 16); }
#pragma unroll
        for (int k4 = 0; k4 < 4; ++k4) {
            if (k4 < 3) {
#pragma unroll
                for (int kq4 = 0; kq4 < 4; ++kq4) { kq[(k4 + 1) & 1][2 * kq4] = ldg8(kp + ((k4 + 1) * 4 + kq4) * 16); kq[(k4 + 1) & 1][2 * kq4 + 1] = ldg8(qp + ((k4 + 1) * 4 + kq4) * 16); } }
            asm volatile("" ::: "memory");
#pragma unroll
            for (int kq4 = 0; kq4 < 4; ++kq4) acc = MFMA32(kq[k4 & 1][2 * kq4], kq[k4 & 1][2 * kq4 + 1], acc);
        }
        const int tloc = c * 64 + ti * 32 + rr; const float bt = Lb[tloc];
        float rs = 0.f;
#pragma unroll
        for (int g = 0; g < 4; ++g) {
            float v[4];
#pragma unroll
            for (int q = 0; q < 4; ++q) { const int r = g * 4 + q, sl = si * 32 + crow(r, hh);
                float wgt = __expf(bt + Lg[c * 64 + sl]);
                if (sl > ti * 32 + rr) wgt = 0.f;
                v[q] = acc[r] * wgt; rs += v[q]; }
            u32x2 o; o.x = pack2(v[0], v[1]); o.y = pack2(v[2], v[3]);
            *(LAS u32x2*)(Sl + (c * 64 + ti * 32 + rr) * 72 + si * 32 + 8 * g + 4 * hh) = o;
        }
        rs += __shfl_xor(rs, 32);
        if (hh == 0) atomicAdd((float*)(F.ldsg + 36864 + 4 * 1024) + tloc, rs);
    }
    __syncthreads();
    if (tid < 256) DENI[(size_t)(tl0 + tid) * 4 + h] = Lden[tid];
#pragma unroll
    for (int p2 = 0; p2 < 2; ++p2) {
        const int p = tid + 512 * p2, c = p >> 8, d = p & 255;
        const bf16_t* kt = KCT + (size_t)(h * 256 + d) * TQ + tl0 + c * 64;
        float s = 0.f;
#pragma unroll
        for (int o = 0; o < 8; ++o) { const u32x4 v = *(const u32x4*)(kt + o * 8); const LAS float* ws = Lws + c * 64 + o * 8;
            s += bflo(v.x) * ws[0] + bfhi(v.x) * ws[1] + bflo(v.y) * ws[2] + bfhi(v.y) * ws[3] + bflo(v.z) * ws[4] + bfhi(v.z) * ws[5] + bflo(v.w) * ws[6] + bfhi(v.w) * ws[7]; }
        DN[((size_t)h * 128 + j * 4 + c) * 256 + d] = s;
    }
    LAS bf16_t* Qs = (LAS bf16_t*)(L + 43008);
    LAS bf16_t* KTs = (LAS bf16_t*)(L + 43008 + 33792);
    f32x16 Ct[8];
#pragma unroll
    for (int i = 0; i < 8; ++i)
#pragma unroll
        for (int r = 0; r < 16; ++r) Ct[i][r] = 0.f;
    for (int c = 0; c < 4; ++c) {
        int rr_ = rr, hh_ = hh, tid_ = tid; asm volatile("" : "+v"(rr_), "+v"(hh_), "+v"(tid_));
        const bf16_t* vbase = VT + (size_t)(h * 256 + w * 32 + rr_) * TQ + tl0 + c * 64 + hh_ * 8;
        bf16x8 vf[4];
        {
            u32x4 stg[8];
#pragma unroll
            for (int i = 0; i < 4; ++i) { const int p = tid_ + 512 * i;
                stg[i] = *(const u32x4*)(QC + (size_t)(tl0 + c * 64 + (p >> 5)) * 1024 + h * 256 + (p & 31) * 8);
                stg[4 + i] = *(const u32x4*)(KCT + (size_t)(h * 256 + (p >> 3)) * TQ + tl0 + c * 64 + (p & 7) * 8); }
#pragma unroll
            for (int ks = 0; ks < 4; ++ks) vf[ks] = ldg8(vbase + ks * 16);
#pragma unroll
            for (int i = 0; i < 4; ++i) { const int p = tid_ + 512 * i;
                *(LAS u32x4*)(Qs + (p >> 5) * 264 + (p & 31) * 8) = stg[i];
                *(LAS u32x4*)(KTs + (p >> 3) * 72 + (p & 7) * 8) = stg[4 + i]; }
        }
        __syncthreads();
        f32x16 a0, a1;
#pragma unroll
        for (int r = 0; r < 16; ++r) { a0[r] = 0.f; a1[r] = 0.f; }
        const LAS bf16_t* q0 = Qs + rr_ * 264 + hh_ * 8; const LAS bf16_t* q1 = q0 + 32 * 264;
#pragma unroll
        for (int db = 0; db < 8; ++db)
#pragma unroll
            for (int s2 = 0; s2 < 2; ++s2) {
                const bf16x8 cf = packf8(Ct[db][8 * s2], Ct[db][8 * s2 + 1], Ct[db][8 * s2 + 2], Ct[db][8 * s2 + 3], Ct[db][8 * s2 + 4], Ct[db][8 * s2 + 5], Ct[db][8 * s2 + 6], Ct[db][8 * s2 + 7]);
                a0 = MFMA32(*(const LAS bf16x8*)(q0 + db * 32 + s2 * 16), cf, a0);
                a1 = MFMA32(*(const LAS bf16x8*)(q1 + db * 32 + s2 * 16), cf, a1);
                if (s2 == 1 && (db & 1)) asm volatile("" ::: "memory");
            }
#pragma unroll
        for (int r = 0; r < 16; ++r) { a0[r] *= Leb[c * 64 + crow(r, hh)]; a1[r] *= Leb[c * 64 + 32 + crow(r, hh)]; }
#pragma unroll
        for (int ks = 0; ks < 4; ++ks) {
            if (ks < 2) a0 = MFMA32(*(const LAS bf16x8*)(Sl + (c * 64 + rr) * 72 + ks * 16 + hh * 8), vf[ks], a0);
            a1 = MFMA32(*(const LAS bf16x8*)(Sl + (c * 64 + 32 + rr) * 72 + ks * 16 + hh * 8), vf[ks], a1);
        }
        { float* np = NUM + (size_t)(tl0 + c * 64) * 1024 + h * 256 + w * 32 + rr_;
#pragma unroll
          for (int r = 0; r < 16; ++r) { np[(size_t)crow(r, hh) * 1024] = a0[r]; np[(size_t)(32 + crow(r, hh)) * 1024] = a1[r]; } }
        const float dec = __expf(Lbl[c]);
#pragma unroll
        for (int ks = 0; ks < 4; ++ks) {
            const u32x4 v = __builtin_bit_cast(u32x4, vf[ks]); const LAS float* ws = Lws + c * 64 + ks * 16 + hh * 8;
            vf[ks] = packf8(bflo(v.x) * ws[0], bfhi(v.x) * ws[1], bflo(v.y) * ws[2], bfhi(v.y) * ws[3], bflo(v.z) * ws[4], bfhi(v.z) * ws[5], bflo(v.w) * ws[6], bfhi(v.w) * ws[7]);
        }
        const LAS bf16_t* ktb = KTs + pi23(rr_) * 72 + hh_ * 8;
#pragma unroll
        for (int db = 0; db < 8; ++db) {
#pragma unroll
            for (int r = 0; r < 16; ++r) Ct[db][r] *= dec;
#pragma unroll
            for (int ks = 0; ks < 4; ++ks) Ct[db] = MFMA32(*(const LAS bf16x8*)(ktb + db * 32 * 72 + ks * 16), vf[ks], Ct[db]);
            if (db & 1) asm volatile("" ::: "memory");
        }
        __syncthreads();
    }
    { float* sp = SLOC + (((size_t)h * 32 + j) * 256 + w * 32 + rr) * 256 + hh * 8;
#pragma unroll
      for (int db = 0; db < 8; ++db)
#pragma unroll
          for (int a = 0; a < 2; ++a) {
              *(f32x4*)(sp + db * 32 + a * 16) = (f32x4){Ct[db][8 * a], Ct[db][8 * a + 1], Ct[db][8 * a + 2], Ct[db][8 * a + 3]};
              *(f32x4*)(sp + db * 32 + a * 16 + 4) = (f32x4){Ct[db][8 * a + 4], Ct[db][8 * a + 5], Ct[db][8 * a + 6], Ct[db][8 * a + 7]}; } }
    __syncthreads();
}

DI void at_block_unit(const Frame& F, int bu) {
    const bf16_t* P = (const bf16_t*)(F.R0 + R_P); const bf16_t* VT = (const bf16_t*)(F.R0 + R_VT); float* LSE = (float*)(F.R0 + R_LSE); bf16_t* OUTG = (bf16_t*)(F.R0 + R_OUTG);
    int lane = F.lane, tid = F.tid; asm volatile("" : "+v"(lane), "+v"(tid));
    const int rr = lane & 31, hh = lane >> 5, w = F.wave;
    const int hd = bu >> 5, qb = bu & 31, g = hd >> 2;
    const int dsh = 2 * g, d = 1 << dsh, lsub = TQ >> dsh, bpr = lsub >> 8;
    const int r = qb / bpr, l0b = (qb % bpr) * 256, l0 = l0b + 32 * w;
    const float slope_d = exp2f(-8.0f * (float)(hd + 1) / 12.0f) * (float)d;
    LAS bf16_t* Ks = (LAS bf16_t*)F.lds;
    LAS bf16_t* Vs = (LAS bf16_t*)F.lds;
    {
        u32x4 st[12];
#pragma unroll
        for (int i = 0; i < 12; ++i) { const int p = tid + 512 * i, row = p >> 4, pc = p & 15; int l = l0b - 128 + row; l = l < 0 ? 0 : l;
            st[i] = *(const u32x4*)(P + (size_t)(l * d + r) * NNAT + 4608 + hd * 128 + pc * 8); }
#pragma unroll
        for (int i = 0; i < 12; ++i) { const int p = tid + 512 * i, row = p >> 4, pc = p & 15; *(LAS u32x4*)(Ks + row * 136 + pc * 8) = st[i]; }
    }
    bf16x8 qf[8];
    { const bf16_t* qp = P + (size_t)((l0 + rr) * d + r) * NNAT + 3072 + hd * 128 + hh * 64;
#pragma unroll
      for (int ks = 0; ks < 8; ++ks) qf[ks] = ldg8(qp + ks * 8); }
    __syncthreads();
    u32x4 vst[12];
#pragma unroll
    for (int i = 0; i < 12; ++i) { const int p = tid + 512 * i, ch = p / 48, pc = p % 48; int l = l0b - 128 + pc * 8; l = l < 0 ? 0 : l;
        vst[i] = *(const u32x4*)(VT + (size_t)(1024 + hd * 128 + ch) * TQ + r * lsub + l); }
    f32x16 sc[5];
    float mx = -1e30f;
    const int prr = pi23(rr);
#pragma unroll
    for (int kt = 0; kt < 5; ++kt) {
#pragma unroll
        for (int i = 0; i < 16; ++i) sc[kt][i] = 0.f;
        const LAS bf16_t* kp = Ks + (32 * (w + kt) + prr) * 136 + hh * 64;
#pragma unroll
        for (int ks = 0; ks < 8; ++ks) sc[kt] = MFMA32(*(const LAS bf16x8*)(kp + ks * 8), qf[ks], sc[kt]);
        const bool tile_ok = (l0 - 128 + 32 * kt) >= 0;
#pragma unroll
        for (int i = 0; i < 16; ++i) {
            const int kk = (i & 3) + 4 * ((i >> 2) & 1) + 8 * hh + 16 * (i >> 3);
            const int dist = 128 - 32 * kt + rr - kk;
            float s = sc[kt][i] - slope_d * (float)dist;
            s = (tile_ok && dist >= 0 && dist <= 128) ? s : -1e30f;
            sc[kt][i] = s; mx = fmaxf(mx, s);
        }
        asm volatile("" ::: "memory");
    }
    mx = fmaxf(mx, __shfl_xor(mx, 32));
    float sum = 0.f;
    bf16x8 pf[5][2];
#pragma unroll
    for (int kt = 0; kt < 5; ++kt) {
        float p[16];
#pragma unroll
        for (int i = 0; i < 16; ++i) { p[i] = __expf(sc[kt][i] - mx); sum += p[i]; }
        pf[kt][0] = packf8(p[0], p[1], p[2], p[3], p[4], p[5], p[6], p[7]);
        pf[kt][1] = packf8(p[8], p[9], p[10], p[11], p[12], p[13], p[14], p[15]);
    }
    sum += __shfl_xor(sum, 32);
    const float inv = 1.0f / sum;
    __syncthreads();
#pragma unroll
    for (int i = 0; i < 12; ++i) { const int p = tid + 512 * i, ch = p / 48, pc = p % 48; *(LAS u32x4*)(Vs + ch * 392 + pc * 8) = vst[i]; }
    __syncthreads();
#pragma unroll
    for (int ct = 0; ct < 4; ++ct) {
        f32x16 o;
#pragma unroll
        for (int i = 0; i < 16; ++i) o[i] = 0.f;
        const LAS bf16_t* vp = Vs + (ct * 32 + rr) * 392 + 32 * w + hh * 8;
#pragma unroll
        for (int kt = 0; kt < 5; ++kt) { o = MFMA32(*(const LAS bf16x8*)(vp + 32 * kt), pf[kt][0], o); o = MFMA32(*(const LAS bf16x8*)(vp + 32 * kt + 16), pf[kt][1], o); }
#pragma unroll
        for (int g4 = 0; g4 < 4; ++g4) { u32x2 wv; wv.x = pack2(o[4 * g4] * inv, o[4 * g4 + 1] * inv); wv.y = pack2(o[4 * g4 + 2] * inv, o[4 * g4 + 3] * inv);
            *(u32x2*)(OUTG + (size_t)((l0 + rr) * d + r) * 1536 + hd * 128 + ct * 32 + 8 * g4 + 4 * hh) = wv; }
        asm volatile("" ::: "memory");
    }
    if (hh == 0) LSE[(size_t)((l0 + rr) * d + r) * 12 + hd] = mx + __logf(sum);
    __syncthreads();
}

DI void phase_p2(const Frame& F) {
    const float* SLOC = (const float*)(F.R0 + R_SLOC); bf16_t* CST = (bf16_t*)(F.R0 + R_CST);
    const float* SCB = (const float*)(F.R0 + R_SCB); const float* CHB = (const float*)(F.R0 + R_CHB);
    const float* DN = (const float*)(F.R0 + R_DN); float* NST = (float*)(F.R0 + R_NST);
    for (int gt = F.bid * 512 + F.tid; gt < 131072; gt += F.G * 512) {
        const int h = gt >> 15, e2 = (gt & 32767) * 2;
        f32x2 run = (f32x2){0.f, 0.f};
#pragma unroll 1
        for (int j0 = 0; j0 < 32; j0 += 8) {
            f32x2 s[8]; float dec[8];
#pragma unroll
            for (int jj = 0; jj < 8; ++jj) { s[jj] = *(const f32x2*)(SLOC + ((size_t)h * 32 + j0 + jj) * 65536 + e2); dec[jj] = SCB[h * 32 + j0 + jj]; }
#pragma unroll
            for (int jj = 0; jj < 8; ++jj) { *(unsigned*)(CST + ((size_t)h * 32 + j0 + jj) * 65536 + e2) = pack2(run[0], run[1]); run = run * __expf(dec[jj]) + s[jj]; }
        }
    }
    const int q = ((F.G - 1 - F.bid) * 512 + F.tid);
    if (q < 1024) {
        const int h = q >> 8, dd = q & 255; float run = 0.f;
#pragma unroll 1
        for (int c0 = 0; c0 < 128; c0 += 16) {
            float dn[16], cb[16];
#pragma unroll
            for (int cc = 0; cc < 16; ++cc) { dn[cc] = DN[((size_t)h * 128 + c0 + cc) * 256 + dd]; cb[cc] = CHB[h * 128 + c0 + cc]; }
#pragma unroll
            for (int cc = 0; cc < 16; ++cc) { NST[((size_t)h * 128 + c0 + cc) * 256 + dd] = run; run = run * __expf(cb[cc]) + dn[cc]; }
        }
    }
}

DI void f_hm_unit(const Frame& F, int l, int h, int tt, int eg) {
    const bf16_t* QC = (const bf16_t*)(F.R0 + R_QC); const bf16_t* CST = (const bf16_t*)(F.R0 + R_CST); const float* NST = (const float*)(F.R0 + R_NST);
    const float* NUM = (const float*)(F.R0 + R_NUM); const bf16_t* P = (const bf16_t*)(F.R0 + R_P);
    const float* DENI = (const float*)(F.R0 + R_DENI); const float* EBC = (const float*)(F.R0 + R_EBC); const float* EBL = (const float*)(F.R0 + R_EBL);
    int lane = F.lane; asm volatile("" : "+v"(lane));
    const int tr = lane & 15, kg = lane >> 4;
    const int tl0 = tt * 16, j = tl0 >> 8, c = tl0 >> 6, tl = tl0 + tr;
    f32x4 acc[16];
#pragma unroll
    for (int i = 0; i < 16; ++i) acc[i] = (f32x4){0.f, 0.f, 0.f, 0.f};
    const bf16_t* qp = QC + (size_t)tl * 1024 + h * 256 + kg * 8;
    const bf16_t* cp = CST + (((size_t)h * 32 + j) * 256 + tr) * 256 + kg * 8;
    const float* np = NST + ((size_t)h * 128 + c) * 256 + kg * 8;
    const float ebl = EBL[(size_t)tl * 4 + h], ebc = EBC[(size_t)tl * 4 + h], deni = DENI[(size_t)tl * 4 + h];
    bf16x8 qf[8];
#pragma unroll
    for (int ks = 0; ks < 8; ++ks) qf[ks] = ldg8(qp + ks * 32);
    float dotn = 0.f;
#pragma unroll
    for (int ks = 0; ks < 8; ++ks) {
        const f32x4 n0 = *(const f32x4*)(np + ks * 32), n1 = *(const f32x4*)(np + ks * 32 + 4);
        const u32x4 qv = __builtin_bit_cast(u32x4, qf[ks]);
        dotn += bflo(qv.x) * n0[0] + bfhi(qv.x) * n0[1] + bflo(qv.y) * n0[2] + bfhi(qv.y) * n0[3] + bflo(qv.z) * n1[0] + bfhi(qv.z) * n1[1] + bflo(qv.w) * n1[2] + bfhi(qv.w) * n1[3];
    }
    bf16x8 cb[2][8];
#pragma unroll
    for (int ks = 0; ks < 8; ++ks) cb[0][ks] = ldg8(cp + ks * 32);
#pragma unroll
    for (int et = 0; et < 16; ++et) {
        if (et < 15) { const bf16_t* cn = cp + (size_t)(et + 1) * 16 * 256;
#pragma unroll
            for (int ks = 0; ks < 8; ++ks) cb[(et + 1) & 1][ks] = ldg8(cn + ks * 32); }
        asm volatile("" ::: "memory");
#pragma unroll
        for (int ks = 0; ks < 8; ++ks) acc[et] = __builtin_amdgcn_mfma_f32_16x16x32_bf16(cb[et & 1][ks], qf[ks], acc[et], 0, 0, 0);
    }
    dotn += __shfl_xor(dotn, 16); dotn += __shfl_xor(dotn, 32);
    const float den = deni + ebc * dotn;
    const float invd = 1.0f / fmaxf(fabsf(den), 1.0f);
    float ssq = 0.f;
    { f32x4 nl[16];
#pragma unroll
      for (int et = 0; et < 16; ++et) nl[et] = *(const f32x4*)(NUM + (size_t)tl * 1024 + h * 256 + et * 16 + 4 * kg);
#pragma unroll
      for (int et = 0; et < 16; ++et)
#pragma unroll
          for (int q = 0; q < 4; ++q) { const float v = (nl[et][q] + ebl * acc[et][q]) * invd; acc[et][q] = v; ssq += v * v; } }
    ssq += __shfl_xor(ssq, 16); ssq += __shfl_xor(ssq, 32);
    const float rn = __builtin_amdgcn_rsqf(ssq * (1.0f / 256.0f) + EPS);
    const size_t tp = (size_t)(eg & 1) * TQ + tl;
    asm volatile("" ::: "memory");
#pragma unroll
    for (int e8 = 0; e8 < 2; ++e8) {
        u32x2 og[8]; f32x4 ng[8];
#pragma unroll
        for (int i = 0; i < 8; ++i) { const int e = (e8 * 8 + i) * 16 + 4 * kg; og[i] = *(const u32x2*)(P + (size_t)tl * NNAT + 2048 + h * 256 + e); ng[i] = *(const f32x4*)(F.norm_g + (size_t)l * 1024 + h * 256 + e); }
#pragma unroll
        for (int i = 0; i < 8; ++i) { const int et = e8 * 8 + i, e = et * 16 + 4 * kg;
            u32x2 w; w.x = pack2(bflo(og[i].x) * acc[et][0] * rn * ng[i][0], bfhi(og[i].x) * acc[et][1] * rn * ng[i][1]);
            w.y = pack2(bflo(og[i].y) * acc[et][2] * rn * ng[i][2], bfhi(og[i].y) * acc[et][3] * rn * ng[i][3]);
            *(u32x2*)(F.HM + tp * 1024 + h * 256 + e) = w; }
        asm volatile("" ::: "memory");
    }
}
DI void f_ha_token(const Frame& F, int tl, int eg) {
    const bf16_t* OUTG = (const bf16_t*)(F.R0 + R_OUTG); const float* LSE = (const float*)(F.R0 + R_LSE);
    int lane = F.lane; asm volatile("" : "+v"(lane));
    const int hs = lane >> 4, ch0 = (lane & 15) * 8;
    const float l0 = LSE[(size_t)tl * 12 + hs], l1 = LSE[(size_t)tl * 12 + 4 + hs], l2 = LSE[(size_t)tl * 12 + 8 + hs];
    const float m = fmaxf(l0, fmaxf(l1, l2));
    float a0 = __expf(l0 - m), a1 = __expf(l1 - m), a2 = __expf(l2 - m); const float inv = 1.0f / (a0 + a1 + a2); a0 *= inv; a1 *= inv; a2 *= inv;
    const bf16_t* pr = OUTG + (size_t)tl * 1536 + hs * 128 + ch0;
    const u32x4 v0 = *(const u32x4*)(pr), v1 = *(const u32x4*)(pr + 512), v2 = *(const u32x4*)(pr + 1024);
    u32x4 o;
    o.x = pack2(a0 * bflo(v0.x) + a1 * bflo(v1.x) + a2 * bflo(v2.x), a0 * bfhi(v0.x) + a1 * bfhi(v1.x) + a2 * bfhi(v2.x));
    o.y = pack2(a0 * bflo(v0.y) + a1 * bflo(v1.y) + a2 * bflo(v2.y), a0 * bfhi(v0.y) + a1 * bfhi(v1.y) + a2 * bfhi(v2.y));
    o.z = pack2(a0 * bflo(v0.z) + a1 * bflo(v1.z) + a2 * bflo(v2.z), a0 * bfhi(v0.z) + a1 * bfhi(v1.z) + a2 * bfhi(v2.z));
    o.w = pack2(a0 * bflo(v0.w) + a1 * bflo(v1.w) + a2 * bflo(v2.w), a0 * bfhi(v0.w) + a1 * bfhi(v1.w) + a2 * bfhi(v2.w));
    *(u32x4*)(F.HA + ((size_t)(eg & 1) * TQ + tl) * 512 + hs * 128 + ch0) = o;
}
using pg8::UnitD;
DI u32x4 pack8(const f32x4& v0, const f32x4& v1) { u32x4 w; w.x = pack2(v0[0], v0[1]); w.y = pack2(v0[2], v0[3]); w.z = pack2(v1[0], v1[1]); w.w = pack2(v1[2], v1[3]); return w; }

struct SchedG1 {
    const char* U; const char* Wnat; const char* Wvt; int G, c;
    DI bool next(int i, UnitD& u) const {
        const int L = i * G + c; if (L >= 768 + 320) return false;
        u.arows = nullptr; u.acount = 0; u.aux = 0;
        if (L < 768) { int pm, pn; pg8::tile_map(L, 32, 24, pm, pn); u.kind = 0; u.pm = pm; u.pn = pn;
            u.A = U + (size_t)pm * 256 * 2048; u.lda = 2048; u.B = Wnat + (size_t)pn * 256 * 2048; u.ldb = 2048; }
        else { const int idx = L - 768, pm = idx % 10, pn = idx / 10; u.kind = 1; u.pm = pm; u.pn = pn;
            u.A = Wvt + (size_t)pm * 256 * 2048; u.lda = 2048;
            int tokbase = pn * 256, dmul = 1;
            if (pm >= 4) { const int g = (pm - 4) >> 1, dsh = 2 * g, lsub = TQ >> dsh, n0 = pn * 256; dmul = 1 << dsh; tokbase = (n0 % lsub) * dmul + n0 / lsub; }
            u.B = U + (size_t)tokbase * 2048; u.ldb = 2048u * (unsigned)dmul; }
        return true;
    }
};
struct EpiG1 {
    static constexpr bool PERM = true;
    bf16_t* P; bf16_t* VT;
    DI void operator()(const f32x4 (&acc)[2][2][4][2], const UnitD& u, int wr, int wc, int fr, int fq) const {
        bf16_t* base; size_t ld; int mode = 0;
        if (u.kind == 0) { base = P + (size_t)u.pm * 256 * NNAT + u.pn * 256; ld = NNAT; mode = (u.pn >= 8 && u.pn < 12) ? 1 : ((u.pn >= 12 && u.pn < 18) ? 2 : 0); }
        else { base = VT + (size_t)u.pm * 256 * TQ + u.pn * 256; ld = TQ; }
        const int row0 = wr * 64 + fr, col0 = wc * 32 + 8 * fq;
#pragma unroll
        for (int ai = 0; ai < 2; ++ai)
#pragma unroll
            for (int m = 0; m < 4; ++m) { bf16_t* rowp = base + (size_t)(row0 + ai * 128 + m * 16) * ld + col0;
#pragma unroll
                for (int bj = 0; bj < 2; ++bj) { f32x4 v0 = acc[ai][bj][m][0], v1 = acc[ai][bj][m][1];
                    if (mode == 1) {
#pragma unroll
                        for (int q = 0; q < 4; ++q) { v0[q] = sigmoidf_(v0[q]); v1[q] = sigmoidf_(v1[q]); } }
                    else if (mode == 2) { v0 *= 0.08838834764831845f; v1 *= 0.08838834764831845f; }
                    *(u32x4*)(rowp + bj * 128) = pack8(v0, v1); }
                asm volatile("" ::: "memory"); }
    }
};
struct SchedDense {
    const char* A; const char* B; unsigned lda, ldb; int nM, nN, G, c;
    DI bool next(int i, UnitD& u) const {
        const int L = i * G + c; if (L >= nM * nN) return false;
        int pm, pn; pg8::tile_map(L, nM, nN, pm, pn); u.kind = 0; u.pm = pm; u.pn = pn; u.aux = 0; u.arows = nullptr; u.acount = 0;
        u.A = A + (size_t)pm * 256 * lda; u.lda = lda; u.B = B + (size_t)pn * 256 * ldb; u.ldb = ldb; return true;
    }
};
struct EpiG1g {
    static constexpr bool PERM = true;
    bf16_t* GT;
    DI void operator()(const f32x4 (&acc)[2][2][4][2], const UnitD& u, int wr, int wc, int fr, int fq) const {
        bf16_t* base = GT + (size_t)u.pm * 256 * 2048 + u.pn * 256; const int row0 = wr * 64 + fr, col0 = wc * 32 + 8 * fq;
#pragma unroll
        for (int ai = 0; ai < 2; ++ai)
#pragma unroll
            for (int m = 0; m < 4; ++m) { bf16_t* rowp = base + (size_t)(row0 + ai * 128 + m * 16) * 2048 + col0;
#pragma unroll
                for (int bj = 0; bj < 2; ++bj) { f32x4 v0 = acc[ai][bj][m][0], v1 = acc[ai][bj][m][1];
#pragma unroll
                    for (int q = 0; q < 4; ++q) { v0[q] = sigmoidf_(v0[q]); v1[q] = sigmoidf_(v1[q]); }
                    *(u32x4*)(rowp + bj * 128) = pack8(v0, v1); }
                asm volatile("" ::: "memory"); }
    }
};
template <int WHICH> struct EpiG2 {
    static constexpr bool PERM = true;
    bf16_t* GT;
    DI void operator()(const f32x4 (&acc)[2][2][4][2], const UnitD& u, int wr, int wc, int fr, int fq) const {
        bf16_t* base = GT + (size_t)u.pm * 256 * 2048 + u.pn * 256 + (WHICH == 0 ? 1024 : 0); const int row0 = wr * 64 + fr, col0 = wc * 32 + 8 * fq;
#pragma unroll
        for (int ai = 0; ai < 2; ++ai)
#pragma unroll
            for (int m = 0; m < 4; ++m) { bf16_t* rowp = base + (size_t)(row0 + ai * 128 + m * 16) * 2048 + col0;
#pragma unroll
                for (int bj = 0; bj < 2; ++bj) { const f32x4 a0 = acc[ai][bj][m][0], a1 = acc[ai][bj][m][1];
                    const u32x4 g = *(const u32x4*)(rowp + bj * 128);
                    f32x4 v0 = (f32x4){bflo(g.x) * a0[0], bfhi(g.x) * a0[1], bflo(g.y) * a0[2], bfhi(g.y) * a0[3]};
                    f32x4 v1 = (f32x4){bflo(g.z) * a1[0], bfhi(g.z) * a1[1], bflo(g.w) * a1[2], bfhi(g.w) * a1[3]};
                    if (WHICH == 1) { const u32x4 y = *(const u32x4*)(rowp + bj * 128 + 1024);
                        v0 += (f32x4){bflo(y.x), bfhi(y.x), bflo(y.y), bfhi(y.y)}; v1 += (f32x4){bflo(y.z), bfhi(y.z), bflo(y.w), bfhi(y.w)}; }
                    *(u32x4*)(rowp + bj * 128) = pack8(v0, v1); }
                asm volatile("" ::: "memory"); }
    }
};
struct EpiG3 {
    static constexpr bool PERM = false;
    const float* xin; float* xout; const float* gta;
    int b0;
    DI void operator()(const f32x4 (&acc)[2][2][4][2], const UnitD& u, int wr, int wc, int fr, int fq) const {
        const int row0 = u.pm * 256 + wr * 64 + fr, col0 = u.pn * 256 + wc * 32 + 4 * fq;
        const float* g = gta + (size_t)(b0 + (u.pm >> 5)) * 6144 + col0;
        f32x4 gv[2][2];
#pragma unroll
        for (int bj = 0; bj < 2; ++bj)
#pragma unroll
            for (int n = 0; n < 2; ++n) gv[bj][n] = *(const f32x4*)(g + bj * 128 + n * 16);
#pragma unroll
        for (int ai = 0; ai < 2; ++ai)
#pragma unroll
            for (int m = 0; m < 4; ++m) { const size_t o = (size_t)(row0 + ai * 128 + m * 16) * 1024 + col0;
#pragma unroll
                for (int bj = 0; bj < 2; ++bj)
#pragma unroll
                    for (int n = 0; n < 2; ++n) { const f32x4 xv = *(const f32x4*)(xin + o + bj * 128 + n * 16); *(f32x4*)(xout + o + bj * 128 + n * 16) = xv + gv[bj][n] * acc[ai][bj][m][n]; }
                asm volatile("" ::: "memory"); }
    }
};
struct SchedMoe {
    const int* pre;
    const unsigned* cnt;
    const char* A; const char* W; const int* SLOT; int G, c; bool gate_up;
    DI bool next(int i, UnitD& u) const {
        const int L = i * G + c, nt = pre[16]; if (L >= nt * 4) return false;
        const int rt = L >> 2, ct = L & 3; int e = 0;
#pragma unroll
        for (int q = 1; q < 16; ++q) e += (rt >= pre[q]) ? 1 : 0;
        u.kind = 0; u.pm = rt; u.pn = ct; u.aux = e;
        const int ti = rt - pre[e];
        if (gate_up) { u.A = A; u.lda = 2048; u.arows = SLOT + (size_t)e * 32768 + ti * 256; u.acount = (int)cnt[e] - ti * 256;
            u.B = W + ((size_t)e * 1024 + ct * 256) * 2048; u.ldb = 2048; }
        else { u.A = A + (size_t)rt * 256 * 1024; u.lda = 1024; u.arows = nullptr; u.acount = 0;
            u.B = W + ((size_t)e * 1024 + ct * 256) * 1024; u.ldb = 1024; }
        return true;
    }
};
struct EpiG4 {
    static constexpr bool PERM = true;
    bf16_t* HH;
    DI void operator()(const f32x4 (&acc)[2][2][4][2], const UnitD& u, int wr, int wc, int fr, int fq) const {
        bf16_t* base = HH + (size_t)u.pm * 256 * 512 + u.pn * 128; const int row0 = wr * 64 + fr, col0 = wc * 16 + 4 * fq;
#pragma unroll
        for (int ai = 0; ai < 2; ++ai)
#pragma unroll
            for (int m = 0; m < 4; ++m) { bf16_t* rowp = base + (size_t)(row0 + ai * 128 + m * 16) * 512 + col0;
#pragma unroll
                for (int bj = 0; bj < 2; ++bj) { const f32x4 v0 = acc[ai][bj][m][0], v1 = acc[ai][bj][m][1];
                    u32x2 w; w.x = pack2(siluf_(v0[0]) * v0[1], siluf_(v0[2]) * v0[3]); w.y = pack2(siluf_(v1[0]) * v1[1], siluf_(v1[2]) * v1[3]);
                    *(u32x2*)(rowp + bj * 64) = w; }
                asm volatile("" ::: "memory"); }
    }
};
struct EpiG5 {
    static constexpr bool PERM = true;
    bf16_t* YS;
    DI void operator()(const f32x4 (&acc)[2][2][4][2], const UnitD& u, int wr, int wc, int fr, int fq) const {
        bf16_t* base = YS + (size_t)u.pm * 256 * 1024 + u.pn * 256; const int row0 = wr * 64 + fr, col0 = wc * 32 + 8 * fq;
#pragma unroll
        for (int ai = 0; ai < 2; ++ai)
#pragma unroll
            for (int m = 0; m < 4; ++m) { bf16_t* rowp = base + (size_t)(row0 + ai * 128 + m * 16) * 1024 + col0;
#pragma unroll
                for (int bj = 0; bj < 2; ++bj) *(u32x4*)(rowp + bj * 128) = pack8(acc[ai][bj][m][0], acc[ai][bj][m][1]);
                asm volatile("" ::: "memory"); }
    }
};
constexpr int LDS_BYTES = 131072 + 1024;
constexpr int LDS_MISC = 131072;
#ifndef MK_ONE_LAUNCH
#define MK_ONE_LAUNCH 1
#endif
constexpr int N_STEPS = 1 + DEPTH * (1 + 2 * (2 * 5 + 4) + 3) + 1;

__global__ void __launch_bounds__(512, 2) fwd_kernel(Args args) {
    extern __shared__ __attribute__((aligned(16))) unsigned char lds_raw[];
    const int tid0 = threadIdx.x;
    LAS unsigned char* lds0 = (LAS unsigned char*)lds_raw;
    if (tid0 < 4) ((volatile LAS unsigned*)(lds0 + LDS_MISC))[tid0] = 0u;
    __syncthreads();
    unsigned* ctl0 = (unsigned*)(args.ws + WS_CTL);
    XcdBarrier bar; bar.bar = ctl0 + CW_BAR; bar.x = 0; bar.st = nullptr;
    const int lo = args.step_lo, hi = args.step_hi;
    if (hi - lo > 1) bar = xcd_barrier_post(ctl0 + CW_BAR, (volatile LAS unsigned*)(lds0 + LDS_MISC));
    int step = 0; int l_probe = 0;
#ifndef SITE_MASK
#define SITE_MASK 0xFFFFFFFFu
#endif
#ifndef DUP_MASK
#define DUP_MASK 0u
#endif
#ifndef DUP_L0
#define DUP_L0 0
#endif
#ifndef EXTRA_BARS
#define EXTRA_BARS 0
#endif
#define RUN(site, ...) do { if (step >= lo && step < hi) { if constexpr ((DUP_MASK >> (site)) & 1u) { if (!DUP_L0 || l_probe == 0) { Frame F; { int t_ = tid0; asm volatile("" : "+v"(t_)); frame_init(F, lds_raw, t_); } int* preL = (int*)(F.ldsg + LDS_MISC + 64); (void)preL; __VA_ARGS__; xcd_barrier(bar); } } if constexpr ((SITE_MASK >> (site)) & 1u) { Frame F; { int t_ = tid0; asm volatile("" : "+v"(t_)); frame_init(F, lds_raw, t_); } int* preL = (int*)(F.ldsg + LDS_MISC + 64); (void)preL; __VA_ARGS__; } if (step + 1 < hi) xcd_barrier(bar); } ++step; } while (0)

    RUN(0, { phase_p0_small(F); __syncthreads(); phase_pw(F, 0, 0, F.G); });
    for (int l = 0; l < DEPTH; ++l) { l_probe = l;
        RUN(1, { if (l > 0) phase_pw(F, l, 0, F.G); phase_n1(F, l); });
        for (int p = 0; p < 2; ++p) {
            for (int e = 0; e < 2; ++e) {
                const int eg = 2 * p + e;
                RUN(2, { SchedG1 S{(const char*)(F.U + (size_t)eg * TQ * 1024), (const char*)(F.W + W_NAT), (const char*)(F.W + W_VT), F.G, F.bid};
                      EpiG1 E{(bf16_t*)(F.R0 + R_P), (bf16_t*)(F.R0 + R_VT)};
                      pg8::gemm_run<EpiG1, SchedG1>(F.lds, 1024, S, E); });
                RUN(3, { phase_cv(F, l); });
                RUN(4, { const int nbm = F.G >> 1;
                      if (F.bid < nbm) {
#ifndef NO_ML1
 for (int u = F.bid; u < 128; u += nbm) ml1_unit(F, u >> 5, u & 31, eg);
#endif
 }
                      else {
#ifndef NO_AT
 for (int bu = F.bid - nbm; bu < 384; bu += F.G - nbm) at_block_unit(F, bu);
#endif
 } });
                RUN(5, { phase_p2(F); });
                RUN(6, { for (int u = F.bid * 8 + F.wave; u < 2048; u += F.G * 8) f_hm_unit(F, l, u >> 9, u & 511, eg);
                      for (int t = F.bid * 8 + F.wave; t < TQ; t += F.G * 8) f_ha_token(F, t, eg); });
            }
            RUN(7, { SchedDense S{(const char*)(F.U + (size_t)p * TP * 1024), (const char*)(F.W + W_G), 2048u, 2048u, 64, 8, F.G, F.bid};
                  EpiG1g E{(bf16_t*)(F.R0 + R_GT)}; pg8::gemm_run<EpiG1g, SchedDense>(F.lds, 1024, S, E); });
            RUN(8, { SchedDense S{(const char*)F.HA, (const char*)(F.W + W_A), 1024u, 1024u, 64, 4, F.G, F.bid};
                  EpiG2<0> E{(bf16_t*)(F.R0 + R_GT)}; pg8::gemm_run<EpiG2<0>, SchedDense>(F.lds, 512, S, E); });
            RUN(9, { SchedDense S{(const char*)F.HM, (const char*)(F.W + W_M), 2048u, 2048u, 64, 4, F.G, F.bid};
                  EpiG2<1> E{(bf16_t*)(F.R0 + R_GT)}; pg8::gemm_run<EpiG2<1>, SchedDense>(F.lds, 1024, S, E); });
            RUN(10, { SchedDense S{(const char*)(F.R0 + R_GT), (const char*)(F.W + W_O), 4096u, 2048u, 64, 4, F.G, F.bid};
                  EpiG3 E{(l == 0 ? F.x : F.out) + (size_t)p * TP * 1024, F.out + (size_t)p * TP * 1024, F.MOD + (size_t)l * 4 * 6144 + 2048, 2 * p};
                  pg8::gemm_run<EpiG3, SchedDense>(F.lds, 1024, S, E); });
        }
        RUN(11, { phase_n2(F, l); });
        RUN(12, { moe_offsets(F.ctl + CW_CNT + 64 * l, preL, F.tid); __syncthreads();
              SchedMoe S{preL, F.ctl + CW_CNT + 64 * l, (const char*)F.U, (const char*)(F.W + W_13), (const int*)(F.R0 + R_SLOT), F.G, F.bid, true};
              EpiG4 E{(bf16_t*)(F.R0 + R_HH)}; pg8::gemm_run<EpiG4, SchedMoe, true>(F.lds, 1024, S, E); });
        RUN(13, { moe_offsets(F.ctl + CW_CNT + 64 * l, preL, F.tid); __syncthreads();
              SchedMoe S{preL, F.ctl + CW_CNT + 64 * l, (const char*)(F.R0 + R_HH), (const char*)(F.W + W_2), (const int*)(F.R0 + R_SLOT), F.G, F.bid, false};
              EpiG5 E{(bf16_t*)(F.R0 + R_YS)}; pg8::gemm_run<EpiG5, SchedMoe>(F.lds, 512, S, E); });
    }
    for (int xb = 0; xb < EXTRA_BARS; ++xb) xcd_barrier(bar);
    RUN(14, { phase_fn(F); });
#undef RUN
}

extern "C" void kernel_launch(void* const* d_in, const int* in_sizes, int n_in, void* d_out, int out_size, void* d_ws, size_t ws_size, hipStream_t stream) {
    static int grid = 0;
    if (grid == 0) {
        if (n_in != 19 || out_size != T_TOK * DM || ws_size < WS_END) { fprintf(stderr, "kernel_launch: unexpected problem (n_in %d out %d ws %zu, need %zu)\n", n_in, out_size, ws_size, (size_t)WS_END); grid = -1; return; }
        int dev = 0, cus = 0, per_cu = 0;
        if (hipGetDevice(&dev) != hipSuccess || hipDeviceGetAttribute(&cus, hipDeviceAttributeMultiprocessorCount, dev) != hipSuccess) { grid = -1; return; }
        if (hipFuncSetAttribute((const void*)fwd_kernel, hipFuncAttributeMaxDynamicSharedMemorySize, LDS_BYTES) != hipSuccess) { fprintf(stderr, "kernel_launch: hipFuncSetAttribute failed\n"); grid = -1; return; }
        if (hipOccupancyMaxActiveBlocksPerMultiprocessor(&per_cu, (const void*)fwd_kernel, 512, LDS_BYTES) != hipSuccess || per_cu < 1) { fprintf(stderr, "kernel_launch: occupancy query says %d blocks per CU\n", per_cu); per_cu = 1; }
        (void)hipGetLastError();
        grid = cus;
        if (grid > 256) grid = 256;
        grid &= ~7;
    }
    if (grid <= 0) return;
    (void)hipMemsetAsync((char*)d_ws + WS_CTL, 0, CTL_BYTES, stream);
    Args a{};
    for (int i = 0; i < 19; ++i) a.in[i] = (const float*)d_in[i];
    a.out = (float*)d_out; a.ws = (unsigned char*)d_ws;
#if MK_ONE_LAUNCH
    a.step_lo = 0; a.step_hi = N_STEPS;
    hipLaunchKernelGGL(fwd_kernel, dim3(grid), dim3(512), LDS_BYTES, stream, a);
#else
    for (int s = 0; s < N_STEPS; ++s) { a.step_lo = s; a.step_hi = s + 1; hipLaunchKernelGGL(fwd_kernel, dim3(grid), dim3(512), LDS_BYTES, stream, a); }
#endif
}
```

```cpp
#define MK_ONE_LAUNCH 1
#include <hip/hip_runtime.h>
#include <cstdio>
#include <cstdint>

#define DI __device__ __forceinline__
#define LAS __attribute__((address_space(3)))
typedef unsigned short bf16_t;
typedef short bf16x8 __attribute__((ext_vector_type(8)));
typedef float f32x2 __attribute__((ext_vector_type(2)));
typedef float f32x4 __attribute__((ext_vector_type(4)));
typedef float f32x16 __attribute__((ext_vector_type(16)));
typedef unsigned u32x2 __attribute__((ext_vector_type(2)));
typedef unsigned u32x4 __attribute__((ext_vector_type(4)));
typedef __bf16 nbf16x2 __attribute__((ext_vector_type(2)));

constexpr int T_TOK = 32768, SEQ = 8192, DM = 1024, NBATCH = 4, DEPTH = 2;
constexpr int TQ = 8192;
constexpr int TP = 16384;
constexpr int INC = 10760;
constexpr int NNAT = 6144;
constexpr int NVT = 2560;
constexpr int NEXP = 16, DFF = 512;
constexpr int SLOT_ROWS = 69632;
constexpr float EPS = 1e-6f;

constexpr size_t al256(size_t x) { return (x + 255) & ~(size_t)255; }
constexpr size_t WS_CTL = 0;
constexpr size_t CTL_BYTES = 65536;
constexpr size_t WS_MOD = WS_CTL + CTL_BYTES;
constexpr size_t WS_WIF = WS_MOD + al256((size_t)2 * 4 * 6144 * 4);
constexpr size_t WS_RW = WS_WIF + (size_t)2 * 8 * 1024 * 4;
constexpr size_t WS_W = WS_RW + (size_t)16 * 1024 * 4;
constexpr size_t W_NAT = 0;
constexpr size_t W_VT = W_NAT + (size_t)NNAT * 1024 * 2;
constexpr size_t W_G = W_VT + (size_t)NVT * 1024 * 2;
constexpr size_t W_M = W_G + (size_t)2048 * 1024 * 2;
constexpr size_t W_A = W_M + (size_t)1024 * 1024 * 2;
constexpr size_t W_O = W_A + (size_t)1024 * 512 * 2;
constexpr size_t W_13 = W_O + (size_t)1024 * 1024 * 2;
constexpr size_t W_2 = W_13 + (size_t)16 * 1024 * 1024 * 2;
constexpr size_t W_BYTES = W_2 + (size_t)16 * 1024 * 512 * 2;
constexpr size_t WS_U = WS_W + W_BYTES;
constexpr size_t WS_GIF = WS_U + (size_t)T_TOK * 1024 * 2;
constexpr size_t WS_HM = WS_GIF + (size_t)T_TOK * 8 * 4;
constexpr size_t WS_HA = WS_HM + (size_t)T_TOK * 1024 * 2;
constexpr size_t WS_TOKI = WS_HA + (size_t)T_TOK * 512 * 2;
constexpr size_t WS_R0 = WS_TOKI + (size_t)2 * T_TOK * 32;
constexpr size_t R_P = 0;
constexpr size_t R_VT = R_P + (size_t)TQ * NNAT * 2;
constexpr size_t R_QC = R_VT + (size_t)NVT * TQ * 2;
constexpr size_t R_NUM = R_QC + (size_t)TQ * 1024 * 2;
constexpr size_t R_SLOC = R_NUM + (size_t)TQ * 1024 * 2;
constexpr size_t R_CST = R_SLOC;
constexpr size_t R_DENI = R_SLOC + (size_t)4 * 32 * 65536 * 2;
constexpr size_t R_EBC = R_DENI + (size_t)TQ * 4 * 4;
constexpr size_t R_EBL = R_EBC + (size_t)TQ * 4 * 4;
constexpr size_t R_SCB = R_EBL + (size_t)TQ * 4 * 4;
constexpr size_t R_CHB = R_SCB + 1024;
constexpr size_t R_DN = R_CHB + 2048;
constexpr size_t R_NST = R_DN + (size_t)4 * 128 * 256 * 4;
constexpr size_t R_LSE = R_NST + (size_t)4 * 128 * 256 * 4;
constexpr size_t R_END = R_LSE + (size_t)TQ * 12 * 4;
constexpr size_t R_GT = 0;
constexpr size_t R_HH = 0;
constexpr size_t R_YS = R_HH + (size_t)SLOT_ROWS * 512 * 2;
constexpr size_t R_SLOT = R_YS + (size_t)SLOT_ROWS * 1024 * 2;
constexpr size_t R_END2 = R_SLOT + (size_t)16 * 32768 * 4;
constexpr size_t WS_END = WS_R0 + (R_END > R_END2 ? R_END : R_END2);
static_assert(WS_END <= (size_t)536870912, "workspace over 512 MiB");

constexpr int CW_BAR = 0;
constexpr int CW_CNT = 4096;

DI float bflo(unsigned w) { return __uint_as_float(w << 16); }
DI float bfhi(unsigned w) { return __uint_as_float(w & 0xffff0000u); }
DI unsigned pack2(float lo, float hi) { f32x2 v = {lo, hi}; nbf16x2 b = __builtin_convertvector(v, nbf16x2); return __builtin_bit_cast(unsigned, b); }
DI float sigmoidf_(float x) { return __builtin_amdgcn_rcpf(1.0f + __expf(-x)); }
DI float siluf_(float x) { return x * sigmoidf_(x); }
DI float wave_sum(float v) { for (int o = 32; o >= 1; o >>= 1) v += __shfl_xor(v, o); return v; }
DI int crow(int reg, int h) { return (reg & 3) + 8 * (reg >> 2) + 4 * h; }
DI int pi23(int m) { return (m & ~12) | ((m & 4) << 1) | ((m & 8) >> 1); }
#define MFMA32(a, b, c) __builtin_amdgcn_mfma_f32_32x32x16_bf16((a), (b), (c), 0, 0, 0)
DI bf16x8 packf8(float a0, float a1, float a2, float a3, float a4, float a5, float a6, float a7) {
    u32x4 p; p.x = pack2(a0, a1); p.y = pack2(a2, a3); p.z = pack2(a4, a5); p.w = pack2(a6, a7); return __builtin_bit_cast(bf16x8, p); }
DI bf16x8 ldg8(const bf16_t* p) { return *(const bf16x8*)p; }
#define XB_TMO      128
#define XB_XCNT(j)  (256  + 64 * (j))
#define XB_XSUB(j)  (1280 + 64 * (j))
#define XB_XGEN(j)  (2304 + 64 * (j))
#define XB_TOP      3328
#define XB_TOPGEN   3392
#define XCD_BAR_WORDS 3456
#define XB_SPIN_CAP (1u << 21)

__device__ __forceinline__ unsigned xb_ld(unsigned* p)              { return __hip_atomic_load(p, __ATOMIC_RELAXED, __HIP_MEMORY_SCOPE_AGENT); }
__device__ __forceinline__ unsigned xb_add(unsigned* p, unsigned v) { return __hip_atomic_fetch_add(p, v, __ATOMIC_RELAXED, __HIP_MEMORY_SCOPE_AGENT); }
__device__ __forceinline__ unsigned xb_xcc_id() { return (unsigned)__builtin_amdgcn_s_getreg((3 << 11) | 20) & 0xFu; }
#define XB_SPIN(cond, bar) do { unsigned _sp = 0; while (cond) { __builtin_amdgcn_s_sleep(1); \
    if ((++_sp & 255u) == 0u) { if (xb_ld(&(bar)[XB_TMO])) break; if (_sp > XB_SPIN_CAP) { atomicAdd(&(bar)[XB_TMO], 1u); break; } } } } while (0)

struct XcdBarrier {
    unsigned* bar; unsigned x;
    volatile LAS unsigned* st;
};

__device__ __forceinline__ XcdBarrier xcd_barrier_post(unsigned* bar, volatile LAS unsigned* st) {
    XcdBarrier b; b.bar = bar; b.x = xb_xcc_id(); b.st = st;
    if (threadIdx.x == 0) (void)xb_add(&bar[XB_XCNT(b.x)], 1u);
    return b;
}
__device__ __forceinline__ void xcd_barrier_complete(unsigned* bar, unsigned x, unsigned& nloc, unsigned& nx) {
    const unsigned G = gridDim.x * gridDim.y * gridDim.z;
    unsigned sum, cnt, mine, sp = 0u;
    for (;;) {
        sum = 0u; cnt = 0u; mine = 0u;
#pragma unroll
        for (unsigned j = 0; j < 16; ++j) { const unsigned c = xb_ld(&bar[XB_XCNT(j)]); sum += c; cnt += (c > 0u) ? 1u : 0u; mine = (j == x) ? c : mine; }
        if (sum == G) break;
        __builtin_amdgcn_s_sleep(1);
        if ((++sp & 255u) == 0u) { if (xb_ld(&bar[XB_TMO])) break; if (sp > XB_SPIN_CAP) { atomicAdd(&bar[XB_TMO], 1u); break; } }
    }
    nloc = mine > 0u ? mine : 1u; nx = cnt > 0u ? cnt : 1u;
}

__device__ __forceinline__ void xcd_barrier(const XcdBarrier& b) {
    asm volatile("s_waitcnt vmcnt(0)" ::: "memory");
    __syncthreads();
    if (threadIdx.x == 0) {
        unsigned* bar = b.bar;
        __builtin_amdgcn_s_waitcnt(0);
        unsigned nloc = b.st[0], nx = b.st[1];
        if (nloc == 0u) { xcd_barrier_complete(bar, b.x, nloc, nx); b.st[0] = nloc; b.st[1] = nx; }
        const unsigned old = xb_add(&bar[XB_XSUB(b.x)], 1u);
        const unsigned gen = old / nloc;
        if (old + 1u == (gen + 1u) * nloc) {
            __builtin_amdgcn_fence(__ATOMIC_RELEASE, "agent");
            asm volatile("s_waitcnt vmcnt(0)" ::: "memory");
            const unsigned og = xb_add(&bar[XB_TOP], 1u);
            const unsigned tg = og / nx;
            if (og + 1u == (tg + 1u) * nx) xb_add(&bar[XB_TOPGEN], 1u);
            else XB_SPIN(xb_ld(&bar[XB_TOPGEN]) == tg, bar);
            __builtin_amdgcn_fence(__ATOMIC_ACQUIRE, "agent");
            xb_add(&bar[XB_XGEN(b.x)], 1u);
            asm volatile("s_waitcnt vmcnt(0)" ::: "memory");
        } else {
            XB_SPIN(xb_ld(&bar[XB_XGEN(b.x)]) == gen, bar);
            __builtin_amdgcn_fence(__ATOMIC_ACQUIRE, "agent");
            asm volatile("s_waitcnt vmcnt(0)" ::: "memory");
        }
    }
    __syncthreads();
}
namespace pg8 {
constexpr int BM = 256, BK = 64, HALF = 128, HTB = HALF * BK * 2, STAGE_BYTES = 8 * HTB, NXCD = 8, WGM = 8;
DI int lds_byte(int r, int c) { const int st = (r >> 4) * 2 + (c >> 5), rr = r & 15, cc = c & 31, ob = rr * 64 + cc * 2; return st * 1024 + (ob ^ (((ob >> 9) & 1) << 5)); }
DI void stage_rc(int b, int& R, int& C) { const int st = b / 1024, sb = b % 1024, swz = sb ^ (((sb >> 9) & 1) << 5); R = (st >> 1) * 16 + swz / 64; C = (st & 1) * 32 + (swz % 64) / 2; }
DI int perm32(int rho) { const int n = rho >> 4, i = rho & 15; return 8 * (i >> 2) + 4 * n + (i & 3); }

struct UnitD {
    const char* A; const char* B;
    unsigned lda, ldb;
    const int* arows; int acount;
    int kind, pm, pn, aux;
    int K;
};
DI void tile_map(int L, int nM, int nN, int& pm, int& pn) {
    const int nwg = nM * nN; int wgid = L;
    { const int q = nwg / NXCD, r = nwg % NXCD, xcd = wgid % NXCD, off = wgid / NXCD; wgid = (xcd < r ? xcd * (q + 1) : r * (q + 1) + (xcd - r) * q) + off; }
    const int nig = WGM * nN, gid = wgid / nig, fm = gid * WGM, gsz = (nM - fm) < WGM ? (nM - fm) : WGM;
    pm = fm + ((wgid % nig) % gsz); pn = (wgid % nig) / gsz;
}
template <bool PERM, bool GATHER>
DI void unit_off(const UnitD& u, int tid, unsigned (&offA)[2][2], unsigned (&offB)[2]) {
#pragma unroll
    for (int i = 0; i < 2; ++i) {
        int R, C; stage_rc(tid * 16 + i * 8192, R, C);
        const int Rb = PERM ? ((R & ~31) + perm32(R & 31)) : R;
        offB[i] = (unsigned)Rb * u.ldb + (unsigned)C * 2u;
        if (GATHER) {
#pragma unroll
            for (int h = 0; h < 2; ++h) { const int ra = h * HALF + R; const int rr = ra < u.acount ? ra : 0; offA[h][i] = (unsigned)u.arows[rr] * u.lda + (unsigned)C * 2u; }
        } else { offA[0][i] = (unsigned)R * u.lda + (unsigned)C * 2u; offA[1][i] = 0u; }
    }
}

template <class Epi, class Sched, bool GATHER = false>
DI void gemm_run(LAS unsigned char* lds, const Sched& S, const Epi& E, int tid_in) {
    int tid_ = tid_in; asm volatile("" : "+v"(tid_));
    const int tid = tid_, wid = __builtin_amdgcn_readfirstlane(tid >> 6), lane = tid & 63, wr = wid >> 2, wc = wid & 3, fr = lane & 15, fq = lane >> 4;
    const size_t kstep = (size_t)(BK * 2);
    const unsigned ldsw = (unsigned)wid * 1024u;
    const int aoff = lds_byte(wr * 64 + fr, fq * 8), boff = lds_byte(wc * 32 + fr, fq * 8);
#define PG8_SA(b, h) (((b) * 2 + (h)) * HTB)
#define PG8_SB(b, h) ((4 + (b) * 2 + (h)) * HTB)
#define PG8_STAGE(bufoff, gbase, voff) do { _Pragma("unroll") for (int _i = 0; _i < 2; ++_i) \
        __builtin_amdgcn_global_load_lds((const unsigned*)((const char*)(gbase) + (voff)[_i]), (LAS unsigned*)(lds + (bufoff) + ldsw + _i * 8192), 16, 0, 0); } while (0)
#define PG8_LDA(dst, b, h) do { _Pragma("unroll") for (int m = 0; m < 4; ++m) _Pragma("unroll") for (int k = 0; k < 2; ++k) dst[m][k] = *(const LAS bf16x8*)(lds + PG8_SA(b, h) + aoff + m * 2048 + k * 1024); } while (0)
#define PG8_LDB(dst, b, h) do { _Pragma("unroll") for (int n = 0; n < 2; ++n) _Pragma("unroll") for (int k = 0; k < 2; ++k) dst[n][k] = *(const LAS bf16x8*)(lds + PG8_SB(b, h) + boff + n * 2048 + k * 1024); } while (0)
#define PG8_MMA(ai, bj, At, Bt) do { __builtin_amdgcn_s_setprio(1); _Pragma("unroll") for (int m = 0; m < 4; ++m) _Pragma("unroll") for (int n = 0; n < 2; ++n) _Pragma("unroll") for (int k = 0; k < 2; ++k) \
        acc[ai][bj][m][n] = __builtin_amdgcn_mfma_f32_16x16x32_bf16(Bt[n][k], At[m][k], acc[ai][bj][m][n], 0, 0, 0); __builtin_amdgcn_s_setprio(0); } while (0)
#define PG8_WAIT_V(n) asm volatile("s_waitcnt vmcnt(" #n ")" ::: "memory")
#define PG8_WAIT_L(n) asm volatile("s_waitcnt lgkmcnt(" #n ")" ::: "memory")
#define PG8_BAR __builtin_amdgcn_s_barrier()
#define PG8_SCHED __builtin_amdgcn_sched_barrier(0)
    UnitD cur, nxt; int ui = 0;
    if (!S.next(0, cur)) return;
    unsigned offA[2][2], offB[2];
    unit_off<Epi::PERM, GATHER>(cur, tid, offA, offB);
    size_t hA = GATHER ? 0 : (size_t)HALF * cur.lda, hB = (size_t)HALF * cur.ldb;
#define OA(h) offA[GATHER ? (h) : 0]
    f32x4 acc[2][2][4][2];
#pragma unroll
    for (int a = 0; a < 2; ++a)
#pragma unroll
        for (int b = 0; b < 2; ++b)
#pragma unroll
            for (int m = 0; m < 4; ++m)
#pragma unroll
                for (int n = 0; n < 2; ++n) acc[a][b][m][n] = (f32x4){0.f, 0.f, 0.f, 0.f};
    bf16x8 At[4][2], B0[2][2], B1[2][2];
    PG8_STAGE(PG8_SB(0, 0), cur.B, offB); PG8_STAGE(PG8_SA(0, 0), cur.A, OA(0)); PG8_STAGE(PG8_SB(0, 1), cur.B + hB, offB); PG8_STAGE(PG8_SA(0, 1), cur.A + hA, OA(1));
    if (wr == 1) PG8_BAR;
    PG8_WAIT_V(4); PG8_BAR;
    PG8_STAGE(PG8_SB(1, 0), cur.B + kstep, offB); PG8_STAGE(PG8_SA(1, 0), cur.A + kstep, OA(0)); PG8_STAGE(PG8_SB(1, 1), cur.B + kstep + hB, offB);
    PG8_WAIT_V(6); PG8_BAR;
    for (;;) {
        const bool has_next = S.next(ui + 1, nxt);
        const int nt = cur.K / BK;
        for (int t = 0; t < nt; t += 2) {
            const bool last = (t == nt - 2);
            const char* a1 = cur.A + (size_t)(t + 1) * kstep;
            PG8_LDB(B0, 0, 0); PG8_SCHED; PG8_LDA(At, 0, 0); PG8_STAGE(PG8_SA(1, 1), a1 + hA, OA(1));
            PG8_WAIT_L(8); PG8_BAR; PG8_WAIT_L(0); PG8_MMA(0, 0, At, B0); PG8_BAR; PG8_SCHED;
            const char* a2; const char* b2;
            if (last) { if (has_next) { unit_off<Epi::PERM, GATHER>(nxt, tid, offA, offB); a2 = nxt.A; b2 = nxt.B; hA = GATHER ? 0 : (size_t)HALF * nxt.lda; hB = (size_t)HALF * nxt.ldb; } else { a2 = cur.A; b2 = cur.B; } }
            else { a2 = cur.A + (size_t)(t + 2) * kstep; b2 = cur.B + (size_t)(t + 2) * kstep; }
            const char* a3 = a2 + kstep; const char* b3 = b2 + kstep;
            PG8_LDB(B1, 0, 1); PG8_STAGE(PG8_SB(0, 0), b2, offB);
            PG8_BAR; PG8_WAIT_L(0); PG8_MMA(0, 1, At, B1); PG8_BAR;
            PG8_LDA(At, 0, 1); PG8_STAGE(PG8_SA(0, 0), a2, OA(0));
            PG8_BAR; PG8_WAIT_L(0); PG8_MMA(1, 0, At, B0); PG8_BAR; PG8_SCHED;
            PG8_STAGE(PG8_SB(0, 1), b2 + hB, offB);
            PG8_WAIT_V(6); PG8_BAR; PG8_MMA(1, 1, At, B1); PG8_BAR;
            PG8_LDB(B0, 1, 0); PG8_SCHED; PG8_LDA(At, 1, 0); PG8_STAGE(PG8_SA(0, 1), a2 + hA, OA(1));
            PG8_WAIT_L(8); PG8_BAR; PG8_WAIT_L(0); PG8_MMA(0, 0, At, B0); PG8_BAR; PG8_SCHED;
            PG8_LDB(B1, 1, 1); PG8_STAGE(PG8_SB(1, 0), b3, offB);
            PG8_BAR; PG8_WAIT_L(0); PG8_MMA(0, 1, At, B1); PG8_BAR;
            PG8_LDA(At, 1, 1); PG8_STAGE(PG8_SA(1, 0), a3, OA(0));
            PG8_BAR; PG8_WAIT_L(0); PG8_MMA(1, 0, At, B0); PG8_BAR; PG8_SCHED;
            PG8_STAGE(PG8_SB(1, 1), b3 + hB, offB);
            PG8_WAIT_V(6); PG8_BAR; PG8_MMA(1, 1, At, B1); PG8_BAR;
        }
        { int fr_ = fr, fq_ = fq; asm volatile("" : "+v"(fr_), "+v"(fq_)); E(acc, cur, wr, wc, fr_, fq_); }
        if (!has_next) break;
#pragma unroll
        for (int a = 0; a < 2; ++a)
#pragma unroll
            for (int b = 0; b < 2; ++b)
#pragma unroll
                for (int m = 0; m < 4; ++m)
#pragma unroll
                    for (int n = 0; n < 2; ++n) acc[a][b][m][n] = (f32x4){0.f, 0.f, 0.f, 0.f};
        cur = nxt; ++ui;
    }
    PG8_WAIT_V(0);
    if (wr == 0) PG8_BAR;
    PG8_BAR;
#undef OA
#undef PG8_SA
#undef PG8_SB
#undef PG8_STAGE
#undef PG8_LDA
#undef PG8_LDB
#undef PG8_MMA
#undef PG8_WAIT_V
#undef PG8_WAIT_L
#undef PG8_BAR
#undef PG8_SCHED
}
}
struct Args { const float* in[19]; float* out; unsigned char* ws; int step_lo, step_hi; };
struct Frame {
    LAS unsigned char* lds; unsigned char* ldsg;
    int tid, lane, wave, G, bid;
    const float *x, *c, *ada_w, *ada_b, *w_in, *conv_w, *gate_b, *norm_g, *w_bm, *w_ba, *w_out, *router_w, *router_b, *w_gate, *w_up, *w_down, *g_mix, *g_ffn, *g_fin;
    float* out; unsigned char* ws; unsigned* ctl;
    float* MOD; float* WIF; float* RW; unsigned char* W;
    bf16_t* U; float* GIF; bf16_t* HM; bf16_t* HA; unsigned char* TOKI; unsigned char* R0;
};
#define CAS __attribute__((address_space(4)))
DI const void* karg(int idx) { asm volatile("" : "+s"(idx)); const void* const CAS* kp = (const void* const CAS*)__builtin_amdgcn_kernarg_segment_ptr(); return kp[idx]; }
DI void frame_init(Frame& F, unsigned char* lds_generic, int tid) {
    F.ldsg = lds_generic; F.lds = (LAS unsigned char*)lds_generic;
    F.tid = tid; F.lane = F.tid & 63; F.wave = __builtin_amdgcn_readfirstlane(F.tid >> 6); F.G = gridDim.x; F.bid = blockIdx.x;
    F.x = (const float*)karg(0); F.c = (const float*)karg(1); F.ada_w = (const float*)karg(2); F.ada_b = (const float*)karg(3); F.w_in = (const float*)karg(4); F.conv_w = (const float*)karg(5);
    F.gate_b = (const float*)karg(6); F.norm_g = (const float*)karg(7); F.w_bm = (const float*)karg(8); F.w_ba = (const float*)karg(9); F.w_out = (const float*)karg(10); F.router_w = (const float*)karg(11);
    F.router_b = (const float*)karg(12); F.w_gate = (const float*)karg(13); F.w_up = (const float*)karg(14); F.w_down = (const float*)karg(15); F.g_mix = (const float*)karg(16); F.g_ffn = (const float*)karg(17); F.g_fin = (const float*)karg(18);
    F.out = (float*)karg(19); unsigned char* ws = (unsigned char*)karg(20);
    F.ws = ws; F.ctl = (unsigned*)(ws + WS_CTL);
    F.MOD = (float*)(ws + WS_MOD); F.WIF = (float*)(ws + WS_WIF); F.RW = (float*)(ws + WS_RW); F.W = ws + WS_W;
    F.U = (bf16_t*)(ws + WS_U); F.GIF = (float*)(ws + WS_GIF); F.HM = (bf16_t*)(ws + WS_HM); F.HA = (bf16_t*)(ws + WS_HA);
    F.TOKI = ws + WS_TOKI; F.R0 = ws + WS_R0;
}

struct TJob { const float* src; int ld; int K; int N; bf16_t* dst; int rmul, radd; };
DI bool get_job(const Frame& F, int l, int j, TJob& J) {
    const float* win = F.w_in + (size_t)l * DM * INC;
    bf16_t* W = (bf16_t*)F.W;
    J.rmul = 1; J.radd = 0; J.K = 1024; J.ld = INC;
    if (j == 0) { J.src = win + 0;    J.N = 1024; J.dst = W + W_NAT / 2 + (size_t)0 * 1024; return true; }
    if (j == 1) { J.src = win + 1024; J.N = 1024; J.dst = W + W_NAT / 2 + (size_t)1024 * 1024; return true; }
    if (j == 2) { J.src = win + 3072; J.N = 1024; J.dst = W + W_NAT / 2 + (size_t)2048 * 1024; return true; }
    if (j == 3) { J.src = win + 4104; J.N = 1536; J.dst = W + W_NAT / 2 + (size_t)3072 * 1024; return true; }
    if (j == 4) { J.src = win + 5640; J.N = 1536; J.dst = W + W_NAT / 2 + (size_t)4608 * 1024; return true; }
    if (j == 5) { J.src = win + 2048; J.N = 1024; J.dst = W + W_VT / 2 + (size_t)0 * 1024; return true; }
    if (j == 6) { J.src = win + 7176; J.N = 1536; J.dst = W + W_VT / 2 + (size_t)1024 * 1024; return true; }
    if (j == 7) { J.src = win + 8712; J.N = 2048; J.dst = W + W_G / 2; return true; }
    if (j == 8) { J.src = F.w_bm + (size_t)l * 1024 * 1024; J.ld = 1024; J.N = 1024; J.dst = W + W_M / 2; return true; }
    if (j == 9) { J.src = F.w_ba + (size_t)l * 512 * 1024; J.ld = 1024; J.K = 512; J.N = 1024; J.dst = W + W_A / 2; return true; }
    if (j == 10) { J.src = F.w_out + (size_t)l * 1024 * 1024; J.ld = 1024; J.N = 1024; J.dst = W + W_O / 2; return true; }
    const int q = j - 11; if (q >= 48) return false;
    const int e = q / 3, which = q % 3;
    if (which == 0) { J.src = F.w_gate + ((size_t)l * 16 + e) * 1024 * 512; J.ld = 512; J.N = 512; J.dst = W + W_13 / 2 + (size_t)e * 1024 * 1024; J.rmul = 2; J.radd = 0; }
    else if (which == 1) { J.src = F.w_up + ((size_t)l * 16 + e) * 1024 * 512; J.ld = 512; J.N = 512; J.dst = W + W_13 / 2 + (size_t)e * 1024 * 1024; J.rmul = 2; J.radd = 1; }
    else { J.src = F.w_down + ((size_t)l * 16 + e) * 512 * 1024; J.ld = 1024; J.K = 512; J.N = 1024; J.dst = W + W_2 / 2 + (size_t)e * 1024 * 512; }
    return true;
}
constexpr int NJOBS = 59;
struct TIter { int j, t, nk, ntile; TJob J; };
DI bool titer_seek(const Frame& F, int l, TIter& it, int adv) {
    it.t += adv;
    while (it.t >= it.ntile) { it.t -= it.ntile; ++it.j; if (it.j >= NJOBS) return false; get_job(F, l, it.j, it.J); it.nk = it.J.K / 128; it.ntile = it.nk * (it.J.N / 64); }
    return true;
}
DI void tconv_load(const TIter& it, int tid, f32x4 (&v)[4]) {
    const int tk = it.t % it.nk, tn = it.t / it.nk;
#pragma unroll
    for (int i = 0; i < 4; ++i) { const int row = (tid >> 4) + 32 * i, c4 = tid & 15; v[i] = *(const f32x4*)(it.J.src + (size_t)(tk * 128 + row) * it.J.ld + tn * 64 + c4 * 4); }
}
DI void phase_pw(const Frame& F, int l, int b0, int nb) {
    const int me = F.bid - b0; if (me < 0 || me >= nb) return;
    bf16_t* tl = (bf16_t*)F.ldsg;
    const int tid = F.tid;
    TIter it; it.j = 0; it.t = 0; get_job(F, l, 0, it.J); it.nk = it.J.K / 128; it.ntile = it.nk * (it.J.N / 64);
    bool ok = titer_seek(F, l, it, me);
    f32x4 v[4];
    if (ok) tconv_load(it, tid, v);
    while (ok) {
        const int tk = it.t % it.nk, tn = it.t / it.nk; bf16_t* dst = it.J.dst; const int dK = it.J.K, rmul = it.J.rmul, radd = it.J.radd;
#pragma unroll
        for (int i = 0; i < 4; ++i) {
            const int row = (tid >> 4) + 32 * i, c4 = tid & 15;
            const unsigned lo = pack2(v[i][0], v[i][1]), hi = pack2(v[i][2], v[i][3]);
            tl[(c4 * 4 + 0) * 136 + row] = (bf16_t)(lo & 0xffff); tl[(c4 * 4 + 1) * 136 + row] = (bf16_t)(lo >> 16);
            tl[(c4 * 4 + 2) * 136 + row] = (bf16_t)(hi & 0xffff); tl[(c4 * 4 + 3) * 136 + row] = (bf16_t)(hi >> 16);
        }
        ok = titer_seek(F, l, it, nb);
        if (ok) tconv_load(it, tid, v);
        __syncthreads();
#pragma unroll
        for (int i = 0; i < 2; ++i) { const int p = tid + 512 * i, n = p >> 4, k8 = p & 15;
            const u32x4 o = *(const u32x4*)(tl + n * 136 + k8 * 8);
            *(u32x4*)(dst + (size_t)(rmul * (tn * 64 + n) + radd) * dK + tk * 128 + k8 * 8) = o; }
        __syncthreads();
    }
}
DI void phase_p0_small(const Frame& F) {
    float* sc = (float*)F.ldsg;
    float* part = sc + 4096;
    for (int i = F.tid; i < 4096; i += 512) sc[i] = siluf_(F.c[i]);
    __syncthreads();
    for (int it = F.bid; it < 192; it += F.G) {
        const int l = it / 96, cc = it % 96, col = cc * 64 + F.lane, w = F.wave;
        const float* aw = F.ada_w + (size_t)l * 1024 * 6144 + col;
        float a0 = 0.f, a1 = 0.f, a2 = 0.f, a3 = 0.f;
        for (int k = w * 128; k < w * 128 + 128; ++k) { const float wv = aw[(size_t)k * 6144]; a0 += sc[k] * wv; a1 += sc[1024 + k] * wv; a2 += sc[2048 + k] * wv; a3 += sc[3072 + k] * wv; }
        part[(w * 4 + 0) * 64 + F.lane] = a0; part[(w * 4 + 1) * 64 + F.lane] = a1; part[(w * 4 + 2) * 64 + F.lane] = a2; part[(w * 4 + 3) * 64 + F.lane] = a3;
        __syncthreads();
        if (F.tid < 256) { const int b = F.tid >> 6, ln = F.tid & 63; float s = 0.f;
            for (int ww = 0; ww < 8; ++ww) s += part[(ww * 4 + b) * 64 + ln];
            F.MOD[((size_t)l * 4 + b) * 6144 + cc * 64 + ln] = s + F.ada_b[(size_t)l * 6144 + cc * 64 + ln]; }
        __syncthreads();
    }
    for (int i = F.bid * 512 + F.tid; i < 2 * 8 * 1024 + 16 * 1024; i += F.G * 512) {
        if (i < 16384) { const int l = i >> 13, j = (i >> 10) & 7, k = i & 1023; F.WIF[i] = F.w_in[((size_t)l * 1024 + k) * INC + 4096 + j]; }
        else { const int q = i - 16384, e = q >> 10, k = q & 1023; F.RW[q] = F.router_w[k * 16 + e]; }
    }
}

DI void moe_offsets(const unsigned* cnt, int* pre, int tid) { if (tid == 0) { int s = 0; for (int e = 0; e < 16; ++e) { pre[e] = s; s += ((int)cnt[e] + 255) >> 8; } pre[16] = s; } }

struct RowRaw { f32x4 x[4]; u32x2 y1[4], y2[4]; float w1, w2; };
template <bool MOE>
DI void row_issue(const Frame& F, const float* xsrc, int t, int rl, const int* tokiL, const int* pre, RowRaw& r) {
#pragma unroll
    for (int q = 0; q < 4; ++q) r.x[q] = *(const f32x4*)(xsrc + (size_t)t * 1024 + F.lane * 4 + 256 * q);
    if (MOE) {
        const int* ti = tokiL + rl * 8;
        const int e1 = ti[0], s1 = ti[1], e2 = ti[2], s2 = ti[3]; r.w1 = __int_as_float(ti[4]); r.w2 = __int_as_float(ti[5]);
        const bf16_t* YS = (const bf16_t*)(F.R0 + R_YS);
        const bf16_t* y1 = YS + (size_t)(pre[e1] * 256 + s1) * 1024; const bf16_t* y2 = YS + (size_t)(pre[e2] * 256 + s2) * 1024;
#pragma unroll
        for (int q = 0; q < 4; ++q) { r.y1[q] = *(const u32x2*)(y1 + F.lane * 4 + 256 * q); r.y2[q] = *(const u32x2*)(y2 + F.lane * 4 + 256 * q); }
    }
}
template <bool MOE>
DI void row_finish(const Frame& F, const RowRaw& r, const float* gt, float (&xv)[16]) {
#pragma unroll
    for (int q = 0; q < 4; ++q) { xv[q * 4] = r.x[q][0]; xv[q * 4 + 1] = r.x[q][1]; xv[q * 4 + 2] = r.x[q][2]; xv[q * 4 + 3] = r.x[q][3]; }
    if (MOE) {
#pragma unroll
        for (int q = 0; q < 4; ++q) { const f32x4 g = *(const f32x4*)(gt + F.lane * 4 + 256 * q); const u32x2 a = r.y1[q], d = r.y2[q];
            xv[q * 4 + 0] += g[0] * (r.w1 * bflo(a.x) + r.w2 * bflo(d.x)); xv[q * 4 + 1] += g[1] * (r.w1 * bfhi(a.x) + r.w2 * bfhi(d.x));
            xv[q * 4 + 2] += g[2] * (r.w1 * bflo(a.y) + r.w2 * bflo(d.y)); xv[q * 4 + 3] += g[3] * (r.w1 * bfhi(a.y) + r.w2 * bfhi(d.y)); }
    }
}
DI float reduce16(float (&v)[16], int lane) {
    const bool b5 = lane & 32, b4 = lane & 16, b3 = lane & 8, b2 = lane & 4;
    float a[8], b[4], c[2];
#pragma unroll
    for (int i = 0; i < 8; ++i) { const float send = b5 ? v[i] : v[8 + i], mine = b5 ? v[8 + i] : v[i]; a[i] = mine + __shfl_xor(send, 32); }
#pragma unroll
    for (int i = 0; i < 4; ++i) { const float send = b4 ? a[i] : a[4 + i], mine = b4 ? a[4 + i] : a[i]; b[i] = mine + __shfl_xor(send, 16); }
#pragma unroll
    for (int i = 0; i < 2; ++i) { const float send = b3 ? b[i] : b[2 + i], mine = b3 ? b[2 + i] : b[i]; c[i] = mine + __shfl_xor(send, 8); }
    float r = (b2 ? c[1] : c[0]) + __shfl_xor(b2 ? c[0] : c[1], 4);
    r += __shfl_xor(r, 2); r += __shfl_xor(r, 1);
    return r;
}
DI float reduce8(float (&v)[8], int lane) {
    const bool b5 = lane & 32, b4 = lane & 16, b3 = lane & 8;
    float a[4], b[2];
#pragma unroll
    for (int i = 0; i < 4; ++i) { const float send = b5 ? v[i] : v[4 + i], mine = b5 ? v[4 + i] : v[i]; a[i] = mine + __shfl_xor(send, 32); }
#pragma unroll
    for (int i = 0; i < 2; ++i) { const float send = b4 ? a[i] : a[2 + i], mine = b4 ? a[2 + i] : a[i]; b[i] = mine + __shfl_xor(send, 16); }
    float r = (b3 ? b[1] : b[0]) + __shfl_xor(b3 ? b[0] : b[1], 8);
    r += __shfl_xor(r, 4); r += __shfl_xor(r, 2); r += __shfl_xor(r, 1);
    return r;
}
struct RowCtx { float gm[16], sh[16]; };
DI void load_rowconst(const Frame& F, const float* g, const float* shv, const float* scv, RowCtx& rc) {
#pragma unroll
    for (int q = 0; q < 4; ++q) { const int c = F.lane * 4 + 256 * q; const f32x4 gv = *(const f32x4*)(g + c), s1 = *(const f32x4*)(scv + c), s0 = *(const f32x4*)(shv + c);
#pragma unroll
        for (int j = 0; j < 4; ++j) { rc.gm[q * 4 + j] = gv[j] * (1.0f + s1[j]); rc.sh[q * 4 + j] = s0[j]; } }
}
DI void stage_toki(const Frame& F, int lprev, int blk, int* tokiL) {
    const int* src = (const int*)(F.TOKI + ((size_t)lprev * T_TOK + (size_t)blk * 128) * 32);
    for (int i = F.tid; i < 1024; i += 512) tokiL[i] = src[i];
}

template <bool MOE>
DI void phase_n1_t(const Frame& F, int l) {
    float* wif = (float*)F.ldsg;
    int* pre = (int*)(F.ldsg + 32768);
    int* tokiL = (int*)(F.ldsg + 32768 + 128);
    for (int i = F.tid; i < 8192; i += 512) wif[i] = F.WIF[(size_t)l * 8192 + i];
    if (MOE) moe_offsets(F.ctl + CW_CNT + 64 * (l - 1), pre, F.tid);
    __syncthreads();
    const float* xsrc = MOE ? F.out : F.x;
    for (int blk = F.bid; blk < T_TOK / 128; blk += F.G) {
        const int b = blk / (SEQ / 128);
        const float* mod = F.MOD + ((size_t)l * 4 + b) * 6144;
        const float* gt = F.MOD + ((size_t)(MOE ? l - 1 : 0) * 4 + b) * 6144 + 5120;
        RowCtx rc; load_rowconst(F, F.g_mix + (size_t)l * 1024, mod, mod + 1024, rc);
        if (MOE) { __syncthreads(); stage_toki(F, l - 1, blk, tokiL); __syncthreads(); }
        RowRaw nx0, nx1; row_issue<MOE>(F, xsrc, blk * 128 + F.wave * 16, F.wave * 16, tokiL, pre, nx0); row_issue<MOE>(F, xsrc, blk * 128 + F.wave * 16 + 1, F.wave * 16 + 1, tokiL, pre, nx1);
#pragma unroll 1
        for (int i = 0; i < 16; i += 2) {
            const int rl = F.wave * 16 + i, t = blk * 128 + rl;
            asm volatile("" ::: "memory");
            const RowRaw c0 = nx0, c1 = nx1;
            if (i < 14) { row_issue<MOE>(F, xsrc, t + 2, rl + 2, tokiL, pre, nx0); row_issue<MOE>(F, xsrc, t + 3, rl + 3, tokiL, pre, nx1); }
            float xa[16], xb[16]; row_finish<MOE>(F, c0, gt, xa); row_finish<MOE>(F, c1, gt, xb);
            if (MOE) {
#pragma unroll
                for (int q = 0; q < 4; ++q) { *(f32x4*)(F.out + (size_t)t * 1024 + F.lane * 4 + 256 * q) = (f32x4){xa[q * 4], xa[q * 4 + 1], xa[q * 4 + 2], xa[q * 4 + 3]};
                    *(f32x4*)(F.out + (size_t)(t + 1) * 1024 + F.lane * 4 + 256 * q) = (f32x4){xb[q * 4], xb[q * 4 + 1], xb[q * 4 + 2], xb[q * 4 + 3]}; }
            }
            float sa = 0.f, sb = 0.f;
#pragma unroll
            for (int j = 0; j < 16; ++j) { sa += xa[j] * xa[j]; sb += xb[j] * xb[j]; }
            sa = wave_sum(sa); sb = wave_sum(sb);
            const float ra = __builtin_amdgcn_rsqf(sa * (1.0f / 1024.0f) + EPS), rb = __builtin_amdgcn_rsqf(sb * (1.0f / 1024.0f) + EPS);
#pragma unroll
            for (int j = 0; j < 16; ++j) { xa[j] = xa[j] * ra * rc.gm[j] + rc.sh[j]; xb[j] = xb[j] * rb * rc.gm[j] + rc.sh[j]; }
#pragma unroll
            for (int q = 0; q < 4; ++q) { u32x2 w; w.x = pack2(xa[q * 4], xa[q * 4 + 1]); w.y = pack2(xa[q * 4 + 2], xa[q * 4 + 3]); *(u32x2*)(F.U + (size_t)t * 1024 + F.lane * 4 + 256 * q) = w;
                w.x = pack2(xb[q * 4], xb[q * 4 + 1]); w.y = pack2(xb[q * 4 + 2], xb[q * 4 + 3]); *(u32x2*)(F.U + (size_t)(t + 1) * 1024 + F.lane * 4 + 256 * q) = w; }
            float da[8], db[8];
#pragma unroll
            for (int g = 0; g < 8; ++g) { float s0 = 0.f, s1 = 0.f;
#pragma unroll
                for (int q = 0; q < 4; ++q) { const f32x4 wv = *(const f32x4*)(wif + g * 1024 + F.lane * 4 + 256 * q);
                    s0 += xa[q * 4] * wv[0] + xa[q * 4 + 1] * wv[1] + xa[q * 4 + 2] * wv[2] + xa[q * 4 + 3] * wv[3];
                    s1 += xb[q * 4] * wv[0] + xb[q * 4 + 1] * wv[1] + xb[q * 4 + 2] * wv[2] + xb[q * 4 + 3] * wv[3]; }
                da[g] = s0; db[g] = s1; }
            const float reda = reduce8(da, F.lane), redb = reduce8(db, F.lane);
            const float ma = __shfl(reda, (F.lane & 7) * 8), mb = __shfl(redb, (F.lane & 7) * 8);
            if (F.lane < 16) {
                const int gl = F.lane & 7; float v = (F.lane < 8) ? ma : mb;
                v += F.gate_b[l * 8 + gl];
                if (gl >= 4) { const float e = __expf(-fabsf(v)); const float l1p = (e < 0.03f) ? e * (1.0f - e * (0.5f - e * (0.33333334f - 0.25f * e))) : __logf(1.0f + e); v = fminf(v, 0.f) - l1p; }
                F.GIF[(size_t)t * 8 + F.lane] = v;
            }
        }
    }
}
DI void phase_n1(const Frame& F, int l) { if (l == 0) phase_n1_t<false>(F, 0); else phase_n1_t<true>(F, l); }

DI void phase_n2(const Frame& F, int l) {
    float* rw = (float*)F.ldsg;
    int* cntL = (int*)(F.ldsg + 65536);
    int* baseL = cntL + 16;
    int* rec = baseL + 16;
    for (int i = F.tid; i < 16384; i += 512) rw[i] = F.RW[i];
    __syncthreads();
    unsigned* gcnt = F.ctl + CW_CNT + 64 * l;
    int* SLOT = (int*)(F.R0 + R_SLOT);
    for (int blk = F.bid; blk < T_TOK / 128; blk += F.G) {
        const int b = blk / (SEQ / 128);
        const float* mod = F.MOD + ((size_t)l * 4 + b) * 6144;
        RowCtx rc; load_rowconst(F, F.g_ffn + (size_t)l * 1024, mod + 3072, mod + 4096, rc);
        if (F.tid < 16) cntL[F.tid] = 0;
        __syncthreads();
        RowRaw nx0, nx1, fx0, fx1;
        row_issue<false>(F, F.out, blk * 128 + F.wave * 16, 0, nullptr, nullptr, nx0); row_issue<false>(F, F.out, blk * 128 + F.wave * 16 + 1, 0, nullptr, nullptr, nx1);
        row_issue<false>(F, F.out, blk * 128 + F.wave * 16 + 2, 0, nullptr, nullptr, fx0); row_issue<false>(F, F.out, blk * 128 + F.wave * 16 + 3, 0, nullptr, nullptr, fx1);
#pragma unroll 1
        for (int i = 0; i < 16; i += 2) {
            const int rl = F.wave * 16 + i, t = blk * 128 + rl;
            asm volatile("" ::: "memory");
            const RowRaw c0 = nx0, c1 = nx1; nx0 = fx0; nx1 = fx1;
            if (i < 12) { row_issue<false>(F, F.out, t + 4, 0, nullptr, nullptr, fx0); row_issue<false>(F, F.out, t + 5, 0, nullptr, nullptr, fx1); }
            float xa[16], xb[16]; row_finish<false>(F, c0, nullptr, xa); row_finish<false>(F, c1, nullptr, xb);
            float sa = 0.f, sb = 0.f;
#pragma unroll
            for (int j = 0; j < 16; ++j) { sa += xa[j] * xa[j]; sb += xb[j] * xb[j]; }
            sa = wave_sum(sa); sb = wave_sum(sb);
            const float ra = __builtin_amdgcn_rsqf(sa * (1.0f / 1024.0f) + EPS), rb = __builtin_amdgcn_rsqf(sb * (1.0f / 1024.0f) + EPS);
#pragma unroll
            for (int j = 0; j < 16; ++j) { xa[j] = xa[j] * ra * rc.gm[j] + rc.sh[j]; xb[j] = xb[j] * rb * rc.gm[j] + rc.sh[j]; }
#pragma unroll
            for (int q = 0; q < 4; ++q) { u32x2 w; w.x = pack2(xa[q * 4], xa[q * 4 + 1]); w.y = pack2(xa[q * 4 + 2], xa[q * 4 + 3]); *(u32x2*)(F.U + (size_t)t * 1024 + F.lane * 4 + 256 * q) = w;
                w.x = pack2(xb[q * 4], xb[q * 4 + 1]); w.y = pack2(xb[q * 4 + 2], xb[q * 4 + 3]); *(u32x2*)(F.U + (size_t)(t + 1) * 1024 + F.lane * 4 + 256 * q) = w; }
            float la[16], lb[16];
#pragma unroll
            for (int e = 0; e < 16; ++e) { float s0 = 0.f, s1 = 0.f;
#pragma unroll
                for (int q = 0; q < 4; ++q) { const f32x4 wv = *(const f32x4*)(rw + e * 1024 + F.lane * 4 + 256 * q);
                    s0 += xa[q * 4] * wv[0] + xa[q * 4 + 1] * wv[1] + xa[q * 4 + 2] * wv[2] + xa[q * 4 + 3] * wv[3];
                    s1 += xb[q * 4] * wv[0] + xb[q * 4 + 1] * wv[1] + xb[q * 4 + 2] * wv[2] + xb[q * 4 + 3] * wv[3]; }
                la[e] = s0; lb[e] = s1; }
            const float reda = reduce16(la, F.lane), redb = reduce16(lb, F.lane);
            const float ma = __shfl(reda, (F.lane & 15) * 4), mb = __shfl(redb, (F.lane & 15) * 4);
            const int base = F.lane & 16;
            const float mine = base ? mb : ma;
            const float score = 1.0f / (1.0f + __expf(-mine));
            const float sel = score + F.router_b[F.lane & 15];
            const float s0 = __shfl(sel, (F.lane & ~3) + 0), s1 = __shfl(sel, (F.lane & ~3) + 1), s2 = __shfl(sel, (F.lane & ~3) + 2), s3 = __shfl(sel, (F.lane & ~3) + 3);
            const float mx = fmaxf(fmaxf(s0, s1), fmaxf(s2, s3));
            const int im = (s0 == mx) ? 0 : (s1 == mx) ? 1 : (s2 == mx) ? 2 : 3;
            const float t0 = (im == 0) ? -INFINITY : s0, t1 = (im == 1) ? -INFINITY : s1, t2 = (im == 2) ? -INFINITY : s2, t3 = (im == 3) ? -INFINITY : s3;
            const float mx2 = fmaxf(fmaxf(t0, t1), fmaxf(t2, t3));
            const int im2 = (t0 == mx2) ? 0 : (t1 == mx2) ? 1 : (t2 == mx2) ? 2 : 3;
            const float gs = mx + mx2;
            const float g0 = __shfl(gs, base + 0), g1 = __shfl(gs, base + 4), g2 = __shfl(gs, base + 8), g3 = __shfl(gs, base + 12);
            const float gm = fmaxf(fmaxf(g0, g1), fmaxf(g2, g3));
            const int bg = (g0 == gm) ? 0 : (g1 == gm) ? 1 : (g2 == gm) ? 2 : 3;
            const int e1 = __shfl(bg * 4 + im, base + bg * 4), e2 = __shfl(bg * 4 + im2, base + bg * 4);
            const float sc1 = __shfl(score, base + e1), sc2 = __shfl(score, base + e2);
            if (F.lane == 0 || F.lane == 16) {
                const int rr = rl + (F.lane >> 4);
                const float inv = 1.0f / (sc1 + sc2);
                const int r1 = atomicAdd(&cntL[e1], 1), r2 = atomicAdd(&cntL[e2], 1);
                int* r = rec + rr * 6; r[0] = e1; r[1] = r1; r[2] = e2; r[3] = r2; r[4] = __float_as_int(sc1 * inv); r[5] = __float_as_int(sc2 * inv);
            }
        }
        __syncthreads();
        if (F.tid < 16) baseL[F.tid] = (int)atomicAdd(&gcnt[F.tid], (unsigned)cntL[F.tid]);
        __syncthreads();
        if (F.tid < 128) {
            const int t = blk * 128 + F.tid; const int* r = rec + F.tid * 6;
            const int e1 = r[0], s1 = baseL[e1] + r[1], e2 = r[2], s2 = baseL[e2] + r[3];
            SLOT[e1 * 32768 + s1] = t; SLOT[e2 * 32768 + s2] = t;
            int* ti = (int*)(F.TOKI + ((size_t)l * T_TOK + t) * 32);
            ti[0] = e1; ti[1] = s1; ti[2] = e2; ti[3] = s2; ti[4] = r[4]; ti[5] = r[5];
        }
        __syncthreads();
    }
}

DI void phase_fn(const Frame& F) {
    int* pre = (int*)F.ldsg;
    int* tokiL = (int*)(F.ldsg + 128);
    moe_offsets(F.ctl + CW_CNT + 64 * (DEPTH - 1), pre, F.tid);
    __syncthreads();
    for (int blk = F.bid; blk < T_TOK / 128; blk += F.G) {
        const int b = blk / (SEQ / 128);
        const float* gt = F.MOD + ((size_t)(DEPTH - 1) * 4 + b) * 6144 + 5120;
        __syncthreads(); stage_toki(F, DEPTH - 1, blk, tokiL); __syncthreads();
        RowRaw nx; row_issue<true>(F, F.out, blk * 128 + F.wave * 16, F.wave * 16, tokiL, pre, nx);
#pragma unroll 1
        for (int i = 0; i < 16; ++i) {
            const int rl = F.wave * 16 + i, t = blk * 128 + rl;
            const RowRaw cur = nx;
            if (i < 15) row_issue<true>(F, F.out, t + 1, rl + 1, tokiL, pre, nx);
            float xv[16]; row_finish<true>(F, cur, gt, xv);
            float ss = 0.f;
#pragma unroll
            for (int j = 0; j < 16; ++j) ss += xv[j] * xv[j];
            ss = wave_sum(ss);
            const float rn = __builtin_amdgcn_rsqf(ss * (1.0f / 1024.0f) + EPS);
#pragma unroll
            for (int q = 0; q < 4; ++q) { const f32x4 g = *(const f32x4*)(F.g_fin + F.lane * 4 + 256 * q);
                *(f32x4*)(F.out + (size_t)t * 1024 + F.lane * 4 + 256 * q) = (f32x4){xv[q * 4] * rn * g[0], xv[q * 4 + 1] * rn * g[1], xv[q * 4 + 2] * rn * g[2], xv[q * 4 + 3] * rn * g[3]}; }
        }
    }
}
DI void ml1_unit(const Frame& F, int l, int h, int j, int eg) {
    const bf16_t* P = (const bf16_t*)(F.R0 + R_P); bf16_t* QC = (bf16_t*)(F.R0 + R_QC);
    const bf16_t* VT = (const bf16_t*)(F.R0 + R_VT);
    bf16_t* NUM = (bf16_t*)(F.R0 + R_NUM); bf16_t* SLOC = (bf16_t*)(F.R0 + R_SLOC);
    float* DENI = (float*)(F.R0 + R_DENI); float* EBC = (float*)(F.R0 + R_EBC); float* EBL = (float*)(F.R0 + R_EBL);
    float* SCB = (float*)(F.R0 + R_SCB); float* CHB = (float*)(F.R0 + R_CHB); float* DN = (float*)(F.R0 + R_DN);
    const int tid = F.tid, lane = F.lane, w = F.wave, rr = lane & 31, hh = lane >> 5;
    const int tl0 = j * 256;
    const size_t tg0 = (size_t)eg * TQ + tl0;
    LAS unsigned char* L = F.lds;
    LAS bf16_t* Sl = (LAS bf16_t*)L;
    LAS float* Lb = (LAS float*)(L + 9216);
    LAS float* Lg = Lb + 256;
    LAS float* Lws = Lg + 256;
    LAS float* Leb = Lws + 256;
    LAS float* Lden = Leb + 256;
    LAS float* Lbl = Lden + 256;
    LAS float* Wc = (LAS float*)(L + 14592);
    LAS bf16_t* Qs = (LAS bf16_t*)(L + 22784);
    LAS bf16_t* KTs = (LAS bf16_t*)(L + 56576);
    LAS bf16_t* Rw = (LAS bf16_t*)(L + 93440);
    for (int i = tid; i < 2048; i += 512) { const int which = i >> 10, jj = (i >> 8) & 3, ch = i & 255; Wc[i] = F.conv_w[((size_t)l * 4 + jj) * 2048 + which * 1024 + h * 256 + ch]; }
    if (w < 4) {
        const int c = w, t = c * 64 + lane;
        const float li = F.GIF[(tg0 + t) * 8 + h], lf = F.GIF[(tg0 + t) * 8 + 4 + h];
        float b = lf;
#pragma unroll
        for (int o = 1; o < 64; o <<= 1) { const float v = __shfl_up(b, o); if (lane >= o) b += v; }
        const float bl = __shfl(b, 63);
        Lb[t] = b; Lg[t] = li - b; Lws[t] = __expf(bl - b + li); Leb[t] = __expf(b); Lden[t] = 0.f;
        if (lane == 0) Lbl[c] = bl;
    }
    __syncthreads();
    if (tid < 256) {
        const int c = tid >> 6; float pre = 0.f;
        for (int cc = 0; cc < c; ++cc) pre += Lbl[cc];
        EBC[(size_t)(tl0 + tid) * 4 + h] = Leb[tid];
        EBL[(size_t)(tl0 + tid) * 4 + h] = __expf(Lb[tid] + pre);
        if (tid < 4) CHB[h * 128 + j * 4 + tid] = Lbl[tid];
        if (tid == 0) SCB[h * 32 + j] = Lbl[0] + Lbl[1] + Lbl[2] + Lbl[3];
    }
    f32x16 Ct[8];
#pragma unroll
    for (int i = 0; i < 8; ++i)
#pragma unroll
        for (int r = 0; r < 16; ++r) Ct[i][r] = 0.f;
    for (int c = 0; c < 4; ++c) {
        int rr_ = rr, hh_ = hh, tid_ = tid; asm volatile("" : "+v"(rr_), "+v"(hh_), "+v"(tid_));
        const bf16_t* vbase = VT + (size_t)(h * 256 + w * 32 + rr_) * TQ + tl0 + c * 64 + hh_ * 8;
        bf16x8 vf[4];
        const int t0c = tl0 + c * 64;
        u32x4 rk[5];
        { u32x4 rq[5];
#pragma unroll
          for (int i5 = 0; i5 < 5; ++i5) { const int i = tid_ + 512 * i5, r = i >> 5, pc = i & 31, t = t0c - 3 + r;
              rq[i5] = (u32x4){0u, 0u, 0u, 0u};
              if (i < 67 * 32 && t >= 0) rq[i5] = *(const u32x4*)(P + (size_t)t * NNAT + h * 256 + pc * 8); }
#pragma unroll
          for (int i5 = 0; i5 < 5; ++i5) { const int i = tid_ + 512 * i5, r = i >> 5, pc = i & 31; if (i < 67 * 32) *(LAS u32x4*)(Rw + r * 264 + pc * 8) = rq[i5]; } }
#pragma unroll
        for (int i5 = 0; i5 < 5; ++i5) { const int i = tid_ + 512 * i5, r = i >> 5, pc = i & 31, t = t0c - 3 + r;
            rk[i5] = (u32x4){0u, 0u, 0u, 0u};
            if (i < 67 * 32 && t >= 0) rk[i5] = *(const u32x4*)(P + (size_t)t * NNAT + 1024 + h * 256 + pc * 8); }
        __syncthreads();
        { const int cg = tid_ & 31;
#pragma unroll
          for (int i = 0; i < 4; ++i) { const int tr = (tid_ >> 5) + 16 * i;
              float y[8];
#pragma unroll
              for (int k = 0; k < 8; ++k) y[k] = 0.f;
#pragma unroll
              for (int jj = 0; jj < 4; ++jj) { const u32x4 v = *(const LAS u32x4*)(Rw + (tr + jj) * 264 + cg * 8);
                  const f32x4 wa = *(const LAS f32x4*)(Wc + jj * 256 + cg * 8), wb = *(const LAS f32x4*)(Wc + jj * 256 + cg * 8 + 4);
                  y[0] += wa[0] * bflo(v.x); y[1] += wa[1] * bfhi(v.x); y[2] += wa[2] * bflo(v.y); y[3] += wa[3] * bfhi(v.y);
                  y[4] += wb[0] * bflo(v.z); y[5] += wb[1] * bfhi(v.z); y[6] += wb[2] * bflo(v.w); y[7] += wb[3] * bfhi(v.w); }
#pragma unroll
              for (int k = 0; k < 8; ++k) y[k] = siluf_(y[k]) * 0.0625f;
              u32x4 o; o.x = pack2(y[0], y[1]); o.y = pack2(y[2], y[3]); o.z = pack2(y[4], y[5]); o.w = pack2(y[6], y[7]);
              *(LAS u32x4*)(Qs + tr * 264 + cg * 8) = o;
              *(u32x4*)(QC + (size_t)(t0c + tr) * 1024 + h * 256 + cg * 8) = o;
              asm volatile("" ::: "memory"); } }
        __syncthreads();
#pragma unroll
        for (int i5 = 0; i5 < 5; ++i5) { const int i = tid_ + 512 * i5, r = i >> 5, pc = i & 31; if (i < 67 * 32) *(LAS u32x4*)(Rw + r * 264 + pc * 8) = rk[i5]; }
        __syncthreads();
        { const int tr = tid_ & 63, wv = tid_ >> 6;
#pragma unroll
          for (int sub = 0; sub < 4; ++sub) { const int ch0 = wv * 32 + sub * 8;
              float y[8];
#pragma unroll
              for (int k = 0; k < 8; ++k) y[k] = 0.f;
#pragma unroll
              for (int jj = 0; jj < 4; ++jj) { const u32x4 v = *(const LAS u32x4*)(Rw + (tr + jj) * 264 + ch0);
                  const f32x4 wa = *(const LAS f32x4*)(Wc + 1024 + jj * 256 + ch0), wb = *(const LAS f32x4*)(Wc + 1024 + jj * 256 + ch0 + 4);
                  y[0] += wa[0] * bflo(v.x); y[1] += wa[1] * bfhi(v.x); y[2] += wa[2] * bflo(v.y); y[3] += wa[3] * bfhi(v.y);
                  y[4] += wb[0] * bflo(v.z); y[5] += wb[1] * bfhi(v.z); y[6] += wb[2] * bflo(v.w); y[7] += wb[3] * bfhi(v.w); }
#pragma unroll
              for (int k = 0; k < 8; k += 2) { const unsigned pk = pack2(siluf_(y[k]), siluf_(y[k + 1]));
                  KTs[(ch0 + k) * 72 + tr] = (bf16_t)(pk & 0xffff); KTs[(ch0 + k + 1) * 72 + tr] = (bf16_t)(pk >> 16); }
              asm volatile("" ::: "memory"); } }
        __syncthreads();
        if (w < 3) {
            const int ti = (w == 0) ? 0 : 1, si = (w == 2) ? 1 : 0;
            f32x16 acc;
#pragma unroll
            for (int r = 0; r < 16; ++r) acc[r] = 0.f;
            const LAS bf16_t* kcol = KTs + hh_ * 8 * 72 + si * 32 + rr_;
            const LAS bf16_t* qrow = Qs + (ti * 32 + rr_) * 264 + hh_ * 8;
#pragma unroll 1
            for (int ks = 0; ks < 16; ++ks) {
                unsigned short e[8];
#pragma unroll
                for (int jj = 0; jj < 8; ++jj) e[jj] = kcol[(ks * 16 + jj) * 72];
                u32x4 kp; kp.x = e[0] | ((unsigned)e[1] << 16); kp.y = e[2] | ((unsigned)e[3] << 16); kp.z = e[4] | ((unsigned)e[5] << 16); kp.w = e[6] | ((unsigned)e[7] << 16);
                acc = MFMA32(__builtin_bit_cast(bf16x8, kp), *(const LAS bf16x8*)(qrow + ks * 16), acc);
            }
            const int tloc = c * 64 + ti * 32 + rr; const float bt = Lb[tloc];
            float rs = 0.f;
#pragma unroll
            for (int g = 0; g < 4; ++g) {
                float v[4];
#pragma unroll
                for (int q = 0; q < 4; ++q) { const int r = g * 4 + q, sl = si * 32 + crow(r, hh);
                    float wgt = __expf(bt + Lg[c * 64 + sl]);
                    if (sl > ti * 32 + rr) wgt = 0.f;
                    v[q] = acc[r] * wgt; rs += v[q]; }
                u32x2 o; o.x = pack2(v[0], v[1]); o.y = pack2(v[2], v[3]);
                *(LAS u32x2*)(Sl + (ti * 32 + rr) * 72 + si * 32 + 8 * g + 4 * hh) = o;
            }
            rs += __shfl_xor(rs, 32);
            if (hh == 0) atomicAdd((float*)(F.ldsg + 9216 + 4 * 1024) + tloc, rs);
        } else if (w >= 4) {
            const int d = tid_ - 256;
            const LAS bf16_t* kt = KTs + d * 72; const LAS float* ws = Lws + c * 64;
            float s = 0.f;
#pragma unroll
            for (int o = 0; o < 8; ++o) { const u32x4 v = *(const LAS u32x4*)(kt + o * 8);
                s += bflo(v.x) * ws[o * 8] + bfhi(v.x) * ws[o * 8 + 1] + bflo(v.y) * ws[o * 8 + 2] + bfhi(v.y) * ws[o * 8 + 3] + bflo(v.z) * ws[o * 8 + 4] + bfhi(v.z) * ws[o * 8 + 5] + bflo(v.w) * ws[o * 8 + 6] + bfhi(v.w) * ws[o * 8 + 7]; }
            DN[((size_t)h * 128 + j * 4 + c) * 256 + d] = s;
        }
        __syncthreads();
        if (tid_ < 64) DENI[(size_t)(tl0 + c * 64 + tid_) * 4 + h] = Lden[c * 64 + tid_];
#pragma unroll
        for (int ks = 0; ks < 4; ++ks) vf[ks] = ldg8(vbase + ks * 16);
        f32x16 a0, a1;
#pragma unroll
        for (int r = 0; r < 16; ++r) { a0[r] = 0.f; a1[r] = 0.f; }
        const LAS bf16_t* q0 = Qs + rr_ * 264 + hh_ * 8; const LAS bf16_t* q1 = q0 + 32 * 264;
#pragma unroll
        for (int db = 0; db < 8; ++db)
#pragma unroll
            for (int s2 = 0; s2 < 2; ++s2) {
                const bf16x8 cf = packf8(Ct[db][8 * s2], Ct[db][8 * s2 + 1], Ct[db][8 * s2 + 2], Ct[db][8 * s2 + 3], Ct[db][8 * s2 + 4], Ct[db][8 * s2 + 5], Ct[db][8 * s2 + 6], Ct[db][8 * s2 + 7]);
                a0 = MFMA32(*(const LAS bf16x8*)(q0 + db * 32 + s2 * 16), cf, a0);
                a1 = MFMA32(*(const LAS bf16x8*)(q1 + db * 32 + s2 * 16), cf, a1);
                if (s2 == 1 && (db & 1)) asm volatile("" ::: "memory");
            }
#pragma unroll
        for (int r = 0; r < 16; ++r) { a0[r] *= Leb[c * 64 + crow(r, hh)]; a1[r] *= Leb[c * 64 + 32 + crow(r, hh)]; }
#pragma unroll
        for (int ks = 0; ks < 4; ++ks) {
            if (ks < 2) a0 = MFMA32(*(const LAS bf16x8*)(Sl + rr * 72 + ks * 16 + hh * 8), vf[ks], a0);
            a1 = MFMA32(*(const LAS bf16x8*)(Sl + (32 + rr) * 72 + ks * 16 + hh * 8), vf[ks], a1);
        }
        { bf16_t* np = NUM + (size_t)(tl0 + c * 64) * 1024 + h * 256 + w * 32 + rr_;
#pragma unroll
          for (int r = 0; r < 16; r += 2) { const unsigned p0 = pack2(a0[r], a0[r + 1]), p1 = pack2(a1[r], a1[r + 1]);
              np[(size_t)crow(r, hh) * 1024] = (bf16_t)(p0 & 0xffff); np[(size_t)crow(r + 1, hh) * 1024] = (bf16_t)(p0 >> 16);
              np[(size_t)(32 + crow(r, hh)) * 1024] = (bf16_t)(p1 & 0xffff); np[(size_t)(32 + crow(r + 1, hh)) * 1024] = (bf16_t)(p1 >> 16); } }
        const float dec = __expf(Lbl[c]);
#pragma unroll
        for (int ks = 0; ks < 4; ++ks) {
            const u32x4 v = __builtin_bit_cast(u32x4, vf[ks]); const LAS float* ws = Lws + c * 64 + ks * 16 + hh * 8;
            vf[ks] = packf8(bflo(v.x) * ws[0], bfhi(v.x) * ws[1], bflo(v.y) * ws[2], bfhi(v.y) * ws[3], bflo(v.z) * ws[4], bfhi(v.z) * ws[5], bflo(v.w) * ws[6], bfhi(v.w) * ws[7]);
        }
        const LAS bf16_t* ktb = KTs + pi23(rr_) * 72 + hh_ * 8;
#pragma unroll
        for (int db = 0; db < 8; ++db) {
#pragma unroll
            for (int r = 0; r < 16; ++r) Ct[db][r] *= dec;
#pragma unroll
            for (int ks = 0; ks < 4; ++ks) Ct[db] = MFMA32(*(const LAS bf16x8*)(ktb + db * 32 * 72 + ks * 16), vf[ks], Ct[db]);
            if (db & 1) asm volatile("" ::: "memory");
        }
        __syncthreads();
    }
    { int rr2 = rr, hh2 = hh; asm volatile("" : "+v"(rr2), "+v"(hh2));
      bf16_t* sp = SLOC + (((size_t)h * 32 + j) * 256 + w * 32 + rr2) * 256 + hh2 * 8;
#pragma unroll
      for (int db = 0; db < 8; ++db)
#pragma unroll
          for (int a = 0; a < 2; ++a) {
              u32x4 o; o.x = pack2(Ct[db][8 * a], Ct[db][8 * a + 1]); o.y = pack2(Ct[db][8 * a + 2], Ct[db][8 * a + 3]); o.z = pack2(Ct[db][8 * a + 4], Ct[db][8 * a + 5]); o.w = pack2(Ct[db][8 * a + 6], Ct[db][8 * a + 7]);
              *(u32x4*)(sp + db * 32 + a * 16) = o; } }
    __syncthreads();
}

DI void at_block_unit(const Frame& F, int bu_in) {
    int bu = bu_in; asm volatile("" : "+s"(bu));
    bf16_t* P = (bf16_t*)(F.R0 + R_P); const bf16_t* VT = (const bf16_t*)(F.R0 + R_VT); float* LSE = (float*)(F.R0 + R_LSE);
    int lane = F.lane, tid = F.tid; asm volatile("" : "+v"(lane), "+v"(tid));
    const int rr = lane & 31, hh = lane >> 5, w = F.wave;
    const int hd = bu >> 5, qb = bu & 31, g = hd >> 2;
    const int dsh = 2 * g, d = 1 << dsh, lsub = TQ >> dsh, bpr = lsub >> 8;
    const int r = qb / bpr, l0b = (qb % bpr) * 256, l0 = l0b + 32 * w;
    const float slope_d = exp2f(-8.0f * (float)(hd + 1) / 12.0f) * (float)d;
    LAS bf16_t* Ks = (LAS bf16_t*)F.lds;
    LAS bf16_t* Vs = (LAS bf16_t*)F.lds;
    {
        u32x4 st[12];
#pragma unroll
        for (int i = 0; i < 12; ++i) { const int p = tid + 512 * i, row = p >> 4, pc = p & 15; int l = l0b - 128 + row; l = l < 0 ? 0 : l;
            st[i] = *(const u32x4*)(P + (size_t)(l * d + r) * NNAT + 4608 + hd * 128 + pc * 8); }
#pragma unroll
        for (int i = 0; i < 12; ++i) { const int p = tid + 512 * i, row = p >> 4, pc = p & 15; *(LAS u32x4*)(Ks + row * 136 + pc * 8) = st[i]; }
    }
    bf16x8 qf[8];
    { const bf16_t* qp = P + (size_t)((l0 + rr) * d + r) * NNAT + 3072 + hd * 128 + hh * 64;
#pragma unroll
      for (int ks = 0; ks < 8; ++ks) qf[ks] = ldg8(qp + ks * 8); }
    __syncthreads();
    u32x4 vst[12];
#pragma unroll
    for (int i = 0; i < 12; ++i) { const int p = tid + 512 * i, ch = p / 48, pc = p % 48; int l = l0b - 128 + pc * 8; l = l < 0 ? 0 : l;
        vst[i] = *(const u32x4*)(VT + (size_t)(1024 + hd * 128 + ch) * TQ + r * lsub + l); }
    f32x16 sc[5];
    float mx = -1e30f;
    const int prr = pi23(rr);
#pragma unroll
    for (int kt = 0; kt < 5; ++kt) {
#pragma unroll
        for (int i = 0; i < 16; ++i) sc[kt][i] = 0.f;
        const LAS bf16_t* kp = Ks + (32 * (w + kt) + prr) * 136 + hh * 64;
#pragma unroll
        for (int ks = 0; ks < 8; ++ks) sc[kt] = MFMA32(*(const LAS bf16x8*)(kp + ks * 8), qf[ks], sc[kt]);
        const bool tile_ok = (l0 - 128 + 32 * kt) >= 0;
#pragma unroll
        for (int i = 0; i < 16; ++i) {
            const int kk = (i & 3) + 4 * ((i >> 2) & 1) + 8 * hh + 16 * (i >> 3);
            const int dist = 128 - 32 * kt + rr - kk;
            float s = sc[kt][i] - slope_d * (float)dist;
            s = (tile_ok && dist >= 0 && dist <= 128) ? s : -1e30f;
            sc[kt][i] = s; mx = fmaxf(mx, s);
        }
        asm volatile("" ::: "memory");
    }
    mx = fmaxf(mx, __shfl_xor(mx, 32));
    float sum = 0.f;
    bf16x8 pf[5][2];
#pragma unroll
    for (int kt = 0; kt < 5; ++kt) {
        float p[16];
#pragma unroll
        for (int i = 0; i < 16; ++i) { p[i] = __expf(sc[kt][i] - mx); sum += p[i]; }
        pf[kt][0] = packf8(p[0], p[1], p[2], p[3], p[4], p[5], p[6], p[7]);
        pf[kt][1] = packf8(p[8], p[9], p[10], p[11], p[12], p[13], p[14], p[15]);
    }
    sum += __shfl_xor(sum, 32);
    const float inv = 1.0f / sum;
    __syncthreads();
#pragma unroll
    for (int i = 0; i < 12; ++i) { const int p = tid + 512 * i, ch = p / 48, pc = p % 48; *(LAS u32x4*)(Vs + ch * 392 + pc * 8) = vst[i]; }
    __syncthreads();
#pragma unroll
    for (int ct = 0; ct < 4; ++ct) {
        f32x16 o;
#pragma unroll
        for (int i = 0; i < 16; ++i) o[i] = 0.f;
        const LAS bf16_t* vp = Vs + (ct * 32 + rr) * 392 + 32 * w + hh * 8;
#pragma unroll
        for (int kt = 0; kt < 5; ++kt) { o = MFMA32(*(const LAS bf16x8*)(vp + 32 * kt), pf[kt][0], o); o = MFMA32(*(const LAS bf16x8*)(vp + 32 * kt + 16), pf[kt][1], o); }
#pragma unroll
        for (int g4 = 0; g4 < 4; ++g4) { u32x2 wv; wv.x = pack2(o[4 * g4] * inv, o[4 * g4 + 1] * inv); wv.y = pack2(o[4 * g4 + 2] * inv, o[4 * g4 + 3] * inv);
            *(u32x2*)(P + (size_t)((l0 + rr) * d + r) * NNAT + 3072 + hd * 128 + ct * 32 + 8 * g4 + 4 * hh) = wv; }
        asm volatile("" ::: "memory");
    }
    if (hh == 0) LSE[(size_t)((l0 + rr) * d + r) * 12 + hd] = mx + __logf(sum);
    __syncthreads();
}

DI void phase_p2(const Frame& F, int me, int nb) {
    bf16_t* SL = (bf16_t*)(F.R0 + R_SLOC);
    const float* SCB = (const float*)(F.R0 + R_SCB); const float* CHB = (const float*)(F.R0 + R_CHB);
    const float* DN = (const float*)(F.R0 + R_DN); float* NST = (float*)(F.R0 + R_NST);
    if (nb <= 0) return;
    for (int gt = me * 512 + F.tid; gt < 131072; gt += nb * 512) {
        const int h = gt >> 15, e2 = (gt & 32767) * 2;
        f32x2 run = (f32x2){0.f, 0.f};
#pragma unroll 1
        for (int j0 = 0; j0 < 32; j0 += 8) {
            unsigned s[8]; float dec[8];
#pragma unroll
            for (int jj = 0; jj < 8; ++jj) { s[jj] = *(const unsigned*)(SL + ((size_t)h * 32 + j0 + jj) * 65536 + e2); dec[jj] = SCB[h * 32 + j0 + jj]; }
#pragma unroll
            for (int jj = 0; jj < 8; ++jj) { *(unsigned*)(SL + ((size_t)h * 32 + j0 + jj) * 65536 + e2) = pack2(run[0], run[1]); run = run * __expf(dec[jj]) + (f32x2){bflo(s[jj]), bfhi(s[jj])}; }
        }
    }
    const int q = ((nb - 1 - me) * 512 + F.tid);
    if (q < 1024) {
        const int h = q >> 8, dd = q & 255; float run = 0.f;
#pragma unroll 1
        for (int c0 = 0; c0 < 128; c0 += 16) {
            float dn[16], cb[16];
#pragma unroll
            for (int cc = 0; cc < 16; ++cc) { dn[cc] = DN[((size_t)h * 128 + c0 + cc) * 256 + dd]; cb[cc] = CHB[h * 128 + c0 + cc]; }
#pragma unroll
            for (int cc = 0; cc < 16; ++cc) { NST[((size_t)h * 128 + c0 + cc) * 256 + dd] = run; run = run * __expf(cb[cc]) + dn[cc]; }
        }
    }
}

DI void f_hm_block(const Frame& F, int l, int h, int j, int half, int eg) {
    const bf16_t* QC = (const bf16_t*)(F.R0 + R_QC); const bf16_t* CST = (const bf16_t*)(F.R0 + R_CST); const float* NST = (const float*)(F.R0 + R_NST);
    const bf16_t* NUM = (const bf16_t*)(F.R0 + R_NUM); const bf16_t* P = (const bf16_t*)(F.R0 + R_P);
    const float* DENI = (const float*)(F.R0 + R_DENI); const float* EBC = (const float*)(F.R0 + R_EBC); const float* EBL = (const float*)(F.R0 + R_EBL);
    int lane = F.lane, tid = F.tid; asm volatile("" : "+v"(lane), "+v"(tid));
    const int tr = lane & 15, kg = lane >> 4, w = F.wave;
    const int tl0 = j * 256 + half * 128 + w * 16, c = tl0 >> 6, tl = tl0 + tr;
    LAS unsigned char* Cs = F.lds;
    const bf16_t* qp = QC + (size_t)tl * 1024 + h * 256 + kg * 8;
    const float* np = NST + ((size_t)h * 128 + c) * 256 + kg * 8;
    const float ebl = EBL[(size_t)tl * 4 + h], ebc = EBC[(size_t)tl * 4 + h], deni = DENI[(size_t)tl * 4 + h];
    bf16x8 qf[8];
#pragma unroll
    for (int ks = 0; ks < 8; ++ks) qf[ks] = ldg8(qp + ks * 32);
    { const bf16_t* src = CST + ((size_t)h * 32 + j) * 65536;
#pragma unroll
      for (int hf = 0; hf < 4; ++hf) {
          u32x4 st[4];
#pragma unroll
          for (int i = 0; i < 4; ++i) { const int p = tid + 512 * (hf * 4 + i); st[i] = *(const u32x4*)(src + (size_t)p * 8); }
#pragma unroll
          for (int i = 0; i < 4; ++i) { const int p = tid + 512 * (hf * 4 + i), row = p >> 5, pc = p & 31; *(LAS u32x4*)(Cs + row * 512 + ((pc ^ (row & 15)) << 4)) = st[i]; }
      } }
    float dotn = 0.f;
#pragma unroll
    for (int ks = 0; ks < 8; ++ks) {
        const f32x4 n0 = *(const f32x4*)(np + ks * 32), n1 = *(const f32x4*)(np + ks * 32 + 4);
        const u32x4 qv = __builtin_bit_cast(u32x4, qf[ks]);
        dotn += bflo(qv.x) * n0[0] + bfhi(qv.x) * n0[1] + bflo(qv.y) * n0[2] + bfhi(qv.y) * n0[3] + bflo(qv.z) * n1[0] + bfhi(qv.z) * n1[1] + bflo(qv.w) * n1[2] + bfhi(qv.w) * n1[3];
    }
    __syncthreads();
    f32x4 acc[16];
#pragma unroll
    for (int et = 0; et < 16; ++et) {
        acc[et] = (f32x4){0.f, 0.f, 0.f, 0.f};
        const LAS unsigned char* rowp = Cs + (et * 16 + tr) * 512;
#pragma unroll
        for (int ks = 0; ks < 8; ++ks) acc[et] = __builtin_amdgcn_mfma_f32_16x16x32_bf16(*(const LAS bf16x8*)(rowp + (((4 * ks + kg) ^ tr) << 4)), qf[ks], acc[et], 0, 0, 0);
        if ((et & 3) == 3) asm volatile("" ::: "memory");
    }
    dotn += __shfl_xor(dotn, 16); dotn += __shfl_xor(dotn, 32);
    const float den = deni + ebc * dotn;
    const float invd = 1.0f / fmaxf(fabsf(den), 1.0f);
    float ssq = 0.f;
    { u32x2 nl[16];
#pragma unroll
      for (int et = 0; et < 16; ++et) nl[et] = *(const u32x2*)(NUM + (size_t)tl * 1024 + h * 256 + et * 16 + 4 * kg);
#pragma unroll
      for (int et = 0; et < 16; ++et) { const float n4[4] = {bflo(nl[et].x), bfhi(nl[et].x), bflo(nl[et].y), bfhi(nl[et].y)};
#pragma unroll
          for (int q = 0; q < 4; ++q) { const float v = (n4[q] + ebl * acc[et][q]) * invd; acc[et][q] = v; ssq += v * v; } } }
    ssq += __shfl_xor(ssq, 16); ssq += __shfl_xor(ssq, 32);
    const float rn = __builtin_amdgcn_rsqf(ssq * (1.0f / 256.0f) + EPS);
    const size_t tp = (size_t)eg * TQ + tl;
    asm volatile("" ::: "memory");
#pragma unroll
    for (int e8 = 0; e8 < 2; ++e8) {
        f32x4 ng[8]; u32x2 og[8];
#pragma unroll
        for (int i = 0; i < 8; ++i) { const int e = (e8 * 8 + i) * 16 + 4 * kg; og[i] = *(const u32x2*)(P + (size_t)tl * NNAT + 2048 + h * 256 + e); ng[i] = *(const f32x4*)(F.norm_g + (size_t)l * 1024 + h * 256 + e); }
#pragma unroll
        for (int i = 0; i < 8; ++i) { const int et = e8 * 8 + i, e = et * 16 + 4 * kg;
            u32x2 wv; wv.x = pack2(bflo(og[i].x) * acc[et][0] * rn * ng[i][0], bfhi(og[i].x) * acc[et][1] * rn * ng[i][1]);
            wv.y = pack2(bflo(og[i].y) * acc[et][2] * rn * ng[i][2], bfhi(og[i].y) * acc[et][3] * rn * ng[i][3]);
            *(u32x2*)(F.HM + tp * 1024 + h * 256 + e) = wv; }
        asm volatile("" ::: "memory");
    }
    __syncthreads();
}
DI void f_ha_tokens4(const Frame& F, int t0, int tstride, int eg) {
    const bf16_t* P = (const bf16_t*)(F.R0 + R_P); const float* LSE = (const float*)(F.R0 + R_LSE);
    int lane = F.lane; asm volatile("" : "+v"(lane));
    const int hs = lane >> 4, ch0 = (lane & 15) * 8;
    float l0[4], l1[4], l2[4]; u32x4 v0[4], v1[4], v2[4];
#pragma unroll
    for (int k = 0; k < 4; ++k) { const int tl = t0 + k * tstride;
        l0[k] = LSE[(size_t)tl * 12 + hs]; l1[k] = LSE[(size_t)tl * 12 + 4 + hs]; l2[k] = LSE[(size_t)tl * 12 + 8 + hs];
        const bf16_t* pr = P + (size_t)tl * NNAT + 3072 + hs * 128 + ch0;
        v0[k] = *(const u32x4*)(pr); v1[k] = *(const u32x4*)(pr + 512); v2[k] = *(const u32x4*)(pr + 1024); }
#pragma unroll
    for (int k = 0; k < 4; ++k) { const int tl = t0 + k * tstride;
        const float mm = fmaxf(l0[k], fmaxf(l1[k], l2[k]));
        float a0 = __expf(l0[k] - mm), a1 = __expf(l1[k] - mm), a2 = __expf(l2[k] - mm); const float inv = 1.0f / (a0 + a1 + a2); a0 *= inv; a1 *= inv; a2 *= inv;
        u32x4 o;
        o.x = pack2(a0 * bflo(v0[k].x) + a1 * bflo(v1[k].x) + a2 * bflo(v2[k].x), a0 * bfhi(v0[k].x) + a1 * bfhi(v1[k].x) + a2 * bfhi(v2[k].x));
        o.y = pack2(a0 * bflo(v0[k].y) + a1 * bflo(v1[k].y) + a2 * bflo(v2[k].y), a0 * bfhi(v0[k].y) + a1 * bfhi(v1[k].y) + a2 * bfhi(v2[k].y));
        o.z = pack2(a0 * bflo(v0[k].z) + a1 * bflo(v1[k].z) + a2 * bflo(v2[k].z), a0 * bfhi(v0[k].z) + a1 * bfhi(v1[k].z) + a2 * bfhi(v2[k].z));
        o.w = pack2(a0 * bflo(v0[k].w) + a1 * bflo(v1[k].w) + a2 * bflo(v2[k].w), a0 * bfhi(v0[k].w) + a1 * bfhi(v1[k].w) + a2 * bfhi(v2[k].w));
        *(u32x4*)(F.HA + ((size_t)eg * TQ + tl) * 512 + hs * 128 + ch0) = o; }
}
using pg8::UnitD;
DI u32x4 pack8(const f32x4& v0, const f32x4& v1) { u32x4 w; w.x = pack2(v0[0], v0[1]); w.y = pack2(v0[2], v0[3]); w.z = pack2(v1[0], v1[1]); w.w = pack2(v1[2], v1[3]); return w; }

struct SchedG1 {
    const char* U; const char* Wnat; const char* Wvt; int G, c;
    DI bool next(int i, UnitD& u) const {
        const int L = i * G + c; if (L >= 704 + 320) return false;
        u.arows = nullptr; u.acount = 0; u.aux = 0; u.K = 1024;
        if (L < 704) { int pm, pc; pg8::tile_map(L, 32, 22, pm, pc); const int pn = pc < 10 ? pc : pc + 2; u.kind = 0; u.pm = pm; u.pn = pn;
            u.A = U + (size_t)pm * 256 * 2048; u.lda = 2048; u.B = Wnat + (size_t)pn * 256 * 2048; u.ldb = 2048; }
        else { const int idx = L - 704, pm = idx % 10, pn = idx / 10; u.kind = 1; u.pm = pm; u.pn = pn;
            u.A = Wvt + (size_t)pm * 256 * 2048; u.lda = 2048;
            int tokbase = pn * 256, dmul = 1;
            if (pm >= 4) { const int g = (pm - 4) >> 1, dsh = 2 * g, lsub = TQ >> dsh, n0 = pn * 256; dmul = 1 << dsh; tokbase = (n0 % lsub) * dmul + n0 / lsub; }
            u.B = U + (size_t)tokbase * 2048; u.ldb = 2048u * (unsigned)dmul; }
        return true;
    }
};
struct SchedG1Def {
    const char* U; const char* Wnat; int c;
    DI bool next(int i, UnitD& u) const {
        if (i > 0 || c >= 64) return false;
        const int pm = c >> 1, pn = 10 + (c & 1);
        u.arows = nullptr; u.acount = 0; u.aux = 0; u.K = 1024; u.kind = 0; u.pm = pm; u.pn = pn;
        u.A = U + (size_t)pm * 256 * 2048; u.lda = 2048; u.B = Wnat + (size_t)pn * 256 * 2048; u.ldb = 2048;
        return true;
    }
};
struct EpiG1 {
    static constexpr bool PERM = true;
    bf16_t* P; bf16_t* VT;
    DI void operator()(const f32x4 (&acc)[2][2][4][2], const UnitD& u, int wr, int wc, int fr, int fq) const {
        bf16_t* base; size_t ld; int mode = 0;
        if (u.kind == 0) { base = P + (size_t)u.pm * 256 * NNAT + u.pn * 256; ld = NNAT; mode = (u.pn >= 8 && u.pn < 12) ? 1 : ((u.pn >= 12 && u.pn < 18) ? 2 : 0); }
        else { base = VT + (size_t)u.pm * 256 * TQ + u.pn * 256; ld = TQ; }
        const int row0 = wr * 64 + fr, col0 = wc * 32 + 8 * fq;
#pragma unroll
        for (int ai = 0; ai < 2; ++ai)
#pragma unroll
            for (int m = 0; m < 4; ++m) { bf16_t* rowp = base + (size_t)(row0 + ai * 128 + m * 16) * ld + col0;
#pragma unroll
                for (int bj = 0; bj < 2; ++bj) { f32x4 v0 = acc[ai][bj][m][0], v1 = acc[ai][bj][m][1];
                    if (mode == 1) {
#pragma unroll
                        for (int q = 0; q < 4; ++q) { v0[q] = sigmoidf_(v0[q]); v1[q] = sigmoidf_(v1[q]); } }
                    else if (mode == 2) { v0 *= 0.08838834764831845f; v1 *= 0.08838834764831845f; }
                    *(u32x4*)(rowp + bj * 128) = pack8(v0, v1); }
                asm volatile("" ::: "memory"); }
    }
};
struct SchedDense {
    const char* A; const char* B; unsigned lda, ldb; int nM, nN, G, c, K;
    DI bool next(int i, UnitD& u) const {
        const int L = i * G + c; if (L >= nM * nN) return false;
        int pm, pn; pg8::tile_map(L, nM, nN, pm, pn); u.kind = 0; u.K = K; u.pm = pm; u.pn = pn; u.aux = 0; u.arows = nullptr; u.acount = 0;
        u.A = A + (size_t)pm * 256 * lda; u.lda = lda; u.B = B + (size_t)pn * 256 * ldb; u.ldb = ldb; return true;
    }
};
struct EpiG1g {
    static constexpr bool PERM = true;
    bf16_t* GT;
    DI void operator()(const f32x4 (&acc)[2][2][4][2], const UnitD& u, int wr, int wc, int fr, int fq) const {
        bf16_t* base = GT + (size_t)u.pm * 256 * 2048 + u.pn * 256; const int row0 = wr * 64 + fr, col0 = wc * 32 + 8 * fq;
#pragma unroll
        for (int ai = 0; ai < 2; ++ai)
#pragma unroll
            for (int m = 0; m < 4; ++m) { bf16_t* rowp = base + (size_t)(row0 + ai * 128 + m * 16) * 2048 + col0;
#pragma unroll
                for (int bj = 0; bj < 2; ++bj) { f32x4 v0 = acc[ai][bj][m][0], v1 = acc[ai][bj][m][1];
#pragma unroll
                    for (int q = 0; q < 4; ++q) { v0[q] = sigmoidf_(v0[q]); v1[q] = sigmoidf_(v1[q]); }
                    *(u32x4*)(rowp + bj * 128) = pack8(v0, v1); }
                asm volatile("" ::: "memory"); }
    }
};
template <int WHICH> struct EpiG2 {
    static constexpr bool PERM = true;
    bf16_t* GT;
    DI void operator()(const f32x4 (&acc)[2][2][4][2], const UnitD& u, int wr, int wc, int fr, int fq) const {
        bf16_t* base = GT + (size_t)u.pm * 256 * 2048 + u.pn * 256 + (WHICH == 0 ? 1024 : 0); const int row0 = wr * 64 + fr, col0 = wc * 32 + 8 * fq;
#pragma unroll
        for (int ai = 0; ai < 2; ++ai)
#pragma unroll
            for (int m = 0; m < 4; ++m) { bf16_t* rowp = base + (size_t)(row0 + ai * 128 + m * 16) * 2048 + col0;
#pragma unroll
                for (int bj = 0; bj < 2; ++bj) { const f32x4 a0 = acc[ai][bj][m][0], a1 = acc[ai][bj][m][1];
                    const u32x4 g = *(const u32x4*)(rowp + bj * 128);
                    f32x4 v0 = (f32x4){bflo(g.x) * a0[0], bfhi(g.x) * a0[1], bflo(g.y) * a0[2], bfhi(g.y) * a0[3]};
                    f32x4 v1 = (f32x4){bflo(g.z) * a1[0], bfhi(g.z) * a1[1], bflo(g.w) * a1[2], bfhi(g.w) * a1[3]};
                    if (WHICH == 1) { const u32x4 y = *(const u32x4*)(rowp + bj * 128 + 1024);
                        v0 += (f32x4){bflo(y.x), bfhi(y.x), bflo(y.y), bfhi(y.y)}; v1 += (f32x4){bflo(y.z), bfhi(y.z), bflo(y.w), bfhi(y.w)}; }
                    *(u32x4*)(rowp + bj * 128) = pack8(v0, v1); }
                asm volatile("" ::: "memory"); }
    }
};
struct EpiG3 {
    static constexpr bool PERM = false;
    const float* xin; float* xout; const float* gta;
    int b0;
    DI void operator()(const f32x4 (&acc)[2][2][4][2], const UnitD& u, int wr, int wc, int fr, int fq) const {
        const int row0 = u.pm * 256 + wr * 64 + fr, col0 = u.pn * 256 + wc * 32 + 4 * fq;
        const float* g = gta + (size_t)(b0 + (u.pm >> 5)) * 6144 + col0;
        f32x4 gv[2][2];
#pragma unroll
        for (int bj = 0; bj < 2; ++bj)
#pragma unroll
            for (int n = 0; n < 2; ++n) gv[bj][n] = *(const f32x4*)(g + bj * 128 + n * 16);
        f32x4 xb[4][4];
#pragma unroll
        for (int g0 = 0; g0 < 3; ++g0) { const size_t o0 = (size_t)(row0 + (g0 >> 2) * 128 + (g0 & 3) * 16) * 1024 + col0;
#pragma unroll
            for (int q = 0; q < 4; ++q) xb[g0][q] = *(const f32x4*)(xin + o0 + (q >> 1) * 128 + (q & 1) * 16); }
#pragma unroll
        for (int gi = 0; gi < 8; ++gi) { const int ai = gi >> 2, m = gi & 3; const size_t o = (size_t)(row0 + ai * 128 + m * 16) * 1024 + col0;
            if (gi + 3 < 8) { const int ai2 = (gi + 3) >> 2, m2 = (gi + 3) & 3; const size_t o2 = (size_t)(row0 + ai2 * 128 + m2 * 16) * 1024 + col0;
#pragma unroll
                for (int q = 0; q < 4; ++q) xb[(gi + 3) & 3][q] = *(const f32x4*)(xin + o2 + (q >> 1) * 128 + (q & 1) * 16); }
            asm volatile("" ::: "memory");
#pragma unroll
            for (int q = 0; q < 4; ++q) *(f32x4*)(xout + o + (q >> 1) * 128 + (q & 1) * 16) = xb[gi & 3][q] + gv[q >> 1][q & 1] * acc[ai][q >> 1][m][q & 1]; }
    }
};
struct SchedMoe {
    const int* pre;
    const unsigned* cnt;
    const char* A; const char* W; const int* SLOT; int G, c; bool gate_up;
    DI bool next(int i, UnitD& u) const {
        const int L = i * G + c, nt = pre[16]; if (L >= nt * 4) return false;
        const int rt = L >> 2, ct = L & 3; int e = 0;
#pragma unroll
        for (int q = 1; q < 16; ++q) e += (rt >= pre[q]) ? 1 : 0;
        u.kind = 0; u.pm = rt; u.pn = ct; u.aux = e; u.K = gate_up ? 1024 : 512;
        const int ti = rt - pre[e];
        if (gate_up) { u.A = A; u.lda = 2048; u.arows = SLOT + (size_t)e * 32768 + ti * 256; u.acount = (int)cnt[e] - ti * 256;
            u.B = W + ((size_t)e * 1024 + ct * 256) * 2048; u.ldb = 2048; }
        else { u.A = A + (size_t)rt * 256 * 1024; u.lda = 1024; u.arows = nullptr; u.acount = 0;
            u.B = W + ((size_t)e * 1024 + ct * 256) * 1024; u.ldb = 1024; }
        return true;
    }
};
struct EpiG4 {
    static constexpr bool PERM = true;
    bf16_t* HH;
    DI void operator()(const f32x4 (&acc)[2][2][4][2], const UnitD& u, int wr, int wc, int fr, int fq) const {
        bf16_t* base = HH + (size_t)u.pm * 256 * 512 + u.pn * 128; const int row0 = wr * 64 + fr, col0 = wc * 16 + 4 * fq;
#pragma unroll
        for (int ai = 0; ai < 2; ++ai)
#pragma unroll
            for (int m = 0; m < 4; ++m) { bf16_t* rowp = base + (size_t)(row0 + ai * 128 + m * 16) * 512 + col0;
#pragma unroll
                for (int bj = 0; bj < 2; ++bj) { const f32x4 v0 = acc[ai][bj][m][0], v1 = acc[ai][bj][m][1];
                    u32x2 w; w.x = pack2(siluf_(v0[0]) * v0[1], siluf_(v0[2]) * v0[3]); w.y = pack2(siluf_(v1[0]) * v1[1], siluf_(v1[2]) * v1[3]);
                    *(u32x2*)(rowp + bj * 64) = w; }
                asm volatile("" ::: "memory"); }
    }
};
struct EpiG5 {
    static constexpr bool PERM = true;
    bf16_t* YS;
    DI void operator()(const f32x4 (&acc)[2][2][4][2], const UnitD& u, int wr, int wc, int fr, int fq) const {
        bf16_t* base = YS + (size_t)u.pm * 256 * 1024 + u.pn * 256; const int row0 = wr * 64 + fr, col0 = wc * 32 + 8 * fq;
#pragma unroll
        for (int ai = 0; ai < 2; ++ai)
#pragma unroll
            for (int m = 0; m < 4; ++m) { bf16_t* rowp = base + (size_t)(row0 + ai * 128 + m * 16) * 1024 + col0;
#pragma unroll
                for (int bj = 0; bj < 2; ++bj) *(u32x4*)(rowp + bj * 128) = pack8(acc[ai][bj][m][0], acc[ai][bj][m][1]);
                asm volatile("" ::: "memory"); }
    }
};

struct SchedChain {
    const char* U; const char* HA; const char* HM; const char* Wg; const char* Wa; const char* Wm; int G, c;
    DI bool next(int i, UnitD& u) const {
        const int per = (512 + G - 1) / G;
        const int ti = i >> 2, st = i & 3; if (ti >= per) return false;
        const int L = ti * G + c; if (L >= 512) return false;
        int pm, pn; pg8::tile_map(L, 128, 4, pm, pn); u.pm = pm; u.pn = pn; u.kind = st; u.aux = 0; u.arows = nullptr; u.acount = 0;
        if (st == 0) { u.A = U + (size_t)pm * 256 * 2048; u.lda = 2048; u.B = Wg + (size_t)pn * 256 * 2048; u.ldb = 2048; u.K = 1024; }
        else if (st == 1) { u.A = U + (size_t)pm * 256 * 2048; u.lda = 2048; u.B = Wg + (size_t)(4 + pn) * 256 * 2048; u.ldb = 2048; u.K = 1024; }
        else if (st == 2) { u.A = HA + (size_t)pm * 256 * 1024; u.lda = 1024; u.B = Wa + (size_t)pn * 256 * 1024; u.ldb = 1024; u.K = 512; }
        else { u.A = HM + (size_t)pm * 256 * 2048; u.lda = 2048; u.B = Wm + (size_t)pn * 256 * 2048; u.ldb = 2048; u.K = 1024; }
        return true;
    }
};
struct EpiChain {
    static constexpr bool PERM = true;
    bf16_t* GT;
    DI void operator()(const f32x4 (&acc)[2][2][4][2], const UnitD& u, int wr, int wc, int fr, int fq) const {
        const int st = u.kind;
        bf16_t* base = GT + (size_t)u.pm * 256 * 2048 + u.pn * 256 + ((st == 1 || st == 2) ? 1024 : 0); const int row0 = wr * 64 + fr, col0 = wc * 32 + 8 * fq;
        if (st < 2) {
#pragma unroll
            for (int ai = 0; ai < 2; ++ai)
#pragma unroll
                for (int m = 0; m < 4; ++m) { bf16_t* rowp = base + (size_t)(row0 + ai * 128 + m * 16) * 2048 + col0;
#pragma unroll
                    for (int bj = 0; bj < 2; ++bj) { f32x4 v0 = acc[ai][bj][m][0], v1 = acc[ai][bj][m][1];
#pragma unroll
                        for (int q = 0; q < 4; ++q) { v0[q] = sigmoidf_(v0[q]); v1[q] = sigmoidf_(v1[q]); }
                        *(u32x4*)(rowp + bj * 128) = pack8(v0, v1); }
                    asm volatile("" ::: "memory"); }
        } else {
            u32x4 gb[4][4];
#pragma unroll
            for (int g0 = 0; g0 < 3; ++g0) { bf16_t* rp0 = base + (size_t)(row0 + (g0 >> 2) * 128 + (g0 & 3) * 16) * 2048 + col0;
                gb[g0][0] = *(const u32x4*)(rp0); gb[g0][1] = *(const u32x4*)(rp0 + 128);
                if (st == 3) { gb[g0][2] = *(const u32x4*)(rp0 + 1024); gb[g0][3] = *(const u32x4*)(rp0 + 128 + 1024); } }
#pragma unroll
            for (int gi = 0; gi < 8; ++gi) { const int ai = gi >> 2, m = gi & 3; bf16_t* rowp = base + (size_t)(row0 + ai * 128 + m * 16) * 2048 + col0;
                if (gi + 3 < 8) { const int ai2 = (gi + 3) >> 2, m2 = (gi + 3) & 3; bf16_t* rp2 = base + (size_t)(row0 + ai2 * 128 + m2 * 16) * 2048 + col0;
                    gb[(gi + 3) & 3][0] = *(const u32x4*)(rp2); gb[(gi + 3) & 3][1] = *(const u32x4*)(rp2 + 128);
                    if (st == 3) { gb[(gi + 3) & 3][2] = *(const u32x4*)(rp2 + 1024); gb[(gi + 3) & 3][3] = *(const u32x4*)(rp2 + 128 + 1024); } }
                asm volatile("" ::: "memory");
#pragma unroll
                for (int bj = 0; bj < 2; ++bj) { f32x4 v0 = acc[ai][bj][m][0], v1 = acc[ai][bj][m][1];
                    const u32x4 g = gb[gi & 3][bj];
                    v0 *= (f32x4){bflo(g.x), bfhi(g.x), bflo(g.y), bfhi(g.y)}; v1 *= (f32x4){bflo(g.z), bfhi(g.z), bflo(g.w), bfhi(g.w)};
                    if (st == 3) { const u32x4 y = gb[gi & 3][2 + bj];
                        v0 += (f32x4){bflo(y.x), bfhi(y.x), bflo(y.y), bfhi(y.y)}; v1 += (f32x4){bflo(y.z), bfhi(y.z), bflo(y.w), bfhi(y.w)}; }
                    *(u32x4*)(rowp + bj * 128) = pack8(v0, v1); } }
        }
    }
};
constexpr int LDS_BYTES = 131072 + 1024;
constexpr int LDS_MISC = 131072;
#ifndef MK_ONE_LAUNCH
#define MK_ONE_LAUNCH 1
#endif
constexpr int N_STEPS = 1 + DEPTH * (1 + 4 * 4 + 2 + 3) + 1;

DI int fresh_tid(int wave) { int l_; asm volatile("v_mbcnt_lo_u32_b32 %0, -1, 0\n\tv_mbcnt_hi_u32_b32 %0, -1, %0" : "=v"(l_)); return wave * 64 + l_; }
__global__ void __launch_bounds__(512, 2) fwd_kernel(Args args) {
    extern __shared__ __attribute__((aligned(16))) unsigned char lds_raw[];
    const int wave0 = __builtin_amdgcn_readfirstlane((int)threadIdx.x >> 6);
#define tid0 fresh_tid(wave0)
    LAS unsigned char* lds0 = (LAS unsigned char*)lds_raw;
    if (tid0 < 4) ((volatile LAS unsigned*)(lds0 + LDS_MISC))[tid0] = 0u;
    __syncthreads();
    unsigned* ctl0 = (unsigned*)(args.ws + WS_CTL);
    XcdBarrier bar; bar.bar = ctl0 + CW_BAR; bar.x = 0; bar.st = nullptr;
    const int lo = args.step_lo, hi = args.step_hi;
    if (hi - lo > 1) bar = xcd_barrier_post(ctl0 + CW_BAR, (volatile LAS unsigned*)(lds0 + LDS_MISC));
    int step = 0; int l_probe = 0; unsigned long long probe_acc = 0;
#ifndef SITE_MASK
#define SITE_MASK 0xFFFFFFFFu
#endif
#ifndef REP_ML1
#define REP_ML1 1
#endif
#ifndef REP_AT
#define REP_AT 1
#endif
#ifndef DUP_MASK
#define DUP_MASK 0u
#endif
#ifndef DUP_L0
#define DUP_L0 0
#endif
#ifndef EXTRA_BARS
#define EXTRA_BARS 0
#endif
#ifndef PROBE_SITE
#define PROBE_SITE -1
#endif
#ifndef PROBE_AMP
#define PROBE_AMP 4
#endif
#define RUN(site, ...) do { if (step >= lo && step < hi) { unsigned long long pt0_ = 0; if constexpr (PROBE_SITE == (site)) pt0_ = wall_clock64(); if constexpr ((DUP_MASK >> (site)) & 1u) { if (!DUP_L0 || l_probe == 0) { Frame F; { int t_ = tid0; asm volatile("" : "+v"(t_)); frame_init(F, lds_raw, t_); } int* preL = (int*)(F.ldsg + LDS_MISC + 64); (void)preL; __VA_ARGS__; xcd_barrier(bar); } } if constexpr ((SITE_MASK >> (site)) & 1u) { Frame F; { int t_ = tid0; asm volatile("" : "+v"(t_)); frame_init(F, lds_raw, t_); } int* preL = (int*)(F.ldsg + LDS_MISC + 64); (void)preL; __VA_ARGS__; } if (step + 1 < hi) xcd_barrier(bar); if constexpr (PROBE_SITE == (site)) probe_acc += wall_clock64() - pt0_; } ++step; } while (0)

    RUN(0, { phase_p0_small(F); });
    for (int l = 0; l < DEPTH; ++l) { l_probe = l;
        RUN(1, { phase_pw(F, l, 0, F.G); __syncthreads(); phase_n1(F, l); });
        for (int eg = 0; eg < 4; ++eg) {
                RUN(2, { SchedG1 S{(const char*)(F.U + (size_t)eg * TQ * 1024), (const char*)(F.W + W_NAT), (const char*)(F.W + W_VT), F.G, F.bid};
                      EpiG1 E{(bf16_t*)(F.R0 + R_P), (bf16_t*)(F.R0 + R_VT)};
                      pg8::gemm_run<EpiG1, SchedG1>(F.lds, S, E, F.tid); });
                RUN(4, {
                      if (F.bid < 128) ml1_unit(F, l, F.bid >> 5, F.bid & 31, eg);
                      else if (F.bid < 192) { SchedG1Def S{(const char*)(F.U + (size_t)eg * TQ * 1024), (const char*)(F.W + W_NAT), F.bid - 128}; EpiG1 E{(bf16_t*)(F.R0 + R_P), (bf16_t*)(F.R0 + R_VT)};
                          pg8::gemm_run<EpiG1, SchedG1Def>(F.lds, S, E, F.tid);
                          at_block_unit(F, F.bid - 128); at_block_unit(F, F.bid - 64); }
                      else { for (int q4 = 0; q4 < 4; ++q4) at_block_unit(F, 128 + (F.bid - 192) * 4 + q4); } });
                RUN(5, { phase_p2(F, F.bid, F.G); });
                RUN(6, { for (int u = F.bid; u < 256; u += F.G) f_hm_block(F, l, (u & 127) >> 5, u & 31, u >> 7, eg);
                      f_ha_tokens4(F, F.bid * 8 + F.wave, F.G * 8, eg); });
        }
        RUN(7, { SchedChain S{(const char*)F.U, (const char*)F.HA, (const char*)F.HM, (const char*)(F.W + W_G), (const char*)(F.W + W_A), (const char*)(F.W + W_M), F.G, F.bid};
              EpiChain E{(bf16_t*)(F.R0 + R_GT)}; pg8::gemm_run<EpiChain, SchedChain>(F.lds, S, E, F.tid); });
        RUN(10, { SchedDense S{(const char*)(F.R0 + R_GT), (const char*)(F.W + W_O), 4096u, 2048u, 128, 4, F.G, F.bid, 1024};
              EpiG3 E{(l == 0 ? F.x : F.out), F.out, F.MOD + (size_t)l * 4 * 6144 + 2048, 0};
              pg8::gemm_run<EpiG3, SchedDense>(F.lds, S, E, F.tid); });
        RUN(11, { phase_n2(F, l); });
        RUN(12, { moe_offsets(F.ctl + CW_CNT + 64 * l, preL, F.tid); __syncthreads();
              SchedMoe S{preL, F.ctl + CW_CNT + 64 * l, (const char*)F.U, (const char*)(F.W + W_13), (const int*)(F.R0 + R_SLOT), F.G, F.bid, true};
              EpiG4 E{(bf16_t*)(F.R0 + R_HH)}; pg8::gemm_run<EpiG4, SchedMoe, true>(F.lds, S, E, F.tid); });
        RUN(13, { moe_offsets(F.ctl + CW_CNT + 64 * l, preL, F.tid); __syncthreads();
              SchedMoe S{preL, F.ctl + CW_CNT + 64 * l, (const char*)(F.R0 + R_HH), (const char*)(F.W + W_2), (const int*)(F.R0 + R_SLOT), F.G, F.bid, false};
              EpiG5 E{(bf16_t*)(F.R0 + R_YS)}; pg8::gemm_run<EpiG5, SchedMoe>(F.lds, S, E, F.tid); });
    }
    for (int xb = 0; xb < EXTRA_BARS; ++xb) xcd_barrier(bar);
    RUN(14, { phase_fn(F); });
#undef RUN
#undef tid0
    if constexpr (PROBE_SITE >= 0) { if (blockIdx.x == 0 && fresh_tid(wave0) == 0) { const unsigned long long te = wall_clock64(); while (wall_clock64() - te < (unsigned long long)PROBE_AMP * probe_acc) __builtin_amdgcn_s_sleep(8); } }
}

extern "C" void kernel_launch(void* const* d_in, const int* in_sizes, int n_in, void* d_out, int out_size, void* d_ws, size_t ws_size, hipStream_t stream) {
    static int grid = 0;
    if (grid == 0) {
        if (n_in != 19 || out_size != T_TOK * DM || ws_size < WS_END) { fprintf(stderr, "kernel_launch: unexpected problem (n_in %d out %d ws %zu, need %zu)\n", n_in, out_size, ws_size, (size_t)WS_END); grid = -1; return; }
        int dev = 0, cus = 0, per_cu = 0;
        if (hipGetDevice(&dev) != hipSuccess || hipDeviceGetAttribute(&cus, hipDeviceAttributeMultiprocessorCount, dev) != hipSuccess) { grid = -1; return; }
        if (hipFuncSetAttribute((const void*)fwd_kernel, hipFuncAttributeMaxDynamicSharedMemorySize, LDS_BYTES) != hipSuccess) { fprintf(stderr, "kernel_launch: hipFuncSetAttribute failed\n"); grid = -1; return; }
        if (hipOccupancyMaxActiveBlocksPerMultiprocessor(&per_cu, (const void*)fwd_kernel, 512, LDS_BYTES) != hipSuccess || per_cu < 1) { fprintf(stderr, "kernel_launch: occupancy query says %d blocks per CU\n", per_cu); per_cu = 1; }
        (void)hipGetLastError();
        if (cus < 256) { fprintf(stderr, "kernel_launch: this kernel's phase program is written for 256 workgroups (one per CU of a 256-CU device); found %d CUs\n", cus); grid = -1; return; }
        grid = 256;
    }
    if (grid <= 0) return;
    (void)hipMemsetAsync((char*)d_ws + WS_CTL, 0, CTL_BYTES, stream);
    Args a{};
    for (int i = 0; i < 19; ++i) a.in[i] = (const float*)d_in[i];
    a.out = (float*)d_out; a.ws = (unsigned char*)d_ws;
#if MK_ONE_LAUNCH
    a.step_lo = 0; a.step_hi = N_STEPS;
    hipLaunchKernelGGL(fwd_kernel, dim3(grid), dim3(512), LDS_BYTES, stream, a);
#else
    for (int s = 0; s < N_STEPS; ++s) { a.step_lo = s; a.step_hi = s + 1; hipLaunchKernelGGL(fwd_kernel, dim3(grid), dim3(512), LDS_BYTES, stream, a); }
#endif
}
```

```cpp
#define MK_ONE_LAUNCH 1
#include <hip/hip_runtime.h>
#include <cstdio>
#include <cstdint>

#define DI __device__ __forceinline__
#define LAS __attribute__((address_space(3)))
typedef unsigned short bf16_t;
typedef short bf16x8 __attribute__((ext_vector_type(8)));
typedef float f32x2 __attribute__((ext_vector_type(2)));
typedef float f32x4 __attribute__((ext_vector_type(4)));
typedef float f32x16 __attribute__((ext_vector_type(16)));
typedef unsigned u32x2 __attribute__((ext_vector_type(2)));
typedef unsigned u32x4 __attribute__((ext_vector_type(4)));
typedef __bf16 nbf16x2 __attribute__((ext_vector_type(2)));

constexpr int T_TOK = 32768, SEQ = 8192, DM = 1024, NBATCH = 4, DEPTH = 2;
constexpr int TQ = 8192;
constexpr int TP = 16384;
constexpr int INC = 10760;
constexpr int NNAT = 6144;
constexpr int NVT = 2560;
constexpr int NEXP = 16, DFF = 512;
constexpr int SLOT_ROWS = 69632;
constexpr float EPS = 1e-6f;

constexpr size_t al256(size_t x) { return (x + 255) & ~(size_t)255; }
constexpr size_t WS_CTL = 0;
constexpr size_t CTL_BYTES = 65536;
constexpr size_t WS_MOD = WS_CTL + CTL_BYTES;
constexpr size_t WS_WIF = WS_MOD + al256((size_t)2 * 4 * 6144 * 4);
constexpr size_t WS_RW = WS_WIF + (size_t)2 * 8 * 1024 * 4;
constexpr size_t WS_W = WS_RW + (size_t)16 * 1024 * 4;
constexpr size_t W_NAT = 0;
constexpr size_t W_VT = W_NAT + (size_t)NNAT * 1024 * 2;
constexpr size_t W_G = W_VT + (size_t)NVT * 1024 * 2;
constexpr size_t W_M = W_G + (size_t)2048 * 1024 * 2;
constexpr size_t W_A = W_M + (size_t)1024 * 1024 * 2;
constexpr size_t W_O = W_A + (size_t)1024 * 512 * 2;
constexpr size_t W_13 = W_O + (size_t)1024 * 1024 * 2;
constexpr size_t W_2 = W_13 + (size_t)16 * 1024 * 1024 * 2;
constexpr size_t W_BYTES = W_2 + (size_t)16 * 1024 * 512 * 2;
constexpr size_t WS_U = WS_W + W_BYTES;
constexpr size_t WS_GIF = WS_U + (size_t)T_TOK * 1024 * 2;
constexpr size_t WS_HM = WS_GIF + (size_t)T_TOK * 8 * 4;
constexpr size_t WS_HA = WS_HM + (size_t)T_TOK * 1024 * 2;
constexpr size_t WS_TOKI = WS_HA + (size_t)T_TOK * 512 * 2;
constexpr size_t WS_R0 = WS_TOKI + (size_t)2 * T_TOK * 32;
constexpr size_t R_P = 0;
constexpr size_t R_VT = R_P + (size_t)TQ * NNAT * 2;
constexpr size_t R_QC = R_VT + (size_t)NVT * TQ * 2;
constexpr size_t R_NUM = R_QC + (size_t)TQ * 1024 * 2;
constexpr size_t R_SLOC = R_NUM + (size_t)TQ * 1024 * 2;
constexpr size_t R_CST = R_SLOC;
constexpr size_t R_DENI = R_SLOC + (size_t)4 * 32 * 65536 * 2;
constexpr size_t R_EBC = R_DENI + (size_t)TQ * 4 * 4;
constexpr size_t R_EBL = R_EBC + (size_t)TQ * 4 * 4;
constexpr size_t R_SCB = R_EBL + (size_t)TQ * 4 * 4;
constexpr size_t R_CHB = R_SCB + 1024;
constexpr size_t R_DN = R_CHB + 2048;
constexpr size_t R_NST = R_DN + (size_t)4 * 128 * 256 * 4;
constexpr size_t R_LSE = R_NST + (size_t)4 * 128 * 256 * 4;
constexpr size_t R_END = R_LSE + (size_t)TQ * 12 * 4;
constexpr size_t R_GT = 0;
constexpr size_t R_HH = 0;
constexpr size_t R_YS = R_HH + (size_t)SLOT_ROWS * 512 * 2;
constexpr size_t R_SLOT = R_YS + (size_t)SLOT_ROWS * 1024 * 2;
constexpr size_t R_END2 = R_SLOT + (size_t)16 * 32768 * 4;
constexpr size_t WS_END = WS_R0 + (R_END > R_END2 ? R_END : R_END2);
static_assert(WS_END <= (size_t)536870912, "workspace over 512 MiB");

constexpr int CW_BAR = 0;
constexpr int CW_CNT = 4096;

DI float bflo(unsigned w) { return __uint_as_float(w << 16); }
DI float bfhi(unsigned w) { return __uint_as_float(w & 0xffff0000u); }
DI unsigned pack2(float lo, float hi) { f32x2 v = {lo, hi}; nbf16x2 b = __builtin_convertvector(v, nbf16x2); return __builtin_bit_cast(unsigned, b); }
DI float sigmoidf_(float x) { return __builtin_amdgcn_rcpf(1.0f + __expf(-x)); }
DI float siluf_(float x) { return x * sigmoidf_(x); }
DI float wave_sum(float v) { for (int o = 32; o >= 1; o >>= 1) v += __shfl_xor(v, o); return v; }
DI int crow(int reg, int h) { return (reg & 3) + 8 * (reg >> 2) + 4 * h; }
DI int pi23(int m) { return (m & ~12) | ((m & 4) << 1) | ((m & 8) >> 1); }
#define MFMA32(a, b, c) __builtin_amdgcn_mfma_f32_32x32x16_bf16((a), (b), (c), 0, 0, 0)
DI bf16x8 packf8(float a0, float a1, float a2, float a3, float a4, float a5, float a6, float a7) {
    u32x4 p; p.x = pack2(a0, a1); p.y = pack2(a2, a3); p.z = pack2(a4, a5); p.w = pack2(a6, a7); return __builtin_bit_cast(bf16x8, p); }
DI bf16x8 ldg8(const bf16_t* p) { return *(const bf16x8*)p; }
#define XB_TMO      128
#define XB_XCNT(j)  (256  + 64 * (j))
#define XB_XSUB(j)  (1280 + 64 * (j))
#define XB_XGEN(j)  (2304 + 64 * (j))
#define XB_TOP      3328
#define XB_TOPGEN   3392
#define XCD_BAR_WORDS 3456
#define XB_SPIN_CAP (1u << 21)

__device__ __forceinline__ unsigned xb_ld(unsigned* p)              { return __hip_atomic_load(p, __ATOMIC_RELAXED, __HIP_MEMORY_SCOPE_AGENT); }
__device__ __forceinline__ unsigned xb_add(unsigned* p, unsigned v) { return __hip_atomic_fetch_add(p, v, __ATOMIC_RELAXED, __HIP_MEMORY_SCOPE_AGENT); }
__device__ __forceinline__ unsigned xb_xcc_id() { return (unsigned)__builtin_amdgcn_s_getreg((3 << 11) | 20) & 0xFu; }
#define XB_SPIN(cond, bar) do { unsigned _sp = 0; while (cond) { __builtin_amdgcn_s_sleep(1); \
    if ((++_sp & 255u) == 0u) { if (xb_ld(&(bar)[XB_TMO])) break; if (_sp > XB_SPIN_CAP) { atomicAdd(&(bar)[XB_TMO], 1u); break; } } } } while (0)

struct XcdBarrier {
    unsigned* bar; unsigned x;
    volatile LAS unsigned* st;
};

__device__ __forceinline__ XcdBarrier xcd_barrier_post(unsigned* bar, volatile LAS unsigned* st) {
    XcdBarrier b; b.bar = bar; b.x = xb_xcc_id(); b.st = st;
    if (threadIdx.x == 0) (void)xb_add(&bar[XB_XCNT(b.x)], 1u);
    return b;
}
__device__ __forceinline__ void xcd_barrier_complete(unsigned* bar, unsigned x, unsigned& nloc, unsigned& nx) {
    const unsigned G = gridDim.x * gridDim.y * gridDim.z;
    unsigned sum, cnt, mine, sp = 0u;
    for (;;) {
        sum = 0u; cnt = 0u; mine = 0u;
#pragma unroll
        for (unsigned j = 0; j < 16; ++j) { const unsigned c = xb_ld(&bar[XB_XCNT(j)]); sum += c; cnt += (c > 0u) ? 1u : 0u; mine = (j == x) ? c : mine; }
        if (sum == G) break;
        __builtin_amdgcn_s_sleep(1);
        if ((++sp & 255u) == 0u) { if (xb_ld(&bar[XB_TMO])) break; if (sp > XB_SPIN_CAP) { atomicAdd(&bar[XB_TMO], 1u); break; } }
    }
    nloc = mine > 0u ? mine : 1u; nx = cnt > 0u ? cnt : 1u;
}

__device__ __forceinline__ void xcd_barrier(const XcdBarrier& b) {
    asm volatile("s_waitcnt vmcnt(0)" ::: "memory");
    __syncthreads();
    if (threadIdx.x == 0) {
        unsigned* bar = b.bar;
        __builtin_amdgcn_s_waitcnt(0);
        unsigned nloc = b.st[0], nx = b.st[1];
        if (nloc == 0u) { xcd_barrier_complete(bar, b.x, nloc, nx); b.st[0] = nloc; b.st[1] = nx; }
        const unsigned old = xb_add(&bar[XB_XSUB(b.x)], 1u);
        const unsigned gen = old / nloc;
        if (old + 1u == (gen + 1u) * nloc) {
            __builtin_amdgcn_fence(__ATOMIC_RELEASE, "agent");
            asm volatile("s_waitcnt vmcnt(0)" ::: "memory");
            const unsigned og = xb_add(&bar[XB_TOP], 1u);
            const unsigned tg = og / nx;
            if (og + 1u == (tg + 1u) * nx) xb_add(&bar[XB_TOPGEN], 1u);
            else XB_SPIN(xb_ld(&bar[XB_TOPGEN]) == tg, bar);
            __builtin_amdgcn_fence(__ATOMIC_ACQUIRE, "agent");
            xb_add(&bar[XB_XGEN(b.x)], 1u);
            asm volatile("s_waitcnt vmcnt(0)" ::: "memory");
        } else {
            XB_SPIN(xb_ld(&bar[XB_XGEN(b.x)]) == gen, bar);
            __builtin_amdgcn_fence(__ATOMIC_ACQUIRE, "agent");
            asm volatile("s_waitcnt vmcnt(0)" ::: "memory");
        }
    }
    __syncthreads();
}
namespace pg8 {
constexpr int BM = 256, BK = 64, HALF = 128, HTB = HALF * BK * 2, STAGE_BYTES = 8 * HTB, NXCD = 8, WGM = 8;
DI int lds_byte(int r, int c) { const int st = (r >> 4) * 2 + (c >> 5), rr = r & 15, cc = c & 31, ob = rr * 64 + cc * 2; return st * 1024 + (ob ^ (((ob >> 9) & 1) << 5)); }
DI void stage_rc(int b, int& R, int& C) { const int st = b / 1024, sb = b % 1024, swz = sb ^ (((sb >> 9) & 1) << 5); R = (st >> 1) * 16 + swz / 64; C = (st & 1) * 32 + (swz % 64) / 2; }
DI int perm32(int rho) { const int n = rho >> 4, i = rho & 15; return 8 * (i >> 2) + 4 * n + (i & 3); }

struct UnitD {
    const char* A; const char* B;
    unsigned lda, ldb;
    const int* arows; int acount;
    int kind, pm, pn, aux;
    int K;
};
DI void tile_map(int L, int nM, int nN, int& pm, int& pn) {
    const int nwg = nM * nN; int wgid = L;
    { const int q = nwg / NXCD, r = nwg % NXCD, xcd = wgid % NXCD, off = wgid / NXCD; wgid = (xcd < r ? xcd * (q + 1) : r * (q + 1) + (xcd - r) * q) + off; }
    const int nig = WGM * nN, gid = wgid / nig, fm = gid * WGM, gsz = (nM - fm) < WGM ? (nM - fm) : WGM;
    pm = fm + ((wgid % nig) % gsz); pn = (wgid % nig) / gsz;
}
template <bool PERM, bool GATHER>
DI void unit_off(const UnitD& u, int tid, unsigned (&offA)[2][2], unsigned (&offB)[2]) {
#pragma unroll
    for (int i = 0; i < 2; ++i) {
        int R, C; stage_rc(tid * 16 + i * 8192, R, C);
        const int Rb = PERM ? ((R & ~31) + perm32(R & 31)) : R;
        offB[i] = (unsigned)Rb * u.ldb + (unsigned)C * 2u;
        if (GATHER) {
#pragma unroll
            for (int h = 0; h < 2; ++h) { const int ra = h * HALF + R; const int rr = ra < u.acount ? ra : 0; offA[h][i] = (unsigned)u.arows[rr] * u.lda + (unsigned)C * 2u; }
        } else { offA[0][i] = (unsigned)R * u.lda + (unsigned)C * 2u; offA[1][i] = 0u; }
    }
}

template <class Epi, class Sched, bool GATHER = false>
DI void gemm_run(LAS unsigned char* lds, const Sched& S, const Epi& E, int tid_in) {
    int tid_ = tid_in; asm volatile("" : "+v"(tid_));
    const int tid = tid_, wid = __builtin_amdgcn_readfirstlane(tid >> 6), lane = tid & 63, wr = wid >> 2, wc = wid & 3, fr = lane & 15, fq = lane >> 4;
    const size_t kstep = (size_t)(BK * 2);
    const unsigned ldsw = (unsigned)wid * 1024u;
    const int aoff = lds_byte(wr * 64 + fr, fq * 8), boff = lds_byte(wc * 32 + fr, fq * 8);
#define PG8_SA(b, h) (((b) * 2 + (h)) * HTB)
#define PG8_SB(b, h) ((4 + (b) * 2 + (h)) * HTB)
#define PG8_STAGE(bufoff, gbase, voff) do { _Pragma("unroll") for (int _i = 0; _i < 2; ++_i) \
        __builtin_amdgcn_global_load_lds((const unsigned*)((const char*)(gbase) + (voff)[_i]), (LAS unsigned*)(lds + (bufoff) + ldsw + _i * 8192), 16, 0, 0); } while (0)
#define PG8_LDA(dst, b, h) do { _Pragma("unroll") for (int m = 0; m < 4; ++m) _Pragma("unroll") for (int k = 0; k < 2; ++k) dst[m][k] = *(const LAS bf16x8*)(lds + PG8_SA(b, h) + aoff + m * 2048 + k * 1024); } while (0)
#define PG8_LDB(dst, b, h) do { _Pragma("unroll") for (int n = 0; n < 2; ++n) _Pragma("unroll") for (int k = 0; k < 2; ++k) dst[n][k] = *(const LAS bf16x8*)(lds + PG8_SB(b, h) + boff + n * 2048 + k * 1024); } while (0)
#define PG8_MMA(ai, bj, At, Bt) do { __builtin_amdgcn_s_setprio(1); _Pragma("unroll") for (int m = 0; m < 4; ++m) _Pragma("unroll") for (int n = 0; n < 2; ++n) _Pragma("unroll") for (int k = 0; k < 2; ++k) \
        acc[ai][bj][m][n] = __builtin_amdgcn_mfma_f32_16x16x32_bf16(Bt[n][k], At[m][k], acc[ai][bj][m][n], 0, 0, 0); __builtin_amdgcn_s_setprio(0); } while (0)
#define PG8_WAIT_V(n) asm volatile("s_waitcnt vmcnt(" #n ")" ::: "memory")
#define PG8_WAIT_L(n) asm volatile("s_waitcnt lgkmcnt(" #n ")" ::: "memory")
#define PG8_BAR __builtin_amdgcn_s_barrier()
#define PG8_SCHED __builtin_amdgcn_sched_barrier(0)
    UnitD cur, nxt; int ui = 0;
    if (!S.next(0, cur)) return;
    unsigned offA[2][2], offB[2];
    unit_off<Epi::PERM, GATHER>(cur, tid, offA, offB);
    size_t hA = GATHER ? 0 : (size_t)HALF * cur.lda, hB = (size_t)HALF * cur.ldb;
#define OA(h) offA[GATHER ? (h) : 0]
    f32x4 acc[2][2][4][2];
#pragma unroll
    for (int a = 0; a < 2; ++a)
#pragma unroll
        for (int b = 0; b < 2; ++b)
#pragma unroll
            for (int m = 0; m < 4; ++m)
#pragma unroll
                for (int n = 0; n < 2; ++n) acc[a][b][m][n] = (f32x4){0.f, 0.f, 0.f, 0.f};
    bf16x8 At[4][2], B0[2][2], B1[2][2];
    PG8_STAGE(PG8_SB(0, 0), cur.B, offB); PG8_STAGE(PG8_SA(0, 0), cur.A, OA(0)); PG8_STAGE(PG8_SB(0, 1), cur.B + hB, offB); PG8_STAGE(PG8_SA(0, 1), cur.A + hA, OA(1));
    if (wr == 1) PG8_BAR;
    PG8_WAIT_V(4); PG8_BAR;
    PG8_STAGE(PG8_SB(1, 0), cur.B + kstep, offB); PG8_STAGE(PG8_SA(1, 0), cur.A + kstep, OA(0)); PG8_STAGE(PG8_SB(1, 1), cur.B + kstep + hB, offB);
    PG8_WAIT_V(6); PG8_BAR;
    for (;;) {
        const bool has_next = S.next(ui + 1, nxt);
        const int nt = cur.K / BK;
        for (int t = 0; t < nt; t += 2) {
            const bool last = (t == nt - 2);
            const char* a1 = cur.A + (size_t)(t + 1) * kstep;
            PG8_LDB(B0, 0, 0); PG8_SCHED; PG8_LDA(At, 0, 0); PG8_STAGE(PG8_SA(1, 1), a1 + hA, OA(1));
            PG8_WAIT_L(8); PG8_BAR; PG8_WAIT_L(0); PG8_MMA(0, 0, At, B0); PG8_BAR; PG8_SCHED;
            const char* a2; const char* b2;
            if (last) { if (has_next) { unit_off<Epi::PERM, GATHER>(nxt, tid, offA, offB); a2 = nxt.A; b2 = nxt.B; hA = GATHER ? 0 : (size_t)HALF * nxt.lda; hB = (size_t)HALF * nxt.ldb; } else { a2 = cur.A; b2 = cur.B; } }
            else { a2 = cur.A + (size_t)(t + 2) * kstep; b2 = cur.B + (size_t)(t + 2) * kstep; }
            const char* a3 = a2 + kstep; const char* b3 = b2 + kstep;
            PG8_LDB(B1, 0, 1); PG8_STAGE(PG8_SB(0, 0), b2, offB);
            PG8_BAR; PG8_WAIT_L(0); PG8_MMA(0, 1, At, B1); PG8_BAR;
            PG8_LDA(At, 0, 1); PG8_STAGE(PG8_SA(0, 0), a2, OA(0));
            PG8_BAR; PG8_WAIT_L(0); PG8_MMA(1, 0, At, B0); PG8_BAR; PG8_SCHED;
            PG8_STAGE(PG8_SB(0, 1), b2 + hB, offB);
            PG8_WAIT_V(6); PG8_BAR; PG8_MMA(1, 1, At, B1); PG8_BAR;
            PG8_LDB(B0, 1, 0); PG8_SCHED; PG8_LDA(At, 1, 0); PG8_STAGE(PG8_SA(0, 1), a2 + hA, OA(1));
            PG8_WAIT_L(8); PG8_BAR; PG8_WAIT_L(0); PG8_MMA(0, 0, At, B0); PG8_BAR; PG8_SCHED;
            PG8_LDB(B1, 1, 1); PG8_STAGE(PG8_SB(1, 0), b3, offB);
            PG8_BAR; PG8_WAIT_L(0); PG8_MMA(0, 1, At, B1); PG8_BAR;
            PG8_LDA(At, 1, 1); PG8_STAGE(PG8_SA(1, 0), a3, OA(0));
            PG8_BAR; PG8_WAIT_L(0); PG8_MMA(1, 0, At, B0); PG8_BAR; PG8_SCHED;
            PG8_STAGE(PG8_SB(1, 1), b3 + hB, offB);
            PG8_WAIT_V(6); PG8_BAR; PG8_MMA(1, 1, At, B1); PG8_BAR;
        }
        { int fr_ = fr, fq_ = fq; asm volatile("" : "+v"(fr_), "+v"(fq_)); E(acc, cur, wr, wc, fr_, fq_); }
        if (!has_next) break;
#pragma unroll
        for (int a = 0; a < 2; ++a)
#pragma unroll
            for (int b = 0; b < 2; ++b)
#pragma unroll
                for (int m = 0; m < 4; ++m)
#pragma unroll
                    for (int n = 0; n < 2; ++n) acc[a][b][m][n] = (f32x4){0.f, 0.f, 0.f, 0.f};
        cur = nxt; ++ui;
    }
    PG8_WAIT_V(0);
    if (wr == 0) PG8_BAR;
    PG8_BAR;
#undef OA
#undef PG8_SA
#undef PG8_SB
#undef PG8_STAGE
#undef PG8_LDA
#undef PG8_LDB
#undef PG8_MMA
#undef PG8_WAIT_V
#undef PG8_WAIT_L
#undef PG8_BAR
#undef PG8_SCHED
}
}
struct Args { const float* in[19]; float* out; unsigned char* ws; int step_lo, step_hi; };
struct Frame {
    LAS unsigned char* lds; unsigned char* ldsg;
    int tid, lane, wave, G, bid;
    const float *x, *c, *ada_w, *ada_b, *w_in, *conv_w, *gate_b, *norm_g, *w_bm, *w_ba, *w_out, *router_w, *router_b, *w_gate, *w_up, *w_down, *g_mix, *g_ffn, *g_fin;
    float* out; unsigned char* ws; unsigned* ctl;
    float* MOD; float* WIF; float* RW; unsigned char* W;
    bf16_t* U; float* GIF; bf16_t* HM; bf16_t* HA; unsigned char* TOKI; unsigned char* R0;
};
#define CAS __attribute__((address_space(4)))
DI const void* karg(int idx) { asm volatile("" : "+s"(idx)); const void* const CAS* kp = (const void* const CAS*)__builtin_amdgcn_kernarg_segment_ptr(); return kp[idx]; }
DI void frame_init(Frame& F, unsigned char* lds_generic, int tid) {
    F.ldsg = lds_generic; F.lds = (LAS unsigned char*)lds_generic;
    F.tid = tid; F.lane = F.tid & 63; F.wave = __builtin_amdgcn_readfirstlane(F.tid >> 6); F.G = gridDim.x; F.bid = blockIdx.x;
    F.x = (const float*)karg(0); F.c = (const float*)karg(1); F.ada_w = (const float*)karg(2); F.ada_b = (const float*)karg(3); F.w_in = (const float*)karg(4); F.conv_w = (const float*)karg(5);
    F.gate_b = (const float*)karg(6); F.norm_g = (const float*)karg(7); F.w_bm = (const float*)karg(8); F.w_ba = (const float*)karg(9); F.w_out = (const float*)karg(10); F.router_w = (const float*)karg(11);
    F.router_b = (const float*)karg(12); F.w_gate = (const float*)karg(13); F.w_up = (const float*)karg(14); F.w_down = (const float*)karg(15); F.g_mix = (const float*)karg(16); F.g_ffn = (const float*)karg(17); F.g_fin = (const float*)karg(18);
    F.out = (float*)karg(19); unsigned char* ws = (unsigned char*)karg(20);
    F.ws = ws; F.ctl = (unsigned*)(ws + WS_CTL);
    F.MOD = (float*)(ws + WS_MOD); F.WIF = (float*)(ws + WS_WIF); F.RW = (float*)(ws + WS_RW); F.W = ws + WS_W;
    F.U = (bf16_t*)(ws + WS_U); F.GIF = (float*)(ws + WS_GIF); F.HM = (bf16_t*)(ws + WS_HM); F.HA = (bf16_t*)(ws + WS_HA);
    F.TOKI = ws + WS_TOKI; F.R0 = ws + WS_R0;
}

struct TJob { const float* src; int ld; int K; int N; bf16_t* dst; int rmul, radd; };
DI bool get_job(const Frame& F, int l, int j, TJob& J) {
    const float* win = F.w_in + (size_t)l * DM * INC;
    bf16_t* W = (bf16_t*)F.W;
    J.rmul = 1; J.radd = 0; J.K = 1024; J.ld = INC;
    if (j == 0) { J.src = win + 0;    J.N = 1024; J.dst = W + W_NAT / 2 + (size_t)0 * 1024; return true; }
    if (j == 1) { J.src = win + 1024; J.N = 1024; J.dst = W + W_NAT / 2 + (size_t)1024 * 1024; return true; }
    if (j == 2) { J.src = win + 3072; J.N = 1024; J.dst = W + W_NAT / 2 + (size_t)2048 * 1024; return true; }
    if (j == 3) { J.src = win + 4104; J.N = 1536; J.dst = W + W_NAT / 2 + (size_t)3072 * 1024; return true; }
    if (j == 4) { J.src = win + 5640; J.N = 1536; J.dst = W + W_NAT / 2 + (size_t)4608 * 1024; return true; }
    if (j == 5) { J.src = win + 2048; J.N = 1024; J.dst = W + W_VT / 2 + (size_t)0 * 1024; return true; }
    if (j == 6) { J.src = win + 7176; J.N = 1536; J.dst = W + W_VT / 2 + (size_t)1024 * 1024; return true; }
    if (j == 7) { J.src = win + 8712; J.N = 2048; J.dst = W + W_G / 2; return true; }
    if (j == 8) { J.src = F.w_bm + (size_t)l * 1024 * 1024; J.ld = 1024; J.N = 1024; J.dst = W + W_M / 2; return true; }
    if (j == 9) { J.src = F.w_ba + (size_t)l * 512 * 1024; J.ld = 1024; J.K = 512; J.N = 1024; J.dst = W + W_A / 2; return true; }
    if (j == 10) { J.src = F.w_out + (size_t)l * 1024 * 1024; J.ld = 1024; J.N = 1024; J.dst = W + W_O / 2; return true; }
    const int q = j - 11; if (q >= 48) return false;
    const int e = q / 3, which = q % 3;
    if (which == 0) { J.src = F.w_gate + ((size_t)l * 16 + e) * 1024 * 512; J.ld = 512; J.N = 512; J.dst = W + W_13 / 2 + (size_t)e * 1024 * 1024; J.rmul = 2; J.radd = 0; }
    else if (which == 1) { J.src = F.w_up + ((size_t)l * 16 + e) * 1024 * 512; J.ld = 512; J.N = 512; J.dst = W + W_13 / 2 + (size_t)e * 1024 * 1024; J.rmul = 2; J.radd = 1; }
    else { J.src = F.w_down + ((size_t)l * 16 + e) * 512 * 1024; J.ld = 1024; J.K = 512; J.N = 1024; J.dst = W + W_2 / 2 + (size_t)e * 1024 * 512; }
    return true;
}
constexpr int NJOBS = 59;
struct TIter { int j, t, nk, ntile; TJob J; };
DI bool titer_seek(const Frame& F, int l, TIter& it, int adv) {
    it.t += adv;
    while (it.t >= it.ntile) { it.t -= it.ntile; ++it.j; if (it.j >= NJOBS) return false; get_job(F, l, it.j, it.J); it.nk = it.J.K / 128; it.ntile = it.nk * (it.J.N / 64); }
    return true;
}
DI void tconv_load(const TIter& it, int tid, f32x4 (&v)[4]) {
    const int tk = it.t % it.nk, tn = it.t / it.nk;
#pragma unroll
    for (int i = 0; i < 4; ++i) { const int row = (tid >> 4) + 32 * i, c4 = tid & 15; v[i] = *(const f32x4*)(it.J.src + (size_t)(tk * 128 + row) * it.J.ld + tn * 64 + c4 * 4); }
}
DI void phase_pw(const Frame& F, int l, int b0, int nb) {
    const int me = F.bid - b0; if (me < 0 || me >= nb) return;
    bf16_t* tl = (bf16_t*)F.ldsg;
    const int tid = F.tid;
    TIter it; it.j = 0; it.t = 0; get_job(F, l, 0, it.J); it.nk = it.J.K / 128; it.ntile = it.nk * (it.J.N / 64);
    bool ok = titer_seek(F, l, it, me);
    f32x4 v[4];
    if (ok) tconv_load(it, tid, v);
    while (ok) {
        const int tk = it.t % it.nk, tn = it.t / it.nk; bf16_t* dst = it.J.dst; const int dK = it.J.K, rmul = it.J.rmul, radd = it.J.radd;
#pragma unroll
        for (int i = 0; i < 4; ++i) {
            const int row = (tid >> 4) + 32 * i, c4 = tid & 15;
            const unsigned lo = pack2(v[i][0], v[i][1]), hi = pack2(v[i][2], v[i][3]);
            tl[(c4 * 4 + 0) * 136 + row] = (bf16_t)(lo & 0xffff); tl[(c4 * 4 + 1) * 136 + row] = (bf16_t)(lo >> 16);
            tl[(c4 * 4 + 2) * 136 + row] = (bf16_t)(hi & 0xffff); tl[(c4 * 4 + 3) * 136 + row] = (bf16_t)(hi >> 16);
        }
        ok = titer_seek(F, l, it, nb);
        if (ok) tconv_load(it, tid, v);
        __syncthreads();
#pragma unroll
        for (int i = 0; i < 2; ++i) { const int p = tid + 512 * i, n = p >> 4, k8 = p & 15;
            const u32x4 o = *(const u32x4*)(tl + n * 136 + k8 * 8);
            *(u32x4*)(dst + (size_t)(rmul * (tn * 64 + n) + radd) * dK + tk * 128 + k8 * 8) = o; }
        __syncthreads();
    }
}
DI void phase_p0_small(const Frame& F) {
    float* sc = (float*)F.ldsg;
    float* part = sc + 4096;
    for (int i = F.tid; i < 4096; i += 512) sc[i] = siluf_(F.c[i]);
    __syncthreads();
    for (int it = F.bid; it < 192; it += F.G) {
        const int l = it / 96, cc = it % 96, col = cc * 64 + F.lane, w = F.wave;
        const float* aw = F.ada_w + (size_t)l * 1024 * 6144 + col;
        float a0 = 0.f, a1 = 0.f, a2 = 0.f, a3 = 0.f;
        for (int k = w * 128; k < w * 128 + 128; ++k) { const float wv = aw[(size_t)k * 6144]; a0 += sc[k] * wv; a1 += sc[1024 + k] * wv; a2 += sc[2048 + k] * wv; a3 += sc[3072 + k] * wv; }
        part[(w * 4 + 0) * 64 + F.lane] = a0; part[(w * 4 + 1) * 64 + F.lane] = a1; part[(w * 4 + 2) * 64 + F.lane] = a2; part[(w * 4 + 3) * 64 + F.lane] = a3;
        __syncthreads();
        if (F.tid < 256) { const int b = F.tid >> 6, ln = F.tid & 63; float s = 0.f;
            for (int ww = 0; ww < 8; ++ww) s += part[(ww * 4 + b) * 64 + ln];
            F.MOD[((size_t)l * 4 + b) * 6144 + cc * 64 + ln] = s + F.ada_b[(size_t)l * 6144 + cc * 64 + ln]; }
        __syncthreads();
    }
    for (int i = F.bid * 512 + F.tid; i < 2 * 8 * 1024 + 16 * 1024; i += F.G * 512) {
        if (i < 16384) { const int l = i >> 13, j = (i >> 10) & 7, k = i & 1023; F.WIF[i] = F.w_in[((size_t)l * 1024 + k) * INC + 4096 + j]; }
        else { const int q = i - 16384, e = q >> 10, k = q & 1023; F.RW[q] = F.router_w[k * 16 + e]; }
    }
}

DI void moe_offsets(const unsigned* cnt, int* pre, int tid) { if (tid == 0) { int s = 0; for (int e = 0; e < 16; ++e) { pre[e] = s; s += ((int)cnt[e] + 255) >> 8; } pre[16] = s; } }

struct RowRaw { f32x4 x[4]; u32x2 y1[4], y2[4]; float w1, w2; };
template <bool MOE>
DI void row_issue(const Frame& F, const float* xsrc, int t, int rl, const int* tokiL, const int* pre, RowRaw& r) {
#pragma unroll
    for (int q = 0; q < 4; ++q) r.x[q] = *(const f32x4*)(xsrc + (size_t)t * 1024 + F.lane * 4 + 256 * q);
    if (MOE) {
        const int* ti = tokiL + rl * 8;
        const int e1 = ti[0], s1 = ti[1], e2 = ti[2], s2 = ti[3]; r.w1 = __int_as_float(ti[4]); r.w2 = __int_as_float(ti[5]);
        const bf16_t* YS = (const bf16_t*)(F.R0 + R_YS);
        const bf16_t* y1 = YS + (size_t)(pre[e1] * 256 + s1) * 1024; const bf16_t* y2 = YS + (size_t)(pre[e2] * 256 + s2) * 1024;
#pragma unroll
        for (int q = 0; q < 4; ++q) { r.y1[q] = *(const u32x2*)(y1 + F.lane * 4 + 256 * q); r.y2[q] = *(const u32x2*)(y2 + F.lane * 4 + 256 * q); }
    }
}
template <bool MOE>
DI void row_finish(const Frame& F, const RowRaw& r, const float* gt, float (&xv)[16]) {
#pragma unroll
    for (int q = 0; q < 4; ++q) { xv[q * 4] = r.x[q][0]; xv[q * 4 + 1] = r.x[q][1]; xv[q * 4 + 2] = r.x[q][2]; xv[q * 4 + 3] = r.x[q][3]; }
    if (MOE) {
#pragma unroll
        for (int q = 0; q < 4; ++q) { const f32x4 g = *(const f32x4*)(gt + F.lane * 4 + 256 * q); const u32x2 a = r.y1[q], d = r.y2[q];
            xv[q * 4 + 0] += g[0] * (r.w1 * bflo(a.x) + r.w2 * bflo(d.x)); xv[q * 4 + 1] += g[1] * (r.w1 * bfhi(a.x) + r.w2 * bfhi(d.x));
            xv[q * 4 + 2] += g[2] * (r.w1 * bflo(a.y) + r.w2 * bflo(d.y)); xv[q * 4 + 3] += g[3] * (r.w1 * bfhi(a.y) + r.w2 * bfhi(d.y)); }
    }
}
DI float reduce16(float (&v)[16], int lane) {
    const bool b5 = lane & 32, b4 = lane & 16, b3 = lane & 8, b2 = lane & 4;
    float a[8], b[4], c[2];
#pragma unroll
    for (int i = 0; i < 8; ++i) { const float send = b5 ? v[i] : v[8 + i], mine = b5 ? v[8 + i] : v[i]; a[i] = mine + __shfl_xor(send, 32); }
#pragma unroll
    for (int i = 0; i < 4; ++i) { const float send = b4 ? a[i] : a[4 + i], mine = b4 ? a[4 + i] : a[i]; b[i] = mine + __shfl_xor(send, 16); }
#pragma unroll
    for (int i = 0; i < 2; ++i) { const float send = b3 ? b[i] : b[2 + i], mine = b3 ? b[2 + i] : b[i]; c[i] = mine + __shfl_xor(send, 8); }
    float r = (b2 ? c[1] : c[0]) + __shfl_xor(b2 ? c[0] : c[1], 4);
    r += __shfl_xor(r, 2); r += __shfl_xor(r, 1);
    return r;
}
DI float reduce8(float (&v)[8], int lane) {
    const bool b5 = lane & 32, b4 = lane & 16, b3 = lane & 8;
    float a[4], b[2];
#pragma unroll
    for (int i = 0; i < 4; ++i) { const float send = b5 ? v[i] : v[4 + i], mine = b5 ? v[4 + i] : v[i]; a[i] = mine + __shfl_xor(send, 32); }
#pragma unroll
    for (int i = 0; i < 2; ++i) { const float send = b4 ? a[i] : a[2 + i], mine = b4 ? a[2 + i] : a[i]; b[i] = mine + __shfl_xor(send, 16); }
    float r = (b3 ? b[1] : b[0]) + __shfl_xor(b3 ? b[0] : b[1], 8);
    r += __shfl_xor(r, 4); r += __shfl_xor(r, 2); r += __shfl_xor(r, 1);
    return r;
}
struct RowCtx { float gm[16], sh[16]; };
DI void load_rowconst(const Frame& F, const float* g, const float* shv, const float* scv, RowCtx& rc) {
#pragma unroll
    for (int q = 0; q < 4; ++q) { const int c = F.lane * 4 + 256 * q; const f32x4 gv = *(const f32x4*)(g + c), s1 = *(const f32x4*)(scv + c), s0 = *(const f32x4*)(shv + c);
#pragma unroll
        for (int j = 0; j < 4; ++j) { rc.gm[q * 4 + j] = gv[j] * (1.0f + s1[j]); rc.sh[q * 4 + j] = s0[j]; } }
}
DI void stage_toki(const Frame& F, int lprev, int blk, int* tokiL) {
    const int* src = (const int*)(F.TOKI + ((size_t)lprev * T_TOK + (size_t)blk * 128) * 32);
    for (int i = F.tid; i < 1024; i += 512) tokiL[i] = src[i];
}

template <bool MOE>
DI void phase_n1_t(const Frame& F, int l) {
    float* wif = (float*)F.ldsg;
    int* pre = (int*)(F.ldsg + 32768);
    int* tokiL = (int*)(F.ldsg + 32768 + 128);
    for (int i = F.tid; i < 8192; i += 512) wif[i] = F.WIF[(size_t)l * 8192 + i];
    if (MOE) moe_offsets(F.ctl + CW_CNT + 64 * (l - 1), pre, F.tid);
    __syncthreads();
    const float* xsrc = MOE ? F.out : F.x;
    for (int blk = F.bid; blk < T_TOK / 128; blk += F.G) {
        const int b = blk / (SEQ / 128);
        const float* mod = F.MOD + ((size_t)l * 4 + b) * 6144;
        const float* gt = F.MOD + ((size_t)(MOE ? l - 1 : 0) * 4 + b) * 6144 + 5120;
        RowCtx rc; load_rowconst(F, F.g_mix + (size_t)l * 1024, mod, mod + 1024, rc);
        if (MOE) { __syncthreads(); stage_toki(F, l - 1, blk, tokiL); __syncthreads(); }
        RowRaw nx0, nx1; row_issue<MOE>(F, xsrc, blk * 128 + F.wave * 16, F.wave * 16, tokiL, pre, nx0); row_issue<MOE>(F, xsrc, blk * 128 + F.wave * 16 + 1, F.wave * 16 + 1, tokiL, pre, nx1);
#pragma unroll 1
        for (int i = 0; i < 16; i += 2) {
            const int rl = F.wave * 16 + i, t = blk * 128 + rl;
            asm volatile("" ::: "memory");
            const RowRaw c0 = nx0, c1 = nx1;
            if (i < 14) { row_issue<MOE>(F, xsrc, t + 2, rl + 2, tokiL, pre, nx0); row_issue<MOE>(F, xsrc, t + 3, rl + 3, tokiL, pre, nx1); }
            float xa[16], xb[16]; row_finish<MOE>(F, c0, gt, xa); row_finish<MOE>(F, c1, gt, xb);
            if (MOE) {
#pragma unroll
                for (int q = 0; q < 4; ++q) { *(f32x4*)(F.out + (size_t)t * 1024 + F.lane * 4 + 256 * q) = (f32x4){xa[q * 4], xa[q * 4 + 1], xa[q * 4 + 2], xa[q * 4 + 3]};
                    *(f32x4*)(F.out + (size_t)(t + 1) * 1024 + F.lane * 4 + 256 * q) = (f32x4){xb[q * 4], xb[q * 4 + 1], xb[q * 4 + 2], xb[q * 4 + 3]}; }
            }
            float sa = 0.f, sb = 0.f;
#pragma unroll
            for (int j = 0; j < 16; ++j) { sa += xa[j] * xa[j]; sb += xb[j] * xb[j]; }
            sa = wave_sum(sa); sb = wave_sum(sb);
            const float ra = __builtin_amdgcn_rsqf(sa * (1.0f / 1024.0f) + EPS), rb = __builtin_amdgcn_rsqf(sb * (1.0f / 1024.0f) + EPS);
#pragma unroll
            for (int j = 0; j < 16; ++j) { xa[j] = xa[j] * ra * rc.gm[j] + rc.sh[j]; xb[j] = xb[j] * rb * rc.gm[j] + rc.sh[j]; }
#pragma unroll
            for (int q = 0; q < 4; ++q) { u32x2 w; w.x = pack2(xa[q * 4], xa[q * 4 + 1]); w.y = pack2(xa[q * 4 + 2], xa[q * 4 + 3]); *(u32x2*)(F.U + (size_t)t * 1024 + F.lane * 4 + 256 * q) = w;
                w.x = pack2(xb[q * 4], xb[q * 4 + 1]); w.y = pack2(xb[q * 4 + 2], xb[q * 4 + 3]); *(u32x2*)(F.U + (size_t)(t + 1) * 1024 + F.lane * 4 + 256 * q) = w; }
            float da[8], db[8];
#pragma unroll
            for (int g = 0; g < 8; ++g) { float s0 = 0.f, s1 = 0.f;
#pragma unroll
                for (int q = 0; q < 4; ++q) { const f32x4 wv = *(const f32x4*)(wif + g * 1024 + F.lane * 4 + 256 * q);
                    s0 += xa[q * 4] * wv[0] + xa[q * 4 + 1] * wv[1] + xa[q * 4 + 2] * wv[2] + xa[q * 4 + 3] * wv[3];
                    s1 += xb[q * 4] * wv[0] + xb[q * 4 + 1] * wv[1] + xb[q * 4 + 2] * wv[2] + xb[q * 4 + 3] * wv[3]; }
                da[g] = s0; db[g] = s1; }
            const float reda = reduce8(da, F.lane), redb = reduce8(db, F.lane);
            const float ma = __shfl(reda, (F.lane & 7) * 8), mb = __shfl(redb, (F.lane & 7) * 8);
            if (F.lane < 16) {
                const int gl = F.lane & 7; float v = (F.lane < 8) ? ma : mb;
                v += F.gate_b[l * 8 + gl];
                if (gl >= 4) { const float e = __expf(-fabsf(v)); const float l1p = (e < 0.03f) ? e * (1.0f - e * (0.5f - e * (0.33333334f - 0.25f * e))) : __logf(1.0f + e); v = fminf(v, 0.f) - l1p; }
                F.GIF[(size_t)t * 8 + F.lane] = v;
            }
        }
    }
}
DI void phase_n1(const Frame& F, int l) { if (l == 0) phase_n1_t<false>(F, 0); else phase_n1_t<true>(F, l); }

DI void phase_n2(const Frame& F, int l) {
    float* rw = (float*)F.ldsg;
    int* cntL = (int*)(F.ldsg + 65536);
    int* baseL = cntL + 16;
    int* rec = baseL + 16;
    for (int i = F.tid; i < 16384; i += 512) rw[i] = F.RW[i];
    __syncthreads();
    unsigned* gcnt = F.ctl + CW_CNT + 64 * l;
    int* SLOT = (int*)(F.R0 + R_SLOT);
    for (int blk = F.bid; blk < T_TOK / 128; blk += F.G) {
        const int b = blk / (SEQ / 128);
        const float* mod = F.MOD + ((size_t)l * 4 + b) * 6144;
        RowCtx rc; load_rowconst(F, F.g_ffn + (size_t)l * 1024, mod + 3072, mod + 4096, rc);
        if (F.tid < 16) cntL[F.tid] = 0;
        __syncthreads();
        RowRaw nx0, nx1, fx0, fx1;
        row_issue<false>(F, F.out, blk * 128 + F.wave * 16, 0, nullptr, nullptr, nx0); row_issue<false>(F, F.out, blk * 128 + F.wave * 16 + 1, 0, nullptr, nullptr, nx1);
        row_issue<false>(F, F.out, blk * 128 + F.wave * 16 + 2, 0, nullptr, nullptr, fx0); row_issue<false>(F, F.out, blk * 128 + F.wave * 16 + 3, 0, nullptr, nullptr, fx1);
#pragma unroll 1
        for (int i = 0; i < 16; i += 2) {
            const int rl = F.wave * 16 + i, t = blk * 128 + rl;
            asm volatile("" ::: "memory");
            const RowRaw c0 = nx0, c1 = nx1; nx0 = fx0; nx1 = fx1;
            if (i < 12) { row_issue<false>(F, F.out, t + 4, 0, nullptr, nullptr, fx0); row_issue<false>(F, F.out, t + 5, 0, nullptr, nullptr, fx1); }
            float xa[16], xb[16]; row_finish<false>(F, c0, nullptr, xa); row_finish<false>(F, c1, nullptr, xb);
            float sa = 0.f, sb = 0.f;
#pragma unroll
            for (int j = 0; j < 16; ++j) { sa += xa[j] * xa[j]; sb += xb[j] * xb[j]; }
            sa = wave_sum(sa); sb = wave_sum(sb);
            const float ra = __builtin_amdgcn_rsqf(sa * (1.0f / 1024.0f) + EPS), rb = __builtin_amdgcn_rsqf(sb * (1.0f / 1024.0f) + EPS);
#pragma unroll
            for (int j = 0; j < 16; ++j) { xa[j] = xa[j] * ra * rc.gm[j] + rc.sh[j]; xb[j] = xb[j] * rb * rc.gm[j] + rc.sh[j]; }
#pragma unroll
            for (int q = 0; q < 4; ++q) { u32x2 w; w.x = pack2(xa[q * 4], xa[q * 4 + 1]); w.y = pack2(xa[q * 4 + 2], xa[q * 4 + 3]); *(u32x2*)(F.U + (size_t)t * 1024 + F.lane * 4 + 256 * q) = w;
                w.x = pack2(xb[q * 4], xb[q * 4 + 1]); w.y = pack2(xb[q * 4 + 2], xb[q * 4 + 3]); *(u32x2*)(F.U + (size_t)(t + 1) * 1024 + F.lane * 4 + 256 * q) = w; }
            float la[16], lb[16];
#pragma unroll
            for (int e = 0; e < 16; ++e) { float s0 = 0.f, s1 = 0.f;
#pragma unroll
                for (int q = 0; q < 4; ++q) { const f32x4 wv = *(const f32x4*)(rw + e * 1024 + F.lane * 4 + 256 * q);
                    s0 += xa[q * 4] * wv[0] + xa[q * 4 + 1] * wv[1] + xa[q * 4 + 2] * wv[2] + xa[q * 4 + 3] * wv[3];
                    s1 += xb[q * 4] * wv[0] + xb[q * 4 + 1] * wv[1] + xb[q * 4 + 2] * wv[2] + xb[q * 4 + 3] * wv[3]; }
                la[e] = s0; lb[e] = s1; }
            const float reda = reduce16(la, F.lane), redb = reduce16(lb, F.lane);
            const float ma = __shfl(reda, (F.lane & 15) * 4), mb = __shfl(redb, (F.lane & 15) * 4);
            const int base = F.lane & 16;
            const float mine = base ? mb : ma;
            const float score = 1.0f / (1.0f + __expf(-mine));
            const float sel = score + F.router_b[F.lane & 15];
            const float s0 = __shfl(sel, (F.lane & ~3) + 0), s1 = __shfl(sel, (F.lane & ~3) + 1), s2 = __shfl(sel, (F.lane & ~3) + 2), s3 = __shfl(sel, (F.lane & ~3) + 3);
            const float mx = fmaxf(fmaxf(s0, s1), fmaxf(s2, s3));
            const int im = (s0 == mx) ? 0 : (s1 == mx) ? 1 : (s2 == mx) ? 2 : 3;
            const float t0 = (im == 0) ? -INFINITY : s0, t1 = (im == 1) ? -INFINITY : s1, t2 = (im == 2) ? -INFINITY : s2, t3 = (im == 3) ? -INFINITY : s3;
            const float mx2 = fmaxf(fmaxf(t0, t1), fmaxf(t2, t3));
            const int im2 = (t0 == mx2) ? 0 : (t1 == mx2) ? 1 : (t2 == mx2) ? 2 : 3;
            const float gs = mx + mx2;
            const float g0 = __shfl(gs, base + 0), g1 = __shfl(gs, base + 4), g2 = __shfl(gs, base + 8), g3 = __shfl(gs, base + 12);
            const float gm = fmaxf(fmaxf(g0, g1), fmaxf(g2, g3));
            const int bg = (g0 == gm) ? 0 : (g1 == gm) ? 1 : (g2 == gm) ? 2 : 3;
            const int e1 = __shfl(bg * 4 + im, base + bg * 4), e2 = __shfl(bg * 4 + im2, base + bg * 4);
            const float sc1 = __shfl(score, base + e1), sc2 = __shfl(score, base + e2);
            if (F.lane == 0 || F.lane == 16) {
                const int rr = rl + (F.lane >> 4);
                const float inv = 1.0f / (sc1 + sc2);
                const int r1 = atomicAdd(&cntL[e1], 1), r2 = atomicAdd(&cntL[e2], 1);
                int* r = rec + rr * 6; r[0] = e1; r[1] = r1; r[2] = e2; r[3] = r2; r[4] = __float_as_int(sc1 * inv); r[5] = __float_as_int(sc2 * inv);
            }
        }
        __syncthreads();
        if (F.tid < 16) baseL[F.tid] = (int)atomicAdd(&gcnt[F.tid], (unsigned)cntL[F.tid]);
        __syncthreads();
        if (F.tid < 128) {
            const int t = blk * 128 + F.tid; const int* r = rec + F.tid * 6;
            const int e1 = r[0], s1 = baseL[e1] + r[1], e2 = r[2], s2 = baseL[e2] + r[3];
            SLOT[e1 * 32768 + s1] = t; SLOT[e2 * 32768 + s2] = t;
            int* ti = (int*)(F.TOKI + ((size_t)l * T_TOK + t) * 32);
            ti[0] = e1; ti[1] = s1; ti[2] = e2; ti[3] = s2; ti[4] = r[4]; ti[5] = r[5];
        }
        __syncthreads();
    }
}

DI void phase_fn(const Frame& F) {
    int* pre = (int*)F.ldsg;
    int* tokiL = (int*)(F.ldsg + 128);
    moe_offsets(F.ctl + CW_CNT + 64 * (DEPTH - 1), pre, F.tid);
    __syncthreads();
    for (int blk = F.bid; blk < T_TOK / 128; blk += F.G) {
        const int b = blk / (SEQ / 128);
        const float* gt = F.MOD + ((size_t)(DEPTH - 1) * 4 + b) * 6144 + 5120;
        __syncthreads(); stage_toki(F, DEPTH - 1, blk, tokiL); __syncthreads();
        RowRaw nx; row_issue<true>(F, F.out, blk * 128 + F.wave * 16, F.wave * 16, tokiL, pre, nx);
#pragma unroll 1
        for (int i = 0; i < 16; ++i) {
            const int rl = F.wave * 16 + i, t = blk * 128 + rl;
            const RowRaw cur = nx;
            if (i < 15) row_issue<true>(F, F.out, t + 1, rl + 1, tokiL, pre, nx);
            float xv[16]; row_finish<true>(F, cur, gt, xv);
            float ss = 0.f;
#pragma unroll
            for (int j = 0; j < 16; ++j) ss += xv[j] * xv[j];
            ss = wave_sum(ss);
            const float rn = __builtin_amdgcn_rsqf(ss * (1.0f / 1024.0f) + EPS);
#pragma unroll
            for (int q = 0; q < 4; ++q) { const f32x4 g = *(const f32x4*)(F.g_fin + F.lane * 4 + 256 * q);
                *(f32x4*)(F.out + (size_t)t * 1024 + F.lane * 4 + 256 * q) = (f32x4){xv[q * 4] * rn * g[0], xv[q * 4 + 1] * rn * g[1], xv[q * 4 + 2] * rn * g[2], xv[q * 4 + 3] * rn * g[3]}; }
        }
    }
}
DI void ml1_unit(const Frame& F, int l, int h, int j, int eg) {
    const bf16_t* P = (const bf16_t*)(F.R0 + R_P); bf16_t* QC = (bf16_t*)(F.R0 + R_QC);
    const bf16_t* VT = (const bf16_t*)(F.R0 + R_VT);
    bf16_t* NUM = (bf16_t*)(F.R0 + R_NUM); bf16_t* SLOC = (bf16_t*)(F.R0 + R_SLOC);
    float* DENI = (float*)(F.R0 + R_DENI); float* EBC = (float*)(F.R0 + R_EBC); float* EBL = (float*)(F.R0 + R_EBL);
    float* SCB = (float*)(F.R0 + R_SCB); float* CHB = (float*)(F.R0 + R_CHB); float* DN = (float*)(F.R0 + R_DN);
    const int tid = F.tid, lane = F.lane, w = F.wave, rr = lane & 31, hh = lane >> 5;
    const int tl0 = j * 256;
    const size_t tg0 = (size_t)eg * TQ + tl0;
    LAS unsigned char* L = F.lds;
    LAS bf16_t* Sl = (LAS bf16_t*)L;
    LAS float* Lb = (LAS float*)(L + 9216);
    LAS float* Lg = Lb + 256;
    LAS float* Lws = Lg + 256;
    LAS float* Leb = Lws + 256;
    LAS float* Lden = Leb + 256;
    LAS float* Lbl = Lden + 256;
    LAS float* Wc = (LAS float*)(L + 14592);
    LAS bf16_t* Qs = (LAS bf16_t*)(L + 22784);
    LAS bf16_t* KTs = (LAS bf16_t*)(L + 56576);
    LAS bf16_t* Rw = (LAS bf16_t*)(L + 93440);
    for (int i = tid; i < 2048; i += 512) { const int which = i >> 10, jj = (i >> 8) & 3, ch = i & 255; Wc[i] = F.conv_w[((size_t)l * 4 + jj) * 2048 + which * 1024 + h * 256 + ch]; }
    if (w < 4) {
        const int c = w, t = c * 64 + lane;
        const float li = F.GIF[(tg0 + t) * 8 + h], lf = F.GIF[(tg0 + t) * 8 + 4 + h];
        float b = lf;
#pragma unroll
        for (int o = 1; o < 64; o <<= 1) { const float v = __shfl_up(b, o); if (lane >= o) b += v; }
        const float bl = __shfl(b, 63);
        Lb[t] = b; Lg[t] = li - b; Lws[t] = __expf(bl - b + li); Leb[t] = __expf(b); Lden[t] = 0.f;
        if (lane == 0) Lbl[c] = bl;
    }
    __syncthreads();
    if (tid < 256) {
        const int c = tid >> 6; float pre = 0.f;
        for (int cc = 0; cc < c; ++cc) pre += Lbl[cc];
        EBC[(size_t)(tl0 + tid) * 4 + h] = Leb[tid];
        EBL[(size_t)(tl0 + tid) * 4 + h] = __expf(Lb[tid] + pre);
        if (tid < 4) CHB[h * 128 + j * 4 + tid] = Lbl[tid];
        if (tid == 0) SCB[h * 32 + j] = Lbl[0] + Lbl[1] + Lbl[2] + Lbl[3];
    }
    f32x16 Ct[8];
#pragma unroll
    for (int i = 0; i < 8; ++i)
#pragma unroll
        for (int r = 0; r < 16; ++r) Ct[i][r] = 0.f;
    for (int c = 0; c < 4; ++c) {
        int rr_ = rr, hh_ = hh, tid_ = tid; asm volatile("" : "+v"(rr_), "+v"(hh_), "+v"(tid_));
        const bf16_t* vbase = VT + (size_t)(h * 256 + w * 32 + rr_) * TQ + tl0 + c * 64 + hh_ * 8;
        bf16x8 vf[4];
        const int t0c = tl0 + c * 64;
        u32x4 rk[5];
        { u32x4 rq[5];
#pragma unroll
          for (int i5 = 0; i5 < 5; ++i5) { const int i = tid_ + 512 * i5, r = i >> 5, pc = i & 31, t = t0c - 3 + r;
              rq[i5] = (u32x4){0u, 0u, 0u, 0u};
              if (i < 67 * 32 && t >= 0) rq[i5] = *(const u32x4*)(P + (size_t)t * NNAT + h * 256 + pc * 8); }
#pragma unroll
          for (int i5 = 0; i5 < 5; ++i5) { const int i = tid_ + 512 * i5, r = i >> 5, pc = i & 31; if (i < 67 * 32) *(LAS u32x4*)(Rw + r * 264 + pc * 8) = rq[i5]; } }
#pragma unroll
        for (int i5 = 0; i5 < 5; ++i5) { const int i = tid_ + 512 * i5, r = i >> 5, pc = i & 31, t = t0c - 3 + r;
            rk[i5] = (u32x4){0u, 0u, 0u, 0u};
            if (i < 67 * 32 && t >= 0) rk[i5] = *(const u32x4*)(P + (size_t)t * NNAT + 1024 + h * 256 + pc * 8); }
        __syncthreads();
        { const int cg = tid_ & 31;
#pragma unroll
          for (int i = 0; i < 4; ++i) { const int tr = (tid_ >> 5) + 16 * i;
              float y[8];
#pragma unroll
              for (int k = 0; k < 8; ++k) y[k] = 0.f;
#pragma unroll
              for (int jj = 0; jj < 4; ++jj) { const u32x4 v = *(const LAS u32x4*)(Rw + (tr + jj) * 264 + cg * 8);
                  const f32x4 wa = *(const LAS f32x4*)(Wc + jj * 256 + cg * 8), wb = *(const LAS f32x4*)(Wc + jj * 256 + cg * 8 + 4);
                  y[0] += wa[0] * bflo(v.x); y[1] += wa[1] * bfhi(v.x); y[2] += wa[2] * bflo(v.y); y[3] += wa[3] * bfhi(v.y);
                  y[4] += wb[0] * bflo(v.z); y[5] += wb[1] * bfhi(v.z); y[6] += wb[2] * bflo(v.w); y[7] += wb[3] * bfhi(v.w); }
#pragma unroll
              for (int k = 0; k < 8; ++k) y[k] = siluf_(y[k]) * 0.0625f;
              u32x4 o; o.x = pack2(y[0], y[1]); o.y = pack2(y[2], y[3]); o.z = pack2(y[4], y[5]); o.w = pack2(y[6], y[7]);
              *(LAS u32x4*)(Qs + tr * 264 + cg * 8) = o;
              *(u32x4*)(QC + (size_t)(t0c + tr) * 1024 + h * 256 + cg * 8) = o;
              asm volatile("" ::: "memory"); } }
        __syncthreads();
#pragma unroll
        for (int i5 = 0; i5 < 5; ++i5) { const int i = tid_ + 512 * i5, r = i >> 5, pc = i & 31; if (i < 67 * 32) *(LAS u32x4*)(Rw + r * 264 + pc * 8) = rk[i5]; }
        __syncthreads();
        { const int tr = tid_ & 63, wv = tid_ >> 6;
#pragma unroll
          for (int sub = 0; sub < 4; ++sub) { const int ch0 = wv * 32 + sub * 8;
              float y[8];
#pragma unroll
              for (int k = 0; k < 8; ++k) y[k] = 0.f;
#pragma unroll
              for (int jj = 0; jj < 4; ++jj) { const u32x4 v = *(const LAS u32x4*)(Rw + (tr + jj) * 264 + ch0);
                  const f32x4 wa = *(const LAS f32x4*)(Wc + 1024 + jj * 256 + ch0), wb = *(const LAS f32x4*)(Wc + 1024 + jj * 256 + ch0 + 4);
                  y[0] += wa[0] * bflo(v.x); y[1] += wa[1] * bfhi(v.x); y[2] += wa[2] * bflo(v.y); y[3] += wa[3] * bfhi(v.y);
                  y[4] += wb[0] * bflo(v.z); y[5] += wb[1] * bfhi(v.z); y[6] += wb[2] * bflo(v.w); y[7] += wb[3] * bfhi(v.w); }
#pragma unroll
              for (int k = 0; k < 8; k += 2) { const unsigned pk = pack2(siluf_(y[k]), siluf_(y[k + 1]));
                  KTs[(ch0 + k) * 72 + tr] = (bf16_t)(pk & 0xffff); KTs[(ch0 + k + 1) * 72 + tr] = (bf16_t)(pk >> 16); }
              asm volatile("" ::: "memory"); } }
        __syncthreads();
        if (w < 3) {
            const int ti = (w == 0) ? 0 : 1, si = (w == 2) ? 1 : 0;
            f32x16 acc;
#pragma unroll
            for (int r = 0; r < 16; ++r) acc[r] = 0.f;
            const LAS bf16_t* kcol = KTs + hh_ * 8 * 72 + si * 32 + rr_;
            const LAS bf16_t* qrow = Qs + (ti * 32 + rr_) * 264 + hh_ * 8;
#pragma unroll 1
            for (int ks = 0; ks < 16; ++ks) {
                unsigned short e[8];
#pragma unroll
                for (int jj = 0; jj < 8; ++jj) e[jj] = kcol[(ks * 16 + jj) * 72];
                u32x4 kp; kp.x = e[0] | ((unsigned)e[1] << 16); kp.y = e[2] | ((unsigned)e[3] << 16); kp.z = e[4] | ((unsigned)e[5] << 16); kp.w = e[6] | ((unsigned)e[7] << 16);
                acc = MFMA32(__builtin_bit_cast(bf16x8, kp), *(const LAS bf16x8*)(qrow + ks * 16), acc);
            }
            const int tloc = c * 64 + ti * 32 + rr; const float bt = Lb[tloc];
            float rs = 0.f;
#pragma unroll
            for (int g = 0; g < 4; ++g) {
                float v[4];
#pragma unroll
                for (int q = 0; q < 4; ++q) { const int r = g * 4 + q, sl = si * 32 + crow(r, hh);
                    float wgt = __expf(bt + Lg[c * 64 + sl]);
                    if (sl > ti * 32 + rr) wgt = 0.f;
                    v[q] = acc[r] * wgt; rs += v[q]; }
                u32x2 o; o.x = pack2(v[0], v[1]); o.y = pack2(v[2], v[3]);
                *(LAS u32x2*)(Sl + (ti * 32 + rr) * 72 + si * 32 + 8 * g + 4 * hh) = o;
            }
            rs += __shfl_xor(rs, 32);
            if (hh == 0) atomicAdd((float*)(F.ldsg + 9216 + 4 * 1024) + tloc, rs);
        } else if (w >= 4) {
            const int d = tid_ - 256;
            const LAS bf16_t* kt = KTs + d * 72; const LAS float* ws = Lws + c * 64;
            float s = 0.f;
#pragma unroll
            for (int o = 0; o < 8; ++o) { const u32x4 v = *(const LAS u32x4*)(kt + o * 8);
                s += bflo(v.x) * ws[o * 8] + bfhi(v.x) * ws[o * 8 + 1] + bflo(v.y) * ws[o * 8 + 2] + bfhi(v.y) * ws[o * 8 + 3] + bflo(v.z) * ws[o * 8 + 4] + bfhi(v.z) * ws[o * 8 + 5] + bflo(v.w) * ws[o * 8 + 6] + bfhi(v.w) * ws[o * 8 + 7]; }
            DN[((size_t)h * 128 + j * 4 + c) * 256 + d] = s;
        }
        __syncthreads();
        if (tid_ < 64) DENI[(size_t)(tl0 + c * 64 + tid_) * 4 + h] = Lden[c * 64 + tid_];
#pragma unroll
        for (int ks = 0; ks < 4; ++ks) vf[ks] = ldg8(vbase + ks * 16);
        f32x16 a0, a1;
#pragma unroll
        for (int r = 0; r < 16; ++r) { a0[r] = 0.f; a1[r] = 0.f; }
        const LAS bf16_t* q0 = Qs + rr_ * 264 + hh_ * 8; const LAS bf16_t* q1 = q0 + 32 * 264;
#pragma unroll
        for (int db = 0; db < 8; ++db)
#pragma unroll
            for (int s2 = 0; s2 < 2; ++s2) {
                const bf16x8 cf = packf8(Ct[db][8 * s2], Ct[db][8 * s2 + 1], Ct[db][8 * s2 + 2], Ct[db][8 * s2 + 3], Ct[db][8 * s2 + 4], Ct[db][8 * s2 + 5], Ct[db][8 * s2 + 6], Ct[db][8 * s2 + 7]);
                a0 = MFMA32(*(const LAS bf16x8*)(q0 + db * 32 + s2 * 16), cf, a0);
                a1 = MFMA32(*(const LAS bf16x8*)(q1 + db * 32 + s2 * 16), cf, a1);
                if (s2 == 1 && (db & 1)) asm volatile("" ::: "memory");
            }
#pragma unroll
        for (int r = 0; r < 16; ++r) { a0[r] *= Leb[c * 64 + crow(r, hh)]; a1[r] *= Leb[c * 64 + 32 + crow(r, hh)]; }
#pragma unroll
        for (int ks = 0; ks < 4; ++ks) {
            if (ks < 2) a0 = MFMA32(*(const LAS bf16x8*)(Sl + rr * 72 + ks * 16 + hh * 8), vf[ks], a0);
            a1 = MFMA32(*(const LAS bf16x8*)(Sl + (32 + rr) * 72 + ks * 16 + hh * 8), vf[ks], a1);
        }
        { bf16_t* np = NUM + (size_t)(tl0 + c * 64) * 1024 + h * 256 + w * 32 + rr_;
#pragma unroll
          for (int r = 0; r < 16; r += 2) { const unsigned p0 = pack2(a0[r], a0[r + 1]), p1 = pack2(a1[r], a1[r + 1]);
              np[(size_t)crow(r, hh) * 1024] = (bf16_t)(p0 & 0xffff); np[(size_t)crow(r + 1, hh) * 1024] = (bf16_t)(p0 >> 16);
              np[(size_t)(32 + crow(r, hh)) * 1024] = (bf16_t)(p1 & 0xffff); np[(size_t)(32 + crow(r + 1, hh)) * 1024] = (bf16_t)(p1 >> 16); } }
        const float dec = __expf(Lbl[c]);
#pragma unroll
        for (int ks = 0; ks < 4; ++ks) {
            const u32x4 v = __builtin_bit_cast(u32x4, vf[ks]); const LAS float* ws = Lws + c * 64 + ks * 16 + hh * 8;
            vf[ks] = packf8(bflo(v.x) * ws[0], bfhi(v.x) * ws[1], bflo(v.y) * ws[2], bfhi(v.y) * ws[3], bflo(v.z) * ws[4], bfhi(v.z) * ws[5], bflo(v.w) * ws[6], bfhi(v.w) * ws[7]);
        }
        const LAS bf16_t* ktb = KTs + pi23(rr_) * 72 + hh_ * 8;
#pragma unroll
        for (int db = 0; db < 8; ++db) {
#pragma unroll
            for (int r = 0; r < 16; ++r) Ct[db][r] *= dec;
#pragma unroll
            for (int ks = 0; ks < 4; ++ks) Ct[db] = MFMA32(*(const LAS bf16x8*)(ktb + db * 32 * 72 + ks * 16), vf[ks], Ct[db]);
            if (db & 1) asm volatile("" ::: "memory");
        }
        __syncthreads();
    }
    { int rr2 = rr, hh2 = hh; asm volatile("" : "+v"(rr2), "+v"(hh2));
      bf16_t* sp = SLOC + (((size_t)h * 32 + j) * 256 + w * 32 + rr2) * 256 + hh2 * 8;
#pragma unroll
      for (int db = 0; db < 8; ++db)
#pragma unroll
          for (int a = 0; a < 2; ++a) {
              u32x4 o; o.x = pack2(Ct[db][8 * a], Ct[db][8 * a + 1]); o.y = pack2(Ct[db][8 * a + 2], Ct[db][8 * a + 3]); o.z = pack2(Ct[db][8 * a + 4], Ct[db][8 * a + 5]); o.w = pack2(Ct[db][8 * a + 6], Ct[db][8 * a + 7]);
              *(u32x4*)(sp + db * 32 + a * 16) = o; } }
    __syncthreads();
}

DI void at_block_unit(const Frame& F, int bu_in) {
    int bu = bu_in; asm volatile("" : "+s"(bu));
    bf16_t* P = (bf16_t*)(F.R0 + R_P); const bf16_t* VT = (const bf16_t*)(F.R0 + R_VT); float* LSE = (float*)(F.R0 + R_LSE);
    int lane = F.lane, tid = F.tid; asm volatile("" : "+v"(lane), "+v"(tid));
    const int rr = lane & 31, hh = lane >> 5, w = F.wave;
    const int hd = bu >> 5, qb = bu & 31, g = hd >> 2;
    const int dsh = 2 * g, d = 1 << dsh, lsub = TQ >> dsh, bpr = lsub >> 8;
    const int r = qb / bpr, l0b = (qb % bpr) * 256, l0 = l0b + 32 * w;
    const float slope_d = exp2f(-8.0f * (float)(hd + 1) / 12.0f) * (float)d;
    LAS bf16_t* Ks = (LAS bf16_t*)F.lds;
    LAS bf16_t* Vs = (LAS bf16_t*)F.lds;
    {
        u32x4 st[12];
#pragma unroll
        for (int i = 0; i < 12; ++i) { const int p = tid + 512 * i, row = p >> 4, pc = p & 15; int l = l0b - 128 + row; l = l < 0 ? 0 : l;
            st[i] = *(const u32x4*)(P + (size_t)(l * d + r) * NNAT + 4608 + hd * 128 + pc * 8); }
#pragma unroll
        for (int i = 0; i < 12; ++i) { const int p = tid + 512 * i, row = p >> 4, pc = p & 15; *(LAS u32x4*)(Ks + row * 136 + pc * 8) = st[i]; }
    }
    bf16x8 qf[8];
    { const bf16_t* qp = P + (size_t)((l0 + rr) * d + r) * NNAT + 3072 + hd * 128 + hh * 64;
#pragma unroll
      for (int ks = 0; ks < 8; ++ks) qf[ks] = ldg8(qp + ks * 8); }
    __syncthreads();
    u32x4 vst[12];
#pragma unroll
    for (int i = 0; i < 12; ++i) { const int p = tid + 512 * i, ch = p / 48, pc = p % 48; int l = l0b - 128 + pc * 8; l = l < 0 ? 0 : l;
        vst[i] = *(const u32x4*)(VT + (size_t)(1024 + hd * 128 + ch) * TQ + r * lsub + l); }
    f32x16 sc[5];
    float mx = -1e30f;
    const int prr = pi23(rr);
#pragma unroll
    for (int kt = 0; kt < 5; ++kt) {
#pragma unroll
        for (int i = 0; i < 16; ++i) sc[kt][i] = 0.f;
        const LAS bf16_t* kp = Ks + (32 * (w + kt) + prr) * 136 + hh * 64;
#pragma unroll
        for (int ks = 0; ks < 8; ++ks) sc[kt] = MFMA32(*(const LAS bf16x8*)(kp + ks * 8), qf[ks], sc[kt]);
        const bool tile_ok = (l0 - 128 + 32 * kt) >= 0;
#pragma unroll
        for (int i = 0; i < 16; ++i) {
            const int kk = (i & 3) + 4 * ((i >> 2) & 1) + 8 * hh + 16 * (i >> 3);
            const int dist = 128 - 32 * kt + rr - kk;
            float s = sc[kt][i] - slope_d * (float)dist;
            s = (tile_ok && dist >= 0 && dist <= 128) ? s : -1e30f;
            sc[kt][i] = s; mx = fmaxf(mx, s);
        }
        asm volatile("" ::: "memory");
    }
    mx = fmaxf(mx, __shfl_xor(mx, 32));
    float sum = 0.f;
    bf16x8 pf[5][2];
#pragma unroll
    for (int kt = 0; kt < 5; ++kt) {
        float p[16];
#pragma unroll
        for (int i = 0; i < 16; ++i) { p[i] = __expf(sc[kt][i] - mx); sum += p[i]; }
        pf[kt][0] = packf8(p[0], p[1], p[2], p[3], p[4], p[5], p[6], p[7]);
        pf[kt][1] = packf8(p[8], p[9], p[10], p[11], p[12], p[13], p[14], p[15]);
    }
    sum += __shfl_xor(sum, 32);
    const float inv = 1.0f / sum;
    __syncthreads();
#pragma unroll
    for (int i = 0; i < 12; ++i) { const int p = tid + 512 * i, ch = p / 48, pc = p % 48; *(LAS u32x4*)(Vs + ch * 392 + pc * 8) = vst[i]; }
    __syncthreads();
#pragma unroll
    for (int ct = 0; ct < 4; ++ct) {
        f32x16 o;
#pragma unroll
        for (int i = 0; i < 16; ++i) o[i] = 0.f;
        const LAS bf16_t* vp = Vs + (ct * 32 + rr) * 392 + 32 * w + hh * 8;
#pragma unroll
        for (int kt = 0; kt < 5; ++kt) { o = MFMA32(*(const LAS bf16x8*)(vp + 32 * kt), pf[kt][0], o); o = MFMA32(*(const LAS bf16x8*)(vp + 32 * kt + 16), pf[kt][1], o); }
#pragma unroll
        for (int g4 = 0; g4 < 4; ++g4) { u32x2 wv; wv.x = pack2(o[4 * g4] * inv, o[4 * g4 + 1] * inv); wv.y = pack2(o[4 * g4 + 2] * inv, o[4 * g4 + 3] * inv);
            *(u32x2*)(P + (size_t)((l0 + rr) * d + r) * NNAT + 3072 + hd * 128 + ct * 32 + 8 * g4 + 4 * hh) = wv; }
        asm volatile("" ::: "memory");
    }
    if (hh == 0) LSE[(size_t)((l0 + rr) * d + r) * 12 + hd] = mx + __logf(sum);
    __syncthreads();
}

DI void phase_p2(const Frame& F, int me, int nb) {
    bf16_t* SL = (bf16_t*)(F.R0 + R_SLOC);
    const float* SCB = (const float*)(F.R0 + R_SCB); const float* CHB = (const float*)(F.R0 + R_CHB);
    const float* DN = (const float*)(F.R0 + R_DN); float* NST = (float*)(F.R0 + R_NST);
    if (nb <= 0) return;
    for (int gt = me * 512 + F.tid; gt < 131072; gt += nb * 512) {
        const int h = gt >> 15, e2 = (gt & 32767) * 2;
        f32x2 run = (f32x2){0.f, 0.f};
#pragma unroll 1
        for (int j0 = 0; j0 < 32; j0 += 8) {
            unsigned s[8]; float dec[8];
#pragma unroll
            for (int jj = 0; jj < 8; ++jj) { s[jj] = *(const unsigned*)(SL + ((size_t)h * 32 + j0 + jj) * 65536 + e2); dec[jj] = SCB[h * 32 + j0 + jj]; }
#pragma unroll
            for (int jj = 0; jj < 8; ++jj) { *(unsigned*)(SL + ((size_t)h * 32 + j0 + jj) * 65536 + e2) = pack2(run[0], run[1]); run = run * __expf(dec[jj]) + (f32x2){bflo(s[jj]), bfhi(s[jj])}; }
        }
    }
    const int q = ((nb - 1 - me) * 512 + F.tid);
    if (q < 1024) {
        const int h = q >> 8, dd = q & 255; float run = 0.f;
#pragma unroll 1
        for (int c0 = 0; c0 < 128; c0 += 16) {
            float dn[16], cb[16];
#pragma unroll
            for (int cc = 0; cc < 16; ++cc) { dn[cc] = DN[((size_t)h * 128 + c0 + cc) * 256 + dd]; cb[cc] = CHB[h * 128 + c0 + cc]; }
#pragma unroll
            for (int cc = 0; cc < 16; ++cc) { NST[((size_t)h * 128 + c0 + cc) * 256 + dd] = run; run = run * __expf(cb[cc]) + dn[cc]; }
        }
    }
}

DI void f_hm_block(const Frame& F, int l, int h, int j, int half, int eg) {
    const bf16_t* QC = (const bf16_t*)(F.R0 + R_QC); const bf16_t* CST = (const bf16_t*)(F.R0 + R_CST); const float* NST = (const float*)(F.R0 + R_NST);
    const bf16_t* NUM = (const bf16_t*)(F.R0 + R_NUM); const bf16_t* P = (const bf16_t*)(F.R0 + R_P);
    const float* DENI = (const float*)(F.R0 + R_DENI); const float* EBC = (const float*)(F.R0 + R_EBC); const float* EBL = (const float*)(F.R0 + R_EBL);
    int lane = F.lane, tid = F.tid; asm volatile("" : "+v"(lane), "+v"(tid));
    const int tr = lane & 15, kg = lane >> 4, w = F.wave;
    const int tl0 = j * 256 + half * 128 + w * 16, c = tl0 >> 6, tl = tl0 + tr;
    LAS unsigned char* Cs = F.lds;
    { const bf16_t* src = CST + ((size_t)h * 32 + j) * 65536;
#pragma unroll
      for (int hf = 0; hf < 2; ++hf) {
          u32x4 st[8];
#pragma unroll
          for (int i = 0; i < 8; ++i) { const int p = tid + 512 * (hf * 8 + i); st[i] = *(const u32x4*)(src + (size_t)p * 8); }
#pragma unroll
          for (int i = 0; i < 8; ++i) { const int p = tid + 512 * (hf * 8 + i), row = p >> 5, pc = p & 31; *(LAS u32x4*)(Cs + row * 512 + ((pc ^ (row & 15)) << 4)) = st[i]; }
      } }
    const bf16_t* qp = QC + (size_t)tl * 1024 + h * 256 + kg * 8;
    const float* np = NST + ((size_t)h * 128 + c) * 256 + kg * 8;
    const float ebl = EBL[(size_t)tl * 4 + h], ebc = EBC[(size_t)tl * 4 + h], deni = DENI[(size_t)tl * 4 + h];
    bf16x8 qf[8];
#pragma unroll
    for (int ks = 0; ks < 8; ++ks) qf[ks] = ldg8(qp + ks * 32);
    float dotn = 0.f;
#pragma unroll
    for (int ks = 0; ks < 8; ++ks) {
        const f32x4 n0 = *(const f32x4*)(np + ks * 32), n1 = *(const f32x4*)(np + ks * 32 + 4);
        const u32x4 qv = __builtin_bit_cast(u32x4, qf[ks]);
        dotn += bflo(qv.x) * n0[0] + bfhi(qv.x) * n0[1] + bflo(qv.y) * n0[2] + bfhi(qv.y) * n0[3] + bflo(qv.z) * n1[0] + bfhi(qv.z) * n1[1] + bflo(qv.w) * n1[2] + bfhi(qv.w) * n1[3];
    }
    __syncthreads();
    f32x4 acc[16];
#pragma unroll
    for (int et = 0; et < 16; ++et) {
        acc[et] = (f32x4){0.f, 0.f, 0.f, 0.f};
        const LAS unsigned char* rowp = Cs + (et * 16 + tr) * 512;
#pragma unroll
        for (int ks = 0; ks < 8; ++ks) acc[et] = __builtin_amdgcn_mfma_f32_16x16x32_bf16(*(const LAS bf16x8*)(rowp + (((4 * ks + kg) ^ tr) << 4)), qf[ks], acc[et], 0, 0, 0);
        if ((et & 3) == 3) asm volatile("" ::: "memory");
    }
    dotn += __shfl_xor(dotn, 16); dotn += __shfl_xor(dotn, 32);
    const float den = deni + ebc * dotn;
    const float invd = 1.0f / fmaxf(fabsf(den), 1.0f);
    float ssq = 0.f;
    { u32x2 nl[16];
#pragma unroll
      for (int et = 0; et < 16; ++et) nl[et] = *(const u32x2*)(NUM + (size_t)tl * 1024 + h * 256 + et * 16 + 4 * kg);
#pragma unroll
      for (int et = 0; et < 16; ++et) { const float n4[4] = {bflo(nl[et].x), bfhi(nl[et].x), bflo(nl[et].y), bfhi(nl[et].y)};
#pragma unroll
          for (int q = 0; q < 4; ++q) { const float v = (n4[q] + ebl * acc[et][q]) * invd; acc[et][q] = v; ssq += v * v; } } }
    ssq += __shfl_xor(ssq, 16); ssq += __shfl_xor(ssq, 32);
    const float rn = __builtin_amdgcn_rsqf(ssq * (1.0f / 256.0f) + EPS);
    const size_t tp = (size_t)eg * TQ + tl;
    asm volatile("" ::: "memory");
#pragma unroll
    for (int e8 = 0; e8 < 2; ++e8) {
        u32x2 og[8]; f32x4 ng[8];
#pragma unroll
        for (int i = 0; i < 8; ++i) { const int e = (e8 * 8 + i) * 16 + 4 * kg; og[i] = *(const u32x2*)(P + (size_t)tl * NNAT + 2048 + h * 256 + e); ng[i] = *(const f32x4*)(F.norm_g + (size_t)l * 1024 + h * 256 + e); }
#pragma unroll
        for (int i = 0; i < 8; ++i) { const int et = e8 * 8 + i, e = et * 16 + 4 * kg;
            u32x2 wv; wv.x = pack2(bflo(og[i].x) * acc[et][0] * rn * ng[i][0], bfhi(og[i].x) * acc[et][1] * rn * ng[i][1]);
            wv.y = pack2(bflo(og[i].y) * acc[et][2] * rn * ng[i][2], bfhi(og[i].y) * acc[et][3] * rn * ng[i][3]);
            *(u32x2*)(F.HM + tp * 1024 + h * 256 + e) = wv; }
        asm volatile("" ::: "memory");
    }
    __syncthreads();
}
DI void f_ha_token(const Frame& F, int tl, int eg) {
    const bf16_t* P = (const bf16_t*)(F.R0 + R_P); const float* LSE = (const float*)(F.R0 + R_LSE);
    int lane = F.lane; asm volatile("" : "+v"(lane));
    const int hs = lane >> 4, ch0 = (lane & 15) * 8;
    const float l0 = LSE[(size_t)tl * 12 + hs], l1 = LSE[(size_t)tl * 12 + 4 + hs], l2 = LSE[(size_t)tl * 12 + 8 + hs];
    const float m = fmaxf(l0, fmaxf(l1, l2));
    float a0 = __expf(l0 - m), a1 = __expf(l1 - m), a2 = __expf(l2 - m); const float inv = 1.0f / (a0 + a1 + a2); a0 *= inv; a1 *= inv; a2 *= inv;
    const bf16_t* pr = P + (size_t)tl * NNAT + 3072 + hs * 128 + ch0;
    const u32x4 v0 = *(const u32x4*)(pr), v1 = *(const u32x4*)(pr + 512), v2 = *(const u32x4*)(pr + 1024);
    u32x4 o;
    o.x = pack2(a0 * bflo(v0.x) + a1 * bflo(v1.x) + a2 * bflo(v2.x), a0 * bfhi(v0.x) + a1 * bfhi(v1.x) + a2 * bfhi(v2.x));
    o.y = pack2(a0 * bflo(v0.y) + a1 * bflo(v1.y) + a2 * bflo(v2.y), a0 * bfhi(v0.y) + a1 * bfhi(v1.y) + a2 * bfhi(v2.y));
    o.z = pack2(a0 * bflo(v0.z) + a1 * bflo(v1.z) + a2 * bflo(v2.z), a0 * bfhi(v0.z) + a1 * bfhi(v1.z) + a2 * bfhi(v2.z));
    o.w = pack2(a0 * bflo(v0.w) + a1 * bflo(v1.w) + a2 * bflo(v2.w), a0 * bfhi(v0.w) + a1 * bfhi(v1.w) + a2 * bfhi(v2.w));
    *(u32x4*)(F.HA + ((size_t)eg * TQ + tl) * 512 + hs * 128 + ch0) = o;
}
using pg8::UnitD;
DI u32x4 pack8(const f32x4& v0, const f32x4& v1) { u32x4 w; w.x = pack2(v0[0], v0[1]); w.y = pack2(v0[2], v0[3]); w.z = pack2(v1[0], v1[1]); w.w = pack2(v1[2], v1[3]); return w; }

struct SchedG1 {
    const char* U; const char* Wnat; const char* Wvt; int G, c;
    DI bool next(int i, UnitD& u) const {
        const int L = i * G + c; if (L >= 704 + 320) return false;
        u.arows = nullptr; u.acount = 0; u.aux = 0; u.K = 1024;
        if (L >= 320) { int pm, pc; pg8::tile_map(L - 320, 32, 22, pm, pc); const int pn = pc < 10 ? pc : pc + 2; u.kind = 0; u.pm = pm; u.pn = pn;
            u.A = U + (size_t)pm * 256 * 2048; u.lda = 2048; u.B = Wnat + (size_t)pn * 256 * 2048; u.ldb = 2048; }
        else { const int idx = L, pm = idx % 10, pn = idx / 10; u.kind = 1; u.pm = pm; u.pn = pn;
            u.A = Wvt + (size_t)pm * 256 * 2048; u.lda = 2048;
            int tokbase = pn * 256, dmul = 1;
            if (pm >= 4) { const int g = (pm - 4) >> 1, dsh = 2 * g, lsub = TQ >> dsh, n0 = pn * 256; dmul = 1 << dsh; tokbase = (n0 % lsub) * dmul + n0 / lsub; }
            u.B = U + (size_t)tokbase * 2048; u.ldb = 2048u * (unsigned)dmul; }
        return true;
    }
};
struct SchedG1Def {
    const char* U; const char* Wnat; int c;
    DI bool next(int i, UnitD& u) const {
        if (i > 0 || c >= 64) return false;
        const int pm = c >> 1, pn = 10 + (c & 1);
        u.arows = nullptr; u.acount = 0; u.aux = 0; u.K = 1024; u.kind = 0; u.pm = pm; u.pn = pn;
        u.A = U + (size_t)pm * 256 * 2048; u.lda = 2048; u.B = Wnat + (size_t)pn * 256 * 2048; u.ldb = 2048;
        return true;
    }
};
struct EpiG1 {
    static constexpr bool PERM = true;
    bf16_t* P; bf16_t* VT;
    DI void operator()(const f32x4 (&acc)[2][2][4][2], const UnitD& u, int wr, int wc, int fr, int fq) const {
        bf16_t* base; size_t ld; int mode = 0;
        if (u.kind == 0) { base = P + (size_t)u.pm * 256 * NNAT + u.pn * 256; ld = NNAT; mode = (u.pn >= 8 && u.pn < 12) ? 1 : ((u.pn >= 12 && u.pn < 18) ? 2 : 0); }
        else { base = VT + (size_t)u.pm * 256 * TQ + u.pn * 256; ld = TQ; }
        const int row0 = wr * 64 + fr, col0 = wc * 32 + 8 * fq;
#pragma unroll
        for (int ai = 0; ai < 2; ++ai)
#pragma unroll
            for (int m = 0; m < 4; ++m) { bf16_t* rowp = base + (size_t)(row0 + ai * 128 + m * 16) * ld + col0;
#pragma unroll
                for (int bj = 0; bj < 2; ++bj) { f32x4 v0 = acc[ai][bj][m][0], v1 = acc[ai][bj][m][1];
                    if (mode == 1) {
#pragma unroll
                        for (int q = 0; q < 4; ++q) { v0[q] = sigmoidf_(v0[q]); v1[q] = sigmoidf_(v1[q]); } }
                    else if (mode == 2) { v0 *= 0.08838834764831845f; v1 *= 0.08838834764831845f; }
                    *(u32x4*)(rowp + bj * 128) = pack8(v0, v1); }
                asm volatile("" ::: "memory"); }
    }
};
struct SchedDense {
    const char* A; const char* B; unsigned lda, ldb; int nM, nN, G, c, K;
    DI bool next(int i, UnitD& u) const {
        const int L = i * G + c; if (L >= nM * nN) return false;
        int pm, pn; pg8::tile_map(L, nM, nN, pm, pn); u.kind = 0; u.K = K; u.pm = pm; u.pn = pn; u.aux = 0; u.arows = nullptr; u.acount = 0;
        u.A = A + (size_t)pm * 256 * lda; u.lda = lda; u.B = B + (size_t)pn * 256 * ldb; u.ldb = ldb; return true;
    }
};
struct EpiG1g {
    static constexpr bool PERM = true;
    bf16_t* GT;
    DI void operator()(const f32x4 (&acc)[2][2][4][2], const UnitD& u, int wr, int wc, int fr, int fq) const {
        bf16_t* base = GT + (size_t)u.pm * 256 * 2048 + u.pn * 256; const int row0 = wr * 64 + fr, col0 = wc * 32 + 8 * fq;
#pragma unroll
        for (int ai = 0; ai < 2; ++ai)
#pragma unroll
            for (int m = 0; m < 4; ++m) { bf16_t* rowp = base + (size_t)(row0 + ai * 128 + m * 16) * 2048 + col0;
#pragma unroll
                for (int bj = 0; bj < 2; ++bj) { f32x4 v0 = acc[ai][bj][m][0], v1 = acc[ai][bj][m][1];
#pragma unroll
                    for (int q = 0; q < 4; ++q) { v0[q] = sigmoidf_(v0[q]); v1[q] = sigmoidf_(v1[q]); }
                    *(u32x4*)(rowp + bj * 128) = pack8(v0, v1); }
                asm volatile("" ::: "memory"); }
    }
};
template <int WHICH> struct EpiG2 {
    static constexpr bool PERM = true;
    bf16_t* GT;
    DI void operator()(const f32x4 (&acc)[2][2][4][2], const UnitD& u, int wr, int wc, int fr, int fq) const {
        bf16_t* base = GT + (size_t)u.pm * 256 * 2048 + u.pn * 256 + (WHICH == 0 ? 1024 : 0); const int row0 = wr * 64 + fr, col0 = wc * 32 + 8 * fq;
#pragma unroll
        for (int ai = 0; ai < 2; ++ai)
#pragma unroll
            for (int m = 0; m < 4; ++m) { bf16_t* rowp = base + (size_t)(row0 + ai * 128 + m * 16) * 2048 + col0;
#pragma unroll
                for (int bj = 0; bj < 2; ++bj) { const f32x4 a0 = acc[ai][bj][m][0], a1 = acc[ai][bj][m][1];
                    const u32x4 g = *(const u32x4*)(rowp + bj * 128);
                    f32x4 v0 = (f32x4){bflo(g.x) * a0[0], bfhi(g.x) * a0[1], bflo(g.y) * a0[2], bfhi(g.y) * a0[3]};
                    f32x4 v1 = (f32x4){bflo(g.z) * a1[0], bfhi(g.z) * a1[1], bflo(g.w) * a1[2], bfhi(g.w) * a1[3]};
                    if (WHICH == 1) { const u32x4 y = *(const u32x4*)(rowp + bj * 128 + 1024);
                        v0 += (f32x4){bflo(y.x), bfhi(y.x), bflo(y.y), bfhi(y.y)}; v1 += (f32x4){bflo(y.z), bfhi(y.z), bflo(y.w), bfhi(y.w)}; }
                    *(u32x4*)(rowp + bj * 128) = pack8(v0, v1); }
                asm volatile("" ::: "memory"); }
    }
};
struct EpiG3 {
    static constexpr bool PERM = false;
    const float* xin; float* xout; const float* gta;
    int b0;
    DI void operator()(const f32x4 (&acc)[2][2][4][2], const UnitD& u, int wr, int wc, int fr, int fq) const {
        const int row0 = u.pm * 256 + wr * 64 + fr, col0 = u.pn * 256 + wc * 32 + 4 * fq;
        const float* g = gta + (size_t)(b0 + (u.pm >> 5)) * 6144 + col0;
        f32x4 gv[2][2];
#pragma unroll
        for (int bj = 0; bj < 2; ++bj)
#pragma unroll
            for (int n = 0; n < 2; ++n) gv[bj][n] = *(const f32x4*)(g + bj * 128 + n * 16);
        f32x4 xb[4][4];
#pragma unroll
        for (int g0 = 0; g0 < 3; ++g0) { const size_t o0 = (size_t)(row0 + (g0 >> 2) * 128 + (g0 & 3) * 16) * 1024 + col0;
#pragma unroll
            for (int q = 0; q < 4; ++q) xb[g0][q] = *(const f32x4*)(xin + o0 + (q >> 1) * 128 + (q & 1) * 16); }
#pragma unroll
        for (int gi = 0; gi < 8; ++gi) { const int ai = gi >> 2, m = gi & 3; const size_t o = (size_t)(row0 + ai * 128 + m * 16) * 1024 + col0;
            if (gi + 3 < 8) { const int ai2 = (gi + 3) >> 2, m2 = (gi + 3) & 3; const size_t o2 = (size_t)(row0 + ai2 * 128 + m2 * 16) * 1024 + col0;
#pragma unroll
                for (int q = 0; q < 4; ++q) xb[(gi + 3) & 3][q] = *(const f32x4*)(xin + o2 + (q >> 1) * 128 + (q & 1) * 16); }
            asm volatile("" ::: "memory");
#pragma unroll
            for (int q = 0; q < 4; ++q) *(f32x4*)(xout + o + (q >> 1) * 128 + (q & 1) * 16) = xb[gi & 3][q] + gv[q >> 1][q & 1] * acc[ai][q >> 1][m][q & 1]; }
    }
};
struct SchedMoe {
    const int* pre;
    const unsigned* cnt;
    const char* A; const char* W; const int* SLOT; int G, c; bool gate_up;
    DI bool next(int i, UnitD& u) const {
        const int L = i * G + c, nt = pre[16]; if (L >= nt * 4) return false;
        const int rt = L >> 2, ct = L & 3; int e = 0;
#pragma unroll
        for (int q = 1; q < 16; ++q) e += (rt >= pre[q]) ? 1 : 0;
        u.kind = 0; u.pm = rt; u.pn = ct; u.aux = e; u.K = gate_up ? 1024 : 512;
        const int ti = rt - pre[e];
        if (gate_up) { u.A = A; u.lda = 2048; u.arows = SLOT + (size_t)e * 32768 + ti * 256; u.acount = (int)cnt[e] - ti * 256;
            u.B = W + ((size_t)e * 1024 + ct * 256) * 2048; u.ldb = 2048; }
        else { u.A = A + (size_t)rt * 256 * 1024; u.lda = 1024; u.arows = nullptr; u.acount = 0;
            u.B = W + ((size_t)e * 1024 + ct * 256) * 1024; u.ldb = 1024; }
        return true;
    }
};
struct EpiG4 {
    static constexpr bool PERM = true;
    bf16_t* HH;
    DI void operator()(const f32x4 (&acc)[2][2][4][2], const UnitD& u, int wr, int wc, int fr, int fq) const {
        bf16_t* base = HH + (size_t)u.pm * 256 * 512 + u.pn * 128; const int row0 = wr * 64 + fr, col0 = wc * 16 + 4 * fq;
#pragma unroll
        for (int ai = 0; ai < 2; ++ai)
#pragma unroll
            for (int m = 0; m < 4; ++m) { bf16_t* rowp = base + (size_t)(row0 + ai * 128 + m * 16) * 512 + col0;
#pragma unroll
                for (int bj = 0; bj < 2; ++bj) { const f32x4 v0 = acc[ai][bj][m][0], v1 = acc[ai][bj][m][1];
                    u32x2 w; w.x = pack2(siluf_(v0[0]) * v0[1], siluf_(v0[2]) * v0[3]); w.y = pack2(siluf_(v1[0]) * v1[1], siluf_(v1[2]) * v1[3]);
                    *(u32x2*)(rowp + bj * 64) = w; }
                asm volatile("" ::: "memory"); }
    }
};
struct EpiG5 {
    static constexpr bool PERM = true;
    bf16_t* YS;
    DI void operator()(const f32x4 (&acc)[2][2][4][2], const UnitD& u, int wr, int wc, int fr, int fq) const {
        bf16_t* base = YS + (size_t)u.pm * 256 * 1024 + u.pn * 256; const int row0 = wr * 64 + fr, col0 = wc * 32 + 8 * fq;
#pragma unroll
        for (int ai = 0; ai < 2; ++ai)
#pragma unroll
            for (int m = 0; m < 4; ++m) { bf16_t* rowp = base + (size_t)(row0 + ai * 128 + m * 16) * 1024 + col0;
#pragma unroll
                for (int bj = 0; bj < 2; ++bj) *(u32x4*)(rowp + bj * 128) = pack8(acc[ai][bj][m][0], acc[ai][bj][m][1]);
                asm volatile("" ::: "memory"); }
    }
};

struct SchedChain {
    const char* U; const char* HA; const char* HM; const char* Wg; const char* Wa; const char* Wm; int G, c;
    DI bool next(int i, UnitD& u) const {
        const int per = (512 + G - 1) / G;
        const int ti = i >> 2, st = i & 3; if (ti >= per) return false;
        const int L = ti * G + c; if (L >= 512) return false;
        int pm, pn; pg8::tile_map(L, 128, 4, pm, pn); u.pm = pm; u.pn = pn; u.kind = st; u.aux = 0; u.arows = nullptr; u.acount = 0;
        if (st == 0) { u.A = U + (size_t)pm * 256 * 2048; u.lda = 2048; u.B = Wg + (size_t)pn * 256 * 2048; u.ldb = 2048; u.K = 1024; }
        else if (st == 1) { u.A = U + (size_t)pm * 256 * 2048; u.lda = 2048; u.B = Wg + (size_t)(4 + pn) * 256 * 2048; u.ldb = 2048; u.K = 1024; }
        else if (st == 2) { u.A = HA + (size_t)pm * 256 * 1024; u.lda = 1024; u.B = Wa + (size_t)pn * 256 * 1024; u.ldb = 1024; u.K = 512; }
        else { u.A = HM + (size_t)pm * 256 * 2048; u.lda = 2048; u.B = Wm + (size_t)pn * 256 * 2048; u.ldb = 2048; u.K = 1024; }
        return true;
    }
};
struct EpiChain {
    static constexpr bool PERM = true;
    bf16_t* GT;
    DI void operator()(const f32x4 (&acc)[2][2][4][2], const UnitD& u, int wr, int wc, int fr, int fq) const {
        const int st = u.kind;
        bf16_t* base = GT + (size_t)u.pm * 256 * 2048 + u.pn * 256 + ((st == 1 || st == 2) ? 1024 : 0); const int row0 = wr * 64 + fr, col0 = wc * 32 + 8 * fq;
        if (st < 2) {
#pragma unroll
            for (int ai = 0; ai < 2; ++ai)
#pragma unroll
                for (int m = 0; m < 4; ++m) { bf16_t* rowp = base + (size_t)(row0 + ai * 128 + m * 16) * 2048 + col0;
#pragma unroll
                    for (int bj = 0; bj < 2; ++bj) { f32x4 v0 = acc[ai][bj][m][0], v1 = acc[ai][bj][m][1];
#pragma unroll
                        for (int q = 0; q < 4; ++q) { v0[q] = sigmoidf_(v0[q]); v1[q] = sigmoidf_(v1[q]); }
                        *(u32x4*)(rowp + bj * 128) = pack8(v0, v1); }
                    asm volatile("" ::: "memory"); }
        } else {
            u32x4 gb[4][4];
#pragma unroll
            for (int g0 = 0; g0 < 3; ++g0) { bf16_t* rp0 = base + (size_t)(row0 + (g0 >> 2) * 128 + (g0 & 3) * 16) * 2048 + col0;
                gb[g0][0] = *(const u32x4*)(rp0); gb[g0][1] = *(const u32x4*)(rp0 + 128);
                if (st == 3) { gb[g0][2] = *(const u32x4*)(rp0 + 1024); gb[g0][3] = *(const u32x4*)(rp0 + 128 + 1024); } }
#pragma unroll
            for (int gi = 0; gi < 8; ++gi) { const int ai = gi >> 2, m = gi & 3; bf16_t* rowp = base + (size_t)(row0 + ai * 128 + m * 16) * 2048 + col0;
                if (gi + 3 < 8) { const int ai2 = (gi + 3) >> 2, m2 = (gi + 3) & 3; bf16_t* rp2 = base + (size_t)(row0 + ai2 * 128 + m2 * 16) * 2048 + col0;
                    gb[(gi + 3) & 3][0] = *(const u32x4*)(rp2); gb[(gi + 3) & 3][1] = *(const u32x4*)(rp2 + 128);
                    if (st == 3) { gb[(gi + 3) & 3][2] = *(const u32x4*)(rp2 + 1024); gb[(gi + 3) & 3][3] = *(const u32x4*)(rp2 + 128 + 1024); } }
                asm volatile("" ::: "memory");
#pragma unroll
                for (int bj = 0; bj < 2; ++bj) { f32x4 v0 = acc[ai][bj][m][0], v1 = acc[ai][bj][m][1];
                    const u32x4 g = gb[gi & 3][bj];
                    v0 *= (f32x4){bflo(g.x), bfhi(g.x), bflo(g.y), bfhi(g.y)}; v1 *= (f32x4){bflo(g.z), bfhi(g.z), bflo(g.w), bfhi(g.w)};
                    if (st == 3) { const u32x4 y = gb[gi & 3][2 + bj];
                        v0 += (f32x4){bflo(y.x), bfhi(y.x), bflo(y.y), bfhi(y.y)}; v1 += (f32x4){bflo(y.z), bfhi(y.z), bflo(y.w), bfhi(y.w)}; }
                    *(u32x4*)(rowp + bj * 128) = pack8(v0, v1); } }
        }
    }
};
constexpr int LDS_BYTES = 131072 + 1024;
constexpr int LDS_MISC = 131072;
#ifndef MK_ONE_LAUNCH
#define MK_ONE_LAUNCH 1
#endif
constexpr int N_STEPS = 1 + DEPTH * (1 + 4 * 4 + 2 + 3) + 1;

DI int fresh_tid(int wave) { int l_; asm volatile("v_mbcnt_lo_u32_b32 %0, -1, 0\n\tv_mbcnt_hi_u32_b32 %0, -1, %0" : "=v"(l_)); return wave * 64 + l_; }
__global__ void __launch_bounds__(512, 2) fwd_kernel(Args args) {
    extern __shared__ __attribute__((aligned(16))) unsigned char lds_raw[];
    const int wave0 = __builtin_amdgcn_readfirstlane((int)threadIdx.x >> 6);
#define tid0 fresh_tid(wave0)
    LAS unsigned char* lds0 = (LAS unsigned char*)lds_raw;
    if (tid0 < 4) ((volatile LAS unsigned*)(lds0 + LDS_MISC))[tid0] = 0u;
    __syncthreads();
    unsigned* ctl0 = (unsigned*)(args.ws + WS_CTL);
    XcdBarrier bar; bar.bar = ctl0 + CW_BAR; bar.x = 0; bar.st = nullptr;
    const int lo = args.step_lo, hi = args.step_hi;
    if (hi - lo > 1) bar = xcd_barrier_post(ctl0 + CW_BAR, (volatile LAS unsigned*)(lds0 + LDS_MISC));
    int step = 0; int l_probe = 0; unsigned long long probe_acc = 0;
#ifndef SITE_MASK
#define SITE_MASK 0xFFFFFFFFu
#endif
#ifndef REP_ML1
#define REP_ML1 1
#endif
#ifndef REP_AT
#define REP_AT 1
#endif
#ifndef DUP_MASK
#define DUP_MASK 0u
#endif
#ifndef DUP_L0
#define DUP_L0 0
#endif
#ifndef EXTRA_BARS
#define EXTRA_BARS 0
#endif
#ifndef PROBE_SITE
#define PROBE_SITE -1
#endif
#ifndef PROBE_AMP
#define PROBE_AMP 4
#endif
#define RUN(site, ...) do { if (step >= lo && step < hi) { unsigned long long pt0_ = 0; if constexpr (PROBE_SITE == (site)) pt0_ = wall_clock64(); if constexpr ((DUP_MASK >> (site)) & 1u) { if (!DUP_L0 || l_probe == 0) { Frame F; { int t_ = tid0; asm volatile("" : "+v"(t_)); frame_init(F, lds_raw, t_); } int* preL = (int*)(F.ldsg + LDS_MISC + 64); (void)preL; __VA_ARGS__; xcd_barrier(bar); } } if constexpr ((SITE_MASK >> (site)) & 1u) { Frame F; { int t_ = tid0; asm volatile("" : "+v"(t_)); frame_init(F, lds_raw, t_); } int* preL = (int*)(F.ldsg + LDS_MISC + 64); (void)preL; __VA_ARGS__; } if (step + 1 < hi) xcd_barrier(bar); if constexpr (PROBE_SITE == (site)) probe_acc += wall_clock64() - pt0_; } ++step; } while (0)

    RUN(0, { phase_p0_small(F); __syncthreads(); phase_pw(F, 0, 0, F.G); });
    for (int l = 0; l < DEPTH; ++l) { l_probe = l;
        RUN(1, { if (l > 0) phase_pw(F, l, 0, F.G); phase_n1(F, l); });
        for (int eg = 0; eg < 4; ++eg) {
                RUN(2, { SchedG1 S{(const char*)(F.U + (size_t)eg * TQ * 1024), (const char*)(F.W + W_NAT), (const char*)(F.W + W_VT), F.G, F.bid};
                      EpiG1 E{(bf16_t*)(F.R0 + R_P), (bf16_t*)(F.R0 + R_VT)};
                      pg8::gemm_run<EpiG1, SchedG1>(F.lds, S, E, F.tid); });
                RUN(4, {
                      if (F.bid < 128) ml1_unit(F, l, F.bid >> 5, F.bid & 31, eg);
                      else if (F.bid < 192) { SchedG1Def S{(const char*)(F.U + (size_t)eg * TQ * 1024), (const char*)(F.W + W_NAT), F.bid - 128}; EpiG1 E{(bf16_t*)(F.R0 + R_P), (bf16_t*)(F.R0 + R_VT)};
                          pg8::gemm_run<EpiG1, SchedG1Def>(F.lds, S, E, F.tid);
                          at_block_unit(F, F.bid - 128); at_block_unit(F, F.bid - 64); }
                      else { for (int q4 = 0; q4 < 4; ++q4) at_block_unit(F, 128 + (F.bid - 192) * 4 + q4); } });
                RUN(5, { phase_p2(F, F.bid, F.G); });
                RUN(6, { for (int u = F.bid; u < 256; u += F.G) f_hm_block(F, l, (u & 127) >> 5, u & 31, u >> 7, eg);
                      for (int t = F.bid * 8 + F.wave; t < TQ; t += F.G * 8) f_ha_token(F, t, eg); });
        }
        RUN(7, { SchedChain S{(const char*)F.U, (const char*)F.HA, (const char*)F.HM, (const char*)(F.W + W_G), (const char*)(F.W + W_A), (const char*)(F.W + W_M), F.G, F.bid};
              EpiChain E{(bf16_t*)(F.R0 + R_GT)}; pg8::gemm_run<EpiChain, SchedChain>(F.lds, S, E, F.tid); });
        RUN(10, { SchedDense S{(const char*)(F.R0 + R_GT), (const char*)(F.W + W_O), 4096u, 2048u, 128, 4, F.G, F.bid, 1024};
              EpiG3 E{(l == 0 ? F.x : F.out), F.out, F.MOD + (size_t)l * 4 * 6144 + 2048, 0};
              pg8::gemm_run<EpiG3, SchedDense>(F.lds, S, E, F.tid); });
        RUN(11, { phase_n2(F, l); });
        RUN(12, { moe_offsets(F.ctl + CW_CNT + 64 * l, preL, F.tid); __syncthreads();
              SchedMoe S{preL, F.ctl + CW_CNT + 64 * l, (const char*)F.U, (const char*)(F.W + W_13), (const int*)(F.R0 + R_SLOT), F.G, F.bid, true};
              EpiG4 E{(bf16_t*)(F.R0 + R_HH)}; pg8::gemm_run<EpiG4, SchedMoe, true>(F.lds, S, E, F.tid); });
        RUN(13, { moe_offsets(F.ctl + CW_CNT + 64 * l, preL, F.tid); __syncthreads();
              SchedMoe S{preL, F.ctl + CW_CNT + 64 * l, (const char*)(F.R0 + R_HH), (const char*)(F.W + W_2), (const int*)(F.R0 + R_SLOT), F.G, F.bid, false};
              EpiG5 E{(bf16_t*)(F.R0 + R_YS)}; pg8::gemm_run<EpiG5, SchedMoe>(F.lds, S, E, F.tid); });
    }
    for (int xb = 0; xb < EXTRA_BARS; ++xb) xcd_barrier(bar);
    RUN(14, { phase_fn(F); });
#undef RUN
#undef tid0
    if constexpr (PROBE_SITE >= 0) { if (blockIdx.x == 0 && fresh_tid(wave0) == 0) { const unsigned long long te = wall_clock64(); while (wall_clock64() - te < (unsigned long long)PROBE_AMP * probe_acc) __builtin_amdgcn_s_sleep(8); } }
}

extern "C" void kernel_launch(void* const* d_in, const int* in_sizes, int n_in, void* d_out, int out_size, void* d_ws, size_t ws_size, hipStream_t stream) {
    static int grid = 0;
    if (grid == 0) {
        if (n_in != 19 || out_size != T_TOK * DM || ws_size < WS_END) { fprintf(stderr, "kernel_launch: unexpected problem (n_in %d out %d ws %zu, need %zu)\n", n_in, out_size, ws_size, (size_t)WS_END); grid = -1; return; }
        int dev = 0, cus = 0, per_cu = 0;
        if (hipGetDevice(&dev) != hipSuccess || hipDeviceGetAttribute(&cus, hipDeviceAttributeMultiprocessorCount, dev) != hipSuccess) { grid = -1; return; }
        if (hipFuncSetAttribute((const void*)fwd_kernel, hipFuncAttributeMaxDynamicSharedMemorySize, LDS_BYTES) != hipSuccess) { fprintf(stderr, "kernel_launch: hipFuncSetAttribute failed\n"); grid = -1; return; }
        if (hipOccupancyMaxActiveBlocksPerMultiprocessor(&per_cu, (const void*)fwd_kernel, 512, LDS_BYTES) != hipSuccess || per_cu < 1) { fprintf(stderr, "kernel_launch: occupancy query says %d blocks per CU\n", per_cu); per_cu = 1; }
        (void)hipGetLastError();
        if (cus < 256) { fprintf(stderr, "kernel_launch: this kernel's phase program is written for 256 workgroups (one per CU of a 256-CU device); found %d CUs\n", cus); grid = -1; return; }
        grid = 256;
    }
    if (grid <= 0) return;
    (void)hipMemsetAsync((char*)d_ws + WS_CTL, 0, CTL_BYTES, stream);
    Args a{};
    for (int i = 0; i < 19; ++i) a.in[i] = (const float*)d_in[i];
    a.out = (float*)d_out; a.ws = (unsigned char*)d_ws;
#if MK_ONE_LAUNCH
    a.step_lo = 0; a.step_hi = N_STEPS;
    hipLaunchKernelGGL(fwd_kernel, dim3(grid), dim3(512), LDS_BYTES, stream, a);
#else
    for (int s = 0; s < N_STEPS; ++s) { a.step_lo = s; a.step_hi = s + 1; hipLaunchKernelGGL(fwd_kernel, dim3(grid), dim3(512), LDS_BYTES, stream, a); }
#endif
}
```

```cpp
#define MK_ONE_LAUNCH 1
#include <hip/hip_runtime.h>
#include <cstdio>
#include <cstdint>

#define DI __device__ __forceinline__
#define LAS __attribute__((address_space(3)))
typedef unsigned short bf16_t;
typedef short bf16x8 __attribute__((ext_vector_type(8)));
typedef float f32x2 __attribute__((ext_vector_type(2)));
typedef float f32x4 __attribute__((ext_vector_type(4)));
typedef float f32x16 __attribute__((ext_vector_type(16)));
typedef unsigned u32x2 __attribute__((ext_vector_type(2)));
typedef unsigned u32x4 __attribute__((ext_vector_type(4)));
typedef __bf16 nbf16x2 __attribute__((ext_vector_type(2)));

constexpr int T_TOK = 32768, SEQ = 8192, DM = 1024, NBATCH = 4, DEPTH = 2;
constexpr int TQ = 8192;
constexpr int TP = 16384;
constexpr int INC = 10760;
constexpr int NNAT = 6144;
constexpr int NVT = 2560;
constexpr int NEXP = 16, DFF = 512;
constexpr int SLOT_ROWS = 69632;
constexpr float EPS = 1e-6f;

constexpr size_t al256(size_t x) { return (x + 255) & ~(size_t)255; }
constexpr size_t WS_CTL = 0;
constexpr size_t CTL_BYTES = 65536;
constexpr size_t WS_MOD = WS_CTL + CTL_BYTES;
constexpr size_t WS_WIF = WS_MOD + al256((size_t)2 * 4 * 6144 * 4);
constexpr size_t WS_RW = WS_WIF + (size_t)2 * 8 * 1024 * 4;
constexpr size_t WS_W = WS_RW + (size_t)16 * 1024 * 4;
constexpr size_t W_NAT = 0;
constexpr size_t W_VT = W_NAT + (size_t)NNAT * 1024 * 2;
constexpr size_t W_G = W_VT + (size_t)NVT * 1024 * 2;
constexpr size_t W_M = W_G + (size_t)2048 * 1024 * 2;
constexpr size_t W_A = W_M + (size_t)1024 * 1024 * 2;
constexpr size_t W_O = W_A + (size_t)1024 * 512 * 2;
constexpr size_t W_13 = W_O + (size_t)1024 * 1024 * 2;
constexpr size_t W_2 = W_13 + (size_t)16 * 1024 * 1024 * 2;
constexpr size_t W_BYTES = W_2 + (size_t)16 * 1024 * 512 * 2;
constexpr size_t WS_U = WS_W + W_BYTES;
constexpr size_t WS_GIF = WS_U + (size_t)T_TOK * 1024 * 2;
constexpr size_t WS_HM = WS_GIF + (size_t)T_TOK * 8 * 4;
constexpr size_t WS_HA = WS_HM + (size_t)T_TOK * 1024 * 2;
constexpr size_t WS_TOKI = WS_HA + (size_t)T_TOK * 512 * 2;
constexpr size_t WS_XB = WS_TOKI + (size_t)2 * T_TOK * 32;
constexpr size_t WS_R0 = WS_XB + (size_t)T_TOK * 1024 * 2;
constexpr size_t R_P = 0;
constexpr size_t R_VT = R_P + (size_t)TQ * NNAT * 2;
constexpr size_t R_QC = R_VT + (size_t)NVT * TQ * 2;
constexpr size_t R_NUM = R_QC + (size_t)TQ * 1024 * 2;
constexpr size_t R_SLOC = R_NUM + (size_t)TQ * 1024 * 2;
constexpr size_t R_CST = R_SLOC;
constexpr size_t R_DENI = R_SLOC + (size_t)4 * 32 * 65536 * 2;
constexpr size_t R_EBC = R_DENI + (size_t)TQ * 4 * 4;
constexpr size_t R_EBL = R_EBC + (size_t)TQ * 4 * 4;
constexpr size_t R_SCB = R_EBL + (size_t)TQ * 4 * 4;
constexpr size_t R_CHB = R_SCB + 1024;
constexpr size_t R_DN = R_CHB + 2048;
constexpr size_t R_NST = R_DN + (size_t)4 * 128 * 256 * 4;
constexpr size_t R_LSE = R_NST + (size_t)4 * 128 * 256 * 4;
constexpr size_t R_END = R_LSE + (size_t)TQ * 12 * 4;
constexpr size_t R_GT = 0;
constexpr size_t R_HH = 0;
constexpr size_t R_YS = R_HH + (size_t)SLOT_ROWS * 512 * 2;
constexpr size_t R_SLOT = R_YS + (size_t)SLOT_ROWS * 1024 * 2;
constexpr size_t R_END2 = R_SLOT + (size_t)16 * 32768 * 4;
constexpr size_t WS_END = WS_R0 + (R_END > R_END2 ? R_END : R_END2);
static_assert(WS_END <= (size_t)536870912, "workspace over 512 MiB");

constexpr int CW_BAR = 0;
constexpr int CW_CNT = 4096;

DI float bflo(unsigned w) { return __uint_as_float(w << 16); }
DI float bfhi(unsigned w) { return __uint_as_float(w & 0xffff0000u); }
DI unsigned pack2(float lo, float hi) { f32x2 v = {lo, hi}; nbf16x2 b = __builtin_convertvector(v, nbf16x2); return __builtin_bit_cast(unsigned, b); }
typedef _Float16 h16x2 __attribute__((ext_vector_type(2)));
DI unsigned pack2h(float lo, float hi) { f32x2 v = {lo, hi}; h16x2 b = __builtin_convertvector(v, h16x2); return __builtin_bit_cast(unsigned, b); }
DI float hlo(unsigned w) { const h16x2 b = __builtin_bit_cast(h16x2, w); return (float)b[0]; }
DI float hhi(unsigned w) { const h16x2 b = __builtin_bit_cast(h16x2, w); return (float)b[1]; }
DI float sigmoidf_(float x) { return __builtin_amdgcn_rcpf(1.0f + __expf(-x)); }
DI float siluf_(float x) { return x * sigmoidf_(x); }
DI float wave_sum(float v) { for (int o = 32; o >= 1; o >>= 1) v += __shfl_xor(v, o); return v; }
DI int crow(int reg, int h) { return (reg & 3) + 8 * (reg >> 2) + 4 * h; }
DI int pi23(int m) { return (m & ~12) | ((m & 4) << 1) | ((m & 8) >> 1); }
#define MFMA32(a, b, c) __builtin_amdgcn_mfma_f32_32x32x16_bf16((a), (b), (c), 0, 0, 0)
DI bf16x8 packf8(float a0, float a1, float a2, float a3, float a4, float a5, float a6, float a7) {
    u32x4 p; p.x = pack2(a0, a1); p.y = pack2(a2, a3); p.z = pack2(a4, a5); p.w = pack2(a6, a7); return __builtin_bit_cast(bf16x8, p); }
DI bf16x8 ldg8(const bf16_t* p) { return *(const bf16x8*)p; }
#define XB_TMO      128
#define XB_XCNT(j)  (256  + 64 * (j))
#define XB_XSUB(j)  (1280 + 64 * (j))
#define XB_XGEN(j)  (2304 + 64 * (j))
#define XB_TOP      3328
#define XB_TOPGEN   3392
#define XCD_BAR_WORDS 3456
#define XB_SPIN_CAP (1u << 21)

__device__ __forceinline__ unsigned xb_ld(unsigned* p)              { return __hip_atomic_load(p, __ATOMIC_RELAXED, __HIP_MEMORY_SCOPE_AGENT); }
__device__ __forceinline__ unsigned xb_add(unsigned* p, unsigned v) { return __hip_atomic_fetch_add(p, v, __ATOMIC_RELAXED, __HIP_MEMORY_SCOPE_AGENT); }
__device__ __forceinline__ unsigned xb_xcc_id() { return (unsigned)__builtin_amdgcn_s_getreg((3 << 11) | 20) & 0xFu; }
#define XB_SPIN(cond, bar) do { unsigned _sp = 0; while (cond) { __builtin_amdgcn_s_sleep(1); \
    if ((++_sp & 255u) == 0u) { if (xb_ld(&(bar)[XB_TMO])) break; if (_sp > XB_SPIN_CAP) { atomicAdd(&(bar)[XB_TMO], 1u); break; } } } } while (0)

struct XcdBarrier {
    unsigned* bar; unsigned x;
    volatile LAS unsigned* st;
};

__device__ __forceinline__ XcdBarrier xcd_barrier_post(unsigned* bar, volatile LAS unsigned* st) {
    XcdBarrier b; b.bar = bar; b.x = xb_xcc_id(); b.st = st;
    if (threadIdx.x == 0) (void)xb_add(&bar[XB_XCNT(b.x)], 1u);
    return b;
}
__device__ __forceinline__ void xcd_barrier_complete(unsigned* bar, unsigned x, unsigned& nloc, unsigned& nx) {
    const unsigned G = gridDim.x * gridDim.y * gridDim.z;
    unsigned sum, cnt, mine, sp = 0u;
    for (;;) {
        sum = 0u; cnt = 0u; mine = 0u;
#pragma unroll
        for (unsigned j = 0; j < 16; ++j) { const unsigned c = xb_ld(&bar[XB_XCNT(j)]); sum += c; cnt += (c > 0u) ? 1u : 0u; mine = (j == x) ? c : mine; }
        if (sum == G) break;
        __builtin_amdgcn_s_sleep(1);
        if ((++sp & 255u) == 0u) { if (xb_ld(&bar[XB_TMO])) break; if (sp > XB_SPIN_CAP) { atomicAdd(&bar[XB_TMO], 1u); break; } }
    }
    nloc = mine > 0u ? mine : 1u; nx = cnt > 0u ? cnt : 1u;
}

__device__ __forceinline__ void xcd_barrier(const XcdBarrier& b) {
    asm volatile("s_waitcnt vmcnt(0)" ::: "memory");
    __syncthreads();
    if (threadIdx.x == 0) {
        unsigned* bar = b.bar;
        __builtin_amdgcn_s_waitcnt(0);
        unsigned nloc = b.st[0], nx = b.st[1];
        if (nloc == 0u) { xcd_barrier_complete(bar, b.x, nloc, nx); b.st[0] = nloc; b.st[1] = nx; }
        const unsigned old = xb_add(&bar[XB_XSUB(b.x)], 1u);
        const unsigned gen = old / nloc;
        if (old + 1u == (gen + 1u) * nloc) {
            __builtin_amdgcn_fence(__ATOMIC_RELEASE, "agent");
            asm volatile("s_waitcnt vmcnt(0)" ::: "memory");
            const unsigned og = xb_add(&bar[XB_TOP], 1u);
            const unsigned tg = og / nx;
            if (og + 1u == (tg + 1u) * nx) xb_add(&bar[XB_TOPGEN], 1u);
            else XB_SPIN(xb_ld(&bar[XB_TOPGEN]) == tg, bar);
            __builtin_amdgcn_fence(__ATOMIC_ACQUIRE, "agent");
            xb_add(&bar[XB_XGEN(b.x)], 1u);
            asm volatile("s_waitcnt vmcnt(0)" ::: "memory");
        } else {
            XB_SPIN(xb_ld(&bar[XB_XGEN(b.x)]) == gen, bar);
            __builtin_amdgcn_fence(__ATOMIC_ACQUIRE, "agent");
            asm volatile("s_waitcnt vmcnt(0)" ::: "memory");
        }
    }
    __syncthreads();
}
namespace pg8 {
constexpr int BM = 256, BK = 64, HALF = 128, HTB = HALF * BK * 2, STAGE_BYTES = 8 * HTB, NXCD = 8, WGM = 8;
DI int lds_byte(int r, int c) { const int st = (r >> 4) * 2 + (c >> 5), rr = r & 15, cc = c & 31, ob = rr * 64 + cc * 2; return st * 1024 + (ob ^ (((ob >> 9) & 1) << 5)); }
DI void stage_rc(int b, int& R, int& C) { const int st = b / 1024, sb = b % 1024, swz = sb ^ (((sb >> 9) & 1) << 5); R = (st >> 1) * 16 + swz / 64; C = (st & 1) * 32 + (swz % 64) / 2; }
DI int perm32(int rho) { const int n = rho >> 4, i = rho & 15; return 8 * (i >> 2) + 4 * n + (i & 3); }

struct UnitD {
    const char* A; const char* B;
    unsigned lda, ldb;
    const int* arows; int acount;
    int kind, pm, pn, aux;
    int K;
};
DI void tile_map(int L, int nM, int nN, int& pm, int& pn) {
    const int nwg = nM * nN; int wgid = L;
    { const int q = nwg / NXCD, r = nwg % NXCD, xcd = wgid % NXCD, off = wgid / NXCD; wgid = (xcd < r ? xcd * (q + 1) : r * (q + 1) + (xcd - r) * q) + off; }
    const int nig = WGM * nN, gid = wgid / nig, fm = gid * WGM, gsz = (nM - fm) < WGM ? (nM - fm) : WGM;
    pm = fm + ((wgid % nig) % gsz); pn = (wgid % nig) / gsz;
}
template <bool PERM, bool GATHER>
DI void unit_off(const UnitD& u, int tid, unsigned (&offA)[2][2], unsigned (&offB)[2]) {
#pragma unroll
    for (int i = 0; i < 2; ++i) {
        int R, C; stage_rc(tid * 16 + i * 8192, R, C);
        const int Rb = PERM ? ((R & ~31) + perm32(R & 31)) : R;
        offB[i] = (unsigned)Rb * u.ldb + (unsigned)C * 2u;
        if (GATHER) {
#pragma unroll
            for (int h = 0; h < 2; ++h) { const int ra = h * HALF + R; const int rr = ra < u.acount ? ra : 0; offA[h][i] = (unsigned)u.arows[rr] * u.lda + (unsigned)C * 2u; }
        } else { offA[0][i] = (unsigned)R * u.lda + (unsigned)C * 2u; offA[1][i] = 0u; }
    }
}

template <class Epi, class Sched, bool GATHER = false>
DI void gemm_run(LAS unsigned char* lds, const Sched& S, const Epi& E, int tid_in) {
    int tid_ = tid_in; asm volatile("" : "+v"(tid_));
    const int tid = tid_, wid = __builtin_amdgcn_readfirstlane(tid >> 6), lane = tid & 63, wr = wid >> 2, wc = wid & 3, fr = lane & 15, fq = lane >> 4;
    const size_t kstep = (size_t)(BK * 2);
    const unsigned ldsw = (unsigned)wid * 1024u;
    const int aoff = lds_byte(wr * 64 + fr, fq * 8), boff = lds_byte(wc * 32 + fr, fq * 8);
#define PG8_SA(b, h) (((b) * 2 + (h)) * HTB)
#define PG8_SB(b, h) ((4 + (b) * 2 + (h)) * HTB)
#define PG8_STAGE(bufoff, gbase, voff) do { _Pragma("unroll") for (int _i = 0; _i < 2; ++_i) \
        __builtin_amdgcn_global_load_lds((const unsigned*)((const char*)(gbase) + (voff)[_i]), (LAS unsigned*)(lds + (bufoff) + ldsw + _i * 8192), 16, 0, 0); } while (0)
#define PG8_LDA(dst, b, h) do { _Pragma("unroll") for (int m = 0; m < 4; ++m) _Pragma("unroll") for (int k = 0; k < 2; ++k) dst[m][k] = *(const LAS bf16x8*)(lds + PG8_SA(b, h) + aoff + m * 2048 + k * 1024); } while (0)
#define PG8_LDB(dst, b, h) do { _Pragma("unroll") for (int n = 0; n < 2; ++n) _Pragma("unroll") for (int k = 0; k < 2; ++k) dst[n][k] = *(const LAS bf16x8*)(lds + PG8_SB(b, h) + boff + n * 2048 + k * 1024); } while (0)
#define PG8_MMA(ai, bj, At, Bt) do { __builtin_amdgcn_s_setprio(1); _Pragma("unroll") for (int m = 0; m < 4; ++m) _Pragma("unroll") for (int n = 0; n < 2; ++n) _Pragma("unroll") for (int k = 0; k < 2; ++k) \
        acc[ai][bj][m][n] = __builtin_amdgcn_mfma_f32_16x16x32_bf16(Bt[n][k], At[m][k], acc[ai][bj][m][n], 0, 0, 0); __builtin_amdgcn_s_setprio(0); } while (0)
#define PG8_WAIT_V(n) asm volatile("s_waitcnt vmcnt(" #n ")" ::: "memory")
#define PG8_WAIT_L(n) asm volatile("s_waitcnt lgkmcnt(" #n ")" ::: "memory")
#define PG8_BAR __builtin_amdgcn_s_barrier()
#define PG8_SCHED __builtin_amdgcn_sched_barrier(0)
    UnitD cur, nxt; int ui = 0;
    if (!S.next(0, cur)) return;
    unsigned offA[2][2], offB[2];
    unit_off<Epi::PERM, GATHER>(cur, tid, offA, offB);
    size_t hA = GATHER ? 0 : (size_t)HALF * cur.lda, hB = (size_t)HALF * cur.ldb;
#define OA(h) offA[GATHER ? (h) : 0]
    f32x4 acc[2][2][4][2];
#pragma unroll
    for (int a = 0; a < 2; ++a)
#pragma unroll
        for (int b = 0; b < 2; ++b)
#pragma unroll
            for (int m = 0; m < 4; ++m)
#pragma unroll
                for (int n = 0; n < 2; ++n) acc[a][b][m][n] = (f32x4){0.f, 0.f, 0.f, 0.f};
    bf16x8 At[4][2], B0[2][2], B1[2][2];
    PG8_STAGE(PG8_SB(0, 0), cur.B, offB); PG8_STAGE(PG8_SA(0, 0), cur.A, OA(0)); PG8_STAGE(PG8_SB(0, 1), cur.B + hB, offB); PG8_STAGE(PG8_SA(0, 1), cur.A + hA, OA(1));
    if (wr == 1) PG8_BAR;
    PG8_WAIT_V(4); PG8_BAR;
    PG8_STAGE(PG8_SB(1, 0), cur.B + kstep, offB); PG8_STAGE(PG8_SA(1, 0), cur.A + kstep, OA(0)); PG8_STAGE(PG8_SB(1, 1), cur.B + kstep + hB, offB);
    PG8_WAIT_V(6); PG8_BAR;
    for (;;) {
        const bool has_next = S.next(ui + 1, nxt);
        const int nt = cur.K / BK;
        for (int t = 0; t < nt; t += 2) {
            const bool last = (t == nt - 2);
            const char* a1 = cur.A + (size_t)(t + 1) * kstep;
            PG8_LDB(B0, 0, 0); PG8_SCHED; PG8_LDA(At, 0, 0); PG8_STAGE(PG8_SA(1, 1), a1 + hA, OA(1));
            PG8_WAIT_L(8); PG8_BAR; PG8_WAIT_L(0); PG8_MMA(0, 0, At, B0); PG8_BAR; PG8_SCHED;
            const char* a2; const char* b2;
            if (last) { if (has_next) { unit_off<Epi::PERM, GATHER>(nxt, tid, offA, offB); a2 = nxt.A; b2 = nxt.B; hA = GATHER ? 0 : (size_t)HALF * nxt.lda; hB = (size_t)HALF * nxt.ldb; } else { a2 = cur.A; b2 = cur.B; } }
            else { a2 = cur.A + (size_t)(t + 2) * kstep; b2 = cur.B + (size_t)(t + 2) * kstep; }
            const char* a3 = a2 + kstep; const char* b3 = b2 + kstep;
            PG8_LDB(B1, 0, 1); PG8_STAGE(PG8_SB(0, 0), b2, offB);
            PG8_BAR; PG8_WAIT_L(0); PG8_MMA(0, 1, At, B1); PG8_BAR;
            PG8_LDA(At, 0, 1); PG8_STAGE(PG8_SA(0, 0), a2, OA(0));
            PG8_BAR; PG8_WAIT_L(0); PG8_MMA(1, 0, At, B0); PG8_BAR; PG8_SCHED;
            PG8_STAGE(PG8_SB(0, 1), b2 + hB, offB);
            PG8_WAIT_V(6); PG8_BAR; PG8_MMA(1, 1, At, B1); PG8_BAR;
            PG8_LDB(B0, 1, 0); PG8_SCHED; PG8_LDA(At, 1, 0); PG8_STAGE(PG8_SA(0, 1), a2 + hA, OA(1));
            PG8_WAIT_L(8); PG8_BAR; PG8_WAIT_L(0); PG8_MMA(0, 0, At, B0); PG8_BAR; PG8_SCHED;
            PG8_LDB(B1, 1, 1); PG8_STAGE(PG8_SB(1, 0), b3, offB);
            PG8_BAR; PG8_WAIT_L(0); PG8_MMA(0, 1, At, B1); PG8_BAR;
            PG8_LDA(At, 1, 1); PG8_STAGE(PG8_SA(1, 0), a3, OA(0));
            PG8_BAR; PG8_WAIT_L(0); PG8_MMA(1, 0, At, B0); PG8_BAR; PG8_SCHED;
            PG8_STAGE(PG8_SB(1, 1), b3 + hB, offB);
            PG8_WAIT_V(6); PG8_BAR; PG8_MMA(1, 1, At, B1); PG8_BAR;
        }
        { int fr_ = fr, fq_ = fq; asm volatile("" : "+v"(fr_), "+v"(fq_)); E(acc, cur, wr, wc, fr_, fq_); }
        if (!has_next) break;
#pragma unroll
        for (int a = 0; a < 2; ++a)
#pragma unroll
            for (int b = 0; b < 2; ++b)
#pragma unroll
                for (int m = 0; m < 4; ++m)
#pragma unroll
                    for (int n = 0; n < 2; ++n) acc[a][b][m][n] = (f32x4){0.f, 0.f, 0.f, 0.f};
        cur = nxt; ++ui;
    }
    PG8_WAIT_V(0);
    if (wr == 0) PG8_BAR;
    PG8_BAR;
#undef OA
#undef PG8_SA
#undef PG8_SB
#undef PG8_STAGE
#undef PG8_LDA
#undef PG8_LDB
#undef PG8_MMA
#undef PG8_WAIT_V
#undef PG8_WAIT_L
#undef PG8_BAR
#undef PG8_SCHED
}
}
struct Args { const float* in[19]; float* out; unsigned char* ws; int step_lo, step_hi; };
struct Frame {
    LAS unsigned char* lds; unsigned char* ldsg;
    int tid, lane, wave, G, bid;
    const float *x, *c, *ada_w, *ada_b, *w_in, *conv_w, *gate_b, *norm_g, *w_bm, *w_ba, *w_out, *router_w, *router_b, *w_gate, *w_up, *w_down, *g_mix, *g_ffn, *g_fin;
    float* out; unsigned char* ws; unsigned* ctl;
    float* MOD; float* WIF; float* RW; unsigned char* W;
    bf16_t* U; float* GIF; bf16_t* HM; bf16_t* HA; unsigned char* TOKI; unsigned char* R0; bf16_t* XB;
};
#define CAS __attribute__((address_space(4)))
DI const void* karg(int idx) { asm volatile("" : "+s"(idx)); const void* const CAS* kp = (const void* const CAS*)__builtin_amdgcn_kernarg_segment_ptr(); return kp[idx]; }
DI void frame_init(Frame& F, unsigned char* lds_generic, int tid) {
    F.ldsg = lds_generic; F.lds = (LAS unsigned char*)lds_generic;
    F.tid = tid; F.lane = F.tid & 63; F.wave = __builtin_amdgcn_readfirstlane(F.tid >> 6); F.G = gridDim.x; F.bid = blockIdx.x;
    F.x = (const float*)karg(0); F.c = (const float*)karg(1); F.ada_w = (const float*)karg(2); F.ada_b = (const float*)karg(3); F.w_in = (const float*)karg(4); F.conv_w = (const float*)karg(5);
    F.gate_b = (const float*)karg(6); F.norm_g = (const float*)karg(7); F.w_bm = (const float*)karg(8); F.w_ba = (const float*)karg(9); F.w_out = (const float*)karg(10); F.router_w = (const float*)karg(11);
    F.router_b = (const float*)karg(12); F.w_gate = (const float*)karg(13); F.w_up = (const float*)karg(14); F.w_down = (const float*)karg(15); F.g_mix = (const float*)karg(16); F.g_ffn = (const float*)karg(17); F.g_fin = (const float*)karg(18);
    F.out = (float*)karg(19); unsigned char* ws = (unsigned char*)karg(20);
    F.ws = ws; F.ctl = (unsigned*)(ws + WS_CTL);
    F.MOD = (float*)(ws + WS_MOD); F.WIF = (float*)(ws + WS_WIF); F.RW = (float*)(ws + WS_RW); F.W = ws + WS_W;
    F.U = (bf16_t*)(ws + WS_U); F.GIF = (float*)(ws + WS_GIF); F.HM = (bf16_t*)(ws + WS_HM); F.HA = (bf16_t*)(ws + WS_HA);
    F.TOKI = ws + WS_TOKI; F.R0 = ws + WS_R0; F.XB = (bf16_t*)(ws + WS_XB);
}

struct TJob { const float* src; int ld; int K; int N; bf16_t* dst; int rmul, radd; };
DI bool get_job(const Frame& F, int l, int j, TJob& J) {
    const float* win = F.w_in + (size_t)l * DM * INC;
    bf16_t* W = (bf16_t*)F.W;
    J.rmul = 1; J.radd = 0; J.K = 1024; J.ld = INC;
    if (j == 0) { J.src = win + 0;    J.N = 1024; J.dst = W + W_NAT / 2 + (size_t)0 * 1024; return true; }
    if (j == 1) { J.src = win + 1024; J.N = 1024; J.dst = W + W_NAT / 2 + (size_t)1024 * 1024; return true; }
    if (j == 2) { J.src = win + 3072; J.N = 1024; J.dst = W + W_NAT / 2 + (size_t)2048 * 1024; return true; }
    if (j == 3) { J.src = win + 4104; J.N = 1536; J.dst = W + W_NAT / 2 + (size_t)3072 * 1024; return true; }
    if (j == 4) { J.src = win + 5640; J.N = 1536; J.dst = W + W_NAT / 2 + (size_t)4608 * 1024; return true; }
    if (j == 5) { J.src = win + 2048; J.N = 1024; J.dst = W + W_VT / 2 + (size_t)0 * 1024; return true; }
    if (j == 6) { J.src = win + 7176; J.N = 1536; J.dst = W + W_VT / 2 + (size_t)1024 * 1024; return true; }
    if (j == 7) { J.src = win + 8712; J.N = 2048; J.dst = W + W_G / 2; return true; }
    if (j == 8) { J.src = F.w_bm + (size_t)l * 1024 * 1024; J.ld = 1024; J.N = 1024; J.dst = W + W_M / 2; return true; }
    if (j == 9) { J.src = F.w_ba + (size_t)l * 512 * 1024; J.ld = 1024; J.K = 512; J.N = 1024; J.dst = W + W_A / 2; return true; }
    if (j == 10) { J.src = F.w_out + (size_t)l * 1024 * 1024; J.ld = 1024; J.N = 1024; J.dst = W + W_O / 2; return true; }
    const int q = j - 11; if (q >= 48) return false;
    const int e = q / 3, which = q % 3;
    if (which == 0) { J.src = F.w_gate + ((size_t)l * 16 + e) * 1024 * 512; J.ld = 512; J.N = 512; J.dst = W + W_13 / 2 + (size_t)e * 1024 * 1024; J.rmul = 2; J.radd = 0; }
    else if (which == 1) { J.src = F.w_up + ((size_t)l * 16 + e) * 1024 * 512; J.ld = 512; J.N = 512; J.dst = W + W_13 / 2 + (size_t)e * 1024 * 1024; J.rmul = 2; J.radd = 1; }
    else { J.src = F.w_down + ((size_t)l * 16 + e) * 512 * 1024; J.ld = 1024; J.K = 512; J.N = 1024; J.dst = W + W_2 / 2 + (size_t)e * 1024 * 512; }
    return true;
}
constexpr int NJOBS = 59;
struct TIter { int j, t, nk, ntile; TJob J; };
DI bool titer_seek(const Frame& F, int l, TIter& it, int adv) {
    it.t += adv;
    while (it.t >= it.ntile) { it.t -= it.ntile; ++it.j; if (it.j >= NJOBS) return false; get_job(F, l, it.j, it.J); it.nk = it.J.K / 128; it.ntile = it.nk * (it.J.N / 64); }
    return true;
}
DI void tconv_load(const TIter& it, int tid, f32x4 (&v)[4]) {
    const int tk = it.t % it.nk, tn = it.t / it.nk;
#pragma unroll
    for (int i = 0; i < 4; ++i) { const int row = (tid >> 4) + 32 * i, c4 = tid & 15; v[i] = *(const f32x4*)(it.J.src + (size_t)(tk * 128 + row) * it.J.ld + tn * 64 + c4 * 4); }
}
DI void phase_pw(const Frame& F, int l, int b0, int nb) {
    const int me = F.bid - b0; if (me < 0 || me >= nb) return;
    bf16_t* tl = (bf16_t*)F.ldsg;
    const int tid = F.tid;
    TIter it; it.j = 0; it.t = 0; get_job(F, l, 0, it.J); it.nk = it.J.K / 128; it.ntile = it.nk * (it.J.N / 64);
    bool ok = titer_seek(F, l, it, me);
    f32x4 v[4];
    if (ok) tconv_load(it, tid, v);
    while (ok) {
        const int tk = it.t % it.nk, tn = it.t / it.nk; bf16_t* dst = it.J.dst; const int dK = it.J.K, rmul = it.J.rmul, radd = it.J.radd;
#pragma unroll
        for (int i = 0; i < 4; ++i) {
            const int row = (tid >> 4) + 32 * i, c4 = tid & 15;
            const unsigned lo = pack2(v[i][0], v[i][1]), hi = pack2(v[i][2], v[i][3]);
            tl[(c4 * 4 + 0) * 136 + row] = (bf16_t)(lo & 0xffff); tl[(c4 * 4 + 1) * 136 + row] = (bf16_t)(lo >> 16);
            tl[(c4 * 4 + 2) * 136 + row] = (bf16_t)(hi & 0xffff); tl[(c4 * 4 + 3) * 136 + row] = (bf16_t)(hi >> 16);
        }
        ok = titer_seek(F, l, it, nb);
        if (ok) tconv_load(it, tid, v);
        __syncthreads();
#pragma unroll
        for (int i = 0; i < 2; ++i) { const int p = tid + 512 * i, n = p >> 4, k8 = p & 15;
            const u32x4 o = *(const u32x4*)(tl + n * 136 + k8 * 8);
            *(u32x4*)(dst + (size_t)(rmul * (tn * 64 + n) + radd) * dK + tk * 128 + k8 * 8) = o; }
        __syncthreads();
    }
}
DI void phase_p0_small(const Frame& F) {
    float* sc = (float*)F.ldsg;
    float* part = sc + 4096;
    for (int i = F.tid; i < 4096; i += 512) sc[i] = siluf_(F.c[i]);
    __syncthreads();
    for (int it = F.bid; it < 192; it += F.G) {
        const int l = it / 96, cc = it % 96, col = cc * 64 + F.lane, w = F.wave;
        const float* aw = F.ada_w + (size_t)l * 1024 * 6144 + col;
        float a0 = 0.f, a1 = 0.f, a2 = 0.f, a3 = 0.f;
        for (int k = w * 128; k < w * 128 + 128; ++k) { const float wv = aw[(size_t)k * 6144]; a0 += sc[k] * wv; a1 += sc[1024 + k] * wv; a2 += sc[2048 + k] * wv; a3 += sc[3072 + k] * wv; }
        part[(w * 4 + 0) * 64 + F.lane] = a0; part[(w * 4 + 1) * 64 + F.lane] = a1; part[(w * 4 + 2) * 64 + F.lane] = a2; part[(w * 4 + 3) * 64 + F.lane] = a3;
        __syncthreads();
        if (F.tid < 256) { const int b = F.tid >> 6, ln = F.tid & 63; float s = 0.f;
            for (int ww = 0; ww < 8; ++ww) s += part[(ww * 4 + b) * 64 + ln];
            F.MOD[((size_t)l * 4 + b) * 6144 + cc * 64 + ln] = s + F.ada_b[(size_t)l * 6144 + cc * 64 + ln]; }
        __syncthreads();
    }
    for (int i = F.bid * 512 + F.tid; i < 2 * 8 * 1024 + 16 * 1024; i += F.G * 512) {
        if (i < 16384) { const int l = i >> 13, j = (i >> 10) & 7, k = i & 1023; F.WIF[i] = F.w_in[((size_t)l * 1024 + k) * INC + 4096 + j]; }
        else { const int q = i - 16384, e = q >> 10, k = q & 1023; F.RW[q] = F.router_w[k * 16 + e]; }
    }
}

DI void moe_offsets(const unsigned* cnt, int* pre, int tid) { if (tid == 0) { int s = 0; for (int e = 0; e < 16; ++e) { pre[e] = s; s += ((int)cnt[e] + 255) >> 8; } pre[16] = s; } }

template <bool XBF> struct RowRawT;
template <> struct RowRawT<false> { f32x4 x[4]; u32x2 y1[4], y2[4]; float w1, w2; };
template <> struct RowRawT<true> { u32x2 x[4]; u32x2 y1[4], y2[4]; float w1, w2; };
template <bool MOE, bool XBF>
DI void row_issue(const Frame& F, const void* xsrc, int t, int rl, const int* tokiL, const int* pre, RowRawT<XBF>& r) {
#pragma unroll
    for (int q = 0; q < 4; ++q) {
        if constexpr (XBF) r.x[q] = *(const u32x2*)((const bf16_t*)xsrc + (size_t)t * 1024 + F.lane * 4 + 256 * q);
        else r.x[q] = *(const f32x4*)((const float*)xsrc + (size_t)t * 1024 + F.lane * 4 + 256 * q); }
    if (MOE) {
        const int* ti = tokiL + rl * 8;
        const int e1 = ti[0], s1 = ti[1], e2 = ti[2], s2 = ti[3]; r.w1 = __int_as_float(ti[4]); r.w2 = __int_as_float(ti[5]);
        const bf16_t* YS = (const bf16_t*)(F.R0 + R_YS);
        const bf16_t* y1 = YS + (size_t)(pre[e1] * 256 + s1) * 1024; const bf16_t* y2 = YS + (size_t)(pre[e2] * 256 + s2) * 1024;
#pragma unroll
        for (int q = 0; q < 4; ++q) { r.y1[q] = *(const u32x2*)(y1 + F.lane * 4 + 256 * q); r.y2[q] = *(const u32x2*)(y2 + F.lane * 4 + 256 * q); }
    }
}
template <bool MOE, bool XBF>
DI void row_finish(const Frame& F, const RowRawT<XBF>& r, const float* gt, float (&xv)[16]) {
#pragma unroll
    for (int q = 0; q < 4; ++q) {
        if constexpr (XBF) { xv[q * 4] = hlo(r.x[q].x); xv[q * 4 + 1] = hhi(r.x[q].x); xv[q * 4 + 2] = hlo(r.x[q].y); xv[q * 4 + 3] = hhi(r.x[q].y); }
        else { xv[q * 4] = r.x[q][0]; xv[q * 4 + 1] = r.x[q][1]; xv[q * 4 + 2] = r.x[q][2]; xv[q * 4 + 3] = r.x[q][3]; } }
    if (MOE) {
#pragma unroll
        for (int q = 0; q < 4; ++q) { const f32x4 g = *(const f32x4*)(gt + F.lane * 4 + 256 * q); const u32x2 a = r.y1[q], d = r.y2[q];
            xv[q * 4 + 0] += g[0] * (r.w1 * bflo(a.x) + r.w2 * bflo(d.x)); xv[q * 4 + 1] += g[1] * (r.w1 * bfhi(a.x) + r.w2 * bfhi(d.x));
            xv[q * 4 + 2] += g[2] * (r.w1 * bflo(a.y) + r.w2 * bflo(d.y)); xv[q * 4 + 3] += g[3] * (r.w1 * bfhi(a.y) + r.w2 * bfhi(d.y)); }
    }
}
DI float reduce16(float (&v)[16], int lane) {
    const bool b5 = lane & 32, b4 = lane & 16, b3 = lane & 8, b2 = lane & 4;
    float a[8], b[4], c[2];
#pragma unroll
    for (int i = 0; i < 8; ++i) { const float send = b5 ? v[i] : v[8 + i], mine = b5 ? v[8 + i] : v[i]; a[i] = mine + __shfl_xor(send, 32); }
#pragma unroll
    for (int i = 0; i < 4; ++i) { const float send = b4 ? a[i] : a[4 + i], mine = b4 ? a[4 + i] : a[i]; b[i] = mine + __shfl_xor(send, 16); }
#pragma unroll
    for (int i = 0; i < 2; ++i) { const float send = b3 ? b[i] : b[2 + i], mine = b3 ? b[2 + i] : b[i]; c[i] = mine + __shfl_xor(send, 8); }
    float r = (b2 ? c[1] : c[0]) + __shfl_xor(b2 ? c[0] : c[1], 4);
    r += __shfl_xor(r, 2); r += __shfl_xor(r, 1);
    return r;
}
DI float reduce8(float (&v)[8], int lane) {
    const bool b5 = lane & 32, b4 = lane & 16, b3 = lane & 8;
    float a[4], b[2];
#pragma unroll
    for (int i = 0; i < 4; ++i) { const float send = b5 ? v[i] : v[4 + i], mine = b5 ? v[4 + i] : v[i]; a[i] = mine + __shfl_xor(send, 32); }
#pragma unroll
    for (int i = 0; i < 2; ++i) { const float send = b4 ? a[i] : a[2 + i], mine = b4 ? a[2 + i] : a[i]; b[i] = mine + __shfl_xor(send, 16); }
    float r = (b3 ? b[1] : b[0]) + __shfl_xor(b3 ? b[0] : b[1], 8);
    r += __shfl_xor(r, 4); r += __shfl_xor(r, 2); r += __shfl_xor(r, 1);
    return r;
}
struct RowCtx { float gm[16], sh[16]; };
DI void load_rowconst(const Frame& F, const float* g, const float* shv, const float* scv, RowCtx& rc) {
#pragma unroll
    for (int q = 0; q < 4; ++q) { const int c = F.lane * 4 + 256 * q; const f32x4 gv = *(const f32x4*)(g + c), s1 = *(const f32x4*)(scv + c), s0 = *(const f32x4*)(shv + c);
#pragma unroll
        for (int j = 0; j < 4; ++j) { rc.gm[q * 4 + j] = gv[j] * (1.0f + s1[j]); rc.sh[q * 4 + j] = s0[j]; } }
}
DI void stage_toki(const Frame& F, int lprev, int blk, int* tokiL) {
    const int* src = (const int*)(F.TOKI + ((size_t)lprev * T_TOK + (size_t)blk * 128) * 32);
    for (int i = F.tid; i < 1024; i += 512) tokiL[i] = src[i];
}

template <bool MOE>
DI void phase_n1_t(const Frame& F, int l) {
    float* wif = (float*)F.ldsg;
    int* pre = (int*)(F.ldsg + 32768);
    int* tokiL = (int*)(F.ldsg + 32768 + 128);
    for (int i = F.tid; i < 8192; i += 512) wif[i] = F.WIF[(size_t)l * 8192 + i];
    if (MOE) moe_offsets(F.ctl + CW_CNT + 64 * (l - 1), pre, F.tid);
    __syncthreads();
    const void* xsrc = MOE ? (const void*)F.XB : (const void*)F.x;
    for (int blk = F.bid; blk < T_TOK / 128; blk += F.G) {
        const int b = blk / (SEQ / 128);
        const float* mod = F.MOD + ((size_t)l * 4 + b) * 6144;
        const float* gt = F.MOD + ((size_t)(MOE ? l - 1 : 0) * 4 + b) * 6144 + 5120;
        RowCtx rc; load_rowconst(F, F.g_mix + (size_t)l * 1024, mod, mod + 1024, rc);
        if (MOE) { __syncthreads(); stage_toki(F, l - 1, blk, tokiL); __syncthreads(); }
        RowRawT<MOE> nx0, nx1; row_issue<MOE, MOE>(F, xsrc, blk * 128 + F.wave * 16, F.wave * 16, tokiL, pre, nx0); row_issue<MOE, MOE>(F, xsrc, blk * 128 + F.wave * 16 + 1, F.wave * 16 + 1, tokiL, pre, nx1);
#pragma unroll 1
        for (int i = 0; i < 16; i += 2) {
            const int rl = F.wave * 16 + i, t = blk * 128 + rl;
            asm volatile("" ::: "memory");
            const RowRawT<MOE> c0 = nx0, c1 = nx1;
            if (i < 14) { row_issue<MOE, MOE>(F, xsrc, t + 2, rl + 2, tokiL, pre, nx0); row_issue<MOE, MOE>(F, xsrc, t + 3, rl + 3, tokiL, pre, nx1); }
            float xa[16], xb[16]; row_finish<MOE, MOE>(F, c0, gt, xa); row_finish<MOE, MOE>(F, c1, gt, xb);
            if (MOE) {
#pragma unroll
                for (int q = 0; q < 4; ++q) { u32x2 w; w.x = pack2h(xa[q * 4], xa[q * 4 + 1]); w.y = pack2h(xa[q * 4 + 2], xa[q * 4 + 3]); *(u32x2*)(F.XB + (size_t)t * 1024 + F.lane * 4 + 256 * q) = w;
                    w.x = pack2h(xb[q * 4], xb[q * 4 + 1]); w.y = pack2h(xb[q * 4 + 2], xb[q * 4 + 3]); *(u32x2*)(F.XB + (size_t)(t + 1) * 1024 + F.lane * 4 + 256 * q) = w; }
            }
            float sa = 0.f, sb = 0.f;
#pragma unroll
            for (int j = 0; j < 16; ++j) { sa += xa[j] * xa[j]; sb += xb[j] * xb[j]; }
            sa = wave_sum(sa); sb = wave_sum(sb);
            const float ra = __builtin_amdgcn_rsqf(sa * (1.0f / 1024.0f) + EPS), rb = __builtin_amdgcn_rsqf(sb * (1.0f / 1024.0f) + EPS);
#pragma unroll
            for (int j = 0; j < 16; ++j) { xa[j] = xa[j] * ra * rc.gm[j] + rc.sh[j]; xb[j] = xb[j] * rb * rc.gm[j] + rc.sh[j]; }
#pragma unroll
            for (int q = 0; q < 4; ++q) { u32x2 w; w.x = pack2(xa[q * 4], xa[q * 4 + 1]); w.y = pack2(xa[q * 4 + 2], xa[q * 4 + 3]); *(u32x2*)(F.U + (size_t)t * 1024 + F.lane * 4 + 256 * q) = w;
                w.x = pack2(xb[q * 4], xb[q * 4 + 1]); w.y = pack2(xb[q * 4 + 2], xb[q * 4 + 3]); *(u32x2*)(F.U + (size_t)(t + 1) * 1024 + F.lane * 4 + 256 * q) = w; }
            float da[8], db[8];
#pragma unroll
            for (int g = 0; g < 8; ++g) { float s0 = 0.f, s1 = 0.f;
#pragma unroll
                for (int q = 0; q < 4; ++q) { const f32x4 wv = *(const f32x4*)(wif + g * 1024 + F.lane * 4 + 256 * q);
                    s0 += xa[q * 4] * wv[0] + xa[q * 4 + 1] * wv[1] + xa[q * 4 + 2] * wv[2] + xa[q * 4 + 3] * wv[3];
                    s1 += xb[q * 4] * wv[0] + xb[q * 4 + 1] * wv[1] + xb[q * 4 + 2] * wv[2] + xb[q * 4 + 3] * wv[3]; }
                da[g] = s0; db[g] = s1; }
            const float reda = reduce8(da, F.lane), redb = reduce8(db, F.lane);
            const float ma = __shfl(reda, (F.lane & 7) * 8), mb = __shfl(redb, (F.lane & 7) * 8);
            if (F.lane < 16) {
                const int gl = F.lane & 7; float v = (F.lane < 8) ? ma : mb;
                v += F.gate_b[l * 8 + gl];
                if (gl >= 4) { const float e = __expf(-fabsf(v)); const float l1p = (e < 0.03f) ? e * (1.0f - e * (0.5f - e * (0.33333334f - 0.25f * e))) : __logf(1.0f + e); v = fminf(v, 0.f) - l1p; }
                F.GIF[(size_t)t * 8 + F.lane] = v;
            }
        }
    }
}
DI void phase_n1(const Frame& F, int l) { if (l == 0) phase_n1_t<false>(F, 0); else phase_n1_t<true>(F, l); }

DI void phase_n2(const Frame& F, int l) {
    float* rw = (float*)F.ldsg;
    int* cntL = (int*)(F.ldsg + 65536);
    int* baseL = cntL + 16;
    int* rec = baseL + 16;
    for (int i = F.tid; i < 16384; i += 512) rw[i] = F.RW[i];
    __syncthreads();
    unsigned* gcnt = F.ctl + CW_CNT + 64 * l;
    int* SLOT = (int*)(F.R0 + R_SLOT);
    for (int blk = F.bid; blk < T_TOK / 128; blk += F.G) {
        const int b = blk / (SEQ / 128);
        const float* mod = F.MOD + ((size_t)l * 4 + b) * 6144;
        RowCtx rc; load_rowconst(F, F.g_ffn + (size_t)l * 1024, mod + 3072, mod + 4096, rc);
        if (F.tid < 16) cntL[F.tid] = 0;
        __syncthreads();
        RowRawT<true> nx0, nx1, fx0, fx1;
        row_issue<false, true>(F, F.XB, blk * 128 + F.wave * 16, 0, nullptr, nullptr, nx0); row_issue<false, true>(F, F.XB, blk * 128 + F.wave * 16 + 1, 0, nullptr, nullptr, nx1);
        row_issue<false, true>(F, F.XB, blk * 128 + F.wave * 16 + 2, 0, nullptr, nullptr, fx0); row_issue<false, true>(F, F.XB, blk * 128 + F.wave * 16 + 3, 0, nullptr, nullptr, fx1);
#pragma unroll 1
        for (int i = 0; i < 16; i += 2) {
            const int rl = F.wave * 16 + i, t = blk * 128 + rl;
            asm volatile("" ::: "memory");
            const RowRawT<true> c0 = nx0, c1 = nx1; nx0 = fx0; nx1 = fx1;
            if (i < 12) { row_issue<false, true>(F, F.XB, t + 4, 0, nullptr, nullptr, fx0); row_issue<false, true>(F, F.XB, t + 5, 0, nullptr, nullptr, fx1); }
            float xa[16], xb[16]; row_finish<false, true>(F, c0, nullptr, xa); row_finish<false, true>(F, c1, nullptr, xb);
            float sa = 0.f, sb = 0.f;
#pragma unroll
            for (int j = 0; j < 16; ++j) { sa += xa[j] * xa[j]; sb += xb[j] * xb[j]; }
            sa = wave_sum(sa); sb = wave_sum(sb);
            const float ra = __builtin_amdgcn_rsqf(sa * (1.0f / 1024.0f) + EPS), rb = __builtin_amdgcn_rsqf(sb * (1.0f / 1024.0f) + EPS);
#pragma unroll
            for (int j = 0; j < 16; ++j) { xa[j] = xa[j] * ra * rc.gm[j] + rc.sh[j]; xb[j] = xb[j] * rb * rc.gm[j] + rc.sh[j]; }
#pragma unroll
            for (int q = 0; q < 4; ++q) { u32x2 w; w.x = pack2(xa[q * 4], xa[q * 4 + 1]); w.y = pack2(xa[q * 4 + 2], xa[q * 4 + 3]); *(u32x2*)(F.U + (size_t)t * 1024 + F.lane * 4 + 256 * q) = w;
                w.x = pack2(xb[q * 4], xb[q * 4 + 1]); w.y = pack2(xb[q * 4 + 2], xb[q * 4 + 3]); *(u32x2*)(F.U + (size_t)(t + 1) * 1024 + F.lane * 4 + 256 * q) = w; }
            float la[16], lb[16];
#pragma unroll
            for (int e = 0; e < 16; ++e) { float s0 = 0.f, s1 = 0.f;
#pragma unroll
                for (int q = 0; q < 4; ++q) { const f32x4 wv = *(const f32x4*)(rw + e * 1024 + F.lane * 4 + 256 * q);
                    s0 += xa[q * 4] * wv[0] + xa[q * 4 + 1] * wv[1] + xa[q * 4 + 2] * wv[2] + xa[q * 4 + 3] * wv[3];
                    s1 += xb[q * 4] * wv[0] + xb[q * 4 + 1] * wv[1] + xb[q * 4 + 2] * wv[2] + xb[q * 4 + 3] * wv[3]; }
                la[e] = s0; lb[e] = s1; }
            const float reda = reduce16(la, F.lane), redb = reduce16(lb, F.lane);
            const float ma = __shfl(reda, (F.lane & 15) * 4), mb = __shfl(redb, (F.lane & 15) * 4);
            const int base = F.lane & 16;
            const float mine = base ? mb : ma;
            const float score = 1.0f / (1.0f + __expf(-mine));
            const float sel = score + F.router_b[F.lane & 15];
            const float s0 = __shfl(sel, (F.lane & ~3) + 0), s1 = __shfl(sel, (F.lane & ~3) + 1), s2 = __shfl(sel, (F.lane & ~3) + 2), s3 = __shfl(sel, (F.lane & ~3) + 3);
            const float mx = fmaxf(fmaxf(s0, s1), fmaxf(s2, s3));
            const int im = (s0 == mx) ? 0 : (s1 == mx) ? 1 : (s2 == mx) ? 2 : 3;
            const float t0 = (im == 0) ? -INFINITY : s0, t1 = (im == 1) ? -INFINITY : s1, t2 = (im == 2) ? -INFINITY : s2, t3 = (im == 3) ? -INFINITY : s3;
            const float mx2 = fmaxf(fmaxf(t0, t1), fmaxf(t2, t3));
            const int im2 = (t0 == mx2) ? 0 : (t1 == mx2) ? 1 : (t2 == mx2) ? 2 : 3;
            const float gs = mx + mx2;
            const float g0 = __shfl(gs, base + 0), g1 = __shfl(gs, base + 4), g2 = __shfl(gs, base + 8), g3 = __shfl(gs, base + 12);
            const float gm = fmaxf(fmaxf(g0, g1), fmaxf(g2, g3));
            const int bg = (g0 == gm) ? 0 : (g1 == gm) ? 1 : (g2 == gm) ? 2 : 3;
            const int e1 = __shfl(bg * 4 + im, base + bg * 4), e2 = __shfl(bg * 4 + im2, base + bg * 4);
            const float sc1 = __shfl(score, base + e1), sc2 = __shfl(score, base + e2);
            if (F.lane == 0 || F.lane == 16) {
                const int rr = rl + (F.lane >> 4);
                const float inv = 1.0f / (sc1 + sc2);
                const int r1 = atomicAdd(&cntL[e1], 1), r2 = atomicAdd(&cntL[e2], 1);
                int* r = rec + rr * 6; r[0] = e1; r[1] = r1; r[2] = e2; r[3] = r2; r[4] = __float_as_int(sc1 * inv); r[5] = __float_as_int(sc2 * inv);
            }
        }
        __syncthreads();
        if (F.tid < 16) baseL[F.tid] = (int)atomicAdd(&gcnt[F.tid], (unsigned)cntL[F.tid]);
        __syncthreads();
        if (F.tid < 128) {
            const int t = blk * 128 + F.tid; const int* r = rec + F.tid * 6;
            const int e1 = r[0], s1 = baseL[e1] + r[1], e2 = r[2], s2 = baseL[e2] + r[3];
            SLOT[e1 * 32768 + s1] = t; SLOT[e2 * 32768 + s2] = t;
            int* ti = (int*)(F.TOKI + ((size_t)l * T_TOK + t) * 32);
            ti[0] = e1; ti[1] = s1; ti[2] = e2; ti[3] = s2; ti[4] = r[4]; ti[5] = r[5];
        }
        __syncthreads();
    }
}

DI void phase_fn(const Frame& F) {
    int* pre = (int*)F.ldsg;
    int* tokiL = (int*)(F.ldsg + 128);
    moe_offsets(F.ctl + CW_CNT + 64 * (DEPTH - 1), pre, F.tid);
    __syncthreads();
    for (int blk = F.bid; blk < T_TOK / 128; blk += F.G) {
        const int b = blk / (SEQ / 128);
        const float* gt = F.MOD + ((size_t)(DEPTH - 1) * 4 + b) * 6144 + 5120;
        __syncthreads(); stage_toki(F, DEPTH - 1, blk, tokiL); __syncthreads();
        RowRawT<true> nx; row_issue<true, true>(F, F.XB, blk * 128 + F.wave * 16, F.wave * 16, tokiL, pre, nx);
#pragma unroll 1
        for (int i = 0; i < 16; ++i) {
            const int rl = F.wave * 16 + i, t = blk * 128 + rl;
            const RowRawT<true> cur = nx;
            if (i < 15) row_issue<true, true>(F, F.XB, t + 1, rl + 1, tokiL, pre, nx);
            float xv[16]; row_finish<true, true>(F, cur, gt, xv);
            float ss = 0.f;
#pragma unroll
            for (int j = 0; j < 16; ++j) ss += xv[j] * xv[j];
            ss = wave_sum(ss);
            const float rn = __builtin_amdgcn_rsqf(ss * (1.0f / 1024.0f) + EPS);
#pragma unroll
            for (int q = 0; q < 4; ++q) { const f32x4 g = *(const f32x4*)(F.g_fin + F.lane * 4 + 256 * q);
                *(f32x4*)(F.out + (size_t)t * 1024 + F.lane * 4 + 256 * q) = (f32x4){xv[q * 4] * rn * g[0], xv[q * 4 + 1] * rn * g[1], xv[q * 4 + 2] * rn * g[2], xv[q * 4 + 3] * rn * g[3]}; }
        }
    }
}
DI void ml1_unit(const Frame& F, int l, int h, int j, int eg) {
    const bf16_t* P = (const bf16_t*)(F.R0 + R_P); bf16_t* QC = (bf16_t*)(F.R0 + R_QC);
    const bf16_t* VT = (const bf16_t*)(F.R0 + R_VT);
    bf16_t* NUM = (bf16_t*)(F.R0 + R_NUM); bf16_t* SLOC = (bf16_t*)(F.R0 + R_SLOC);
    float* DENI = (float*)(F.R0 + R_DENI); float* EBC = (float*)(F.R0 + R_EBC); float* EBL = (float*)(F.R0 + R_EBL);
    float* SCB = (float*)(F.R0 + R_SCB); float* CHB = (float*)(F.R0 + R_CHB); float* DN = (float*)(F.R0 + R_DN);
    const int tid = F.tid, lane = F.lane, w = F.wave, rr = lane & 31, hh = lane >> 5;
    const int tl0 = j * 256;
    const size_t tg0 = (size_t)eg * TQ + tl0;
    LAS unsigned char* L = F.lds;
    LAS bf16_t* Sl = (LAS bf16_t*)L;
    LAS float* Lb = (LAS float*)(L + 9216);
    LAS float* Lg = Lb + 256;
    LAS float* Lws = Lg + 256;
    LAS float* Leb = Lws + 256;
    LAS float* Lden = Leb + 256;
    LAS float* Lbl = Lden + 256;
    LAS float* Wc = (LAS float*)(L + 14592);
    LAS bf16_t* Qs = (LAS bf16_t*)(L + 22784);
    LAS bf16_t* KTs = (LAS bf16_t*)(L + 56576);
    LAS bf16_t* Rw = (LAS bf16_t*)(L + 93440);
    for (int i = tid; i < 2048; i += 512) { const int which = i >> 10, jj = (i >> 8) & 3, ch = i & 255; Wc[i] = F.conv_w[((size_t)l * 4 + jj) * 2048 + which * 1024 + h * 256 + ch]; }
    if (w < 4) {
        const int c = w, t = c * 64 + lane;
        const float li = F.GIF[(tg0 + t) * 8 + h], lf = F.GIF[(tg0 + t) * 8 + 4 + h];
        float b = lf;
#pragma unroll
        for (int o = 1; o < 64; o <<= 1) { const float v = __shfl_up(b, o); if (lane >= o) b += v; }
        const float bl = __shfl(b, 63);
        Lb[t] = b; Lg[t] = li - b; Lws[t] = __expf(bl - b + li); Leb[t] = __expf(b); Lden[t] = 0.f;
        if (lane == 0) Lbl[c] = bl;
    }
    __syncthreads();
    if (tid < 256) {
        const int c = tid >> 6; float pre = 0.f;
        for (int cc = 0; cc < c; ++cc) pre += Lbl[cc];
        EBC[(size_t)(tl0 + tid) * 4 + h] = Leb[tid];
        EBL[(size_t)(tl0 + tid) * 4 + h] = __expf(Lb[tid] + pre);
        if (tid < 4) CHB[h * 128 + j * 4 + tid] = Lbl[tid];
        if (tid == 0) SCB[h * 32 + j] = Lbl[0] + Lbl[1] + Lbl[2] + Lbl[3];
    }
    f32x16 Ct[8];
#pragma unroll
    for (int i = 0; i < 8; ++i)
#pragma unroll
        for (int r = 0; r < 16; ++r) Ct[i][r] = 0.f;
    for (int c = 0; c < 4; ++c) {
        int rr_ = rr, hh_ = hh, tid_ = tid; asm volatile("" : "+v"(rr_), "+v"(hh_), "+v"(tid_));
        const bf16_t* vbase = VT + (size_t)(h * 256 + w * 32 + rr_) * TQ + tl0 + c * 64 + hh_ * 8;
        bf16x8 vf[4];
        const int t0c = tl0 + c * 64;
        u32x4 rk[5];
        { u32x4 rq[5];
#pragma unroll
          for (int i5 = 0; i5 < 5; ++i5) { const int i = tid_ + 512 * i5, r = i >> 5, pc = i & 31, t = t0c - 3 + r;
              rq[i5] = (u32x4){0u, 0u, 0u, 0u};
              if (i < 67 * 32 && t >= 0) rq[i5] = *(const u32x4*)(P + (size_t)t * NNAT + h * 256 + pc * 8); }
#pragma unroll
          for (int i5 = 0; i5 < 5; ++i5) { const int i = tid_ + 512 * i5, r = i >> 5, pc = i & 31; if (i < 67 * 32) *(LAS u32x4*)(Rw + r * 264 + pc * 8) = rq[i5]; } }
#pragma unroll
        for (int i5 = 0; i5 < 5; ++i5) { const int i = tid_ + 512 * i5, r = i >> 5, pc = i & 31, t = t0c - 3 + r;
            rk[i5] = (u32x4){0u, 0u, 0u, 0u};
            if (i < 67 * 32 && t >= 0) rk[i5] = *(const u32x4*)(P + (size_t)t * NNAT + 1024 + h * 256 + pc * 8); }
        __syncthreads();
        { const int cg = tid_ & 31;
#pragma unroll
          for (int i = 0; i < 4; ++i) { const int tr = (tid_ >> 5) + 16 * i;
              float y[8];
#pragma unroll
              for (int k = 0; k < 8; ++k) y[k] = 0.f;
#pragma unroll
              for (int jj = 0; jj < 4; ++jj) { const u32x4 v = *(const LAS u32x4*)(Rw + (tr + jj) * 264 + cg * 8);
                  const f32x4 wa = *(const LAS f32x4*)(Wc + jj * 256 + cg * 8), wb = *(const LAS f32x4*)(Wc + jj * 256 + cg * 8 + 4);
                  y[0] += wa[0] * bflo(v.x); y[1] += wa[1] * bfhi(v.x); y[2] += wa[2] * bflo(v.y); y[3] += wa[3] * bfhi(v.y);
                  y[4] += wb[0] * bflo(v.z); y[5] += wb[1] * bfhi(v.z); y[6] += wb[2] * bflo(v.w); y[7] += wb[3] * bfhi(v.w); }
#pragma unroll
              for (int k = 0; k < 8; ++k) y[k] = siluf_(y[k]) * 0.0625f;
              u32x4 o; o.x = pack2(y[0], y[1]); o.y = pack2(y[2], y[3]); o.z = pack2(y[4], y[5]); o.w = pack2(y[6], y[7]);
              *(LAS u32x4*)(Qs + tr * 264 + cg * 8) = o;
              *(u32x4*)(QC + (size_t)(t0c + tr) * 1024 + h * 256 + cg * 8) = o;
              asm volatile("" ::: "memory"); } }
        __syncthreads();
#pragma unroll
        for (int i5 = 0; i5 < 5; ++i5) { const int i = tid_ + 512 * i5, r = i >> 5, pc = i & 31; if (i < 67 * 32) *(LAS u32x4*)(Rw + r * 264 + pc * 8) = rk[i5]; }
        __syncthreads();
        { const int tr = tid_ & 63, wv = tid_ >> 6;
#pragma unroll
          for (int sub = 0; sub < 4; ++sub) { const int ch0 = wv * 32 + sub * 8;
              float y[8];
#pragma unroll
              for (int k = 0; k < 8; ++k) y[k] = 0.f;
#pragma unroll
              for (int jj = 0; jj < 4; ++jj) { const u32x4 v = *(const LAS u32x4*)(Rw + (tr + jj) * 264 + ch0);
                  const f32x4 wa = *(const LAS f32x4*)(Wc + 1024 + jj * 256 + ch0), wb = *(const LAS f32x4*)(Wc + 1024 + jj * 256 + ch0 + 4);
                  y[0] += wa[0] * bflo(v.x); y[1] += wa[1] * bfhi(v.x); y[2] += wa[2] * bflo(v.y); y[3] += wa[3] * bfhi(v.y);
                  y[4] += wb[0] * bflo(v.z); y[5] += wb[1] * bfhi(v.z); y[6] += wb[2] * bflo(v.w); y[7] += wb[3] * bfhi(v.w); }
#pragma unroll
              for (int k = 0; k < 8; k += 2) { const unsigned pk = pack2(siluf_(y[k]), siluf_(y[k + 1]));
                  KTs[(ch0 + k) * 72 + tr] = (bf16_t)(pk & 0xffff); KTs[(ch0 + k + 1) * 72 + tr] = (bf16_t)(pk >> 16); }
              asm volatile("" ::: "memory"); } }
        __syncthreads();
        if (w < 3) {
            const int ti = (w == 0) ? 0 : 1, si = (w == 2) ? 1 : 0;
            f32x16 acc;
#pragma unroll
            for (int r = 0; r < 16; ++r) acc[r] = 0.f;
            typedef short s16x4 __attribute__((ext_vector_type(4)));
            const int l16 = rr_ & 15;
            const LAS bf16_t* ktr = KTs + (hh_ * 8 + (l16 >> 2)) * 72 + si * 32 + 16 * (rr_ >> 4) + 4 * (l16 & 3);
            const LAS bf16_t* qrow = Qs + (ti * 32 + rr_) * 264 + hh_ * 8;
#pragma unroll 4
            for (int ks = 0; ks < 16; ++ks) {
                const s16x4 lo = __builtin_amdgcn_ds_read_tr16_b64_v4i16((LAS s16x4*)(ktr + (ks * 16) * 72));
                const s16x4 hi = __builtin_amdgcn_ds_read_tr16_b64_v4i16((LAS s16x4*)(ktr + (ks * 16 + 4) * 72));
                const bf16x8 kf = __builtin_shufflevector(lo, hi, 0, 1, 2, 3, 4, 5, 6, 7);
                acc = MFMA32(kf, *(const LAS bf16x8*)(qrow + ks * 16), acc);
            }
            const int tloc = c * 64 + ti * 32 + rr; const float bt = Lb[tloc];
            float rs = 0.f;
#pragma unroll
            for (int g = 0; g < 4; ++g) {
                float v[4];
#pragma unroll
                for (int q = 0; q < 4; ++q) { const int r = g * 4 + q, sl = si * 32 + crow(r, hh);
                    float wgt = __expf(bt + Lg[c * 64 + sl]);
                    if (sl > ti * 32 + rr) wgt = 0.f;
                    v[q] = acc[r] * wgt; rs += v[q]; }
                u32x2 o; o.x = pack2(v[0], v[1]); o.y = pack2(v[2], v[3]);
                *(LAS u32x2*)(Sl + (ti * 32 + rr) * 72 + si * 32 + 8 * g + 4 * hh) = o;
            }
            rs += __shfl_xor(rs, 32);
            if (hh == 0) atomicAdd((float*)(F.ldsg + 9216 + 4 * 1024) + tloc, rs);
        } else if (w >= 4) {
            const int d = tid_ - 256;
            const LAS bf16_t* kt = KTs + d * 72; const LAS float* ws = Lws + c * 64;
            float s = 0.f;
#pragma unroll
            for (int o = 0; o < 8; ++o) { const u32x4 v = *(const LAS u32x4*)(kt + o * 8);
                s += bflo(v.x) * ws[o * 8] + bfhi(v.x) * ws[o * 8 + 1] + bflo(v.y) * ws[o * 8 + 2] + bfhi(v.y) * ws[o * 8 + 3] + bflo(v.z) * ws[o * 8 + 4] + bfhi(v.z) * ws[o * 8 + 5] + bflo(v.w) * ws[o * 8 + 6] + bfhi(v.w) * ws[o * 8 + 7]; }
            DN[((size_t)h * 128 + j * 4 + c) * 256 + d] = s;
        }
        __syncthreads();
        if (tid_ < 64) DENI[(size_t)(tl0 + c * 64 + tid_) * 4 + h] = Lden[c * 64 + tid_];
#pragma unroll
        for (int ks = 0; ks < 4; ++ks) vf[ks] = ldg8(vbase + ks * 16);
        f32x16 a0, a1;
#pragma unroll
        for (int r = 0; r < 16; ++r) { a0[r] = 0.f; a1[r] = 0.f; }
        const LAS bf16_t* q0 = Qs + rr_ * 264 + hh_ * 8; const LAS bf16_t* q1 = q0 + 32 * 264;
#pragma unroll
        for (int db = 0; db < 8; ++db)
#pragma unroll
            for (int s2 = 0; s2 < 2; ++s2) {
                const bf16x8 cf = packf8(Ct[db][8 * s2], Ct[db][8 * s2 + 1], Ct[db][8 * s2 + 2], Ct[db][8 * s2 + 3], Ct[db][8 * s2 + 4], Ct[db][8 * s2 + 5], Ct[db][8 * s2 + 6], Ct[db][8 * s2 + 7]);
                a0 = MFMA32(*(const LAS bf16x8*)(q0 + db * 32 + s2 * 16), cf, a0);
                a1 = MFMA32(*(const LAS bf16x8*)(q1 + db * 32 + s2 * 16), cf, a1);
                if (s2 == 1 && (db & 1)) asm volatile("" ::: "memory");
            }
#pragma unroll
        for (int r = 0; r < 16; ++r) { a0[r] *= Leb[c * 64 + crow(r, hh)]; a1[r] *= Leb[c * 64 + 32 + crow(r, hh)]; }
#pragma unroll
        for (int ks = 0; ks < 4; ++ks) {
            if (ks < 2) a0 = MFMA32(*(const LAS bf16x8*)(Sl + rr * 72 + ks * 16 + hh * 8), vf[ks], a0);
            a1 = MFMA32(*(const LAS bf16x8*)(Sl + (32 + rr) * 72 + ks * 16 + hh * 8), vf[ks], a1);
        }
        { bf16_t* np = NUM + (size_t)(tl0 + c * 64) * 1024 + h * 256 + w * 32 + rr_;
#pragma unroll
          for (int r = 0; r < 16; r += 2) { const unsigned p0 = pack2(a0[r], a0[r + 1]), p1 = pack2(a1[r], a1[r + 1]);
              np[(size_t)crow(r, hh) * 1024] = (bf16_t)(p0 & 0xffff); np[(size_t)crow(r + 1, hh) * 1024] = (bf16_t)(p0 >> 16);
              np[(size_t)(32 + crow(r, hh)) * 1024] = (bf16_t)(p1 & 0xffff); np[(size_t)(32 + crow(r + 1, hh)) * 1024] = (bf16_t)(p1 >> 16); } }
        const float dec = __expf(Lbl[c]);
#pragma unroll
        for (int ks = 0; ks < 4; ++ks) {
            const u32x4 v = __builtin_bit_cast(u32x4, vf[ks]); const LAS float* ws = Lws + c * 64 + ks * 16 + hh * 8;
            vf[ks] = packf8(bflo(v.x) * ws[0], bfhi(v.x) * ws[1], bflo(v.y) * ws[2], bfhi(v.y) * ws[3], bflo(v.z) * ws[4], bfhi(v.z) * ws[5], bflo(v.w) * ws[6], bfhi(v.w) * ws[7]);
        }
        const LAS bf16_t* ktb = KTs + pi23(rr_) * 72 + hh_ * 8;
#pragma unroll
        for (int db = 0; db < 8; ++db) {
#pragma unroll
            for (int r = 0; r < 16; ++r) Ct[db][r] *= dec;
#pragma unroll
            for (int ks = 0; ks < 4; ++ks) Ct[db] = MFMA32(*(const LAS bf16x8*)(ktb + db * 32 * 72 + ks * 16), vf[ks], Ct[db]);
            if (db & 1) asm volatile("" ::: "memory");
        }
        __syncthreads();
    }
    { int rr2 = rr, hh2 = hh; asm volatile("" : "+v"(rr2), "+v"(hh2));
      bf16_t* sp = SLOC + (((size_t)h * 32 + j) * 256 + w * 32 + rr2) * 256 + hh2 * 8;
#pragma unroll
      for (int db = 0; db < 8; ++db)
#pragma unroll
          for (int a = 0; a < 2; ++a) {
              u32x4 o; o.x = pack2(Ct[db][8 * a], Ct[db][8 * a + 1]); o.y = pack2(Ct[db][8 * a + 2], Ct[db][8 * a + 3]); o.z = pack2(Ct[db][8 * a + 4], Ct[db][8 * a + 5]); o.w = pack2(Ct[db][8 * a + 6], Ct[db][8 * a + 7]);
              *(u32x4*)(sp + db * 32 + a * 16) = o; } }
    __syncthreads();
}

DI void at_block_unit(const Frame& F, int bu_in) {
    int bu = bu_in; asm volatile("" : "+s"(bu));
    bf16_t* P = (bf16_t*)(F.R0 + R_P); const bf16_t* VT = (const bf16_t*)(F.R0 + R_VT); float* LSE = (float*)(F.R0 + R_LSE);
    int lane = F.lane, tid = F.tid; asm volatile("" : "+v"(lane), "+v"(tid));
    const int rr = lane & 31, hh = lane >> 5, w = F.wave;
    const int hd = bu >> 5, qb = bu & 31, g = hd >> 2;
    const int dsh = 2 * g, d = 1 << dsh, lsub = TQ >> dsh, bpr = lsub >> 8;
    const int r = qb / bpr, l0b = (qb % bpr) * 256, l0 = l0b + 32 * w;
    const float slope_d = exp2f(-8.0f * (float)(hd + 1) / 12.0f) * (float)d;
    LAS bf16_t* Ks = (LAS bf16_t*)F.lds;
    LAS bf16_t* Vs = (LAS bf16_t*)F.lds;
    {
        u32x4 st[12];
#pragma unroll
        for (int i = 0; i < 12; ++i) { const int p = tid + 512 * i, row = p >> 4, pc = p & 15; int l = l0b - 128 + row; l = l < 0 ? 0 : l;
            st[i] = *(const u32x4*)(P + (size_t)(l * d + r) * NNAT + 4608 + hd * 128 + pc * 8); }
#pragma unroll
        for (int i = 0; i < 12; ++i) { const int p = tid + 512 * i, row = p >> 4, pc = p & 15; *(LAS u32x4*)(Ks + row * 136 + pc * 8) = st[i]; }
    }
    bf16x8 qf[8];
    { const bf16_t* qp = P + (size_t)((l0 + rr) * d + r) * NNAT + 3072 + hd * 128 + hh * 64;
#pragma unroll
      for (int ks = 0; ks < 8; ++ks) qf[ks] = ldg8(qp + ks * 8); }
    __syncthreads();
    u32x4 vst[12];
#pragma unroll
    for (int i = 0; i < 12; ++i) { const int p = tid + 512 * i, ch = p / 48, pc = p % 48; int l = l0b - 128 + pc * 8; l = l < 0 ? 0 : l;
        vst[i] = *(const u32x4*)(VT + (size_t)(1024 + hd * 128 + ch) * TQ + r * lsub + l); }
    f32x16 sc[5];
    float mx = -1e30f;
    const int prr = pi23(rr);
#pragma unroll
    for (int kt = 0; kt < 5; ++kt) {
#pragma unroll
        for (int i = 0; i < 16; ++i) sc[kt][i] = 0.f;
        const LAS bf16_t* kp = Ks + (32 * (w + kt) + prr) * 136 + hh * 64;
#pragma unroll
        for (int ks = 0; ks < 8; ++ks) sc[kt] = MFMA32(*(const LAS bf16x8*)(kp + ks * 8), qf[ks], sc[kt]);
        const bool tile_ok = (l0 - 128 + 32 * kt) >= 0;
#pragma unroll
        for (int i = 0; i < 16; ++i) {
            const int kk = (i & 3) + 4 * ((i >> 2) & 1) + 8 * hh + 16 * (i >> 3);
            const int dist = 128 - 32 * kt + rr - kk;
            float s = sc[kt][i] - slope_d * (float)dist;
            s = (tile_ok && dist >= 0 && dist <= 128) ? s : -1e30f;
            sc[kt][i] = s; mx = fmaxf(mx, s);
        }
        asm volatile("" ::: "memory");
    }
    mx = fmaxf(mx, __shfl_xor(mx, 32));
    float sum = 0.f;
    bf16x8 pf[5][2];
#pragma unroll
    for (int kt = 0; kt < 5; ++kt) {
        float p[16];
#pragma unroll
        for (int i = 0; i < 16; ++i) { p[i] = __expf(sc[kt][i] - mx); sum += p[i]; }
        pf[kt][0] = packf8(p[0], p[1], p[2], p[3], p[4], p[5], p[6], p[7]);
        pf[kt][1] = packf8(p[8], p[9], p[10], p[11], p[12], p[13], p[14], p[15]);
    }
    sum += __shfl_xor(sum, 32);
    const float inv = 1.0f / sum;
    __syncthreads();
#pragma unroll
    for (int i = 0; i < 12; ++i) { const int p = tid + 512 * i, ch = p / 48, pc = p % 48; *(LAS u32x4*)(Vs + ch * 392 + pc * 8) = vst[i]; }
    __syncthreads();
#pragma unroll
    for (int ct = 0; ct < 4; ++ct) {
        f32x16 o;
#pragma unroll
        for (int i = 0; i < 16; ++i) o[i] = 0.f;
        const LAS bf16_t* vp = Vs + (ct * 32 + rr) * 392 + 32 * w + hh * 8;
#pragma unroll
        for (int kt = 0; kt < 5; ++kt) { o = MFMA32(*(const LAS bf16x8*)(vp + 32 * kt), pf[kt][0], o); o = MFMA32(*(const LAS bf16x8*)(vp + 32 * kt + 16), pf[kt][1], o); }
#pragma unroll
        for (int g4 = 0; g4 < 4; ++g4) { u32x2 wv; wv.x = pack2(o[4 * g4] * inv, o[4 * g4 + 1] * inv); wv.y = pack2(o[4 * g4 + 2] * inv, o[4 * g4 + 3] * inv);
            *(u32x2*)(P + (size_t)((l0 + rr) * d + r) * NNAT + 3072 + hd * 128 + ct * 32 + 8 * g4 + 4 * hh) = wv; }
        asm volatile("" ::: "memory");
    }
    if (hh == 0) LSE[(size_t)((l0 + rr) * d + r) * 12 + hd] = mx + __logf(sum);
    __syncthreads();
}

DI void phase_p2(const Frame& F, int me, int nb) {
    bf16_t* SL = (bf16_t*)(F.R0 + R_SLOC);
    const float* SCB = (const float*)(F.R0 + R_SCB); const float* CHB = (const float*)(F.R0 + R_CHB);
    const float* DN = (const float*)(F.R0 + R_DN); float* NST = (float*)(F.R0 + R_NST);
    if (nb <= 0) return;
    for (int gt = me * 512 + F.tid; gt < 131072; gt += nb * 512) {
        const int h = gt >> 15, e2 = (gt & 32767) * 2;
        f32x2 run = (f32x2){0.f, 0.f};
#pragma unroll 1
        for (int j0 = 0; j0 < 32; j0 += 8) {
            unsigned s[8]; float dec[8];
#pragma unroll
            for (int jj = 0; jj < 8; ++jj) { s[jj] = *(const unsigned*)(SL + ((size_t)h * 32 + j0 + jj) * 65536 + e2); dec[jj] = SCB[h * 32 + j0 + jj]; }
#pragma unroll
            for (int jj = 0; jj < 8; ++jj) { *(unsigned*)(SL + ((size_t)h * 32 + j0 + jj) * 65536 + e2) = pack2(run[0], run[1]); run = run * __expf(dec[jj]) + (f32x2){bflo(s[jj]), bfhi(s[jj])}; }
        }
    }
    const int q = ((nb - 1 - me) * 512 + F.tid);
    if (q < 1024) {
        const int h = q >> 8, dd = q & 255; float run = 0.f;
#pragma unroll 1
        for (int c0 = 0; c0 < 128; c0 += 16) {
            float dn[16], cb[16];
#pragma unroll
            for (int cc = 0; cc < 16; ++cc) { dn[cc] = DN[((size_t)h * 128 + c0 + cc) * 256 + dd]; cb[cc] = CHB[h * 128 + c0 + cc]; }
#pragma unroll
            for (int cc = 0; cc < 16; ++cc) { NST[((size_t)h * 128 + c0 + cc) * 256 + dd] = run; run = run * __expf(cb[cc]) + dn[cc]; }
        }
    }
}

DI void f_hm_block(const Frame& F, int l, int h, int j, int half, int eg) {
    const bf16_t* QC = (const bf16_t*)(F.R0 + R_QC); const bf16_t* CST = (const bf16_t*)(F.R0 + R_CST); const float* NST = (const float*)(F.R0 + R_NST);
    const bf16_t* NUM = (const bf16_t*)(F.R0 + R_NUM); const bf16_t* P = (const bf16_t*)(F.R0 + R_P);
    const float* DENI = (const float*)(F.R0 + R_DENI); const float* EBC = (const float*)(F.R0 + R_EBC); const float* EBL = (const float*)(F.R0 + R_EBL);
    int lane = F.lane, tid = F.tid; asm volatile("" : "+v"(lane), "+v"(tid));
    const int tr = lane & 15, kg = lane >> 4, w = F.wave;
    const int tl0 = j * 256 + half * 128 + w * 16, c = tl0 >> 6, tl = tl0 + tr;
    LAS unsigned char* Cs = F.lds;
    { const bf16_t* src = CST + ((size_t)h * 32 + j) * 65536;
#pragma unroll
      for (int hf = 0; hf < 2; ++hf) {
          u32x4 st[8];
#pragma unroll
          for (int i = 0; i < 8; ++i) { const int p = tid + 512 * (hf * 8 + i); st[i] = *(const u32x4*)(src + (size_t)p * 8); }
#pragma unroll
          for (int i = 0; i < 8; ++i) { const int p = tid + 512 * (hf * 8 + i), row = p >> 5, pc = p & 31; *(LAS u32x4*)(Cs + row * 512 + ((pc ^ (row & 15)) << 4)) = st[i]; }
      } }
    const bf16_t* qp = QC + (size_t)tl * 1024 + h * 256 + kg * 8;
    const float* np = NST + ((size_t)h * 128 + c) * 256 + kg * 8;
    const float ebl = EBL[(size_t)tl * 4 + h], ebc = EBC[(size_t)tl * 4 + h], deni = DENI[(size_t)tl * 4 + h];
    bf16x8 qf[8];
#pragma unroll
    for (int ks = 0; ks < 8; ++ks) qf[ks] = ldg8(qp + ks * 32);
    float dotn = 0.f;
#pragma unroll
    for (int ks = 0; ks < 8; ++ks) {
        const f32x4 n0 = *(const f32x4*)(np + ks * 32), n1 = *(const f32x4*)(np + ks * 32 + 4);
        const u32x4 qv = __builtin_bit_cast(u32x4, qf[ks]);
        dotn += bflo(qv.x) * n0[0] + bfhi(qv.x) * n0[1] + bflo(qv.y) * n0[2] + bfhi(qv.y) * n0[3] + bflo(qv.z) * n1[0] + bfhi(qv.z) * n1[1] + bflo(qv.w) * n1[2] + bfhi(qv.w) * n1[3];
    }
    __syncthreads();
    f32x4 acc[16];
#pragma unroll
    for (int et = 0; et < 16; ++et) {
        acc[et] = (f32x4){0.f, 0.f, 0.f, 0.f};
        const LAS unsigned char* rowp = Cs + (et * 16 + tr) * 512;
#pragma unroll
        for (int ks = 0; ks < 8; ++ks) acc[et] = __builtin_amdgcn_mfma_f32_16x16x32_bf16(*(const LAS bf16x8*)(rowp + (((4 * ks + kg) ^ tr) << 4)), qf[ks], acc[et], 0, 0, 0);
        if ((et & 3) == 3) asm volatile("" ::: "memory");
    }
    dotn += __shfl_xor(dotn, 16); dotn += __shfl_xor(dotn, 32);
    const float den = deni + ebc * dotn;
    const float invd = 1.0f / fmaxf(fabsf(den), 1.0f);
    float ssq = 0.f;
    { u32x2 nl[16];
#pragma unroll
      for (int et = 0; et < 16; ++et) nl[et] = *(const u32x2*)(NUM + (size_t)tl * 1024 + h * 256 + et * 16 + 4 * kg);
#pragma unroll
      for (int et = 0; et < 16; ++et) { const float n4[4] = {bflo(nl[et].x), bfhi(nl[et].x), bflo(nl[et].y), bfhi(nl[et].y)};
#pragma unroll
          for (int q = 0; q < 4; ++q) { const float v = (n4[q] + ebl * acc[et][q]) * invd; acc[et][q] = v; ssq += v * v; } } }
    ssq += __shfl_xor(ssq, 16); ssq += __shfl_xor(ssq, 32);
    const float rn = __builtin_amdgcn_rsqf(ssq * (1.0f / 256.0f) + EPS);
    const size_t tp = (size_t)eg * TQ + tl;
    asm volatile("" ::: "memory");
#pragma unroll
    for (int e8 = 0; e8 < 2; ++e8) {
        u32x2 og[8]; f32x4 ng[8];
#pragma unroll
        for (int i = 0; i < 8; ++i) { const int e = (e8 * 8 + i) * 16 + 4 * kg; og[i] = *(const u32x2*)(P + (size_t)tl * NNAT + 2048 + h * 256 + e); ng[i] = *(const f32x4*)(F.norm_g + (size_t)l * 1024 + h * 256 + e); }
#pragma unroll
        for (int i = 0; i < 8; ++i) { const int et = e8 * 8 + i, e = et * 16 + 4 * kg;
            u32x2 wv; wv.x = pack2(bflo(og[i].x) * acc[et][0] * rn * ng[i][0], bfhi(og[i].x) * acc[et][1] * rn * ng[i][1]);
            wv.y = pack2(bflo(og[i].y) * acc[et][2] * rn * ng[i][2], bfhi(og[i].y) * acc[et][3] * rn * ng[i][3]);
            *(u32x2*)(F.HM + tp * 1024 + h * 256 + e) = wv; }
        asm volatile("" ::: "memory");
    }
    __syncthreads();
}
DI void f_ha_token(const Frame& F, int tl, int eg) {
    const bf16_t* P = (const bf16_t*)(F.R0 + R_P); const float* LSE = (const float*)(F.R0 + R_LSE);
    int lane = F.lane; asm volatile("" : "+v"(lane));
    const int hs = lane >> 4, ch0 = (lane & 15) * 8;
    const float l0 = LSE[(size_t)tl * 12 + hs], l1 = LSE[(size_t)tl * 12 + 4 + hs], l2 = LSE[(size_t)tl * 12 + 8 + hs];
    const float m = fmaxf(l0, fmaxf(l1, l2));
    float a0 = __expf(l0 - m), a1 = __expf(l1 - m), a2 = __expf(l2 - m); const float inv = 1.0f / (a0 + a1 + a2); a0 *= inv; a1 *= inv; a2 *= inv;
    const bf16_t* pr = P + (size_t)tl * NNAT + 3072 + hs * 128 + ch0;
    const u32x4 v0 = *(const u32x4*)(pr), v1 = *(const u32x4*)(pr + 512), v2 = *(const u32x4*)(pr + 1024);
    u32x4 o;
    o.x = pack2(a0 * bflo(v0.x) + a1 * bflo(v1.x) + a2 * bflo(v2.x), a0 * bfhi(v0.x) + a1 * bfhi(v1.x) + a2 * bfhi(v2.x));
    o.y = pack2(a0 * bflo(v0.y) + a1 * bflo(v1.y) + a2 * bflo(v2.y), a0 * bfhi(v0.y) + a1 * bfhi(v1.y) + a2 * bfhi(v2.y));
    o.z = pack2(a0 * bflo(v0.z) + a1 * bflo(v1.z) + a2 * bflo(v2.z), a0 * bfhi(v0.z) + a1 * bfhi(v1.z) + a2 * bfhi(v2.z));
    o.w = pack2(a0 * bflo(v0.w) + a1 * bflo(v1.w) + a2 * bflo(v2.w), a0 * bfhi(v0.w) + a1 * bfhi(v1.w) + a2 * bfhi(v2.w));
    *(u32x4*)(F.HA + ((size_t)eg * TQ + tl) * 512 + hs * 128 + ch0) = o;
}
using pg8::UnitD;
DI u32x4 pack8h(const f32x4& v0, const f32x4& v1) { u32x4 w; w.x = pack2h(v0[0], v0[1]); w.y = pack2h(v0[2], v0[3]); w.z = pack2h(v1[0], v1[1]); w.w = pack2h(v1[2], v1[3]); return w; }
DI u32x4 pack8(const f32x4& v0, const f32x4& v1) { u32x4 w; w.x = pack2(v0[0], v0[1]); w.y = pack2(v0[2], v0[3]); w.z = pack2(v1[0], v1[1]); w.w = pack2(v1[2], v1[3]); return w; }

struct SchedG1 {
    const char* U; const char* Wnat; const char* Wvt; int G, c;
    DI bool next(int i, UnitD& u) const {
        const int L = i * G + c; if (L >= 704 + 320) return false;
        u.arows = nullptr; u.acount = 0; u.aux = 0; u.K = 1024;
        if (L < 704) { int pm, pc; pg8::tile_map(L, 32, 22, pm, pc); const int pn = pc < 10 ? pc : pc + 2; u.kind = 0; u.pm = pm; u.pn = pn;
            u.A = U + (size_t)pm * 256 * 2048; u.lda = 2048; u.B = Wnat + (size_t)pn * 256 * 2048; u.ldb = 2048; }
        else { const int idx = L - 704, pm = idx % 10, pn = idx / 10; u.kind = 1; u.pm = pm; u.pn = pn;
            u.A = Wvt + (size_t)pm * 256 * 2048; u.lda = 2048;
            int tokbase = pn * 256, dmul = 1;
            if (pm >= 4) { const int g = (pm - 4) >> 1, dsh = 2 * g, lsub = TQ >> dsh, n0 = pn * 256; dmul = 1 << dsh; tokbase = (n0 % lsub) * dmul + n0 / lsub; }
            u.B = U + (size_t)tokbase * 2048; u.ldb = 2048u * (unsigned)dmul; }
        return true;
    }
};
struct SchedG1Def {
    const char* U; const char* Wnat; int c;
    DI bool next(int i, UnitD& u) const {
        if (i > 0 || c >= 64) return false;
        const int pm = c >> 1, pn = 10 + (c & 1);
        u.arows = nullptr; u.acount = 0; u.aux = 0; u.K = 1024; u.kind = 0; u.pm = pm; u.pn = pn;
        u.A = U + (size_t)pm * 256 * 2048; u.lda = 2048; u.B = Wnat + (size_t)pn * 256 * 2048; u.ldb = 2048;
        return true;
    }
};
struct EpiG1 {
    static constexpr bool PERM = true;
    bf16_t* P; bf16_t* VT;
    DI void operator()(const f32x4 (&acc)[2][2][4][2], const UnitD& u, int wr, int wc, int fr, int fq) const {
        bf16_t* base; size_t ld; int mode = 0;
        if (u.kind == 0) { base = P + (size_t)u.pm * 256 * NNAT + u.pn * 256; ld = NNAT; mode = (u.pn >= 8 && u.pn < 12) ? 1 : ((u.pn >= 12 && u.pn < 18) ? 2 : 0); }
        else { base = VT + (size_t)u.pm * 256 * TQ + u.pn * 256; ld = TQ; }
        const int row0 = wr * 64 + fr, col0 = wc * 32 + 8 * fq;
#pragma unroll
        for (int ai = 0; ai < 2; ++ai)
#pragma unroll
            for (int m = 0; m < 4; ++m) { bf16_t* rowp = base + (size_t)(row0 + ai * 128 + m * 16) * ld + col0;
#pragma unroll
                for (int bj = 0; bj < 2; ++bj) { f32x4 v0 = acc[ai][bj][m][0], v1 = acc[ai][bj][m][1];
                    if (mode == 1) {
#pragma unroll
                        for (int q = 0; q < 4; ++q) { v0[q] = sigmoidf_(v0[q]); v1[q] = sigmoidf_(v1[q]); } }
                    else if (mode == 2) { v0 *= 0.08838834764831845f; v1 *= 0.08838834764831845f; }
                    *(u32x4*)(rowp + bj * 128) = pack8(v0, v1); }
                asm volatile("" ::: "memory"); }
    }
};
struct SchedDense {
    const char* A; const char* B; unsigned lda, ldb; int nM, nN, G, c, K;
    DI bool next(int i, UnitD& u) const {
        const int L = i * G + c; if (L >= nM * nN) return false;
        int pm, pn; pg8::tile_map(L, nM, nN, pm, pn); u.kind = 0; u.K = K; u.pm = pm; u.pn = pn; u.aux = 0; u.arows = nullptr; u.acount = 0;
        u.A = A + (size_t)pm * 256 * lda; u.lda = lda; u.B = B + (size_t)pn * 256 * ldb; u.ldb = ldb; return true;
    }
};
struct EpiG1g {
    static constexpr bool PERM = true;
    bf16_t* GT;
    DI void operator()(const f32x4 (&acc)[2][2][4][2], const UnitD& u, int wr, int wc, int fr, int fq) const {
        bf16_t* base = GT + (size_t)u.pm * 256 * 2048 + u.pn * 256; const int row0 = wr * 64 + fr, col0 = wc * 32 + 8 * fq;
#pragma unroll
        for (int ai = 0; ai < 2; ++ai)
#pragma unroll
            for (int m = 0; m < 4; ++m) { bf16_t* rowp = base + (size_t)(row0 + ai * 128 + m * 16) * 2048 + col0;
#pragma unroll
                for (int bj = 0; bj < 2; ++bj) { f32x4 v0 = acc[ai][bj][m][0], v1 = acc[ai][bj][m][1];
#pragma unroll
                    for (int q = 0; q < 4; ++q) { v0[q] = sigmoidf_(v0[q]); v1[q] = sigmoidf_(v1[q]); }
                    *(u32x4*)(rowp + bj * 128) = pack8(v0, v1); }
                asm volatile("" ::: "memory"); }
    }
};
template <int WHICH> struct EpiG2 {
    static constexpr bool PERM = true;
    bf16_t* GT;
    DI void operator()(const f32x4 (&acc)[2][2][4][2], const UnitD& u, int wr, int wc, int fr, int fq) const {
        bf16_t* base = GT + (size_t)u.pm * 256 * 2048 + u.pn * 256 + (WHICH == 0 ? 1024 : 0); const int row0 = wr * 64 + fr, col0 = wc * 32 + 8 * fq;
#pragma unroll
        for (int ai = 0; ai < 2; ++ai)
#pragma unroll
            for (int m = 0; m < 4; ++m) { bf16_t* rowp = base + (size_t)(row0 + ai * 128 + m * 16) * 2048 + col0;
#pragma unroll
                for (int bj = 0; bj < 2; ++bj) { const f32x4 a0 = acc[ai][bj][m][0], a1 = acc[ai][bj][m][1];
                    const u32x4 g = *(const u32x4*)(rowp + bj * 128);
                    f32x4 v0 = (f32x4){bflo(g.x) * a0[0], bfhi(g.x) * a0[1], bflo(g.y) * a0[2], bfhi(g.y) * a0[3]};
                    f32x4 v1 = (f32x4){bflo(g.z) * a1[0], bfhi(g.z) * a1[1], bflo(g.w) * a1[2], bfhi(g.w) * a1[3]};
                    if (WHICH == 1) { const u32x4 y = *(const u32x4*)(rowp + bj * 128 + 1024);
                        v0 += (f32x4){bflo(y.x), bfhi(y.x), bflo(y.y), bfhi(y.y)}; v1 += (f32x4){bflo(y.z), bfhi(y.z), bflo(y.w), bfhi(y.w)}; }
                    *(u32x4*)(rowp + bj * 128) = pack8(v0, v1); }
                asm volatile("" ::: "memory"); }
    }
};
struct EpiG3 {
    static constexpr bool PERM = true;
    const float* xin; bf16_t* xb; const float* gta;
    int f32in;
    DI void operator()(const f32x4 (&acc)[2][2][4][2], const UnitD& u, int wr, int wc, int fr, int fq) const {
        const int row0 = u.pm * 256 + wr * 64 + fr, col0 = u.pn * 256 + wc * 32 + 8 * fq;
        const float* g = gta + (size_t)(u.pm >> 5) * 6144 + col0;
        f32x4 gv[2][2];
#pragma unroll
        for (int bj = 0; bj < 2; ++bj)
#pragma unroll
            for (int n = 0; n < 2; ++n) gv[bj][n] = *(const f32x4*)(g + bj * 128 + n * 4);
        if (f32in) {
            f32x4 xr[4][4];
#pragma unroll
            for (int g0 = 0; g0 < 3; ++g0) { const size_t o0 = (size_t)(row0 + (g0 >> 2) * 128 + (g0 & 3) * 16) * 1024 + col0;
#pragma unroll
                for (int q = 0; q < 4; ++q) xr[g0][q] = *(const f32x4*)(xin + o0 + (q >> 1) * 128 + (q & 1) * 4); }
#pragma unroll
            for (int gi = 0; gi < 8; ++gi) { const int ai = gi >> 2, m = gi & 3; const size_t o = (size_t)(row0 + ai * 128 + m * 16) * 1024 + col0;
                if (gi + 3 < 8) { const int ai2 = (gi + 3) >> 2, m2 = (gi + 3) & 3; const size_t o2 = (size_t)(row0 + ai2 * 128 + m2 * 16) * 1024 + col0;
#pragma unroll
                    for (int q = 0; q < 4; ++q) xr[(gi + 3) & 3][q] = *(const f32x4*)(xin + o2 + (q >> 1) * 128 + (q & 1) * 4); }
                asm volatile("" ::: "memory");
#pragma unroll
                for (int bj = 0; bj < 2; ++bj) *(u32x4*)(xb + o + bj * 128) = pack8h(xr[gi & 3][bj * 2] + gv[bj][0] * acc[ai][bj][m][0], xr[gi & 3][bj * 2 + 1] + gv[bj][1] * acc[ai][bj][m][1]); }
        } else {
            u32x4 xr[4][2];
#pragma unroll
            for (int g0 = 0; g0 < 3; ++g0) { const size_t o0 = (size_t)(row0 + (g0 >> 2) * 128 + (g0 & 3) * 16) * 1024 + col0; xr[g0][0] = *(const u32x4*)(xb + o0); xr[g0][1] = *(const u32x4*)(xb + o0 + 128); }
#pragma unroll
            for (int gi = 0; gi < 8; ++gi) { const int ai = gi >> 2, m = gi & 3; const size_t o = (size_t)(row0 + ai * 128 + m * 16) * 1024 + col0;
                if (gi + 3 < 8) { const int ai2 = (gi + 3) >> 2, m2 = (gi + 3) & 3; const size_t o2 = (size_t)(row0 + ai2 * 128 + m2 * 16) * 1024 + col0;
                    xr[(gi + 3) & 3][0] = *(const u32x4*)(xb + o2); xr[(gi + 3) & 3][1] = *(const u32x4*)(xb + o2 + 128); }
                asm volatile("" ::: "memory");
#pragma unroll
                for (int bj = 0; bj < 2; ++bj) { const u32x4 y = xr[gi & 3][bj];
                    const f32x4 v0 = (f32x4){hlo(y.x), hhi(y.x), hlo(y.y), hhi(y.y)} + gv[bj][0] * acc[ai][bj][m][0], v1 = (f32x4){hlo(y.z), hhi(y.z), hlo(y.w), hhi(y.w)} + gv[bj][1] * acc[ai][bj][m][1];
                    *(u32x4*)(xb + o + bj * 128) = pack8h(v0, v1); } }
        }
    }
};
struct SchedMoe {
    const int* pre;
    const unsigned* cnt;
    const char* A; const char* W; const int* SLOT; int G, c; bool gate_up;
    DI bool next(int i, UnitD& u) const {
        const int L = i * G + c, nt = pre[16]; if (L >= nt * 4) return false;
        const int rt = L >> 2, ct = L & 3; int e = 0;
#pragma unroll
        for (int q = 1; q < 16; ++q) e += (rt >= pre[q]) ? 1 : 0;
        u.kind = 0; u.pm = rt; u.pn = ct; u.aux = e; u.K = gate_up ? 1024 : 512;
        const int ti = rt - pre[e];
        if (gate_up) { u.A = A; u.lda = 2048; u.arows = SLOT + (size_t)e * 32768 + ti * 256; u.acount = (int)cnt[e] - ti * 256;
            u.B = W + ((size_t)e * 1024 + ct * 256) * 2048; u.ldb = 2048; }
        else { u.A = A + (size_t)rt * 256 * 1024; u.lda = 1024; u.arows = nullptr; u.acount = 0;
            u.B = W + ((size_t)e * 1024 + ct * 256) * 1024; u.ldb = 1024; }
        return true;
    }
};
struct EpiG4 {
    static constexpr bool PERM = true;
    bf16_t* HH;
    DI void operator()(const f32x4 (&acc)[2][2][4][2], const UnitD& u, int wr, int wc, int fr, int fq) const {
        bf16_t* base = HH + (size_t)u.pm * 256 * 512 + u.pn * 128; const int row0 = wr * 64 + fr, col0 = wc * 16 + 4 * fq;
#pragma unroll
        for (int ai = 0; ai < 2; ++ai)
#pragma unroll
            for (int m = 0; m < 4; ++m) { bf16_t* rowp = base + (size_t)(row0 + ai * 128 + m * 16) * 512 + col0;
#pragma unroll
                for (int bj = 0; bj < 2; ++bj) { const f32x4 v0 = acc[ai][bj][m][0], v1 = acc[ai][bj][m][1];
                    u32x2 w; w.x = pack2(siluf_(v0[0]) * v0[1], siluf_(v0[2]) * v0[3]); w.y = pack2(siluf_(v1[0]) * v1[1], siluf_(v1[2]) * v1[3]);
                    *(u32x2*)(rowp + bj * 64) = w; }
                asm volatile("" ::: "memory"); }
    }
};
struct EpiG5 {
    static constexpr bool PERM = true;
    bf16_t* YS;
    DI void operator()(const f32x4 (&acc)[2][2][4][2], const UnitD& u, int wr, int wc, int fr, int fq) const {
        bf16_t* base = YS + (size_t)u.pm * 256 * 1024 + u.pn * 256; const int row0 = wr * 64 + fr, col0 = wc * 32 + 8 * fq;
#pragma unroll
        for (int ai = 0; ai < 2; ++ai)
#pragma unroll
            for (int m = 0; m < 4; ++m) { bf16_t* rowp = base + (size_t)(row0 + ai * 128 + m * 16) * 1024 + col0;
#pragma unroll
                for (int bj = 0; bj < 2; ++bj) *(u32x4*)(rowp + bj * 128) = pack8(acc[ai][bj][m][0], acc[ai][bj][m][1]);
                asm volatile("" ::: "memory"); }
    }
};

struct SchedChain {
    const char* U; const char* HA; const char* HM; const char* Wg; const char* Wa; const char* Wm; int G, c;
    DI bool next(int i, UnitD& u) const {
        const int per = (512 + G - 1) / G;
        const int ti = i >> 2, st = i & 3; if (ti >= per) return false;
        const int L = ti * G + c; if (L >= 512) return false;
        int pm, pn; pg8::tile_map(L, 128, 4, pm, pn); u.pm = pm; u.pn = pn; u.kind = st; u.aux = 0; u.arows = nullptr; u.acount = 0;
        if (st == 0) { u.A = U + (size_t)pm * 256 * 2048; u.lda = 2048; u.B = Wg + (size_t)pn * 256 * 2048; u.ldb = 2048; u.K = 1024; }
        else if (st == 1) { u.A = U + (size_t)pm * 256 * 2048; u.lda = 2048; u.B = Wg + (size_t)(4 + pn) * 256 * 2048; u.ldb = 2048; u.K = 1024; }
        else if (st == 2) { u.A = HA + (size_t)pm * 256 * 1024; u.lda = 1024; u.B = Wa + (size_t)pn * 256 * 1024; u.ldb = 1024; u.K = 512; }
        else { u.A = HM + (size_t)pm * 256 * 2048; u.lda = 2048; u.B = Wm + (size_t)pn * 256 * 2048; u.ldb = 2048; u.K = 1024; }
        return true;
    }
};
struct EpiChain {
    static constexpr bool PERM = true;
    bf16_t* GT;
    DI void operator()(const f32x4 (&acc)[2][2][4][2], const UnitD& u, int wr, int wc, int fr, int fq) const {
        const int st = u.kind;
        bf16_t* base = GT + (size_t)u.pm * 256 * 2048 + u.pn * 256 + ((st == 1 || st == 2) ? 1024 : 0); const int row0 = wr * 64 + fr, col0 = wc * 32 + 8 * fq;
        if (st < 2) {
#pragma unroll
            for (int ai = 0; ai < 2; ++ai)
#pragma unroll
                for (int m = 0; m < 4; ++m) { bf16_t* rowp = base + (size_t)(row0 + ai * 128 + m * 16) * 2048 + col0;
#pragma unroll
                    for (int bj = 0; bj < 2; ++bj) { f32x4 v0 = acc[ai][bj][m][0], v1 = acc[ai][bj][m][1];
#pragma unroll
                        for (int q = 0; q < 4; ++q) { v0[q] = sigmoidf_(v0[q]); v1[q] = sigmoidf_(v1[q]); }
                        *(u32x4*)(rowp + bj * 128) = pack8(v0, v1); }
                    asm volatile("" ::: "memory"); }
        } else {
            u32x4 gb[4][4];
#pragma unroll
            for (int g0 = 0; g0 < 3; ++g0) { bf16_t* rp0 = base + (size_t)(row0 + (g0 >> 2) * 128 + (g0 & 3) * 16) * 2048 + col0;
                gb[g0][0] = *(const u32x4*)(rp0); gb[g0][1] = *(const u32x4*)(rp0 + 128);
                if (st == 3) { gb[g0][2] = *(const u32x4*)(rp0 + 1024); gb[g0][3] = *(const u32x4*)(rp0 + 128 + 1024); } }
#pragma unroll
            for (int gi = 0; gi < 8; ++gi) { const int ai = gi >> 2, m = gi & 3; bf16_t* rowp = base + (size_t)(row0 + ai * 128 + m * 16) * 2048 + col0;
                if (gi + 3 < 8) { const int ai2 = (gi + 3) >> 2, m2 = (gi + 3) & 3; bf16_t* rp2 = base + (size_t)(row0 + ai2 * 128 + m2 * 16) * 2048 + col0;
                    gb[(gi + 3) & 3][0] = *(const u32x4*)(rp2); gb[(gi + 3) & 3][1] = *(const u32x4*)(rp2 + 128);
                    if (st == 3) { gb[(gi + 3) & 3][2] = *(const u32x4*)(rp2 + 1024); gb[(gi + 3) & 3][3] = *(const u32x4*)(rp2 + 128 + 1024); } }
                asm volatile("" ::: "memory");
#pragma unroll
                for (int bj = 0; bj < 2; ++bj) { f32x4 v0 = acc[ai][bj][m][0], v1 = acc[ai][bj][m][1];
                    const u32x4 g = gb[gi & 3][bj];
                    v0 *= (f32x4){bflo(g.x), bfhi(g.x), bflo(g.y), bfhi(g.y)}; v1 *= (f32x4){bflo(g.z), bfhi(g.z), bflo(g.w), bfhi(g.w)};
                    if (st == 3) { const u32x4 y = gb[gi & 3][2 + bj];
                        v0 += (f32x4){bflo(y.x), bfhi(y.x), bflo(y.y), bfhi(y.y)}; v1 += (f32x4){bflo(y.z), bfhi(y.z), bflo(y.w), bfhi(y.w)}; }
                    *(u32x4*)(rowp + bj * 128) = pack8(v0, v1); } }
        }
    }
};
constexpr int LDS_BYTES = 131072 + 1024;
constexpr int LDS_MISC = 131072;
#ifndef MK_ONE_LAUNCH
#define MK_ONE_LAUNCH 1
#endif
constexpr int N_STEPS = 1 + DEPTH * (1 + 4 * 4 + 2 + 3) + 1;

DI int fresh_tid(int wave) { int l_; asm volatile("v_mbcnt_lo_u32_b32 %0, -1, 0\n\tv_mbcnt_hi_u32_b32 %0, -1, %0" : "=v"(l_)); return wave * 64 + l_; }
__global__ void __launch_bounds__(512, 2) fwd_kernel(Args args) {
    extern __shared__ __attribute__((aligned(16))) unsigned char lds_raw[];
    const int wave0 = __builtin_amdgcn_readfirstlane((int)threadIdx.x >> 6);
#define tid0 fresh_tid(wave0)
    LAS unsigned char* lds0 = (LAS unsigned char*)lds_raw;
    if (tid0 < 4) ((volatile LAS unsigned*)(lds0 + LDS_MISC))[tid0] = 0u;
    __syncthreads();
    unsigned* ctl0 = (unsigned*)(args.ws + WS_CTL);
    XcdBarrier bar; bar.bar = ctl0 + CW_BAR; bar.x = 0; bar.st = nullptr;
    const int lo = args.step_lo, hi = args.step_hi;
    if (hi - lo > 1) bar = xcd_barrier_post(ctl0 + CW_BAR, (volatile LAS unsigned*)(lds0 + LDS_MISC));
    int step = 0; int l_probe = 0; unsigned long long probe_acc = 0;
#ifndef SITE_MASK
#define SITE_MASK 0xFFFFFFFFu
#endif
#ifndef REP_ML1
#define REP_ML1 1
#endif
#ifndef REP_AT
#define REP_AT 1
#endif
#ifndef DUP_MASK
#define DUP_MASK 0u
#endif
#ifndef DUP_L0
#define DUP_L0 0
#endif
#ifndef EXTRA_BARS
#define EXTRA_BARS 0
#endif
#ifndef PROBE_SITE
#define PROBE_SITE -1
#endif
#ifndef PROBE_AMP
#define PROBE_AMP 4
#endif
#define RUN(site, ...) do { if (step >= lo && step < hi) { unsigned long long pt0_ = 0; if constexpr (PROBE_SITE == (site)) pt0_ = wall_clock64(); if constexpr ((DUP_MASK >> (site)) & 1u) { if (!DUP_L0 || l_probe == 0) { Frame F; { int t_ = tid0; asm volatile("" : "+v"(t_)); frame_init(F, lds_raw, t_); } int* preL = (int*)(F.ldsg + LDS_MISC + 64); (void)preL; __VA_ARGS__; xcd_barrier(bar); } } if constexpr ((SITE_MASK >> (site)) & 1u) { Frame F; { int t_ = tid0; asm volatile("" : "+v"(t_)); frame_init(F, lds_raw, t_); } int* preL = (int*)(F.ldsg + LDS_MISC + 64); (void)preL; __VA_ARGS__; } if (step + 1 < hi) xcd_barrier(bar); if constexpr (PROBE_SITE == (site)) probe_acc += wall_clock64() - pt0_; } ++step; } while (0)

    RUN(0, { phase_p0_small(F); __syncthreads(); phase_pw(F, 0, 0, F.G); });
    for (int l = 0; l < DEPTH; ++l) { l_probe = l;
        RUN(1, { if (l > 0) phase_pw(F, l, 0, F.G); phase_n1(F, l); });
        for (int eg = 0; eg < 4; ++eg) {
                RUN(2, { SchedG1 S{(const char*)(F.U + (size_t)eg * TQ * 1024), (const char*)(F.W + W_NAT), (const char*)(F.W + W_VT), F.G, F.bid};
                      EpiG1 E{(bf16_t*)(F.R0 + R_P), (bf16_t*)(F.R0 + R_VT)};
                      pg8::gemm_run<EpiG1, SchedG1>(F.lds, S, E, F.tid); });
                RUN(4, {
                      if (F.bid < 128) ml1_unit(F, l, F.bid >> 5, F.bid & 31, eg);
                      else if (F.bid < 192) { SchedG1Def S{(const char*)(F.U + (size_t)eg * TQ * 1024), (const char*)(F.W + W_NAT), F.bid - 128}; EpiG1 E{(bf16_t*)(F.R0 + R_P), (bf16_t*)(F.R0 + R_VT)};
                          pg8::gemm_run<EpiG1, SchedG1Def>(F.lds, S, E, F.tid);
                          at_block_unit(F, F.bid - 128); at_block_unit(F, F.bid - 64); }
                      else { for (int q4 = 0; q4 < 4; ++q4) at_block_unit(F, 128 + (F.bid - 192) * 4 + q4); } });
                RUN(5, { phase_p2(F, F.bid, F.G); });
                RUN(6, { for (int u = F.bid; u < 256; u += F.G) f_hm_block(F, l, (u & 127) >> 5, u & 31, u >> 7, eg);
                      for (int t = F.bid * 8 + F.wave; t < TQ; t += F.G * 8) f_ha_token(F, t, eg); });
        }
        RUN(7, { SchedChain S{(const char*)F.U, (const char*)F.HA, (const char*)F.HM, (const char*)(F.W + W_G), (const char*)(F.W + W_A), (const char*)(F.W + W_M), F.G, F.bid};
              EpiChain E{(bf16_t*)(F.R0 + R_GT)}; pg8::gemm_run<EpiChain, SchedChain>(F.lds, S, E, F.tid); });
        RUN(10, { SchedDense S{(const char*)(F.R0 + R_GT), (const char*)(F.W + W_O), 4096u, 2048u, 128, 4, F.G, F.bid, 1024};
              EpiG3 E{F.x, F.XB, F.MOD + (size_t)l * 4 * 6144 + 2048, (l == 0) ? 1 : 0};
              pg8::gemm_run<EpiG3, SchedDense>(F.lds, S, E, F.tid); });
        RUN(11, { phase_n2(F, l); });
        RUN(12, { moe_offsets(F.ctl + CW_CNT + 64 * l, preL, F.tid); __syncthreads();
              SchedMoe S{preL, F.ctl + CW_CNT + 64 * l, (const char*)F.U, (const char*)(F.W + W_13), (const int*)(F.R0 + R_SLOT), F.G, F.bid, true};
              EpiG4 E{(bf16_t*)(F.R0 + R_HH)}; pg8::gemm_run<EpiG4, SchedMoe, true>(F.lds, S, E, F.tid); });
        RUN(13, { moe_offsets(F.ctl + CW_CNT + 64 * l, preL, F.tid); __syncthreads();
              SchedMoe S{preL, F.ctl + CW_CNT + 64 * l, (const char*)(F.R0 + R_HH), (const char*)(F.W + W_2), (const int*)(F.R0 + R_SLOT), F.G, F.bid, false};
              EpiG5 E{(bf16_t*)(F.R0 + R_YS)}; pg8::gemm_run<EpiG5, SchedMoe>(F.lds, S, E, F.tid); });
    }
    for (int xb = 0; xb < EXTRA_BARS; ++xb) xcd_barrier(bar);
    RUN(14, { phase_fn(F); });
#undef RUN
#undef tid0
    if constexpr (PROBE_SITE >= 0) { if (blockIdx.x == 0 && fresh_tid(wave0) == 0) { const unsigned long long te = wall_clock64(); while (wall_clock64() - te < (unsigned long long)PROBE_AMP * probe_acc) __builtin_amdgcn_s_sleep(8); } }
}

extern "C" void kernel_launch(void* const* d_in, const int* in_sizes, int n_in, void* d_out, int out_size, void* d_ws, size_t ws_size, hipStream_t stream) {
    static int grid = 0;
    if (grid == 0) {
        if (n_in != 19 || out_size != T_TOK * DM || ws_size < WS_END) { fprintf(stderr, "kernel_launch: unexpected problem (n_in %d out %d ws %zu, need %zu)\n", n_in, out_size, ws_size, (size_t)WS_END); grid = -1; return; }
        int dev = 0, cus = 0, per_cu = 0;
        if (hipGetDevice(&dev) != hipSuccess || hipDeviceGetAttribute(&cus, hipDeviceAttributeMultiprocessorCount, dev) != hipSuccess) { grid = -1; return; }
        if (hipFuncSetAttribute((const void*)fwd_kernel, hipFuncAttributeMaxDynamicSharedMemorySize, LDS_BYTES) != hipSuccess) { fprintf(stderr, "kernel_launch: hipFuncSetAttribute failed\n"); grid = -1; return; }
        if (hipOccupancyMaxActiveBlocksPerMultiprocessor(&per_cu, (const void*)fwd_kernel, 512, LDS_BYTES) != hipSuccess || per_cu < 1) { fprintf(stderr, "kernel_launch: occupancy query says %d blocks per CU\n", per_cu); per_cu = 1; }
        (void)hipGetLastError();
        if (cus < 256) { fprintf(stderr, "kernel_launch: this kernel's phase program is written for 256 workgroups (one per CU of a 256-CU device); found %d CUs\n", cus); grid = -1; return; }
        grid = 256;
    }
    if (grid <= 0) return;
    (void)hipMemsetAsync((char*)d_ws + WS_CTL, 0, CTL_BYTES, stream);
    Args a{};
    for (int i = 0; i < 19; ++i) a.in[i] = (const float*)d_in[i];
    a.out = (float*)d_out; a.ws = (unsigned char*)d_ws;
#if MK_ONE_LAUNCH
    a.step_lo = 0; a.step_hi = N_STEPS;
    hipLaunchKernelGGL(fwd_kernel, dim3(grid), dim3(512), LDS_BYTES, stream, a);
#else
    for (int s = 0; s < N_STEPS; ++s) { a.step_lo = s; a.step_hi = s + 1; hipLaunchKernelGGL(fwd_kernel, dim3(grid), dim3(512), LDS_BYTES, stream, a); }
#endif
}
```

```cpp
#define MK_ONE_LAUNCH 1
#include <hip/hip_runtime.h>
#include <cstdio>
#include <cstdint>

#define DI __device__ __forceinline__
#define LAS __attribute__((address_space(3)))
typedef unsigned short bf16_t;
typedef short bf16x8 __attribute__((ext_vector_type(8)));
typedef float f32x2 __attribute__((ext_vector_type(2)));
typedef float f32x4 __attribute__((ext_vector_type(4)));
typedef float f32x16 __attribute__((ext_vector_type(16)));
typedef unsigned u32x2 __attribute__((ext_vector_type(2)));
typedef unsigned u32x4 __attribute__((ext_vector_type(4)));
typedef __bf16 nbf16x2 __attribute__((ext_vector_type(2)));

constexpr int T_TOK = 32768, SEQ = 8192, DM = 1024, NBATCH = 4, DEPTH = 2;
constexpr int TQ = 8192;
constexpr int TP = 16384;
constexpr int INC = 10760;
constexpr int NNAT = 6144;
constexpr int NVT = 2560;
constexpr int NEXP = 16, DFF = 512;
constexpr int PP = NNAT, VTP = TQ, XBP = 1024 + 128, HHP = 512, YSP = 1024;
constexpr int SLOT_ROWS = 69632;
constexpr float EPS = 1e-6f;

constexpr size_t al256(size_t x) { return (x + 255) & ~(size_t)255; }
constexpr size_t WS_CTL = 0;
constexpr size_t CTL_BYTES = 65536;
constexpr size_t WS_MOD = WS_CTL + CTL_BYTES;
constexpr size_t WS_WIF = WS_MOD + al256((size_t)2 * 4 * 6144 * 4);
constexpr size_t WS_RW = WS_WIF + (size_t)2 * 8 * 1024 * 4;
constexpr size_t WS_W = WS_RW + (size_t)16 * 1024 * 4;
constexpr size_t W_NAT = 0;
constexpr size_t W_VT = W_NAT + (size_t)NNAT * 1024 * 2;
constexpr size_t W_G = W_VT + (size_t)NVT * 1024 * 2;
constexpr size_t W_M = W_G + (size_t)2048 * 1024 * 2;
constexpr size_t W_A = W_M + (size_t)1024 * 1024 * 2;
constexpr size_t W_O = W_A + (size_t)1024 * 512 * 2;
constexpr size_t W_13 = W_O + (size_t)1024 * 1024 * 2;
constexpr size_t W_2 = W_13 + (size_t)16 * 1024 * 1024 * 2;
constexpr size_t W_BYTES = W_2 + (size_t)16 * 1024 * 512 * 2;
constexpr size_t WS_U = WS_W + W_BYTES;
constexpr size_t WS_GIF = WS_U + (size_t)T_TOK * 1024 * 2;
constexpr size_t WS_HM = WS_GIF + (size_t)T_TOK * 8 * 4;
constexpr size_t WS_HA = WS_HM + (size_t)T_TOK * 1024 * 2;
constexpr size_t WS_TOKI = WS_HA + (size_t)T_TOK * 512 * 2;
constexpr size_t WS_XB = WS_TOKI + (size_t)2 * T_TOK * 32;
constexpr size_t WS_R0 = WS_XB + (size_t)T_TOK * XBP * 2;
constexpr size_t R_P = 0;
constexpr size_t R_VT = R_P + (size_t)TQ * PP * 2;
constexpr size_t R_QC = R_VT + (size_t)NVT * VTP * 2;
constexpr size_t R_NUM = R_QC + (size_t)TQ * 1024 * 2;
constexpr size_t R_SLOC = R_NUM + (size_t)TQ * 1024 * 2;
constexpr size_t R_CST = R_SLOC;
constexpr size_t R_DENI = R_SLOC + (size_t)4 * 32 * 65536 * 2;
constexpr size_t R_EBC = R_DENI + (size_t)TQ * 4 * 4;
constexpr size_t R_EBL = R_EBC + (size_t)TQ * 4 * 4;
constexpr size_t R_SCB = R_EBL + (size_t)TQ * 4 * 4;
constexpr size_t R_CHB = R_SCB + 1024;
constexpr size_t R_DN = R_CHB + 2048;
constexpr size_t R_NST = R_DN + (size_t)4 * 128 * 256 * 4;
constexpr size_t R_LSE = R_NST + (size_t)4 * 128 * 256 * 4;
constexpr size_t R_END = R_LSE + (size_t)TQ * 12 * 4;
constexpr int GTP = 2048 + 128;
constexpr size_t R_GT = 0;
constexpr size_t WS_HH = WS_HM;
static_assert((size_t)SLOT_ROWS * HHP * 2 <= (size_t)T_TOK * 1536 * 2, "HH does not fit over HM | HA");
constexpr size_t R_YS = 0;
constexpr size_t R_SLOT = R_YS + (size_t)SLOT_ROWS * YSP * 2;
constexpr size_t R_END2 = R_SLOT + (size_t)16 * 32768 * 4;
constexpr size_t WS_END = WS_R0 + (R_END > R_END2 ? R_END : R_END2);
static_assert(WS_END <= (size_t)536870912, "workspace over 512 MiB");

constexpr int CW_BAR = 0;
constexpr int CW_CNT = 4096;

DI float bflo(unsigned w) { return __uint_as_float(w << 16); }
DI float bfhi(unsigned w) { return __uint_as_float(w & 0xffff0000u); }
DI unsigned pack2(float lo, float hi) { f32x2 v = {lo, hi}; nbf16x2 b = __builtin_convertvector(v, nbf16x2); return __builtin_bit_cast(unsigned, b); }
typedef _Float16 h16x2 __attribute__((ext_vector_type(2)));
DI unsigned pack2h(float lo, float hi) { f32x2 v = {lo, hi}; h16x2 b = __builtin_convertvector(v, h16x2); return __builtin_bit_cast(unsigned, b); }
DI float hlo(unsigned w) { const h16x2 b = __builtin_bit_cast(h16x2, w); return (float)b[0]; }
DI float hhi(unsigned w) { const h16x2 b = __builtin_bit_cast(h16x2, w); return (float)b[1]; }
DI float sigmoidf_(float x) { return __builtin_amdgcn_rcpf(1.0f + __expf(-x)); }
DI float siluf_(float x) { return x * sigmoidf_(x); }
DI f32x4 sigmoid4(f32x4 x) { const f32x4 t = x * -1.4426950408889634f; f32x4 e = {__builtin_amdgcn_exp2f(t[0]), __builtin_amdgcn_exp2f(t[1]), __builtin_amdgcn_exp2f(t[2]), __builtin_amdgcn_exp2f(t[3])};
    e = e + 1.0f; return (f32x4){__builtin_amdgcn_rcpf(e[0]), __builtin_amdgcn_rcpf(e[1]), __builtin_amdgcn_rcpf(e[2]), __builtin_amdgcn_rcpf(e[3])}; }
DI void lds_barrier() { asm volatile("s_waitcnt lgkmcnt(0)" ::: "memory"); __builtin_amdgcn_s_barrier(); asm volatile("" ::: "memory"); }
DI float wave_sum(float v) { for (int o = 32; o >= 1; o >>= 1) v += __shfl_xor(v, o); return v; }
DI int crow(int reg, int h) { return (reg & 3) + 8 * (reg >> 2) + 4 * h; }
DI int pi23(int m) { return (m & ~12) | ((m & 4) << 1) | ((m & 8) >> 1); }
#define MFMA32(a, b, c) __builtin_amdgcn_mfma_f32_32x32x16_bf16((a), (b), (c), 0, 0, 0)
DI bf16x8 packf8(float a0, float a1, float a2, float a3, float a4, float a5, float a6, float a7) {
    u32x4 p; p.x = pack2(a0, a1); p.y = pack2(a2, a3); p.z = pack2(a4, a5); p.w = pack2(a6, a7); return __builtin_bit_cast(bf16x8, p); }
DI bf16x8 ldg8(const bf16_t* p) { return *(const bf16x8*)p; }
#define XB_TMO      128
#define XB_XCNT(j)  (256  + 64 * (j))
#define XB_XSUB(j)  (1280 + 64 * (j))
#define XB_XGEN(j)  (2304 + 64 * (j))
#define XB_TOP      3328
#define XB_TOPGEN   3392
#define XCD_BAR_WORDS 3456
#define XB_SPIN_CAP (1u << 21)

__device__ __forceinline__ unsigned xb_ld(unsigned* p)              { return __hip_atomic_load(p, __ATOMIC_RELAXED, __HIP_MEMORY_SCOPE_AGENT); }
__device__ __forceinline__ unsigned xb_add(unsigned* p, unsigned v) { return __hip_atomic_fetch_add(p, v, __ATOMIC_RELAXED, __HIP_MEMORY_SCOPE_AGENT); }
__device__ __forceinline__ unsigned xb_xcc_id() { return (unsigned)__builtin_amdgcn_s_getreg((3 << 11) | 20) & 0xFu; }
#define XB_SPIN(cond, bar) do { unsigned _sp = 0; while (cond) { __builtin_amdgcn_s_sleep(1); \
    if ((++_sp & 255u) == 0u) { if (xb_ld(&(bar)[XB_TMO])) break; if (_sp > XB_SPIN_CAP) { atomicAdd(&(bar)[XB_TMO], 1u); break; } } } } while (0)

struct XcdBarrier {
    unsigned* bar; unsigned x;
    volatile LAS unsigned* st;
};

__device__ __forceinline__ XcdBarrier xcd_barrier_post(unsigned* bar, volatile LAS unsigned* st) {
    XcdBarrier b; b.bar = bar; b.x = xb_xcc_id(); b.st = st;
    if (threadIdx.x == 0) (void)xb_add(&bar[XB_XCNT(b.x)], 1u);
    return b;
}
__device__ __forceinline__ void xcd_barrier_complete(unsigned* bar, unsigned x, unsigned& nloc, unsigned& nx) {
    const unsigned G = gridDim.x * gridDim.y * gridDim.z;
    unsigned sum, cnt, mine, sp = 0u;
    for (;;) {
        sum = 0u; cnt = 0u; mine = 0u;
#pragma unroll
        for (unsigned j = 0; j < 16; ++j) { const unsigned c = xb_ld(&bar[XB_XCNT(j)]); sum += c; cnt += (c > 0u) ? 1u : 0u; mine = (j == x) ? c : mine; }
        if (sum == G) break;
        __builtin_amdgcn_s_sleep(1);
        if ((++sp & 255u) == 0u) { if (xb_ld(&bar[XB_TMO])) break; if (sp > XB_SPIN_CAP) { atomicAdd(&bar[XB_TMO], 1u); break; } }
    }
    nloc = mine > 0u ? mine : 1u; nx = cnt > 0u ? cnt : 1u;
}

__device__ __forceinline__ void xcd_barrier(const XcdBarrier& b) {
    asm volatile("s_waitcnt vmcnt(0)" ::: "memory");
    __syncthreads();
    if (threadIdx.x == 0) {
        unsigned* bar = b.bar;
        __builtin_amdgcn_s_waitcnt(0);
        unsigned nloc = b.st[0], nx = b.st[1];
        if (nloc == 0u) { xcd_barrier_complete(bar, b.x, nloc, nx); b.st[0] = nloc; b.st[1] = nx; }
        const unsigned old = xb_add(&bar[XB_XSUB(b.x)], 1u);
        const unsigned gen = old / nloc;
        if (old + 1u == (gen + 1u) * nloc) {
            __builtin_amdgcn_fence(__ATOMIC_RELEASE, "agent");
            asm volatile("s_waitcnt vmcnt(0)" ::: "memory");
            const unsigned og = xb_add(&bar[XB_TOP], 1u);
            const unsigned tg = og / nx;
            if (og + 1u == (tg + 1u) * nx) { xb_add(&bar[XB_TOPGEN], 1u); xb_add(&bar[XB_XGEN(b.x)], 1u); asm volatile("buffer_inv sc1" ::: "memory"); }
            else { asm volatile("buffer_inv sc1" ::: "memory"); XB_SPIN(xb_ld(&bar[XB_TOPGEN]) == tg, bar); xb_add(&bar[XB_XGEN(b.x)], 1u); }
            asm volatile("s_waitcnt vmcnt(0)" ::: "memory");
        } else {
            asm volatile("buffer_inv sc1" ::: "memory");
            XB_SPIN(xb_ld(&bar[XB_XGEN(b.x)]) == gen, bar);
            asm volatile("s_waitcnt vmcnt(0)" ::: "memory");
        }
    }
    __syncthreads();
}
namespace pg8 {
constexpr int BM = 256, BK = 64, HALF = 128, HTB = HALF * BK * 2, STAGE_BYTES = 8 * HTB, NXCD = 8, WGM = 8;
DI int lds_byte(int r, int c) { const int st = (r >> 4) * 2 + (c >> 5), rr = r & 15, cc = c & 31, ob = rr * 64 + cc * 2; return st * 1024 + (ob ^ (((ob >> 9) & 1) << 5)); }
DI void stage_rc(int b, int& R, int& C) { const int st = b / 1024, sb = b % 1024, swz = sb ^ (((sb >> 9) & 1) << 5); R = (st >> 1) * 16 + swz / 64; C = (st & 1) * 32 + (swz % 64) / 2; }
DI int perm32(int rho) { const int n = rho >> 4, i = rho & 15; return 8 * (i >> 2) + 4 * n + (i & 3); }

struct UnitD {
    const char* A; const char* B;
    unsigned lda, ldb;
    const int* arows; int acount;
    int kind, pm, pn, aux;
    int K;
};
DI void tile_map(int L, int nM, int nN, int& pm, int& pn) {
    const int nwg = nM * nN; int wgid = L;
    { const int q = nwg / NXCD, r = nwg % NXCD, xcd = wgid % NXCD, off = wgid / NXCD; wgid = (xcd < r ? xcd * (q + 1) : r * (q + 1) + (xcd - r) * q) + off; }
    const int nig = WGM * nN, gid = wgid / nig, fm = gid * WGM, gsz = (nM - fm) < WGM ? (nM - fm) : WGM;
    pm = fm + ((wgid % nig) % gsz); pn = (wgid % nig) / gsz;
}
template <bool PERM, bool GATHER>
DI void unit_off(const UnitD& u, int tid, unsigned (&offA)[2][2], unsigned (&offB)[2]) {
#pragma unroll
    for (int i = 0; i < 2; ++i) {
        int R, C; stage_rc(tid * 16 + i * 8192, R, C);
        const int Rb = PERM ? ((R & ~31) + perm32(R & 31)) : R;
        offB[i] = (unsigned)Rb * u.ldb + (unsigned)C * 2u;
        if (GATHER) {
#pragma unroll
            for (int h = 0; h < 2; ++h) { const int ra = h * HALF + R; const int rr = ra < u.acount ? ra : 0; offA[h][i] = (unsigned)u.arows[rr] * u.lda + (unsigned)C * 2u; }
        } else { offA[0][i] = (unsigned)R * u.lda + (unsigned)C * 2u; offA[1][i] = 0u; }
    }
}

template <class Epi, class Sched, bool GATHER = false>
DI void gemm_run(LAS unsigned char* lds, const Sched& S, const Epi& E, int tid_in) {
    int tid_ = tid_in; asm volatile("" : "+v"(tid_));
    const int tid = tid_, wid = __builtin_amdgcn_readfirstlane(tid >> 6), lane = tid & 63, wr = wid >> 2, wc = wid & 3, fr = lane & 15, fq = lane >> 4;
    const size_t kstep = (size_t)(BK * 2);
    const unsigned ldsw = (unsigned)wid * 1024u;
    const int aoff = lds_byte(wr * 64 + fr, fq * 8), boff = lds_byte(wc * 32 + fr, fq * 8);
#define PG8_SA(b, h) (((b) * 2 + (h)) * HTB)
#define PG8_SB(b, h) ((4 + (b) * 2 + (h)) * HTB)
#define PG8_STAGE(bufoff, gbase, voff) do { _Pragma("unroll") for (int _i = 0; _i < 2; ++_i) \
        __builtin_amdgcn_global_load_lds((const unsigned*)((const char*)(gbase) + (voff)[_i]), (LAS unsigned*)(lds + (bufoff) + ldsw + _i * 8192), 16, 0, 0); } while (0)
#define PG8_LDA(dst, b, h) do { _Pragma("unroll") for (int m = 0; m < 4; ++m) _Pragma("unroll") for (int k = 0; k < 2; ++k) dst[m][k] = *(const LAS bf16x8*)(lds + PG8_SA(b, h) + aoff + m * 2048 + k * 1024); } while (0)
#define PG8_LDB(dst, b, h) do { _Pragma("unroll") for (int n = 0; n < 2; ++n) _Pragma("unroll") for (int k = 0; k < 2; ++k) dst[n][k] = *(const LAS bf16x8*)(lds + PG8_SB(b, h) + boff + n * 2048 + k * 1024); } while (0)
#define PG8_MMA(ai, bj, At, Bt) do { __builtin_amdgcn_s_setprio(1); _Pragma("unroll") for (int m = 0; m < 4; ++m) _Pragma("unroll") for (int n = 0; n < 2; ++n) _Pragma("unroll") for (int k = 0; k < 2; ++k) \
        acc[ai][bj][m][n] = __builtin_amdgcn_mfma_f32_16x16x32_bf16(Bt[n][k], At[m][k], acc[ai][bj][m][n], 0, 0, 0); __builtin_amdgcn_s_setprio(0); } while (0)
#define PG8_WAIT_V(n) asm volatile("s_waitcnt vmcnt(" #n ")" ::: "memory")
#define PG8_WAIT_L(n) asm volatile("s_waitcnt lgkmcnt(" #n ")" ::: "memory")
#define PG8_BAR __builtin_amdgcn_s_barrier()
#define PG8_SCHED __builtin_amdgcn_sched_barrier(0)
    UnitD cur, nxt; int ui = 0;
    if (!S.next(0, cur)) return;
    unsigned offA[2][2], offB[2];
    unit_off<Epi::PERM, GATHER>(cur, tid, offA, offB);
    size_t hA = GATHER ? 0 : (size_t)HALF * cur.lda, hB = (size_t)HALF * cur.ldb;
#define OA(h) offA[GATHER ? (h) : 0]
    f32x4 acc[2][2][4][2];
#pragma unroll
    for (int a = 0; a < 2; ++a)
#pragma unroll
        for (int b = 0; b < 2; ++b)
#pragma unroll
            for (int m = 0; m < 4; ++m)
#pragma unroll
                for (int n = 0; n < 2; ++n) acc[a][b][m][n] = (f32x4){0.f, 0.f, 0.f, 0.f};
    bf16x8 At[4][2], B0[2][2], B1[2][2];
    PG8_STAGE(PG8_SB(0, 0), cur.B, offB); PG8_STAGE(PG8_SA(0, 0), cur.A, OA(0)); PG8_STAGE(PG8_SB(0, 1), cur.B + hB, offB); PG8_STAGE(PG8_SA(0, 1), cur.A + hA, OA(1));
    if (wr == 1) PG8_BAR;
    PG8_WAIT_V(4); PG8_BAR;
    PG8_STAGE(PG8_SB(1, 0), cur.B + kstep, offB); PG8_STAGE(PG8_SA(1, 0), cur.A + kstep, OA(0)); PG8_STAGE(PG8_SB(1, 1), cur.B + kstep + hB, offB);
    PG8_WAIT_V(6); PG8_BAR;
    for (;;) {
        const bool has_next = S.next(ui + 1, nxt);
        const int nt = cur.K / BK;
        for (int t = 0; t < nt; t += 2) {
            const bool last = (t == nt - 2);
            const char* a1 = cur.A + (size_t)(t + 1) * kstep;
            PG8_LDB(B0, 0, 0); PG8_SCHED; PG8_LDA(At, 0, 0); PG8_STAGE(PG8_SA(1, 1), a1 + hA, OA(1));
            PG8_WAIT_L(8); PG8_BAR; PG8_WAIT_L(0); PG8_MMA(0, 0, At, B0); PG8_BAR; PG8_SCHED;
            const char* a2; const char* b2;
            if (last) { if (has_next) { unit_off<Epi::PERM, GATHER>(nxt, tid, offA, offB); a2 = nxt.A; b2 = nxt.B; hA = GATHER ? 0 : (size_t)HALF * nxt.lda; hB = (size_t)HALF * nxt.ldb; } else { a2 = cur.A; b2 = cur.B; } }
            else { a2 = cur.A + (size_t)(t + 2) * kstep; b2 = cur.B + (size_t)(t + 2) * kstep; }
            const char* a3 = a2 + kstep; const char* b3 = b2 + kstep;
            PG8_LDB(B1, 0, 1); PG8_STAGE(PG8_SB(0, 0), b2, offB);
            PG8_BAR; PG8_WAIT_L(0); PG8_MMA(0, 1, At, B1); PG8_BAR;
            PG8_LDA(At, 0, 1); PG8_STAGE(PG8_SA(0, 0), a2, OA(0));
            PG8_BAR; PG8_WAIT_L(0); PG8_MMA(1, 0, At, B0); PG8_BAR; PG8_SCHED;
            PG8_STAGE(PG8_SB(0, 1), b2 + hB, offB);
            PG8_WAIT_V(6); PG8_BAR; PG8_MMA(1, 1, At, B1); PG8_BAR;
            PG8_LDB(B0, 1, 0); PG8_SCHED; PG8_LDA(At, 1, 0); PG8_STAGE(PG8_SA(0, 1), a2 + hA, OA(1));
            PG8_WAIT_L(8); PG8_BAR; PG8_WAIT_L(0); PG8_MMA(0, 0, At, B0); PG8_BAR; PG8_SCHED;
            PG8_LDB(B1, 1, 1); PG8_STAGE(PG8_SB(1, 0), b3, offB);
            PG8_BAR; PG8_WAIT_L(0); PG8_MMA(0, 1, At, B1); PG8_BAR;
            PG8_LDA(At, 1, 1); PG8_STAGE(PG8_SA(1, 0), a3, OA(0));
            PG8_BAR; PG8_WAIT_L(0); PG8_MMA(1, 0, At, B0); PG8_BAR; PG8_SCHED;
            PG8_STAGE(PG8_SB(1, 1), b3 + hB, offB);
            PG8_WAIT_V(6); PG8_BAR; PG8_MMA(1, 1, At, B1); PG8_BAR;
        }
        { int fr_ = fr, fq_ = fq; asm volatile("" : "+v"(fr_), "+v"(fq_)); E(acc, cur, wr, wc, fr_, fq_); }
        if (!has_next) break;
#pragma unroll
        for (int a = 0; a < 2; ++a)
#pragma unroll
            for (int b = 0; b < 2; ++b)
#pragma unroll
                for (int m = 0; m < 4; ++m)
#pragma unroll
                    for (int n = 0; n < 2; ++n) acc[a][b][m][n] = (f32x4){0.f, 0.f, 0.f, 0.f};
        cur = nxt; ++ui;
    }
    PG8_WAIT_V(0);
    if (wr == 0) PG8_BAR;
    PG8_BAR;
#undef OA
#undef PG8_SA
#undef PG8_SB
#undef PG8_STAGE
#undef PG8_LDA
#undef PG8_LDB
#undef PG8_MMA
#undef PG8_WAIT_V
#undef PG8_WAIT_L
#undef PG8_BAR
#undef PG8_SCHED
}
}
struct Args { const float* in[19]; float* out; unsigned char* ws; int step_lo, step_hi; };
struct Frame {
    LAS unsigned char* lds; unsigned char* ldsg;
    int tid, lane, wave, G, bid;
    const float *x, *c, *ada_w, *ada_b, *w_in, *conv_w, *gate_b, *norm_g, *w_bm, *w_ba, *w_out, *router_w, *router_b, *w_gate, *w_up, *w_down, *g_mix, *g_ffn, *g_fin;
    float* out; unsigned char* ws; unsigned* ctl;
    float* MOD; float* WIF; float* RW; unsigned char* W;
    bf16_t* U; float* GIF; bf16_t* HM; bf16_t* HA; unsigned char* TOKI; unsigned char* R0; bf16_t* XB;
};
#define CAS __attribute__((address_space(4)))
DI const void* karg(int idx) { asm volatile("" : "+s"(idx)); const void* const CAS* kp = (const void* const CAS*)__builtin_amdgcn_kernarg_segment_ptr(); return kp[idx]; }
DI void frame_init(Frame& F, unsigned char* lds_generic, int tid) {
    F.ldsg = lds_generic; F.lds = (LAS unsigned char*)lds_generic;
    F.tid = tid; F.lane = F.tid & 63; F.wave = __builtin_amdgcn_readfirstlane(F.tid >> 6); F.G = gridDim.x; F.bid = blockIdx.x;
    F.x = (const float*)karg(0); F.c = (const float*)karg(1); F.ada_w = (const float*)karg(2); F.ada_b = (const float*)karg(3); F.w_in = (const float*)karg(4); F.conv_w = (const float*)karg(5);
    F.gate_b = (const float*)karg(6); F.norm_g = (const float*)karg(7); F.w_bm = (const float*)karg(8); F.w_ba = (const float*)karg(9); F.w_out = (const float*)karg(10); F.router_w = (const float*)karg(11);
    F.router_b = (const float*)karg(12); F.w_gate = (const float*)karg(13); F.w_up = (const float*)karg(14); F.w_down = (const float*)karg(15); F.g_mix = (const float*)karg(16); F.g_ffn = (const float*)karg(17); F.g_fin = (const float*)karg(18);
    F.out = (float*)karg(19); unsigned char* ws = (unsigned char*)karg(20);
    F.ws = ws; F.ctl = (unsigned*)(ws + WS_CTL);
    F.MOD = (float*)(ws + WS_MOD); F.WIF = (float*)(ws + WS_WIF); F.RW = (float*)(ws + WS_RW); F.W = ws + WS_W;
    F.U = (bf16_t*)(ws + WS_U); F.GIF = (float*)(ws + WS_GIF); F.HM = (bf16_t*)(ws + WS_HM); F.HA = (bf16_t*)(ws + WS_HA);
    F.TOKI = ws + WS_TOKI; F.R0 = ws + WS_R0; F.XB = (bf16_t*)(ws + WS_XB);
}

struct TJob { const float* src; int ld; int K; int N; bf16_t* dst; int rmul, radd; };
DI bool get_job(const Frame& F, int l, int j, TJob& J) {
    const float* win = F.w_in + (size_t)l * DM * INC;
    bf16_t* W = (bf16_t*)F.W;
    J.rmul = 1; J.radd = 0; J.K = 1024; J.ld = INC;
    if (j == 0) { J.src = win + 0;    J.N = 1024; J.dst = W + W_NAT / 2 + (size_t)0 * 1024; return true; }
    if (j == 1) { J.src = win + 1024; J.N = 1024; J.dst = W + W_NAT / 2 + (size_t)1024 * 1024; return true; }
    if (j == 2) { J.src = win + 3072; J.N = 1024; J.dst = W + W_NAT / 2 + (size_t)2048 * 1024; return true; }
    if (j == 3) { J.src = win + 4104; J.N = 1536; J.dst = W + W_NAT / 2 + (size_t)3072 * 1024; return true; }
    if (j == 4) { J.src = win + 5640; J.N = 1536; J.dst = W + W_NAT / 2 + (size_t)4608 * 1024; return true; }
    if (j == 5) { J.src = win + 2048; J.N = 1024; J.dst = W + W_VT / 2 + (size_t)0 * 1024; return true; }
    if (j == 6) { J.src = win + 7176; J.N = 1536; J.dst = W + W_VT / 2 + (size_t)1024 * 1024; return true; }
    if (j == 7) { J.src = win + 8712; J.N = 2048; J.dst = W + W_G / 2; return true; }
    if (j == 8) { J.src = F.w_bm + (size_t)l * 1024 * 1024; J.ld = 1024; J.N = 1024; J.dst = W + W_M / 2; return true; }
    if (j == 9) { J.src = F.w_ba + (size_t)l * 512 * 1024; J.ld = 1024; J.K = 512; J.N = 1024; J.dst = W + W_A / 2; return true; }
    if (j == 10) { J.src = F.w_out + (size_t)l * 1024 * 1024; J.ld = 1024; J.N = 1024; J.dst = W + W_O / 2; return true; }
    const int q = j - 11; if (q >= 48) return false;
    const int e = q / 3, which = q % 3;
    if (which == 0) { J.src = F.w_gate + ((size_t)l * 16 + e) * 1024 * 512; J.ld = 512; J.N = 512; J.dst = W + W_13 / 2 + (size_t)e * 1024 * 1024; J.rmul = 2; J.radd = 0; }
    else if (which == 1) { J.src = F.w_up + ((size_t)l * 16 + e) * 1024 * 512; J.ld = 512; J.N = 512; J.dst = W + W_13 / 2 + (size_t)e * 1024 * 1024; J.rmul = 2; J.radd = 1; }
    else { J.src = F.w_down + ((size_t)l * 16 + e) * 512 * 1024; J.ld = 1024; J.K = 512; J.N = 1024; J.dst = W + W_2 / 2 + (size_t)e * 1024 * 512; }
    return true;
}
constexpr int NJOBS = 59;
DI int job_part(int j) { return j < 6 ? 0 : (j < 8 ? 1 : 2); }
struct TIter { int j, t, nk, ntile, part; TJob J; };
DI bool titer_seek(const Frame& F, int l, TIter& it, int adv) {
    it.t += adv;
    while (it.t >= it.ntile) { it.t -= it.ntile; ++it.j; while (it.part >= 0 && it.j < NJOBS && job_part(it.j) != it.part) ++it.j; if (it.j >= NJOBS) return false; get_job(F, l, it.j, it.J); it.nk = it.J.K / 128; it.ntile = it.nk * (it.J.N / 64); }
    return true;
}
DI void tconv_load(const TIter& it, int tid, f32x4 (&v)[4]) {
    const int tk = it.t % it.nk, tn = it.t / it.nk;
#pragma unroll
    for (int i = 0; i < 4; ++i) { const int row = (tid >> 4) + 32 * i, c4 = tid & 15; v[i] = *(const f32x4*)(it.J.src + (size_t)(tk * 128 + row) * it.J.ld + tn * 64 + c4 * 4); }
}
DI void phase_pw(const Frame& F, int l, int b0, int nb, int part) {
    const int me = F.bid - b0; if (me < 0 || me >= nb) return;
    bf16_t* tl = (bf16_t*)F.ldsg;
    const int tid = F.tid;
    TIter it; it.part = part; it.j = -1; it.t = 0; it.nk = 1; it.ntile = 0;
    bool ok = titer_seek(F, l, it, me);
    f32x4 v[4];
    if (ok) tconv_load(it, tid, v);
    while (ok) {
        const int tk = it.t % it.nk, tn = it.t / it.nk; bf16_t* dst = it.J.dst; const int dK = it.J.K, rmul = it.J.rmul, radd = it.J.radd;
#pragma unroll
        for (int i = 0; i < 4; ++i) {
            const int row = (tid >> 4) + 32 * i, c4 = tid & 15;
            const unsigned lo = pack2(v[i][0], v[i][1]), hi = pack2(v[i][2], v[i][3]);
            tl[(c4 * 4 + 0) * 136 + row] = (bf16_t)(lo & 0xffff); tl[(c4 * 4 + 1) * 136 + row] = (bf16_t)(lo >> 16);
            tl[(c4 * 4 + 2) * 136 + row] = (bf16_t)(hi & 0xffff); tl[(c4 * 4 + 3) * 136 + row] = (bf16_t)(hi >> 16);
        }
        ok = titer_seek(F, l, it, nb);
        if (ok) tconv_load(it, tid, v);
        __syncthreads();
#pragma unroll
        for (int i = 0; i < 2; ++i) { const int p = tid + 512 * i, n = p >> 4, k8 = p & 15;
            const u32x4 o = *(const u32x4*)(tl + n * 136 + k8 * 8);
            *(u32x4*)(dst + (size_t)(rmul * (tn * 64 + n) + radd) * dK + tk * 128 + k8 * 8) = o; }
        __syncthreads();
    }
}
DI void phase_p0_small(const Frame& F) {
    float* sc = (float*)F.ldsg;
    float* part = sc + 4096;
    for (int i = F.tid; i < 4096; i += 512) sc[i] = siluf_(F.c[i]);
    __syncthreads();
    for (int it = F.bid; it < 192; it += F.G) {
        const int l = it / 96, cc = it % 96, col = cc * 64 + F.lane, w = F.wave;
        const float* aw = F.ada_w + (size_t)l * 1024 * 6144 + col;
        float a0 = 0.f, a1 = 0.f, a2 = 0.f, a3 = 0.f;
        for (int k = w * 128; k < w * 128 + 128; ++k) { const float wv = aw[(size_t)k * 6144]; a0 += sc[k] * wv; a1 += sc[1024 + k] * wv; a2 += sc[2048 + k] * wv; a3 += sc[3072 + k] * wv; }
        part[(w * 4 + 0) * 64 + F.lane] = a0; part[(w * 4 + 1) * 64 + F.lane] = a1; part[(w * 4 + 2) * 64 + F.lane] = a2; part[(w * 4 + 3) * 64 + F.lane] = a3;
        __syncthreads();
        if (F.tid < 256) { const int b = F.tid >> 6, ln = F.tid & 63; float s = 0.f;
            for (int ww = 0; ww < 8; ++ww) s += part[(ww * 4 + b) * 64 + ln];
            F.MOD[((size_t)l * 4 + b) * 6144 + cc * 64 + ln] = s + F.ada_b[(size_t)l * 6144 + cc * 64 + ln]; }
        __syncthreads();
    }
    for (int i = F.bid * 512 + F.tid; i < 2 * 8 * 1024 + 16 * 1024; i += F.G * 512) {
        if (i < 16384) { const int l = i >> 13, j = (i >> 10) & 7, k = i & 1023; F.WIF[i] = F.w_in[((size_t)l * 1024 + k) * INC + 4096 + j]; }
        else { const int q = i - 16384, e = q >> 10, k = q & 1023; F.RW[q] = F.router_w[k * 16 + e]; }
    }
}

DI void moe_offsets(const unsigned* cnt, int* pre, int tid) { if (tid == 0) { int s = 0; for (int e = 0; e < 16; ++e) { pre[e] = s; s += ((int)cnt[e] + 255) >> 8; } pre[16] = s; } }

template <bool XBF> struct RowRawT;
template <> struct RowRawT<false> { f32x4 x[4]; u32x2 y1[4], y2[4]; float w1, w2; };
template <> struct RowRawT<true> { u32x2 x[4]; u32x2 y1[4], y2[4]; float w1, w2; };
template <bool MOE, bool XBF>
DI void row_issue(const Frame& F, const void* xsrc, int t, int rl, const int* tokiL, const int* pre, RowRawT<XBF>& r) {
#pragma unroll
    for (int q = 0; q < 4; ++q) {
        if constexpr (XBF) r.x[q] = *(const u32x2*)((const bf16_t*)xsrc + (size_t)t * XBP + F.lane * 4 + 256 * q);
        else r.x[q] = *(const f32x4*)((const float*)xsrc + (size_t)t * 1024 + F.lane * 4 + 256 * q); }
    if (MOE) {
        const int* ti = tokiL + rl * 8;
        const int e1 = ti[0], s1 = ti[1], e2 = ti[2], s2 = ti[3]; r.w1 = __int_as_float(ti[4]); r.w2 = __int_as_float(ti[5]);
        const bf16_t* YS = (const bf16_t*)(F.R0 + R_YS);
        const bf16_t* y1 = YS + (size_t)(pre[e1] * 256 + s1) * YSP; const bf16_t* y2 = YS + (size_t)(pre[e2] * 256 + s2) * YSP;
#pragma unroll
        for (int q = 0; q < 4; ++q) { r.y1[q] = *(const u32x2*)(y1 + F.lane * 4 + 256 * q); r.y2[q] = *(const u32x2*)(y2 + F.lane * 4 + 256 * q); }
    }
}
template <bool MOE, bool XBF>
DI void row_finish(const Frame& F, const RowRawT<XBF>& r, const float* gt, float (&xv)[16]) {
#pragma unroll
    for (int q = 0; q < 4; ++q) {
        if constexpr (XBF) { xv[q * 4] = hlo(r.x[q].x); xv[q * 4 + 1] = hhi(r.x[q].x); xv[q * 4 + 2] = hlo(r.x[q].y); xv[q * 4 + 3] = hhi(r.x[q].y); }
        else { xv[q * 4] = r.x[q][0]; xv[q * 4 + 1] = r.x[q][1]; xv[q * 4 + 2] = r.x[q][2]; xv[q * 4 + 3] = r.x[q][3]; } }
    if (MOE) {
#pragma unroll
        for (int q = 0; q < 4; ++q) { const f32x4 g = *(const f32x4*)(gt + F.lane * 4 + 256 * q); const u32x2 a = r.y1[q], d = r.y2[q];
            xv[q * 4 + 0] += g[0] * (r.w1 * bflo(a.x) + r.w2 * bflo(d.x)); xv[q * 4 + 1] += g[1] * (r.w1 * bfhi(a.x) + r.w2 * bfhi(d.x));
            xv[q * 4 + 2] += g[2] * (r.w1 * bflo(a.y) + r.w2 * bflo(d.y)); xv[q * 4 + 3] += g[3] * (r.w1 * bfhi(a.y) + r.w2 * bfhi(d.y)); }
    }
}
DI float reduce16(float (&v)[16], int lane) {
    const bool b5 = lane & 32, b4 = lane & 16, b3 = lane & 8, b2 = lane & 4;
    float a[8], b[4], c[2];
#pragma unroll
    for (int i = 0; i < 8; ++i) { const float send = b5 ? v[i] : v[8 + i], mine = b5 ? v[8 + i] : v[i]; a[i] = mine + __shfl_xor(send, 32); }
#pragma unroll
    for (int i = 0; i < 4; ++i) { const float send = b4 ? a[i] : a[4 + i], mine = b4 ? a[4 + i] : a[i]; b[i] = mine + __shfl_xor(send, 16); }
#pragma unroll
    for (int i = 0; i < 2; ++i) { const float send = b3 ? b[i] : b[2 + i], mine = b3 ? b[2 + i] : b[i]; c[i] = mine + __shfl_xor(send, 8); }
    float r = (b2 ? c[1] : c[0]) + __shfl_xor(b2 ? c[0] : c[1], 4);
    r += __shfl_xor(r, 2); r += __shfl_xor(r, 1);
    return r;
}
DI float reduce8(float (&v)[8], int lane) {
    const bool b5 = lane & 32, b4 = lane & 16, b3 = lane & 8;
    float a[4], b[2];
#pragma unroll
    for (int i = 0; i < 4; ++i) { const float send = b5 ? v[i] : v[4 + i], mine = b5 ? v[4 + i] : v[i]; a[i] = mine + __shfl_xor(send, 32); }
#pragma unroll
    for (int i = 0; i < 2; ++i) { const float send = b4 ? a[i] : a[2 + i], mine = b4 ? a[2 + i] : a[i]; b[i] = mine + __shfl_xor(send, 16); }
    float r = (b3 ? b[1] : b[0]) + __shfl_xor(b3 ? b[0] : b[1], 8);
    r += __shfl_xor(r, 4); r += __shfl_xor(r, 2); r += __shfl_xor(r, 1);
    return r;
}
struct RowCtx { float gm[16], sh[16]; };
DI void load_rowconst(const Frame& F, const float* g, const float* shv, const float* scv, RowCtx& rc) {
#pragma unroll
    for (int q = 0; q < 4; ++q) { const int c = F.lane * 4 + 256 * q; const f32x4 gv = *(const f32x4*)(g + c), s1 = *(const f32x4*)(scv + c), s0 = *(const f32x4*)(shv + c);
#pragma unroll
        for (int j = 0; j < 4; ++j) { rc.gm[q * 4 + j] = gv[j] * (1.0f + s1[j]); rc.sh[q * 4 + j] = s0[j]; } }
}
DI void stage_toki(const Frame& F, int lprev, int blk, int* tokiL) {
    const int* src = (const int*)(F.TOKI + ((size_t)lprev * T_TOK + (size_t)blk * 128) * 32);
    for (int i = F.tid; i < 1024; i += 512) tokiL[i] = src[i];
}

template <bool MOE>
DI void phase_n1_t(const Frame& F, int l) {
    float* wif = (float*)F.ldsg;
    int* pre = (int*)(F.ldsg + 32768);
    int* tokiL = (int*)(F.ldsg + 32768 + 128);
    for (int i = F.tid; i < 8192; i += 512) wif[i] = F.WIF[(size_t)l * 8192 + i];
    if (MOE) moe_offsets(F.ctl + CW_CNT + 64 * (l - 1), pre, F.tid);
    __syncthreads();
    const void* xsrc = MOE ? (const void*)F.XB : (const void*)F.x;
    for (int blk = F.bid; blk < T_TOK / 128; blk += F.G) {
        const int b = blk / (SEQ / 128);
        const float* mod = F.MOD + ((size_t)l * 4 + b) * 6144;
        const float* gt = F.MOD + ((size_t)(MOE ? l - 1 : 0) * 4 + b) * 6144 + 5120;
        RowCtx rc; load_rowconst(F, F.g_mix + (size_t)l * 1024, mod, mod + 1024, rc);
        if (MOE) { __syncthreads(); stage_toki(F, l - 1, blk, tokiL); __syncthreads(); }
        RowRawT<MOE> nx0, nx1; row_issue<MOE, MOE>(F, xsrc, blk * 128 + F.wave * 16, F.wave * 16, tokiL, pre, nx0); row_issue<MOE, MOE>(F, xsrc, blk * 128 + F.wave * 16 + 1, F.wave * 16 + 1, tokiL, pre, nx1);
#pragma unroll 1
        for (int i = 0; i < 16; i += 2) {
            const int rl = F.wave * 16 + i, t = blk * 128 + rl;
            asm volatile("" ::: "memory");
            const RowRawT<MOE> c0 = nx0, c1 = nx1;
            if (i < 14) { row_issue<MOE, MOE>(F, xsrc, t + 2, rl + 2, tokiL, pre, nx0); row_issue<MOE, MOE>(F, xsrc, t + 3, rl + 3, tokiL, pre, nx1); }
            float xa[16], xb[16]; row_finish<MOE, MOE>(F, c0, gt, xa); row_finish<MOE, MOE>(F, c1, gt, xb);
            if (MOE) {
#pragma unroll
                for (int q = 0; q < 4; ++q) { u32x2 w; w.x = pack2h(xa[q * 4], xa[q * 4 + 1]); w.y = pack2h(xa[q * 4 + 2], xa[q * 4 + 3]); *(u32x2*)(F.XB + (size_t)t * XBP + F.lane * 4 + 256 * q) = w;
                    w.x = pack2h(xb[q * 4], xb[q * 4 + 1]); w.y = pack2h(xb[q * 4 + 2], xb[q * 4 + 3]); *(u32x2*)(F.XB + (size_t)(t + 1) * XBP + F.lane * 4 + 256 * q) = w; }
            }
            float sa = 0.f, sb = 0.f;
#pragma unroll
            for (int j = 0; j < 16; ++j) { sa += xa[j] * xa[j]; sb += xb[j] * xb[j]; }
            sa = wave_sum(sa); sb = wave_sum(sb);
            const float ra = __builtin_amdgcn_rsqf(sa * (1.0f / 1024.0f) + EPS), rb = __builtin_amdgcn_rsqf(sb * (1.0f / 1024.0f) + EPS);
#pragma unroll
            for (int j = 0; j < 16; ++j) { xa[j] = xa[j] * ra * rc.gm[j] + rc.sh[j]; xb[j] = xb[j] * rb * rc.gm[j] + rc.sh[j]; }
#pragma unroll
            for (int q = 0; q < 4; ++q) { u32x2 w; w.x = pack2(xa[q * 4], xa[q * 4 + 1]); w.y = pack2(xa[q * 4 + 2], xa[q * 4 + 3]); *(u32x2*)(F.U + (size_t)t * 1024 + F.lane * 4 + 256 * q) = w;
                w.x = pack2(xb[q * 4], xb[q * 4 + 1]); w.y = pack2(xb[q * 4 + 2], xb[q * 4 + 3]); *(u32x2*)(F.U + (size_t)(t + 1) * 1024 + F.lane * 4 + 256 * q) = w; }
            float da[8], db[8];
#pragma unroll
            for (int g = 0; g < 8; ++g) { float s0 = 0.f, s1 = 0.f;
#pragma unroll
                for (int q = 0; q < 4; ++q) { const f32x4 wv = *(const f32x4*)(wif + g * 1024 + F.lane * 4 + 256 * q);
                    s0 += xa[q * 4] * wv[0] + xa[q * 4 + 1] * wv[1] + xa[q * 4 + 2] * wv[2] + xa[q * 4 + 3] * wv[3];
                    s1 += xb[q * 4] * wv[0] + xb[q * 4 + 1] * wv[1] + xb[q * 4 + 2] * wv[2] + xb[q * 4 + 3] * wv[3]; }
                da[g] = s0; db[g] = s1; }
            const float reda = reduce8(da, F.lane), redb = reduce8(db, F.lane);
            const float ma = __shfl(reda, (F.lane & 7) * 8), mb = __shfl(redb, (F.lane & 7) * 8);
            if (F.lane < 16) {
                const int gl = F.lane & 7; float v = (F.lane < 8) ? ma : mb;
                v += F.gate_b[l * 8 + gl];
                if (gl >= 4) { const float e = __expf(-fabsf(v)); const float l1p = (e < 0.03f) ? e * (1.0f - e * (0.5f - e * (0.33333334f - 0.25f * e))) : __logf(1.0f + e); v = fminf(v, 0.f) - l1p; }
                F.GIF[(size_t)t * 8 + F.lane] = v;
            }
        }
    }
}
DI void phase_n1(const Frame& F, int l) { if (l == 0) phase_n1_t<false>(F, 0); else phase_n1_t<true>(F, l); }

DI void phase_n2(const Frame& F, int l) {
    _Float16* rw = (_Float16*)F.ldsg;
    int* cntL = (int*)(F.ldsg + 65536);
    int* baseL = cntL + 16;
    int* rec = baseL + 16;
    for (int i = F.tid; i < 16384; i += 512) rw[i] = (_Float16)F.RW[i];
    __syncthreads();
    unsigned* gcnt = F.ctl + CW_CNT + 64 * l;
    int* SLOT = (int*)(F.R0 + R_SLOT);
    for (int blk = F.bid; blk < T_TOK / 128; blk += F.G) {
        const int b = blk / (SEQ / 128);
        const float* mod = F.MOD + ((size_t)l * 4 + b) * 6144;
        RowCtx rc; load_rowconst(F, F.g_ffn + (size_t)l * 1024, mod + 3072, mod + 4096, rc);
        if (F.tid < 16) cntL[F.tid] = 0;
        __syncthreads();
        RowRawT<true> nx0, nx1, fx0, fx1;
        row_issue<false, true>(F, F.XB, blk * 128 + F.wave * 16, 0, nullptr, nullptr, nx0); row_issue<false, true>(F, F.XB, blk * 128 + F.wave * 16 + 1, 0, nullptr, nullptr, nx1);
        row_issue<false, true>(F, F.XB, blk * 128 + F.wave * 16 + 2, 0, nullptr, nullptr, fx0); row_issue<false, true>(F, F.XB, blk * 128 + F.wave * 16 + 3, 0, nullptr, nullptr, fx1);
#pragma unroll 1
        for (int i = 0; i < 16; i += 2) {
            const int rl = F.wave * 16 + i, t = blk * 128 + rl;
            asm volatile("" ::: "memory");
            const RowRawT<true> c0 = nx0, c1 = nx1; nx0 = fx0; nx1 = fx1;
            if (i < 12) { row_issue<false, true>(F, F.XB, t + 4, 0, nullptr, nullptr, fx0); row_issue<false, true>(F, F.XB, t + 5, 0, nullptr, nullptr, fx1); }
            float xa[16], xb[16]; row_finish<false, true>(F, c0, nullptr, xa); row_finish<false, true>(F, c1, nullptr, xb);
            float sa = 0.f, sb = 0.f;
#pragma unroll
            for (int j = 0; j < 16; ++j) { sa += xa[j] * xa[j]; sb += xb[j] * xb[j]; }
            sa = wave_sum(sa); sb = wave_sum(sb);
            const float ra = __builtin_amdgcn_rsqf(sa * (1.0f / 1024.0f) + EPS), rb = __builtin_amdgcn_rsqf(sb * (1.0f / 1024.0f) + EPS);
#pragma unroll
            for (int j = 0; j < 16; ++j) { xa[j] = xa[j] * ra * rc.gm[j] + rc.sh[j]; xb[j] = xb[j] * rb * rc.gm[j] + rc.sh[j]; }
#pragma unroll
            for (int q = 0; q < 4; ++q) { u32x2 w; w.x = pack2(xa[q * 4], xa[q * 4 + 1]); w.y = pack2(xa[q * 4 + 2], xa[q * 4 + 3]); *(u32x2*)(F.U + (size_t)t * 1024 + F.lane * 4 + 256 * q) = w;
                w.x = pack2(xb[q * 4], xb[q * 4 + 1]); w.y = pack2(xb[q * 4 + 2], xb[q * 4 + 3]); *(u32x2*)(F.U + (size_t)(t + 1) * 1024 + F.lane * 4 + 256 * q) = w; }
            float la[16], lb[16];
            h16x2 ha[8], hb[8];
#pragma unroll
            for (int j = 0; j < 8; ++j) { ha[j] = __builtin_convertvector((f32x2){xa[2 * j], xa[2 * j + 1]}, h16x2); hb[j] = __builtin_convertvector((f32x2){xb[2 * j], xb[2 * j + 1]}, h16x2); }
#pragma unroll
            for (int e = 0; e < 16; ++e) { float s0 = 0.f, s1 = 0.f;
#pragma unroll
                for (int q = 0; q < 4; ++q) { typedef _Float16 h16x4 __attribute__((ext_vector_type(4)));
                    const h16x4 wv = *(const h16x4*)(rw + e * 1024 + F.lane * 4 + 256 * q);
                    const h16x2 w01 = {wv[0], wv[1]}, w23 = {wv[2], wv[3]};
                    s0 = __builtin_amdgcn_fdot2(ha[2 * q], w01, s0, false); s0 = __builtin_amdgcn_fdot2(ha[2 * q + 1], w23, s0, false);
                    s1 = __builtin_amdgcn_fdot2(hb[2 * q], w01, s1, false); s1 = __builtin_amdgcn_fdot2(hb[2 * q + 1], w23, s1, false); }
                la[e] = s0; lb[e] = s1; }
            const float reda = reduce16(la, F.lane), redb = reduce16(lb, F.lane);
            const float ma = __shfl(reda, (F.lane & 15) * 4), mb = __shfl(redb, (F.lane & 15) * 4);
            const int base = F.lane & 16;
            const float mine = base ? mb : ma;
            const float score = 1.0f / (1.0f + __expf(-mine));
            const float sel = score + F.router_b[F.lane & 15];
            const float s0 = __shfl(sel, (F.lane & ~3) + 0), s1 = __shfl(sel, (F.lane & ~3) + 1), s2 = __shfl(sel, (F.lane & ~3) + 2), s3 = __shfl(sel, (F.lane & ~3) + 3);
            const float mx = fmaxf(fmaxf(s0, s1), fmaxf(s2, s3));
            const int im = (s0 == mx) ? 0 : (s1 == mx) ? 1 : (s2 == mx) ? 2 : 3;
            const float t0 = (im == 0) ? -INFINITY : s0, t1 = (im == 1) ? -INFINITY : s1, t2 = (im == 2) ? -INFINITY : s2, t3 = (im == 3) ? -INFINITY : s3;
            const float mx2 = fmaxf(fmaxf(t0, t1), fmaxf(t2, t3));
            const int im2 = (t0 == mx2) ? 0 : (t1 == mx2) ? 1 : (t2 == mx2) ? 2 : 3;
            const float gs = mx + mx2;
            const float g0 = __shfl(gs, base + 0), g1 = __shfl(gs, base + 4), g2 = __shfl(gs, base + 8), g3 = __shfl(gs, base + 12);
            const float gm = fmaxf(fmaxf(g0, g1), fmaxf(g2, g3));
            const int bg = (g0 == gm) ? 0 : (g1 == gm) ? 1 : (g2 == gm) ? 2 : 3;
            const int e1 = __shfl(bg * 4 + im, base + bg * 4), e2 = __shfl(bg * 4 + im2, base + bg * 4);
            const float sc1 = __shfl(score, base + e1), sc2 = __shfl(score, base + e2);
            if (F.lane == 0 || F.lane == 16) {
                const int rr = rl + (F.lane >> 4);
                const float inv = 1.0f / (sc1 + sc2);
                const int r1 = atomicAdd(&cntL[e1], 1), r2 = atomicAdd(&cntL[e2], 1);
                int* r = rec + rr * 6; r[0] = e1; r[1] = r1; r[2] = e2; r[3] = r2; r[4] = __float_as_int(sc1 * inv); r[5] = __float_as_int(sc2 * inv);
            }
        }
        __syncthreads();
        if (F.tid < 16) baseL[F.tid] = (int)atomicAdd(&gcnt[F.tid], (unsigned)cntL[F.tid]);
        __syncthreads();
        if (F.tid < 128) {
            const int t = blk * 128 + F.tid; const int* r = rec + F.tid * 6;
            const int e1 = r[0], s1 = baseL[e1] + r[1], e2 = r[2], s2 = baseL[e2] + r[3];
            SLOT[e1 * 32768 + s1] = t; SLOT[e2 * 32768 + s2] = t;
            int* ti = (int*)(F.TOKI + ((size_t)l * T_TOK + t) * 32);
            ti[0] = e1; ti[1] = s1; ti[2] = e2; ti[3] = s2; ti[4] = r[4]; ti[5] = r[5];
        }
        __syncthreads();
    }
}

DI void phase_fn(const Frame& F) {
    int* pre = (int*)F.ldsg;
    int* tokiL = (int*)(F.ldsg + 128);
    moe_offsets(F.ctl + CW_CNT + 64 * (DEPTH - 1), pre, F.tid);
    __syncthreads();
    for (int blk = F.bid; blk < T_TOK / 128; blk += F.G) {
        const int b = blk / (SEQ / 128);
        const float* gt = F.MOD + ((size_t)(DEPTH - 1) * 4 + b) * 6144 + 5120;
        __syncthreads(); stage_toki(F, DEPTH - 1, blk, tokiL); __syncthreads();
        RowRawT<true> nx; row_issue<true, true>(F, F.XB, blk * 128 + F.wave * 16, F.wave * 16, tokiL, pre, nx);
#pragma unroll 1
        for (int i = 0; i < 16; ++i) {
            const int rl = F.wave * 16 + i, t = blk * 128 + rl;
            const RowRawT<true> cur = nx;
            if (i < 15) row_issue<true, true>(F, F.XB, t + 1, rl + 1, tokiL, pre, nx);
            float xv[16]; row_finish<true, true>(F, cur, gt, xv);
            float ss = 0.f;
#pragma unroll
            for (int j = 0; j < 16; ++j) ss += xv[j] * xv[j];
            ss = wave_sum(ss);
            const float rn = __builtin_amdgcn_rsqf(ss * (1.0f / 1024.0f) + EPS);
#pragma unroll
            for (int q = 0; q < 4; ++q) { const f32x4 g = *(const f32x4*)(F.g_fin + F.lane * 4 + 256 * q);
                *(f32x4*)(F.out + (size_t)t * 1024 + F.lane * 4 + 256 * q) = (f32x4){xv[q * 4] * rn * g[0], xv[q * 4 + 1] * rn * g[1], xv[q * 4 + 2] * rn * g[2], xv[q * 4 + 3] * rn * g[3]}; }
        }
    }
}
DI void ml1_stage_raw(const bf16_t* P, LAS bf16_t* RwQ, LAS bf16_t* RwK, int h, int t0, int w, int lane) {
#pragma unroll 1
    for (int r = w; r < 67; r += 8) {
        const int t = t0 - 3 + r;
        if (lane < 32) {
            if (t >= 0) {
                const bf16_t* src = P + (size_t)t * PP + h * 256 + lane * 8;
                __builtin_amdgcn_global_load_lds((const unsigned*)src, (LAS unsigned*)(RwQ + r * 264), 16, 0, 0);
                __builtin_amdgcn_global_load_lds((const unsigned*)(src + 1024), (LAS unsigned*)(RwK + r * 264), 16, 0, 0);
            } else { *(LAS u32x4*)(RwQ + r * 264 + lane * 8) = (u32x4){0u, 0u, 0u, 0u}; *(LAS u32x4*)(RwK + r * 264 + lane * 8) = (u32x4){0u, 0u, 0u, 0u}; }
        }
    }
}
DI void ml1_unit(const Frame& F, int l, int h, int j, int eg) {
    const bf16_t* P = (const bf16_t*)(F.R0 + R_P); bf16_t* QC = (bf16_t*)(F.R0 + R_QC);
    const bf16_t* VT = (const bf16_t*)(F.R0 + R_VT);
    bf16_t* NUM = (bf16_t*)(F.R0 + R_NUM); bf16_t* SLOC = (bf16_t*)(F.R0 + R_SLOC);
    float* DENI = (float*)(F.R0 + R_DENI); float* EBC = (float*)(F.R0 + R_EBC); float* EBL = (float*)(F.R0 + R_EBL);
    float* SCB = (float*)(F.R0 + R_SCB); float* CHB = (float*)(F.R0 + R_CHB); float* DN = (float*)(F.R0 + R_DN);
    const int tid = F.tid, lane = F.lane, w = F.wave, rr = lane & 31, hh = lane >> 5;
    const int tl0 = j * 256;
    const size_t tg0 = (size_t)eg * TQ + tl0;
    LAS unsigned char* L = F.lds;
    LAS bf16_t* Sl = (LAS bf16_t*)L;
    LAS float* Lb = (LAS float*)(L + 9216);
    LAS float* Lg = Lb + 256;
    LAS float* Lws = Lg + 256;
    LAS float* Leb = Lws + 256;
    LAS float* Lden = Leb + 256;
    LAS float* Lbl = Lden + 256;
    typedef _Float16 h16x8 __attribute__((ext_vector_type(8)));
    LAS _Float16* Wc = (LAS _Float16*)(L + 14592);
    LAS bf16_t* Qs = (LAS bf16_t*)(L + 18688);
    LAS bf16_t* KTs = (LAS bf16_t*)(L + 52480);
    LAS bf16_t* RwQ = (LAS bf16_t*)(L + 89344);
    LAS bf16_t* RwK = (LAS bf16_t*)(L + 124720);
    ml1_stage_raw(P, RwQ, RwK, h, tl0, w, lane);
    for (int i = tid; i < 2048; i += 512) { const int which = i >> 10, jj = (i >> 8) & 3, ch = i & 255; Wc[i] = (_Float16)F.conv_w[((size_t)l * 4 + jj) * 2048 + which * 1024 + h * 256 + ch]; }
    if (w < 4) {
        const int c = w, t = c * 64 + lane;
        const float li = F.GIF[(tg0 + t) * 8 + h], lf = F.GIF[(tg0 + t) * 8 + 4 + h];
        float b = lf;
#pragma unroll
        for (int o = 1; o < 64; o <<= 1) { const float v = __shfl_up(b, o); if (lane >= o) b += v; }
        const float bl = __shfl(b, 63);
        Lb[t] = b; Lg[t] = li - b; Lws[t] = __expf(bl - b + li); Leb[t] = __expf(b); Lden[t] = 0.f;
        if (lane == 0) Lbl[c] = bl;
    }
    __syncthreads();
    if (tid < 256) {
        const int c = tid >> 6; float pre = 0.f;
        for (int cc = 0; cc < c; ++cc) pre += Lbl[cc];
        EBC[(size_t)(tl0 + tid) * 4 + h] = Leb[tid];
        EBL[(size_t)(tl0 + tid) * 4 + h] = __expf(Lb[tid] + pre);
        if (tid < 4) CHB[h * 128 + j * 4 + tid] = Lbl[tid];
        if (tid == 0) SCB[h * 32 + j] = Lbl[0] + Lbl[1] + Lbl[2] + Lbl[3];
    }
    f32x16 Ct[8];
#pragma unroll
    for (int i = 0; i < 8; ++i)
#pragma unroll
        for (int r = 0; r < 16; ++r) Ct[i][r] = 0.f;
    for (int c = 0; c < 4; ++c) {
        int rr_ = rr, hh_ = hh, tid_ = tid; asm volatile("" : "+v"(rr_), "+v"(hh_), "+v"(tid_));
        const bf16_t* vbase = VT + (size_t)(h * 256 + w * 32 + rr_) * VTP + tl0 + c * 64 + hh_ * 8;
        bf16x8 vf[4];
        const int t0c = tl0 + c * 64;
        { const int cg = tid_ & 31;
#pragma unroll
          for (int i = 0; i < 4; ++i) { const int tr = (tid_ >> 5) + 16 * i;
              float y[8];
#pragma unroll
              for (int k = 0; k < 8; ++k) y[k] = 0.f;
#pragma unroll
              for (int jj = 0; jj < 4; ++jj) { const u32x4 v = *(const LAS u32x4*)(RwQ + (tr + jj) * 264 + cg * 8);
                  const h16x8 wv = *(const LAS h16x8*)(Wc + jj * 256 + cg * 8);
                  y[0] += (float)wv[0] * bflo(v.x); y[1] += (float)wv[1] * bfhi(v.x); y[2] += (float)wv[2] * bflo(v.y); y[3] += (float)wv[3] * bfhi(v.y);
                  y[4] += (float)wv[4] * bflo(v.z); y[5] += (float)wv[5] * bfhi(v.z); y[6] += (float)wv[6] * bflo(v.w); y[7] += (float)wv[7] * bfhi(v.w); }
#pragma unroll
              for (int k = 0; k < 8; ++k) y[k] = siluf_(y[k]) * 0.0625f;
              u32x4 o; o.x = pack2(y[0], y[1]); o.y = pack2(y[2], y[3]); o.z = pack2(y[4], y[5]); o.w = pack2(y[6], y[7]);
              *(LAS u32x4*)(Qs + tr * 264 + cg * 8) = o;
              *(u32x4*)(QC + (size_t)(t0c + tr) * 1024 + h * 256 + cg * 8) = o;
              asm volatile("" ::: "memory"); } }
        { const int tr = tid_ & 63, wv_ = tid_ >> 6;
#pragma unroll
          for (int sub = 0; sub < 4; ++sub) { const int ch0 = wv_ * 32 + sub * 8;
              float y[8];
#pragma unroll
              for (int k = 0; k < 8; ++k) y[k] = 0.f;
#pragma unroll
              for (int jj = 0; jj < 4; ++jj) { const u32x4 v = *(const LAS u32x4*)(RwK + (tr + jj) * 264 + ch0);
                  const h16x8 wv = *(const LAS h16x8*)(Wc + 1024 + jj * 256 + ch0);
                  y[0] += (float)wv[0] * bflo(v.x); y[1] += (float)wv[1] * bfhi(v.x); y[2] += (float)wv[2] * bflo(v.y); y[3] += (float)wv[3] * bfhi(v.y);
                  y[4] += (float)wv[4] * bflo(v.z); y[5] += (float)wv[5] * bfhi(v.z); y[6] += (float)wv[6] * bflo(v.w); y[7] += (float)wv[7] * bfhi(v.w); }
#pragma unroll
              for (int k = 0; k < 8; k += 2) { const unsigned pk = pack2(siluf_(y[k]), siluf_(y[k + 1]));
                  KTs[(ch0 + k) * 72 + tr] = (bf16_t)(pk & 0xffff); KTs[(ch0 + k + 1) * 72 + tr] = (bf16_t)(pk >> 16); }
              asm volatile("" ::: "memory"); } }
        __syncthreads();
        if (c < 3) ml1_stage_raw(P, RwQ, RwK, h, t0c + 64, w, lane);
        if (w < 3) {
            const int ti = (w == 0) ? 0 : 1, si = (w == 2) ? 1 : 0;
            f32x16 acc;
#pragma unroll
            for (int r = 0; r < 16; ++r) acc[r] = 0.f;
            typedef short s16x4 __attribute__((ext_vector_type(4)));
            const int l16 = rr_ & 15;
            const LAS bf16_t* ktr = KTs + (hh_ * 8 + (l16 >> 2)) * 72 + si * 32 + 16 * (rr_ >> 4) + 4 * (l16 & 3);
            const LAS bf16_t* qrow = Qs + (ti * 32 + rr_) * 264 + hh_ * 8;
#pragma unroll 4
            for (int ks = 0; ks < 16; ++ks) {
                const s16x4 lo = __builtin_amdgcn_ds_read_tr16_b64_v4i16((LAS s16x4*)(ktr + (ks * 16) * 72));
                const s16x4 hi = __builtin_amdgcn_ds_read_tr16_b64_v4i16((LAS s16x4*)(ktr + (ks * 16 + 4) * 72));
                const bf16x8 kf = __builtin_shufflevector(lo, hi, 0, 1, 2, 3, 4, 5, 6, 7);
                acc = MFMA32(kf, *(const LAS bf16x8*)(qrow + ks * 16), acc);
            }
            const int tloc = c * 64 + ti * 32 + rr; const float bt = Lb[tloc];
            float rs = 0.f;
#pragma unroll
            for (int g = 0; g < 4; ++g) {
                float v[4];
#pragma unroll
                for (int q = 0; q < 4; ++q) { const int r = g * 4 + q, sl = si * 32 + crow(r, hh);
                    float wgt = __expf(bt + Lg[c * 64 + sl]);
                    if (sl > ti * 32 + rr) wgt = 0.f;
                    v[q] = acc[r] * wgt; rs += v[q]; }
                u32x2 o; o.x = pack2(v[0], v[1]); o.y = pack2(v[2], v[3]);
                *(LAS u32x2*)(Sl + (ti * 32 + rr) * 72 + si * 32 + 8 * g + 4 * hh) = o;
            }
            rs += __shfl_xor(rs, 32);
            if (hh == 0) atomicAdd((float*)(F.ldsg + 9216 + 4 * 1024) + tloc, rs);
        } else if (w >= 4) {
            const int d = tid_ - 256;
            const LAS bf16_t* kt = KTs + d * 72; const LAS float* ws = Lws + c * 64;
            float s = 0.f;
#pragma unroll
            for (int o = 0; o < 8; ++o) { const u32x4 v = *(const LAS u32x4*)(kt + o * 8);
                s += bflo(v.x) * ws[o * 8] + bfhi(v.x) * ws[o * 8 + 1] + bflo(v.y) * ws[o * 8 + 2] + bfhi(v.y) * ws[o * 8 + 3] + bflo(v.z) * ws[o * 8 + 4] + bfhi(v.z) * ws[o * 8 + 5] + bflo(v.w) * ws[o * 8 + 6] + bfhi(v.w) * ws[o * 8 + 7]; }
            DN[((size_t)h * 128 + j * 4 + c) * 256 + d] = s;
        }
        lds_barrier();
        if (tid_ < 64) DENI[(size_t)(tl0 + c * 64 + tid_) * 4 + h] = Lden[c * 64 + tid_];
#pragma unroll
        for (int ks = 0; ks < 4; ++ks) vf[ks] = ldg8(vbase + ks * 16);
        f32x16 a0, a1;
#pragma unroll
        for (int r = 0; r < 16; ++r) { a0[r] = 0.f; a1[r] = 0.f; }
        const LAS bf16_t* q0 = Qs + rr_ * 264 + hh_ * 8; const LAS bf16_t* q1 = q0 + 32 * 264;
#pragma unroll
        for (int db = 0; db < 8; ++db)
#pragma unroll
            for (int s2 = 0; s2 < 2; ++s2) {
                const bf16x8 cf = packf8(Ct[db][8 * s2], Ct[db][8 * s2 + 1], Ct[db][8 * s2 + 2], Ct[db][8 * s2 + 3], Ct[db][8 * s2 + 4], Ct[db][8 * s2 + 5], Ct[db][8 * s2 + 6], Ct[db][8 * s2 + 7]);
                a0 = MFMA32(*(const LAS bf16x8*)(q0 + db * 32 + s2 * 16), cf, a0);
                a1 = MFMA32(*(const LAS bf16x8*)(q1 + db * 32 + s2 * 16), cf, a1);
                if (s2 == 1 && (db & 1)) asm volatile("" ::: "memory");
            }
#pragma unroll
        for (int r = 0; r < 16; ++r) { a0[r] *= Leb[c * 64 + crow(r, hh)]; a1[r] *= Leb[c * 64 + 32 + crow(r, hh)]; }
#pragma unroll
        for (int ks = 0; ks < 4; ++ks) {
            if (ks < 2) a0 = MFMA32(*(const LAS bf16x8*)(Sl + rr * 72 + ks * 16 + hh * 8), vf[ks], a0);
            a1 = MFMA32(*(const LAS bf16x8*)(Sl + (32 + rr) * 72 + ks * 16 + hh * 8), vf[ks], a1);
        }
        { bf16_t* np = NUM + (size_t)(tl0 + c * 64) * 1024 + h * 256 + w * 32 + rr_;
#pragma unroll
          for (int r = 0; r < 16; r += 2) { const unsigned p0 = pack2(a0[r], a0[r + 1]), p1 = pack2(a1[r], a1[r + 1]);
              np[(size_t)crow(r, hh) * 1024] = (bf16_t)(p0 & 0xffff); np[(size_t)crow(r + 1, hh) * 1024] = (bf16_t)(p0 >> 16);
              np[(size_t)(32 + crow(r, hh)) * 1024] = (bf16_t)(p1 & 0xffff); np[(size_t)(32 + crow(r + 1, hh)) * 1024] = (bf16_t)(p1 >> 16); } }
        const float dec = __expf(Lbl[c]);
#pragma unroll
        for (int ks = 0; ks < 4; ++ks) {
            const u32x4 v = __builtin_bit_cast(u32x4, vf[ks]); const LAS float* ws = Lws + c * 64 + ks * 16 + hh * 8;
            vf[ks] = packf8(bflo(v.x) * ws[0], bfhi(v.x) * ws[1], bflo(v.y) * ws[2], bfhi(v.y) * ws[3], bflo(v.z) * ws[4], bfhi(v.z) * ws[5], bflo(v.w) * ws[6], bfhi(v.w) * ws[7]);
        }
        const LAS bf16_t* ktb = KTs + pi23(rr_) * 72 + hh_ * 8;
#pragma unroll
        for (int db = 0; db < 8; ++db) {
#pragma unroll
            for (int r = 0; r < 16; ++r) Ct[db][r] *= dec;
#pragma unroll
            for (int ks = 0; ks < 4; ++ks) Ct[db] = MFMA32(*(const LAS bf16x8*)(ktb + db * 32 * 72 + ks * 16), vf[ks], Ct[db]);
            if (db & 1) asm volatile("" ::: "memory");
        }
        __syncthreads();
    }
    { int rr2 = rr, hh2 = hh; asm volatile("" : "+v"(rr2), "+v"(hh2));
      bf16_t* sp = SLOC + (((size_t)h * 32 + j) * 256 + w * 32 + rr2) * 256 + hh2 * 8;
#pragma unroll
      for (int db = 0; db < 8; ++db)
#pragma unroll
          for (int a = 0; a < 2; ++a) {
              u32x4 o; o.x = pack2(Ct[db][8 * a], Ct[db][8 * a + 1]); o.y = pack2(Ct[db][8 * a + 2], Ct[db][8 * a + 3]); o.z = pack2(Ct[db][8 * a + 4], Ct[db][8 * a + 5]); o.w = pack2(Ct[db][8 * a + 6], Ct[db][8 * a + 7]);
              *(u32x4*)(sp + db * 32 + a * 16) = o; } }
    __syncthreads();
}

DI void at_block_unit(const Frame& F, int bu_in) {
    int bu = bu_in; asm volatile("" : "+s"(bu));
    bf16_t* P = (bf16_t*)(F.R0 + R_P); const bf16_t* VT = (const bf16_t*)(F.R0 + R_VT); float* LSE = (float*)(F.R0 + R_LSE);
    int lane = F.lane, tid = F.tid; asm volatile("" : "+v"(lane), "+v"(tid));
    const int rr = lane & 31, hh = lane >> 5, w = F.wave;
    const int hd = bu >> 5, qb = bu & 31, g = hd >> 2;
    const int dsh = 2 * g, d = 1 << dsh, lsub = TQ >> dsh, bpr = lsub >> 8;
    const int r = qb / bpr, l0b = (qb % bpr) * 256, l0 = l0b + 32 * w;
    const float slope_d = exp2f(-8.0f * (float)(hd + 1) / 12.0f) * (float)d;
    LAS bf16_t* Ks = (LAS bf16_t*)F.lds;
    LAS bf16_t* Vs = (LAS bf16_t*)F.lds;
    {
        u32x4 st[12];
#pragma unroll
        for (int i = 0; i < 12; ++i) { const int p = tid + 512 * i, row = p >> 4, pc = p & 15; int l = l0b - 128 + row; l = l < 0 ? 0 : l;
            st[i] = *(const u32x4*)(P + (size_t)(l * d + r) * PP + 4608 + hd * 128 + pc * 8); }
#pragma unroll
        for (int i = 0; i < 12; ++i) { const int p = tid + 512 * i, row = p >> 4, pc = p & 15; *(LAS u32x4*)(Ks + row * 136 + pc * 8) = st[i]; }
    }
    bf16x8 qf[8];
    { const bf16_t* qp = P + (size_t)((l0 + rr) * d + r) * PP + 3072 + hd * 128 + hh * 64;
#pragma unroll
      for (int ks = 0; ks < 8; ++ks) qf[ks] = ldg8(qp + ks * 8); }
    __syncthreads();
    u32x4 vst[12];
#pragma unroll
    for (int i = 0; i < 12; ++i) { const int p = tid + 512 * i, ch = p / 48, pc = p % 48; int l = l0b - 128 + pc * 8; l = l < 0 ? 0 : l;
        vst[i] = *(const u32x4*)(VT + (size_t)(1024 + hd * 128 + ch) * VTP + r * lsub + l); }
    f32x16 sc[5];
    float mx = -1e30f;
    const int prr = pi23(rr);
#pragma unroll
    for (int kt = 0; kt < 5; ++kt) {
#pragma unroll
        for (int i = 0; i < 16; ++i) sc[kt][i] = 0.f;
        const LAS bf16_t* kp = Ks + (32 * (w + kt) + prr) * 136 + hh * 64;
#pragma unroll
        for (int ks = 0; ks < 8; ++ks) sc[kt] = MFMA32(*(const LAS bf16x8*)(kp + ks * 8), qf[ks], sc[kt]);
        const bool tile_ok = (l0 - 128 + 32 * kt) >= 0;
#pragma unroll
        for (int i = 0; i < 16; ++i) {
            const int kk = (i & 3) + 4 * ((i >> 2) & 1) + 8 * hh + 16 * (i >> 3);
            const int dist = 128 - 32 * kt + rr - kk;
            float s = sc[kt][i] - slope_d * (float)dist;
            s = (tile_ok && dist >= 0 && dist <= 128) ? s : -1e30f;
            sc[kt][i] = s; mx = fmaxf(mx, s);
        }
        asm volatile("" ::: "memory");
    }
    mx = fmaxf(mx, __shfl_xor(mx, 32));
    float sum = 0.f;
    bf16x8 pf[5][2];
#pragma unroll
    for (int kt = 0; kt < 5; ++kt) {
        float p[16];
#pragma unroll
        for (int i = 0; i < 16; ++i) { p[i] = __expf(sc[kt][i] - mx); sum += p[i]; }
        pf[kt][0] = packf8(p[0], p[1], p[2], p[3], p[4], p[5], p[6], p[7]);
        pf[kt][1] = packf8(p[8], p[9], p[10], p[11], p[12], p[13], p[14], p[15]);
    }
    sum += __shfl_xor(sum, 32);
    const float inv = 1.0f / sum;
    __syncthreads();
#pragma unroll
    for (int i = 0; i < 12; ++i) { const int p = tid + 512 * i, ch = p / 48, pc = p % 48; *(LAS u32x4*)(Vs + ch * 392 + pc * 8) = vst[i]; }
    __syncthreads();
#pragma unroll
    for (int ct = 0; ct < 4; ++ct) {
        f32x16 o;
#pragma unroll
        for (int i = 0; i < 16; ++i) o[i] = 0.f;
        const LAS bf16_t* vp = Vs + (ct * 32 + rr) * 392 + 32 * w + hh * 8;
#pragma unroll
        for (int kt = 0; kt < 5; ++kt) { o = MFMA32(*(const LAS bf16x8*)(vp + 32 * kt), pf[kt][0], o); o = MFMA32(*(const LAS bf16x8*)(vp + 32 * kt + 16), pf[kt][1], o); }
#pragma unroll
        for (int g4 = 0; g4 < 4; ++g4) { u32x2 wv; wv.x = pack2(o[4 * g4] * inv, o[4 * g4 + 1] * inv); wv.y = pack2(o[4 * g4 + 2] * inv, o[4 * g4 + 3] * inv);
            *(u32x2*)(P + (size_t)((l0 + rr) * d + r) * PP + 3072 + hd * 128 + ct * 32 + 8 * g4 + 4 * hh) = wv; }
        asm volatile("" ::: "memory");
    }
    if (hh == 0) LSE[(size_t)((l0 + rr) * d + r) * 12 + hd] = mx + __logf(sum);
    __syncthreads();
}

DI void phase_p2(const Frame& F, int me, int nb) {
    bf16_t* SL = (bf16_t*)(F.R0 + R_SLOC);
    const float* SCB = (const float*)(F.R0 + R_SCB); const float* CHB = (const float*)(F.R0 + R_CHB);
    const float* DN = (const float*)(F.R0 + R_DN); float* NST = (float*)(F.R0 + R_NST);
    if (nb <= 0) return;
    for (int gt = me * 512 + F.tid; gt < 131072; gt += nb * 512) {
        const int h = gt >> 15, e2 = (gt & 32767) * 2;
        f32x2 run = (f32x2){0.f, 0.f};
#pragma unroll 1
        for (int j0 = 0; j0 < 32; j0 += 8) {
            unsigned s[8]; float dec[8];
#pragma unroll
            for (int jj = 0; jj < 8; ++jj) { s[jj] = *(const unsigned*)(SL + ((size_t)h * 32 + j0 + jj) * 65536 + e2); dec[jj] = SCB[h * 32 + j0 + jj]; }
#pragma unroll
            for (int jj = 0; jj < 8; ++jj) { *(unsigned*)(SL + ((size_t)h * 32 + j0 + jj) * 65536 + e2) = pack2(run[0], run[1]); run = run * __expf(dec[jj]) + (f32x2){bflo(s[jj]), bfhi(s[jj])}; }
        }
    }
    const int nblk = nb - 1 - me;
    if (nblk < 16) {
        float* xl = (float*)F.ldsg;
        const int seg = F.wave, pp = F.lane, pair = nblk * 64 + pp, h = pair >> 8, dd = pair & 255;
        float dn[16], a[16], pre[16], ap[16];
#pragma unroll
        for (int cc = 0; cc < 16; ++cc) { dn[cc] = DN[((size_t)h * 128 + seg * 16 + cc) * 256 + dd]; a[cc] = __expf(CHB[h * 128 + seg * 16 + cc]); }
        float run = 0.f, prod = 1.f;
#pragma unroll
        for (int cc = 0; cc < 16; ++cc) { pre[cc] = run; ap[cc] = prod; run = run * a[cc] + dn[cc]; prod *= a[cc]; }
        xl[seg * 64 + pp] = run; xl[512 + seg * 64 + pp] = prod;
        __syncthreads();
        float inc = 0.f;
        for (int s = 0; s < seg; ++s) inc = inc * xl[512 + s * 64 + pp] + xl[s * 64 + pp];
#pragma unroll
        for (int cc = 0; cc < 16; ++cc) NST[((size_t)h * 128 + seg * 16 + cc) * 256 + dd] = inc * ap[cc] + pre[cc];
        __syncthreads();
    }
}

DI void f_hm_block(const Frame& F, int l, int h, int j, int half, int eg) {
    const bf16_t* QC = (const bf16_t*)(F.R0 + R_QC); const bf16_t* CST = (const bf16_t*)(F.R0 + R_CST); const float* NST = (const float*)(F.R0 + R_NST);
    const bf16_t* NUM = (const bf16_t*)(F.R0 + R_NUM); const bf16_t* P = (const bf16_t*)(F.R0 + R_P);
    const float* DENI = (const float*)(F.R0 + R_DENI); const float* EBC = (const float*)(F.R0 + R_EBC); const float* EBL = (const float*)(F.R0 + R_EBL);
    int lane = F.lane, tid = F.tid; asm volatile("" : "+v"(lane), "+v"(tid));
    const int tr = lane & 15, kg = lane >> 4, w = F.wave;
    const int tl0 = j * 256 + half * 128 + w * 16, c = tl0 >> 6, tl = tl0 + tr;
    LAS unsigned char* Cs = F.lds;
    { const bf16_t* src = CST + ((size_t)h * 32 + j) * 65536;
#pragma unroll
      for (int hf = 0; hf < 2; ++hf) {
          u32x4 st[8];
#pragma unroll
          for (int i = 0; i < 8; ++i) { const int p = tid + 512 * (hf * 8 + i); st[i] = *(const u32x4*)(src + (size_t)p * 8); }
#pragma unroll
          for (int i = 0; i < 8; ++i) { const int p = tid + 512 * (hf * 8 + i), row = p >> 5, pc = p & 31; *(LAS u32x4*)(Cs + row * 512 + ((pc ^ (row & 15)) << 4)) = st[i]; }
      } }
    const bf16_t* qp = QC + (size_t)tl * 1024 + h * 256 + kg * 8;
    const float* np = NST + ((size_t)h * 128 + c) * 256 + kg * 8;
    const float ebl = EBL[(size_t)tl * 4 + h], ebc = EBC[(size_t)tl * 4 + h], deni = DENI[(size_t)tl * 4 + h];
    bf16x8 qf[8];
#pragma unroll
    for (int ks = 0; ks < 8; ++ks) qf[ks] = ldg8(qp + ks * 32);
    float dotn = 0.f;
#pragma unroll
    for (int ks = 0; ks < 8; ++ks) {
        const f32x4 n0 = *(const f32x4*)(np + ks * 32), n1 = *(const f32x4*)(np + ks * 32 + 4);
        const u32x4 qv = __builtin_bit_cast(u32x4, qf[ks]);
        dotn += bflo(qv.x) * n0[0] + bfhi(qv.x) * n0[1] + bflo(qv.y) * n0[2] + bfhi(qv.y) * n0[3] + bflo(qv.z) * n1[0] + bfhi(qv.z) * n1[1] + bflo(qv.w) * n1[2] + bfhi(qv.w) * n1[3];
    }
    __syncthreads();
    f32x4 acc[16];
#pragma unroll
    for (int et = 0; et < 16; ++et) {
        acc[et] = (f32x4){0.f, 0.f, 0.f, 0.f};
        const LAS unsigned char* rowp = Cs + (et * 16 + tr) * 512;
#pragma unroll
        for (int ks = 0; ks < 8; ++ks) acc[et] = __builtin_amdgcn_mfma_f32_16x16x32_bf16(*(const LAS bf16x8*)(rowp + (((4 * ks + kg) ^ tr) << 4)), qf[ks], acc[et], 0, 0, 0);
        if ((et & 3) == 3) asm volatile("" ::: "memory");
    }
    dotn += __shfl_xor(dotn, 16); dotn += __shfl_xor(dotn, 32);
    const float den = deni + ebc * dotn;
    const float invd = 1.0f / fmaxf(fabsf(den), 1.0f);
    float ssq = 0.f;
    { u32x2 nl[16];
#pragma unroll
      for (int et = 0; et < 16; ++et) nl[et] = *(const u32x2*)(NUM + (size_t)tl * 1024 + h * 256 + et * 16 + 4 * kg);
#pragma unroll
      for (int et = 0; et < 16; ++et) { const float n4[4] = {bflo(nl[et].x), bfhi(nl[et].x), bflo(nl[et].y), bfhi(nl[et].y)};
#pragma unroll
          for (int q = 0; q < 4; ++q) { const float v = (n4[q] + ebl * acc[et][q]) * invd; acc[et][q] = v; ssq += v * v; } } }
    ssq += __shfl_xor(ssq, 16); ssq += __shfl_xor(ssq, 32);
    const float rn = __builtin_amdgcn_rsqf(ssq * (1.0f / 256.0f) + EPS);
    const size_t tp = (size_t)eg * TQ + tl;
    asm volatile("" ::: "memory");
#pragma unroll
    for (int e8 = 0; e8 < 2; ++e8) {
        u32x2 og[8]; f32x4 ng[8];
#pragma unroll
        for (int i = 0; i < 8; ++i) { const int e = (e8 * 8 + i) * 16 + 4 * kg; og[i] = *(const u32x2*)(P + (size_t)tl * PP + 2048 + h * 256 + e); ng[i] = *(const f32x4*)(F.norm_g + (size_t)l * 1024 + h * 256 + e); }
#pragma unroll
        for (int i = 0; i < 8; ++i) { const int et = e8 * 8 + i, e = et * 16 + 4 * kg;
            u32x2 wv; wv.x = pack2(bflo(og[i].x) * acc[et][0] * rn * ng[i][0], bfhi(og[i].x) * acc[et][1] * rn * ng[i][1]);
            wv.y = pack2(bflo(og[i].y) * acc[et][2] * rn * ng[i][2], bfhi(og[i].y) * acc[et][3] * rn * ng[i][3]);
            *(u32x2*)(F.HM + tp * 1024 + h * 256 + e) = wv; }
        asm volatile("" ::: "memory");
    }
    __syncthreads();
}
DI void f_ha_token(const Frame& F, int tl, int eg) {
    const bf16_t* P = (const bf16_t*)(F.R0 + R_P); const float* LSE = (const float*)(F.R0 + R_LSE);
    int lane = F.lane; asm volatile("" : "+v"(lane));
    const int hs = lane >> 4, ch0 = (lane & 15) * 8;
    const float l0 = LSE[(size_t)tl * 12 + hs], l1 = LSE[(size_t)tl * 12 + 4 + hs], l2 = LSE[(size_t)tl * 12 + 8 + hs];
    const float m = fmaxf(l0, fmaxf(l1, l2));
    float a0 = __expf(l0 - m), a1 = __expf(l1 - m), a2 = __expf(l2 - m); const float inv = 1.0f / (a0 + a1 + a2); a0 *= inv; a1 *= inv; a2 *= inv;
    const bf16_t* pr = P + (size_t)tl * PP + 3072 + hs * 128 + ch0;
    const u32x4 v0 = *(const u32x4*)(pr), v1 = *(const u32x4*)(pr + 512), v2 = *(const u32x4*)(pr + 1024);
    u32x4 o;
    o.x = pack2(a0 * bflo(v0.x) + a1 * bflo(v1.x) + a2 * bflo(v2.x), a0 * bfhi(v0.x) + a1 * bfhi(v1.x) + a2 * bfhi(v2.x));
    o.y = pack2(a0 * bflo(v0.y) + a1 * bflo(v1.y) + a2 * bflo(v2.y), a0 * bfhi(v0.y) + a1 * bfhi(v1.y) + a2 * bfhi(v2.y));
    o.z = pack2(a0 * bflo(v0.z) + a1 * bflo(v1.z) + a2 * bflo(v2.z), a0 * bfhi(v0.z) + a1 * bfhi(v1.z) + a2 * bfhi(v2.z));
    o.w = pack2(a0 * bflo(v0.w) + a1 * bflo(v1.w) + a2 * bflo(v2.w), a0 * bfhi(v0.w) + a1 * bfhi(v1.w) + a2 * bfhi(v2.w));
    *(u32x4*)(F.HA + ((size_t)eg * TQ + tl) * 512 + hs * 128 + ch0) = o;
}
using pg8::UnitD;
DI u32x4 pack8h(const f32x4& v0, const f32x4& v1) { u32x4 w; w.x = pack2h(v0[0], v0[1]); w.y = pack2h(v0[2], v0[3]); w.z = pack2h(v1[0], v1[1]); w.w = pack2h(v1[2], v1[3]); return w; }
DI u32x4 pack8(const f32x4& v0, const f32x4& v1) { u32x4 w; w.x = pack2(v0[0], v0[1]); w.y = pack2(v0[2], v0[3]); w.z = pack2(v1[0], v1[1]); w.w = pack2(v1[2], v1[3]); return w; }

struct SchedG1 {
    const char* U; const char* Wnat; const char* Wvt; int G, c;
    DI bool next(int i, UnitD& u) const {
        const int L = i * G + c; if (L >= 704 + 320) return false;
        u.arows = nullptr; u.acount = 0; u.aux = 0; u.K = 1024;
        if (L < 704) { int pm, pc; pg8::tile_map(L, 32, 22, pm, pc); const int pn = pc < 10 ? pc : pc + 2; u.kind = 0; u.pm = pm; u.pn = pn;
            u.A = U + (size_t)pm * 256 * 2048; u.lda = 2048; u.B = Wnat + (size_t)pn * 256 * 2048; u.ldb = 2048; }
        else { const int idx = L - 704, pm = idx % 10, pn = idx / 10; u.kind = 1; u.pm = pm; u.pn = pn;
            u.A = Wvt + (size_t)pm * 256 * 2048; u.lda = 2048;
            int tokbase = pn * 256, dmul = 1;
            if (pm >= 4) { const int g = (pm - 4) >> 1, dsh = 2 * g, lsub = TQ >> dsh, n0 = pn * 256; dmul = 1 << dsh; tokbase = (n0 % lsub) * dmul + n0 / lsub; }
            u.B = U + (size_t)tokbase * 2048; u.ldb = 2048u * (unsigned)dmul; }
        return true;
    }
};
struct SchedG1Def {
    const char* U; const char* Wnat; int c;
    DI bool next(int i, UnitD& u) const {
        if (i > 0 || c >= 64) return false;
        const int pm = c >> 1, pn = 10 + (c & 1);
        u.arows = nullptr; u.acount = 0; u.aux = 0; u.K = 1024; u.kind = 0; u.pm = pm; u.pn = pn;
        u.A = U + (size_t)pm * 256 * 2048; u.lda = 2048; u.B = Wnat + (size_t)pn * 256 * 2048; u.ldb = 2048;
        return true;
    }
};
struct EpiG1 {
    static constexpr bool PERM = true;
    bf16_t* P; bf16_t* VT;
    DI void operator()(const f32x4 (&acc)[2][2][4][2], const UnitD& u, int wr, int wc, int fr, int fq) const {
        bf16_t* base; size_t ld; int mode = 0;
        if (u.kind == 0) { base = P + (size_t)u.pm * 256 * PP + u.pn * 256; ld = PP; mode = (u.pn >= 8 && u.pn < 12) ? 1 : ((u.pn >= 12 && u.pn < 18) ? 2 : 0); }
        else { base = VT + (size_t)u.pm * 256 * VTP + u.pn * 256; ld = VTP; }
        const int row0 = wr * 64 + fr, col0 = wc * 32 + 8 * fq;
#pragma unroll
        for (int ai = 0; ai < 2; ++ai)
#pragma unroll
            for (int m = 0; m < 4; ++m) { bf16_t* rowp = base + (size_t)(row0 + ai * 128 + m * 16) * ld + col0;
#pragma unroll
                for (int bj = 0; bj < 2; ++bj) { f32x4 v0 = acc[ai][bj][m][0], v1 = acc[ai][bj][m][1];
                    if (mode == 1) {
#pragma unroll
                        for (int q = 0; q < 4; ++q) { v0[q] = sigmoidf_(v0[q]); v1[q] = sigmoidf_(v1[q]); } }
                    else if (mode == 2) { v0 *= 0.08838834764831845f; v1 *= 0.08838834764831845f; }
                    *(u32x4*)(rowp + bj * 128) = pack8(v0, v1); }
                asm volatile("" ::: "memory"); }
    }
};
struct SchedDense {
    const char* A; const char* B; unsigned lda, ldb; int nM, nN, G, c, K;
    DI bool next(int i, UnitD& u) const {
        const int L = i * G + c; if (L >= nM * nN) return false;
        int pm, pn; pg8::tile_map(L, nM, nN, pm, pn); u.kind = 0; u.K = K; u.pm = pm; u.pn = pn; u.aux = 0; u.arows = nullptr; u.acount = 0;
        u.A = A + (size_t)pm * 256 * lda; u.lda = lda; u.B = B + (size_t)pn * 256 * ldb; u.ldb = ldb; return true;
    }
};
struct EpiG3 {
    static constexpr bool PERM = true;
    const float* xin; bf16_t* xb; const float* gta;
    int f32in;
    DI void operator()(const f32x4 (&acc)[2][2][4][2], const UnitD& u, int wr, int wc, int fr, int fq) const {
        const int row0 = u.pm * 256 + wr * 64 + fr, col0 = u.pn * 256 + wc * 32 + 8 * fq;
        const float* g = gta + (size_t)(u.pm >> 5) * 6144 + col0;
        f32x4 gv[2][2];
#pragma unroll
        for (int bj = 0; bj < 2; ++bj)
#pragma unroll
            for (int n = 0; n < 2; ++n) gv[bj][n] = *(const f32x4*)(g + bj * 128 + n * 4);
        if (f32in) {
            f32x4 xr[4][4];
#pragma unroll
            for (int g0 = 0; g0 < 3; ++g0) { const size_t o0 = (size_t)(row0 + (g0 >> 2) * 128 + (g0 & 3) * 16) * 1024 + col0;
#pragma unroll
                for (int q = 0; q < 4; ++q) xr[g0][q] = *(const f32x4*)(xin + o0 + (q >> 1) * 128 + (q & 1) * 4); }
#pragma unroll
            for (int gi = 0; gi < 8; ++gi) { const int ai = gi >> 2, m = gi & 3; const size_t o = (size_t)(row0 + ai * 128 + m * 16) * XBP + col0;
                if (gi + 3 < 8) { const int ai2 = (gi + 3) >> 2, m2 = (gi + 3) & 3; const size_t o2 = (size_t)(row0 + ai2 * 128 + m2 * 16) * 1024 + col0;
#pragma unroll
                    for (int q = 0; q < 4; ++q) xr[(gi + 3) & 3][q] = *(const f32x4*)(xin + o2 + (q >> 1) * 128 + (q & 1) * 4); }
                asm volatile("" ::: "memory");
#pragma unroll
                for (int bj = 0; bj < 2; ++bj) *(u32x4*)(xb + o + bj * 128) = pack8h(xr[gi & 3][bj * 2] + gv[bj][0] * acc[ai][bj][m][0], xr[gi & 3][bj * 2 + 1] + gv[bj][1] * acc[ai][bj][m][1]); }
        } else {
            u32x4 xr[4][2];
#pragma unroll
            for (int g0 = 0; g0 < 3; ++g0) { const size_t o0 = (size_t)(row0 + (g0 >> 2) * 128 + (g0 & 3) * 16) * XBP + col0; xr[g0][0] = *(const u32x4*)(xb + o0); xr[g0][1] = *(const u32x4*)(xb + o0 + 128); }
#pragma unroll
            for (int gi = 0; gi < 8; ++gi) { const int ai = gi >> 2, m = gi & 3; const size_t o = (size_t)(row0 + ai * 128 + m * 16) * XBP + col0;
                if (gi + 3 < 8) { const int ai2 = (gi + 3) >> 2, m2 = (gi + 3) & 3; const size_t o2 = (size_t)(row0 + ai2 * 128 + m2 * 16) * XBP + col0;
                    xr[(gi + 3) & 3][0] = *(const u32x4*)(xb + o2); xr[(gi + 3) & 3][1] = *(const u32x4*)(xb + o2 + 128); }
                asm volatile("" ::: "memory");
#pragma unroll
                for (int bj = 0; bj < 2; ++bj) { const u32x4 y = xr[gi & 3][bj];
                    const f32x4 v0 = (f32x4){hlo(y.x), hhi(y.x), hlo(y.y), hhi(y.y)} + gv[bj][0] * acc[ai][bj][m][0], v1 = (f32x4){hlo(y.z), hhi(y.z), hlo(y.w), hhi(y.w)} + gv[bj][1] * acc[ai][bj][m][1];
                    *(u32x4*)(xb + o + bj * 128) = pack8h(v0, v1); } }
        }
    }
};
struct SchedMoe {
    const int* pre;
    const unsigned* cnt;
    const char* A; const char* W; const int* SLOT; int G, c; bool gate_up;
    DI bool next(int i, UnitD& u) const {
        const int L = i * G + c, nt = pre[16]; if (L >= nt * 4) return false;
        const int rt = L >> 2, ct = L & 3; int e = 0;
#pragma unroll
        for (int q = 1; q < 16; ++q) e += (rt >= pre[q]) ? 1 : 0;
        u.kind = 0; u.pm = rt; u.pn = ct; u.aux = e; u.K = gate_up ? 1024 : 512;
        const int ti = rt - pre[e];
        if (gate_up) { u.A = A; u.lda = 2048; u.arows = SLOT + (size_t)e * 32768 + ti * 256; u.acount = (int)cnt[e] - ti * 256;
            u.B = W + ((size_t)e * 1024 + ct * 256) * 2048; u.ldb = 2048; }
        else { u.A = A + (size_t)rt * 256 * (HHP * 2); u.lda = HHP * 2; u.arows = nullptr; u.acount = 0;
            u.B = W + ((size_t)e * 1024 + ct * 256) * 1024; u.ldb = 1024; }
        return true;
    }
};
struct EpiG4 {
    static constexpr bool PERM = true;
    bf16_t* HH;
    DI void operator()(const f32x4 (&acc)[2][2][4][2], const UnitD& u, int wr, int wc, int fr, int fq) const {
        bf16_t* base = HH + (size_t)u.pm * 256 * HHP + u.pn * 128; const int row0 = wr * 64 + fr, col0 = wc * 16 + 4 * fq;
#pragma unroll
        for (int ai = 0; ai < 2; ++ai)
#pragma unroll
            for (int m = 0; m < 4; ++m) { bf16_t* rowp = base + (size_t)(row0 + ai * 128 + m * 16) * HHP + col0;
#pragma unroll
                for (int bj = 0; bj < 2; ++bj) { const f32x4 v0 = acc[ai][bj][m][0], v1 = acc[ai][bj][m][1];
                    u32x2 w; w.x = pack2(siluf_(v0[0]) * v0[1], siluf_(v0[2]) * v0[3]); w.y = pack2(siluf_(v1[0]) * v1[1], siluf_(v1[2]) * v1[3]);
                    *(u32x2*)(rowp + bj * 64) = w; }
                asm volatile("" ::: "memory"); }
    }
};
struct EpiG5 {
    static constexpr bool PERM = true;
    bf16_t* YS;
    DI void operator()(const f32x4 (&acc)[2][2][4][2], const UnitD& u, int wr, int wc, int fr, int fq) const {
        bf16_t* base = YS + (size_t)u.pm * 256 * YSP + u.pn * 256; const int row0 = wr * 64 + fr, col0 = wc * 32 + 8 * fq;
#pragma unroll
        for (int ai = 0; ai < 2; ++ai)
#pragma unroll
            for (int m = 0; m < 4; ++m) { bf16_t* rowp = base + (size_t)(row0 + ai * 128 + m * 16) * YSP + col0;
#pragma unroll
                for (int bj = 0; bj < 2; ++bj) *(u32x4*)(rowp + bj * 128) = pack8(acc[ai][bj][m][0], acc[ai][bj][m][1]);
                asm volatile("" ::: "memory"); }
    }
};

struct SchedChain {
    const char* U; const char* HA; const char* HM; const char* Wg; const char* Wa; const char* Wm; int G, c;
    DI bool next(int i, UnitD& u) const {
        const int per = (512 + G - 1) / G;
        const int ti = i >> 2, st = i & 3; if (ti >= per) return false;
        const int L = ti * G + c; if (L >= 512) return false;
        int pm, pn; pg8::tile_map(L, 128, 4, pm, pn); u.pm = pm; u.pn = pn; u.kind = st; u.aux = 0; u.arows = nullptr; u.acount = 0;
        if (st == 0) { u.A = U + (size_t)pm * 256 * 2048; u.lda = 2048; u.B = Wg + (size_t)pn * 256 * 2048; u.ldb = 2048; u.K = 1024; }
        else if (st == 1) { u.A = U + (size_t)pm * 256 * 2048; u.lda = 2048; u.B = Wg + (size_t)(4 + pn) * 256 * 2048; u.ldb = 2048; u.K = 1024; }
        else if (st == 2) { u.A = HA + (size_t)pm * 256 * 1024; u.lda = 1024; u.B = Wa + (size_t)pn * 256 * 1024; u.ldb = 1024; u.K = 512; }
        else { u.A = HM + (size_t)pm * 256 * 2048; u.lda = 2048; u.B = Wm + (size_t)pn * 256 * 2048; u.ldb = 2048; u.K = 1024; }
        return true;
    }
};
struct EpiChain {
    static constexpr bool PERM = true;
    bf16_t* GT;
    DI void operator()(const f32x4 (&acc)[2][2][4][2], const UnitD& u, int wr, int wc, int fr, int fq) const {
        const int st = u.kind;
        bf16_t* base = GT + (size_t)u.pm * 256 * GTP + u.pn * 256 + ((st == 1 || st == 2) ? 1024 : 0); const int row0 = wr * 64 + fr, col0 = wc * 32 + 8 * fq;
        if (st < 2) {
#pragma unroll
            for (int ai = 0; ai < 2; ++ai)
#pragma unroll
                for (int m = 0; m < 4; ++m) { bf16_t* rowp = base + (size_t)(row0 + ai * 128 + m * 16) * GTP + col0;
#pragma unroll
                    for (int bj = 0; bj < 2; ++bj) { const f32x4 v0 = sigmoid4(acc[ai][bj][m][0]), v1 = sigmoid4(acc[ai][bj][m][1]);
                        *(u32x4*)(rowp + bj * 128) = pack8(v0, v1); }
                    asm volatile("" ::: "memory"); }
        } else {
            u32x4 gb[4][4];
#pragma unroll
            for (int g0 = 0; g0 < 3; ++g0) { bf16_t* rp0 = base + (size_t)(row0 + (g0 >> 2) * 128 + (g0 & 3) * 16) * GTP + col0;
                gb[g0][0] = *(const u32x4*)(rp0); gb[g0][1] = *(const u32x4*)(rp0 + 128);
                if (st == 3) { gb[g0][2] = *(const u32x4*)(rp0 + 1024); gb[g0][3] = *(const u32x4*)(rp0 + 128 + 1024); } }
#pragma unroll
            for (int gi = 0; gi < 8; ++gi) { const int ai = gi >> 2, m = gi & 3; bf16_t* rowp = base + (size_t)(row0 + ai * 128 + m * 16) * GTP + col0;
                if (gi + 3 < 8) { const int ai2 = (gi + 3) >> 2, m2 = (gi + 3) & 3; bf16_t* rp2 = base + (size_t)(row0 + ai2 * 128 + m2 * 16) * GTP + col0;
                    gb[(gi + 3) & 3][0] = *(const u32x4*)(rp2); gb[(gi + 3) & 3][1] = *(const u32x4*)(rp2 + 128);
                    if (st == 3) { gb[(gi + 3) & 3][2] = *(const u32x4*)(rp2 + 1024); gb[(gi + 3) & 3][3] = *(const u32x4*)(rp2 + 128 + 1024); } }
                asm volatile("" ::: "memory");
#pragma unroll
                for (int bj = 0; bj < 2; ++bj) { f32x4 v0 = acc[ai][bj][m][0], v1 = acc[ai][bj][m][1];
                    const u32x4 g = gb[gi & 3][bj];
                    v0 *= (f32x4){bflo(g.x), bfhi(g.x), bflo(g.y), bfhi(g.y)}; v1 *= (f32x4){bflo(g.z), bfhi(g.z), bflo(g.w), bfhi(g.w)};
                    if (st == 3) { const u32x4 y = gb[gi & 3][2 + bj];
                        v0 += (f32x4){bflo(y.x), bfhi(y.x), bflo(y.y), bfhi(y.y)}; v1 += (f32x4){bflo(y.z), bfhi(y.z), bflo(y.w), bfhi(y.w)}; }
                    *(u32x4*)(rowp + bj * 128) = pack8(v0, v1); } }
        }
    }
};
constexpr int LDS_BYTES = 163840;
constexpr int LDS_MISC = 163840 - 1024;
#ifndef MK_ONE_LAUNCH
#define MK_ONE_LAUNCH 1
#endif
constexpr int N_STEPS = 1 + DEPTH * (1 + 4 * 4 + 2 + 3) + 1;

DI int fresh_tid(int wave) { int l_; asm volatile("v_mbcnt_lo_u32_b32 %0, -1, 0\n\tv_mbcnt_hi_u32_b32 %0, -1, %0" : "=v"(l_)); return wave * 64 + l_; }
__global__ void __launch_bounds__(512, 2) fwd_kernel(Args args) {
    extern __shared__ __attribute__((aligned(16))) unsigned char lds_raw[];
    const int wave0 = __builtin_amdgcn_readfirstlane((int)threadIdx.x >> 6);
#define tid0 fresh_tid(wave0)
    LAS unsigned char* lds0 = (LAS unsigned char*)lds_raw;
    if (tid0 < 4) ((volatile LAS unsigned*)(lds0 + LDS_MISC))[tid0] = 0u;
    __syncthreads();
    unsigned* ctl0 = (unsigned*)(args.ws + WS_CTL);
    XcdBarrier bar; bar.bar = ctl0 + CW_BAR; bar.x = 0; bar.st = nullptr;
    const int lo = args.step_lo, hi = args.step_hi;
    if (hi - lo > 1) bar = xcd_barrier_post(ctl0 + CW_BAR, (volatile LAS unsigned*)(lds0 + LDS_MISC));
    int step = 0; int l_probe = 0; unsigned long long probe_acc = 0;
#ifndef SITE_MASK
#define SITE_MASK 0xFFFFFFFFu
#endif
#ifndef REP_ML1
#define REP_ML1 1
#endif
#ifndef REP_AT
#define REP_AT 1
#endif
#ifndef DUP_MASK
#define DUP_MASK 0u
#endif
#ifndef DUP_L0
#define DUP_L0 0
#endif
#ifndef EXTRA_BARS
#define EXTRA_BARS 0
#endif
#ifndef PROBE_SITE
#define PROBE_SITE -1
#endif
#ifndef PROBE_AMP
#define PROBE_AMP 4
#endif
#define RUN(site, ...) do { if (step >= lo && step < hi) { unsigned long long pt0_ = 0; if constexpr (PROBE_SITE == (site)) pt0_ = wall_clock64(); if constexpr ((DUP_MASK >> (site)) & 1u) { if (!DUP_L0 || l_probe == 0) { Frame F; { int t_ = tid0; asm volatile("" : "+v"(t_)); frame_init(F, lds_raw, t_); } int* preL = (int*)(F.ldsg + LDS_MISC + 64); (void)preL; __VA_ARGS__; xcd_barrier(bar); } } if constexpr ((SITE_MASK >> (site)) & 1u) { Frame F; { int t_ = tid0; asm volatile("" : "+v"(t_)); frame_init(F, lds_raw, t_); } int* preL = (int*)(F.ldsg + LDS_MISC + 64); (void)preL; __VA_ARGS__; } if (step + 1 < hi) xcd_barrier(bar); if constexpr (PROBE_SITE == (site)) probe_acc += wall_clock64() - pt0_; } ++step; } while (0)

    RUN(0, { phase_p0_small(F); __syncthreads(); phase_pw(F, 0, 0, F.G, -1); });
    for (int l = 0; l < DEPTH; ++l) { l_probe = l;
        RUN(1, { if (l > 0) phase_pw(F, l, 0, F.G, 2); phase_n1(F, l); });
        for (int eg = 0; eg < 4; ++eg) {
                RUN(2, { SchedG1 S{(const char*)(F.U + (size_t)eg * TQ * 1024), (const char*)(F.W + W_NAT), (const char*)(F.W + W_VT), F.G, F.bid};
                      EpiG1 E{(bf16_t*)(F.R0 + R_P), (bf16_t*)(F.R0 + R_VT)};
                      pg8::gemm_run<EpiG1, SchedG1>(F.lds, S, E, F.tid); });
                RUN(4, {
                      if (F.bid < 128) ml1_unit(F, l, F.bid >> 5, F.bid & 31, eg);
                      else if (F.bid < 192) { SchedG1Def S{(const char*)(F.U + (size_t)eg * TQ * 1024), (const char*)(F.W + W_NAT), F.bid - 128}; EpiG1 E{(bf16_t*)(F.R0 + R_P), (bf16_t*)(F.R0 + R_VT)};
                          pg8::gemm_run<EpiG1, SchedG1Def>(F.lds, S, E, F.tid);
                          at_block_unit(F, F.bid - 128); at_block_unit(F, F.bid - 64); }
                      else { for (int q4 = 0; q4 < 4; ++q4) at_block_unit(F, 128 + (F.bid - 192) * 4 + q4); } });
                RUN(5, { phase_p2(F, F.bid, F.G); });
                RUN(6, { for (int u = F.bid; u < 256; u += F.G) f_hm_block(F, l, (u & 127) >> 5, u & 31, u >> 7, eg);
                      for (int t = F.bid * 8 + F.wave; t < TQ; t += F.G * 8) f_ha_token(F, t, eg); });
        }
        RUN(7, { SchedChain S{(const char*)F.U, (const char*)F.HA, (const char*)F.HM, (const char*)(F.W + W_G), (const char*)(F.W + W_A), (const char*)(F.W + W_M), F.G, F.bid};
              EpiChain E{(bf16_t*)(F.R0 + R_GT)}; pg8::gemm_run<EpiChain, SchedChain>(F.lds, S, E, F.tid); });
        RUN(10, { SchedDense S{(const char*)(F.R0 + R_GT), (const char*)(F.W + W_O), (unsigned)GTP * 2u, 2048u, 128, 4, F.G, F.bid, 1024};
              EpiG3 E{F.x, F.XB, F.MOD + (size_t)l * 4 * 6144 + 2048, (l == 0) ? 1 : 0};
              pg8::gemm_run<EpiG3, SchedDense>(F.lds, S, E, F.tid); });
        RUN(11, { phase_n2(F, l); });
        RUN(12, { moe_offsets(F.ctl + CW_CNT + 64 * l, preL, F.tid); __syncthreads();
              SchedMoe S{preL, F.ctl + CW_CNT + 64 * l, (const char*)F.U, (const char*)(F.W + W_13), (const int*)(F.R0 + R_SLOT), F.G, F.bid, true};
              EpiG4 E{(bf16_t*)(F.ws + WS_HH)}; pg8::gemm_run<EpiG4, SchedMoe, true>(F.lds, S, E, F.tid);
              if (l + 1 < DEPTH) { int ntail = preL[16] * 4 - 4 * F.G; ntail = ntail < 0 ? 0 : (ntail > F.G ? F.G : ntail); __syncthreads(); phase_pw(F, l + 1, ntail, F.G - ntail, 0); } });
        RUN(13, { moe_offsets(F.ctl + CW_CNT + 64 * l, preL, F.tid); __syncthreads();
              SchedMoe S{preL, F.ctl + CW_CNT + 64 * l, (const char*)(F.ws + WS_HH), (const char*)(F.W + W_2), (const int*)(F.R0 + R_SLOT), F.G, F.bid, false};
              EpiG5 E{(bf16_t*)(F.R0 + R_YS)}; pg8::gemm_run<EpiG5, SchedMoe>(F.lds, S, E, F.tid);
              if (l + 1 < DEPTH) { int ntail = preL[16] * 4 - 4 * F.G; ntail = ntail < 0 ? 0 : (ntail > F.G ? F.G : ntail); __syncthreads(); phase_pw(F, l + 1, ntail, F.G - ntail, 1); } });
    }
    for (int xb = 0; xb < EXTRA_BARS; ++xb) xcd_barrier(bar);
    RUN(14, { phase_fn(F); });
#undef RUN
#undef tid0
    if constexpr (PROBE_SITE >= 0) { if (blockIdx.x == 0 && fresh_tid(wave0) == 0) { const unsigned long long te = wall_clock64(); while (wall_clock64() - te < (unsigned long long)PROBE_AMP * probe_acc) __builtin_amdgcn_s_sleep(8); } }
}

extern "C" void kernel_launch(void* const* d_in, const int* in_sizes, int n_in, void* d_out, int out_size, void* d_ws, size_t ws_size, hipStream_t stream) {
    static int grid = 0;
    if (grid == 0) {
        if (n_in != 19 || out_size != T_TOK * DM || ws_size < WS_END) { fprintf(stderr, "kernel_launch: unexpected problem (n_in %d out %d ws %zu, need %zu)\n", n_in, out_size, ws_size, (size_t)WS_END); grid = -1; return; }
        int dev = 0, cus = 0, per_cu = 0;
        if (hipGetDevice(&dev) != hipSuccess || hipDeviceGetAttribute(&cus, hipDeviceAttributeMultiprocessorCount, dev) != hipSuccess) { grid = -1; return; }
        if (hipFuncSetAttribute((const void*)fwd_kernel, hipFuncAttributeMaxDynamicSharedMemorySize, LDS_BYTES) != hipSuccess) { fprintf(stderr, "kernel_launch: hipFuncSetAttribute failed\n"); grid = -1; return; }
        if (hipOccupancyMaxActiveBlocksPerMultiprocessor(&per_cu, (const void*)fwd_kernel, 512, LDS_BYTES) != hipSuccess || per_cu < 1) { fprintf(stderr, "kernel_launch: occupancy query says %d blocks per CU\n", per_cu); per_cu = 1; }
        (void)hipGetLastError();
        if (cus < 256) { fprintf(stderr, "kernel_launch: this kernel's phase program is written for 256 workgroups (one per CU of a 256-CU device); found %d CUs\n", cus); grid = -1; return; }
        grid = 256;
    }
    if (grid <= 0) return;
    (void)hipMemsetAsync((char*)d_ws + WS_CTL, 0, CTL_BYTES, stream);
    Args a{};
    for (int i = 0; i < 19; ++i) a.in[i] = (const float*)d_in[i];
    a.out = (float*)d_out; a.ws = (unsigned char*)d_ws;
#if MK_ONE_LAUNCH
    a.step_lo = 0; a.step_hi = N_STEPS;
    hipLaunchKernelGGL(fwd_kernel, dim3(grid), dim3(512), LDS_BYTES, stream, a);
#else
    for (int s = 0; s < N_STEPS; ++s) { a.step_lo = s; a.step_hi = s + 1; hipLaunchKernelGGL(fwd_kernel, dim3(grid), dim3(512), LDS_BYTES, stream, a); }
#endif
}
```
